# Optimizing an MI355X kernel written in HIP

```python
import math
import jax
import jax.numpy as jnp
from jax import lax
import numpy as np

D_MODEL = 1024
BATCH = 2
SEQ = 8192
DEPTH = 2

HEAD_DIM = 64
Q_BLOCK = 128
EPS = 1e-6
NEG = -1e30

NUM_BUCKETS = 32
MAX_DISTANCE = 128
BIAS_HEADS = 16

NSA_HEADS = 8
NSA_KV_HEADS = 2
NSA_GROUP = NSA_HEADS // NSA_KV_HEADS
CMP_BLOCK = 32
CMP_STRIDE = 16
CMP_HIDDEN = 128
SEL_BLOCK = 64
SEL_TOPN = 16
WINDOW = 512
FORCE_BONUS = 1e3

DIFF_HEADS = 4
DIFF_VDIM = 2 * HEAD_DIM

MOBA_HEADS = 16
MOBA_BLOCK = 256
MOBA_TOPK = 3
MOBA_QCHUNK = 32

D_FF = 4 * D_MODEL

NSA_Q = NSA_HEADS * HEAD_DIM
NSA_KV = NSA_KV_HEADS * HEAD_DIM
NSA_GATES = 3 * NSA_HEADS
DIFF_QK = DIFF_HEADS * 2 * HEAD_DIM
DIFF_V = DIFF_HEADS * DIFF_VDIM
D_MIX = NSA_Q + DIFF_V
EVEN_SIZES = (NSA_Q,) + (NSA_KV,) * 6 + (NSA_GATES, DIFF_QK, DIFF_QK, DIFF_V)
EVEN_PROJ = sum(EVEN_SIZES)
ODD_PROJ = 3 * MOBA_HEADS * HEAD_DIM
ODD_MIX = MOBA_HEADS * HEAD_DIM

kernel_name = 'hybrid_nsa_diff_moba_trunk'


def rms_norm(x, g):
    xf = x.astype(jnp.float32)
    y = xf * lax.rsqrt(jnp.mean(xf * xf, axis=-1, keepdims=True) + EPS)
    return (y * g.astype(jnp.float32)).astype(x.dtype)


def t5_bucket(rel):
    n = jnp.maximum(rel, 0)
    max_exact = NUM_BUCKETS // 2
    large = max_exact + (jnp.log(jnp.maximum(n, 1).astype(jnp.float32) / max_exact)
                         / math.log(MAX_DISTANCE / max_exact)
                         * (NUM_BUCKETS - max_exact)).astype(jnp.int32)
    large = jnp.minimum(large, NUM_BUCKETS - 1)
    return jnp.where(n < max_exact, n, large)


def masked_softmax(logits, mask):
    l = jnp.where(mask, logits.astype(jnp.float32), NEG)
    m = jnp.max(l, axis=-1, keepdims=True)
    p = jnp.where(mask, jnp.exp(l - m), 0.0)
    return p / jnp.maximum(jnp.sum(p, axis=-1, keepdims=True), 1e-30)


def to_heads(t, n):
    b, s, _ = t.shape
    return t.reshape(b, s, n, -1).transpose(0, 2, 1, 3)


def compress_kv(kv, pos, w1, w2):
    b, g, s, d = kv.shape
    nc = (s - CMP_BLOCK) // CMP_STRIDE + 1
    tok = jnp.arange(nc)[:, None] * CMP_STRIDE + jnp.arange(CMP_BLOCK)[None, :]
    blk = kv[:, :, tok] + pos
    hid = jax.nn.gelu(blk.reshape(b, g, nc, CMP_BLOCK * d) @ w1)
    return hid @ w2


def nsa_attention(q, kc, vc, ks, vs, kw, vw, gates, tbl_h):
    b, g, r, s, d = q.shape
    nc = kc.shape[2]
    ns = s // SEL_BLOCK
    n_sel = min(SEL_TOPN, ns)
    scale = d ** -0.5
    tbl_gr = tbl_h.reshape(g, r, NUM_BUCKETS)
    cmp_end = jnp.arange(nc) * CMP_STRIDE + CMP_BLOCK - 1
    tok = jnp.arange(nc)[:, None] * CMP_STRIDE + jnp.arange(CMP_BLOCK)[None, :]
    overlap = jax.nn.one_hot(tok // SEL_BLOCK, ns, dtype=jnp.float32).sum(axis=1) / CMP_BLOCK
    ks_blk = ks.reshape(b, g, ns, SEL_BLOCK, d)
    vs_blk = vs.reshape(b, g, ns, SEL_BLOCK, d)
    kw_pad = jnp.pad(kw, ((0, 0), (0, 0), (WINDOW, 0), (0, 0)))
    vw_pad = jnp.pad(vw, ((0, 0), (0, 0), (WINDOW, 0), (0, 0)))
    span = WINDOW + Q_BLOCK
    bi = jnp.arange(b)[:, None, None, None]
    gi = jnp.arange(g)[None, :, None, None]
    gi6 = jnp.arange(g)[None, :, None, None, None, None]
    ri6 = jnp.arange(r)[None, None, :, None, None, None]
    blk_ids = jnp.arange(ns)

    def block(j):
        q0 = j * Q_BLOCK
        t = q0 + jnp.arange(Q_BLOCK)
        qb = lax.dynamic_slice_in_dim(q, q0, Q_BLOCK, axis=3)
        gb = lax.dynamic_slice_in_dim(gates, q0, Q_BLOCK, axis=4)
        rel_c = t[:, None] - cmp_end[None, :]
        lc = jnp.einsum('bgrqd,bgcd->bgrqc', qb, kc) * scale + tbl_gr[:, :, t5_bucket(rel_c)]
        pc = masked_softmax(lc, rel_c >= 0)
        oc = jnp.einsum('bgrqc,bgcd->bgrqd', pc.astype(vc.dtype), vc)
        imp = jnp.einsum('bgrqc,cn->bgqn', pc, overlap)
        cur = t // SEL_BLOCK
        eligible = blk_ids[None, :] <= cur[:, None]
        forced = ((blk_ids[None, :] == 0) | (blk_ids[None, :] == cur[:, None])
                  | (blk_ids[None, :] == cur[:, None] - 1))
        score = jnp.where(eligible, imp + jnp.where(forced, FORCE_BONUS, 0.0), -1.0)
        _, sel = lax.top_k(score, n_sel)
        k_sel = ks_blk[bi, gi, sel]
        v_sel = vs_blk[bi, gi, sel]
        pos_s = sel[..., None] * SEL_BLOCK + jnp.arange(SEL_BLOCK)
        rel_s = t[None, None, :, None, None] - pos_s
        bias_s = tbl_gr[gi6, ri6, t5_bucket(rel_s)[:, :, None]]
        ls = jnp.einsum('bgrqd,bgqnkd->bgrqnk', qb, k_sel) * scale + bias_s
        ms = jnp.broadcast_to((rel_s >= 0)[:, :, None], ls.shape)
        ps = masked_softmax(ls.reshape(b, g, r, Q_BLOCK, -1),
                            ms.reshape(b, g, r, Q_BLOCK, -1)).reshape(ls.shape)
        o_s = jnp.einsum('bgrqnk,bgqnkd->bgrqd', ps.astype(v_sel.dtype), v_sel)
        kwb = lax.dynamic_slice_in_dim(kw_pad, q0, span, axis=2)
        vwb = lax.dynamic_slice_in_dim(vw_pad, q0, span, axis=2)
        pos_w = q0 - WINDOW + jnp.arange(span)
        rel_w = t[:, None] - pos_w[None, :]
        mask_w = (rel_w >= 0) & (rel_w < WINDOW) & (pos_w[None, :] >= 0)
        lw = jnp.einsum('bgrqd,bgkd->bgrqk', qb, kwb) * scale + tbl_gr[:, :, t5_bucket(rel_w)]
        pw = masked_softmax(lw, mask_w)
        ow = jnp.einsum('bgrqk,bgkd->bgrqd', pw.astype(vwb.dtype), vwb)
        return (gb[:, 0][..., None] * oc + gb[:, 1][..., None] * o_s
                + gb[:, 2][..., None] * ow)

    out = lax.map(block, jnp.arange(s // Q_BLOCK))
    return out.transpose(1, 0, 4, 2, 3, 5).reshape(b, s, g * r * d)


def diff_attention(q, k, v, lam, lam_init, subln_g, tbl_h):
    b, s = q.shape[:2]
    q = q.transpose(0, 3, 2, 1, 4)
    k = k.transpose(0, 3, 2, 1, 4)
    v = v.transpose(0, 2, 1, 3)
    kpos = jnp.arange(s)
    scale = HEAD_DIM ** -0.5

    def block(j):
        q0 = j * Q_BLOCK
        t = q0 + jnp.arange(Q_BLOCK)
        qb = lax.dynamic_slice_in_dim(q, q0, Q_BLOCK, axis=3)
        rel = t[:, None] - kpos[None, :]
        logits = jnp.einsum('bmhqd,bmhkd->bmhqk', qb, k) * scale + tbl_h[:, t5_bucket(rel)]
        p = masked_softmax(logits, rel >= 0)
        a = p[:, 0] - lam * p[:, 1]
        return jnp.einsum('bhqk,bhkv->bhqv', a.astype(v.dtype), v)

    out = lax.map(block, jnp.arange(s // Q_BLOCK))
    out = out.transpose(1, 0, 3, 2, 4).reshape(b, s, DIFF_HEADS, DIFF_VDIM)
    out = rms_norm(out, subln_g) * (1.0 - lam_init)
    return out.reshape(b, s, DIFF_HEADS * DIFF_VDIM)


def moba_attention(q, k, v, tbl_h):
    b, h, s, d = q.shape
    nb = -(-s // MOBA_BLOCK)
    pad = nb * MOBA_BLOCK - s
    k_pad = jnp.pad(k, ((0, 0), (0, 0), (0, pad), (0, 0)))
    v_pad = jnp.pad(v, ((0, 0), (0, 0), (0, pad), (0, 0)))
    kb = k_pad.reshape(b, h, nb, MOBA_BLOCK, d)
    vb = v_pad.reshape(b, h, nb, MOBA_BLOCK, d)
    k_mean = jnp.mean(kb.astype(jnp.float32), axis=3).astype(k.dtype)
    n_sel = min(MOBA_TOPK, nb)
    scale = d ** -0.5
    bi = jnp.arange(b)[:, None, None, None]
    hi = jnp.arange(h)[None, :, None, None]
    hi5 = jnp.arange(h)[None, :, None, None, None]
    blk_ids = jnp.arange(nb)

    def block(j):
        q0 = j * MOBA_QCHUNK
        t = q0 + jnp.arange(MOBA_QCHUNK)
        c = q0 // MOBA_BLOCK
        qb = lax.dynamic_slice_in_dim(q, q0, MOBA_QCHUNK, axis=2)
        gate = jnp.einsum('bhqd,bhnd->bhqn', qb, k_mean).astype(jnp.float32)
        past = blk_ids < c
        _, sel = lax.top_k(jnp.where(past, gate, NEG), n_sel)
        valid = sel < c
        k_sel = kb[bi, hi, sel]
        v_sel = vb[bi, hi, sel]
        pos_s = sel[..., None] * MOBA_BLOCK + jnp.arange(MOBA_BLOCK)
        bias_s = tbl_h[hi5, t5_bucket(t[None, None, :, None, None] - pos_s)]
        ls = jnp.einsum('bhqd,bhqnkd->bhqnk', qb, k_sel) * scale + bias_s
        ms = jnp.broadcast_to(valid[..., None], ls.shape)
        k_own = lax.dynamic_slice_in_dim(k_pad, c * MOBA_BLOCK, MOBA_BLOCK, axis=2)
        v_own = lax.dynamic_slice_in_dim(v_pad, c * MOBA_BLOCK, MOBA_BLOCK, axis=2)
        rel_o = t[:, None] - (c * MOBA_BLOCK + jnp.arange(MOBA_BLOCK))[None, :]
        lo = jnp.einsum('bhqd,bhkd->bhqk', qb, k_own) * scale + tbl_h[:, t5_bucket(rel_o)]
        mo = jnp.broadcast_to(rel_o >= 0, lo.shape)
        n_g = n_sel * MOBA_BLOCK
        logits = jnp.concatenate([ls.reshape(b, h, MOBA_QCHUNK, n_g), lo], axis=-1)
        mask = jnp.concatenate([ms.reshape(b, h, MOBA_QCHUNK, n_g), mo], axis=-1)
        p = masked_softmax(logits, mask)
        ps = p[..., :n_g].reshape(ls.shape).astype(v.dtype)
        po = p[..., n_g:].astype(v.dtype)
        return (jnp.einsum('bhqnk,bhqnkd->bhqd', ps, v_sel)
                + jnp.einsum('bhqk,bhkd->bhqd', po, v_own))

    out = lax.map(block, jnp.arange(s // MOBA_QCHUNK))
    return out.transpose(1, 0, 3, 2, 4).reshape(b, s, h * d)


def even_mixer(hn, w_in, w_out, pos_k, w1_k, w2_k, pos_v, w1_v, w2_v,
               lam_q1, lam_k1, lam_q2, lam_k2, subln_g, bias_table, lam_init):
    b, s, _ = hn.shape
    parts = jnp.split(hn @ w_in, np.cumsum(EVEN_SIZES)[:-1].tolist(), axis=-1)
    q, kc, vc, ks, vs, kw, vw, g, dq, dk, dv = parts
    qn = to_heads(q, NSA_HEADS).reshape(b, NSA_KV_HEADS, NSA_GROUP, s, HEAD_DIM)
    kc = compress_kv(to_heads(kc, NSA_KV_HEADS), pos_k, w1_k, w2_k)
    vc = compress_kv(to_heads(vc, NSA_KV_HEADS), pos_v, w1_v, w2_v)
    gates = jax.nn.sigmoid(g.astype(jnp.float32)).astype(hn.dtype)
    gates = gates.reshape(b, s, 3, NSA_KV_HEADS, NSA_GROUP).transpose(0, 2, 3, 4, 1)
    o_a = nsa_attention(qn, kc, vc, to_heads(ks, NSA_KV_HEADS), to_heads(vs, NSA_KV_HEADS),
                        to_heads(kw, NSA_KV_HEADS), to_heads(vw, NSA_KV_HEADS), gates,
                        bias_table[:, :NSA_HEADS].T)
    lam = (jnp.exp(jnp.sum((lam_q1 * lam_k1).astype(jnp.float32)))
           - jnp.exp(jnp.sum((lam_q2 * lam_k2).astype(jnp.float32))) + lam_init)
    o_b = diff_attention(dq.reshape(b, s, DIFF_HEADS, 2, HEAD_DIM),
                         dk.reshape(b, s, DIFF_HEADS, 2, HEAD_DIM),
                         dv.reshape(b, s, DIFF_HEADS, DIFF_VDIM), lam, lam_init, subln_g,
                         bias_table[:, NSA_HEADS:NSA_HEADS + DIFF_HEADS].T)
    return jnp.concatenate([o_a, o_b], axis=-1) @ w_out


def odd_mixer(hn, w_in, w_out, bias_table):
    q, k, v = jnp.split(hn @ w_in, 3, axis=-1)
    o = moba_attention(to_heads(q, MOBA_HEADS), to_heads(k, MOBA_HEADS),
                       to_heads(v, MOBA_HEADS), bias_table[:, :MOBA_HEADS].T)
    return o @ w_out


def sqrelu_mlp(hn, w1, w2):
    return jnp.square(jax.nn.relu(hn @ w1)) @ w2


def setup_inputs(seed: int = 0) -> dict:
    key = jax.random.key(seed)
    k = jax.random.split(key, 22)
    ne = (DEPTH + 1) // 2
    no = DEPTH // 2
    f32 = jnp.float32

    def nrm(i, shape, scale):
        return jax.random.normal(k[i], shape, f32) * scale

    return {
        'x': nrm(0, (BATCH, SEQ, D_MODEL), 1.0),
        'bias_table': nrm(1, (NUM_BUCKETS, BIAS_HEADS), 0.5),
        'norm_mix': 1.0 + nrm(2, (DEPTH, D_MODEL), 0.1),
        'norm_mlp': 1.0 + nrm(3, (DEPTH, D_MODEL), 0.1),
        'norm_final': 1.0 + nrm(4, (D_MODEL,), 0.1),
        'mlp_w1': nrm(5, (DEPTH, D_MODEL, D_FF), D_MODEL ** -0.5),
        'mlp_w2': nrm(6, (DEPTH, D_FF, D_MODEL), D_FF ** -0.5),
        'ev_w_in': nrm(7, (ne, D_MODEL, EVEN_PROJ), D_MODEL ** -0.5),
        'ev_w_out': nrm(8, (ne, D_MIX, D_MODEL), D_MIX ** -0.5),
        'ev_cmp_pos_k': nrm(9, (ne, CMP_BLOCK, HEAD_DIM), 0.1),
        'ev_cmp_w1_k': nrm(10, (ne, CMP_BLOCK * HEAD_DIM, CMP_HIDDEN), (CMP_BLOCK * HEAD_DIM) ** -0.5),
        'ev_cmp_w2_k': nrm(11, (ne, CMP_HIDDEN, HEAD_DIM), CMP_HIDDEN ** -0.5),
        'ev_cmp_pos_v': nrm(12, (ne, CMP_BLOCK, HEAD_DIM), 0.1),
        'ev_cmp_w1_v': nrm(13, (ne, CMP_BLOCK * HEAD_DIM, CMP_HIDDEN), (CMP_BLOCK * HEAD_DIM) ** -0.5),
        'ev_cmp_w2_v': nrm(14, (ne, CMP_HIDDEN, HEAD_DIM), CMP_HIDDEN ** -0.5),
        'ev_lam_q1': nrm(15, (ne, HEAD_DIM), 0.1),
        'ev_lam_k1': nrm(16, (ne, HEAD_DIM), 0.1),
        'ev_lam_q2': nrm(17, (ne, HEAD_DIM), 0.1),
        'ev_lam_k2': nrm(18, (ne, HEAD_DIM), 0.1),
        'ev_subln': 1.0 + nrm(19, (ne, DIFF_VDIM), 0.1),
        'od_w_in': nrm(20, (no, D_MODEL, ODD_PROJ), D_MODEL ** -0.5),
        'od_w_out': nrm(21, (no, ODD_MIX, D_MODEL), ODD_MIX ** -0.5),
    }


def reference(x, bias_table, norm_mix, norm_mlp, norm_final, mlp_w1, mlp_w2,
              ev_w_in, ev_w_out, ev_cmp_pos_k, ev_cmp_w1_k, ev_cmp_w2_k,
              ev_cmp_pos_v, ev_cmp_w1_v, ev_cmp_w2_v, ev_lam_q1, ev_lam_k1,
              ev_lam_q2, ev_lam_k2, ev_subln, od_w_in, od_w_out):
    for i in range(DEPTH):
        hn = rms_norm(x, norm_mix[i])
        if i % 2 == 0:
            e = i // 2
            lam_init = 0.8 - 0.6 * math.exp(-0.3 * i)
            mix = even_mixer(hn, ev_w_in[e], ev_w_out[e], ev_cmp_pos_k[e], ev_cmp_w1_k[e],
                             ev_cmp_w2_k[e], ev_cmp_pos_v[e], ev_cmp_w1_v[e], ev_cmp_w2_v[e],
                             ev_lam_q1[e], ev_lam_k1[e], ev_lam_q2[e], ev_lam_k2[e],
                             ev_subln[e], bias_table, lam_init)
        else:
            o = i // 2
            mix = odd_mixer(hn, od_w_in[o], od_w_out[o], bias_table)
        x = x + mix
        x = x + sqrelu_mlp(rms_norm(x, norm_mlp[i]), mlp_w1[i], mlp_w2[i])
    return rms_norm(x, norm_final)
```

```cpp
#include <hip/hip_runtime.h>
#include <cstdint>
#include <cstdio>

typedef unsigned short bf16;
typedef unsigned v4u __attribute__((ext_vector_type(4)));
typedef float f32x4 __attribute__((ext_vector_type(4)));

constexpr int BATCH = 2, SEQ = 8192, DM = 1024, M = BATCH * SEQ, FF = 4096;
constexpr int NP0 = 2816, NP1 = 3072, EVEN_PROJ = 2840;
constexpr float EPS = 1e-6f;
constexpr float LOG2E = 1.4426950408889634f, C2 = 0.125f * LOG2E;
constexpr int C_Q = 0, C_KC = 512, C_VC = 640, C_KS = 768, C_VS = 896, C_KW = 1024, C_VW = 1152, C_DQ = 1280, C_DK = 1792, C_DV = 2304;
constexpr int NCMP = 511;

constexpr size_t MiB = 1u << 20;
constexpr size_t WS_CTL = 0;
constexpr size_t WS_SSA = 1 * MiB, WS_SSB = 2 * MiB;
constexpr size_t WS_GATES = 3 * MiB;
constexpr size_t WS_KCMP = 4 * MiB + 512 * 1024, WS_VCMP = WS_KCMP + 256 * 1024;
constexpr size_t WS_CMPB = 5 * MiB;
constexpr size_t WS_BIASL = 5 * MiB + 4096;
constexpr size_t WS_KMEAN = 5 * MiB + 256 * 1024;
constexpr size_t WS_WIN0 = 8 * MiB, WS_WOUT0 = 14 * MiB, WS_W1_0 = 16 * MiB, WS_W2_0 = 24 * MiB;
constexpr size_t WS_WIN1 = 32 * MiB, WS_WOUT1 = 38 * MiB, WS_W1_1 = 40 * MiB, WS_W2_1 = 48 * MiB;
constexpr size_t WS_CW1K = 56 * MiB, WS_CW1V = 56 * MiB + 512 * 1024, WS_CW2K = 57 * MiB, WS_CW2V = 57 * MiB + 64 * 1024;
constexpr size_t WS_XB = 58 * MiB, WS_OC = 90 * MiB, WS_H = 122 * MiB, WS_PROJ = 122 * MiB, WS_END = 250 * MiB;

__device__ __forceinline__ unsigned f2bf(float f) { unsigned u = __builtin_bit_cast(unsigned, f); return (u + 0x7fffu + ((u >> 16) & 1u)) >> 16; }
__device__ __forceinline__ float bf2f(unsigned h) { return __builtin_bit_cast(float, h << 16); }
__device__ __forceinline__ unsigned pk2(float lo, float hi) { return f2bf(lo) | (f2bf(hi) << 16); }
__device__ __forceinline__ float wave_sum(float v) {
#pragma unroll
    for (int o = 1; o < 64; o <<= 1) v += __shfl_xor(v, o);
    return v;
}
__device__ __forceinline__ float wave_max(float v) {
#pragma unroll
    for (int o = 1; o < 64; o <<= 1) v = fmaxf(v, __shfl_xor(v, o));
    return v;
}
__device__ __forceinline__ float rstd_of(const float* SS, int row) {
    const f32x4* p = (const f32x4*)(SS + (size_t)row * 16);
    f32x4 a = p[0], b = p[1], c = p[2], d = p[3];
    float s = ((a.x + a.y) + (a.z + a.w)) + ((b.x + b.y) + (b.z + b.w)) + ((c.x + c.y) + (c.z + c.w)) + ((d.x + d.y) + (d.z + d.w));
    return 1.0f / sqrtf(s * (1.0f / DM) + EPS);
}
__device__ __forceinline__ int t5_bucket(int rel) {
    int n = rel < 0 ? 0 : rel;
    if (n < 16) return n;
    int large = 16 + (int)(logf((float)n / 16.0f) / logf(8.0f) * 16.0f);
    return large < 31 ? large : 31;
}

struct WJob { const float* W; bf16* WT; const float* kscale; int K, Nsrc, Ndst, kind; };
struct WJobs { WJob j[12]; int n; int pad; };
__device__ __forceinline__ void transpose_item(const WJob& J, int item, float* scr, int lane) {
    const int nblk = J.Ndst / 32, kb = item / nblk, nb = item % nblk, k0 = 64 * kb, n0 = 32 * nb;
    int s0 = n0; float cs = 1.0f;
    if (J.kind == 1) { s0 = n0 < 1280 ? n0 : n0 + 24; if (n0 < 512 || (n0 >= C_DQ && n0 < C_DK)) cs = C2; }
    if (J.kind == 2) { if (n0 < 1024) cs = C2; }
#pragma unroll 8
    for (int i = 0; i < 32; ++i) { const int kk = 2 * i + (lane >> 5); scr[kk * 33 + (lane & 31)] = J.W[(size_t)(k0 + kk) * J.Nsrc + s0 + (lane & 31)]; }
    __builtin_amdgcn_s_waitcnt(0xC07F); asm volatile("" ::: "memory");
    const int c = lane & 7;
    float ks[8];
#pragma unroll
    for (int i = 0; i < 8; ++i) ks[i] = (J.kscale ? J.kscale[k0 + 8 * c + i] : 1.0f) * cs;
#pragma unroll
    for (int j = 0; j < 4; ++j) { const int n = (lane >> 3) + 8 * j; const float* s = scr + (8 * c) * 33 + n;
        v4u o; o.x = pk2(s[0 * 33] * ks[0], s[1 * 33] * ks[1]); o.y = pk2(s[2 * 33] * ks[2], s[3 * 33] * ks[3]); o.z = pk2(s[4 * 33] * ks[4], s[5 * 33] * ks[5]); o.w = pk2(s[6 * 33] * ks[6], s[7 * 33] * ks[7]);
        *(v4u*)(J.WT + (size_t)(n0 + n) * J.K + k0 + 8 * c) = o; }
    __builtin_amdgcn_s_waitcnt(0xC07F); asm volatile("" ::: "memory");
}
__global__ void __launch_bounds__(512) k_prep_weights(WJobs jobs) {
    __shared__ float scr_all[8 * 64 * 33];
    const int lane = threadIdx.x & 63, wave = threadIdx.x >> 6;
    float* scr = scr_all + wave * 64 * 33;
    const int gw = blockIdx.x * 8 + wave, NGW = gridDim.x * 8;
    int base = 0;
    for (int m = 0; m < jobs.n; ++m) {
        const WJob& J = jobs.j[m];
        const int nit = (J.K / 64) * (J.Ndst / 32);
        int first = ((gw - base) % NGW + NGW) % NGW;
        for (int it = first; it < nit; it += NGW) transpose_item(J, it, scr, lane);
        base += nit;
    }
}

__global__ void __launch_bounds__(512) k_prep_misc(const float* bias_table, const float* pos_k, const float* w1_k, const float* pos_v, const float* w1_v, float* BIASL, float* CMPB) {
    const int t = threadIdx.x;
    if (blockIdx.x == 0) {
        for (int i = t; i < 16 * 128; i += 512) { const int h = i >> 7, rel = i & 127; BIASL[i] = bias_table[t5_bucket(rel) * 16 + h] * LOG2E; }
    } else {
        const float* pos = blockIdx.x == 1 ? pos_k : pos_v; const float* w1 = blockIdx.x == 1 ? w1_k : w1_v;
        __shared__ float part[4][128];
        const int n = t & 127, pr = t >> 7;
        float s = 0.f;
        for (int kk = pr * 512; kk < pr * 512 + 512; ++kk) s += pos[kk] * w1[(size_t)kk * 128 + n];
        part[pr][n] = s; __syncthreads();
        if (t < 128) CMPB[(blockIdx.x - 1) * 128 + t] = (part[0][t] + part[1][t]) + (part[2][t] + part[3][t]);
    }
}

constexpr int WG_PITCH = 1028;
__global__ void __launch_bounds__(512) k_prep_rows(const float* x, const float* norm_mix0, const float* w_in0, bf16* XB, float* SS, float* GATES) {
    extern __shared__ __attribute__((aligned(16))) float wg[];
    const int t = threadIdx.x, lane = t & 63, wave = t >> 6;
    for (int idx = t; idx < 24 * 1024; idx += 512) { const int k = idx / 24, j = idx % 24; wg[j * WG_PITCH + k] = w_in0[(size_t)k * EVEN_PROJ + 1280 + j] * norm_mix0[k]; }
    __syncthreads();
    for (int row = blockIdx.x * 8 + wave; row < M; row += gridDim.x * 8) {
        const f32x4* xr = (const f32x4*)(x + (size_t)row * DM) + lane;
        f32x4 v[4]; float s = 0.f;
#pragma unroll
        for (int j = 0; j < 4; ++j) { v[j] = xr[64 * j]; s += (v[j].x * v[j].x + v[j].y * v[j].y) + (v[j].z * v[j].z + v[j].w * v[j].w); }
        s = wave_sum(s);
        const float rstd = 1.0f / sqrtf(s * (1.0f / DM) + EPS);
        unsigned long long* o8 = (unsigned long long*)(XB + (size_t)row * DM) + lane;
#pragma unroll
        for (int j = 0; j < 4; ++j) o8[64 * j] = (unsigned long long)pk2(v[j].x, v[j].y) | ((unsigned long long)pk2(v[j].z, v[j].w) << 32);
        if (lane < 16) SS[(size_t)row * 16 + lane] = lane == 0 ? s : 0.f;
        float gsum = 0.f;
#pragma unroll 1
        for (int g = 0; g < 24; ++g) {
            float p = 0.f;
#pragma unroll
            for (int j = 0; j < 4; ++j) { const f32x4 w = *(const f32x4*)(wg + g * WG_PITCH + 256 * j + 4 * lane); p += (v[j].x * w.x + v[j].y * w.y) + (v[j].z * w.z + v[j].w * w.w); }
            p = wave_sum(p);
            if (lane == g) gsum = p;
        }
        if (lane < 24) GATES[(size_t)row * 24 + lane] = 1.0f / (1.0f + expf(-gsum * rstd));
    }
}

struct NEpiProj { bf16* out; const float* SS; int ldc; int pad;
    __device__ __forceinline__ void operator()(int row, int col, float acc, float rs) const { out[(size_t)row * ldc + col] = (bf16)f2bf(acc * rs); }
    __device__ __forceinline__ float rowscale(int row) const { return rstd_of(SS, row); } };
struct NEpiRes { const float* xin; float* xout; bf16* xb;
    __device__ __forceinline__ void operator()(int row, int col, float acc, float) const { const float v = xin[(size_t)row * DM + col] + acc; xout[(size_t)row * DM + col] = v; xb[(size_t)row * DM + col] = (bf16)f2bf(v); }
    __device__ __forceinline__ float rowscale(int) const { return 1.f; } };
struct NEpiMlp1 { bf16* H; const float* SS;
    __device__ __forceinline__ void operator()(int row, int col, float acc, float rs) const { float v = acc * rs; v = v > 0.f ? v : 0.f; H[(size_t)row * FF + col] = (bf16)f2bf(v * v); }
    __device__ __forceinline__ float rowscale(int row) const { return rstd_of(SS, row); } };

template <class Epi>
__global__ void __launch_bounds__(256) k_ngemm(const bf16* A, const bf16* Bt, int N, int K, Epi E) {
    __shared__ float As[32][65], Bs[32][65];
    const int t = threadIdx.x, tx = t & 15, ty = t >> 4;
    const int m0 = blockIdx.y * 64, n0 = blockIdx.x * 64;
    const int lr = t >> 2, lk = (t & 3) * 8;
    float acc[4][4] = {};
    for (int k0 = 0; k0 < K; k0 += 32) {
        const v4u a = *(const v4u*)(A + (size_t)(m0 + lr) * K + k0 + lk);
        const v4u b = *(const v4u*)(Bt + (size_t)(n0 + lr) * K + k0 + lk);
        __syncthreads();
        As[lk + 0][lr] = bf2f(a.x & 0xffff); As[lk + 1][lr] = bf2f(a.x >> 16); As[lk + 2][lr] = bf2f(a.y & 0xffff); As[lk + 3][lr] = bf2f(a.y >> 16);
        As[lk + 4][lr] = bf2f(a.z & 0xffff); As[lk + 5][lr] = bf2f(a.z >> 16); As[lk + 6][lr] = bf2f(a.w & 0xffff); As[lk + 7][lr] = bf2f(a.w >> 16);
        Bs[lk + 0][lr] = bf2f(b.x & 0xffff); Bs[lk + 1][lr] = bf2f(b.x >> 16); Bs[lk + 2][lr] = bf2f(b.y & 0xffff); Bs[lk + 3][lr] = bf2f(b.y >> 16);
        Bs[lk + 4][lr] = bf2f(b.z & 0xffff); Bs[lk + 5][lr] = bf2f(b.z >> 16); Bs[lk + 6][lr] = bf2f(b.w & 0xffff); Bs[lk + 7][lr] = bf2f(b.w >> 16);
        __syncthreads();
#pragma unroll
        for (int k = 0; k < 32; ++k) {
            float av[4], bv[4];
#pragma unroll
            for (int i = 0; i < 4; ++i) { av[i] = As[k][ty * 4 + i]; bv[i] = Bs[k][tx * 4 + i]; }
#pragma unroll
            for (int i = 0; i < 4; ++i)
#pragma unroll
                for (int j = 0; j < 4; ++j) acc[i][j] += av[i] * bv[j];
        }
    }
#pragma unroll
    for (int i = 0; i < 4; ++i) { const int row = m0 + ty * 4 + i; const float rs = E.rowscale(row);
#pragma unroll
        for (int j = 0; j < 4; ++j) E(row, n0 + tx * 4 + j, acc[i][j], rs); }
}

__global__ void __launch_bounds__(256) k_rowstats(const float* x, float* SS) {
    const int lane = threadIdx.x & 63, wave = threadIdx.x >> 6;
    const int row = blockIdx.x * 4 + wave;
    const f32x4* xr = (const f32x4*)(x + (size_t)row * DM) + lane; float s = 0.f;
#pragma unroll
    for (int j = 0; j < 4; ++j) { const f32x4 v = xr[64 * j]; s += (v.x * v.x + v.y * v.y) + (v.z * v.z + v.w * v.w); }
    s = wave_sum(s);
    if (lane < 16) SS[(size_t)row * 16 + lane] = lane == 0 ? s : 0.f;
}
__global__ void __launch_bounds__(256) k_final_norm(float* x, const float* g) {
    const int lane = threadIdx.x & 63, wave = threadIdx.x >> 6;
    const int row = blockIdx.x * 4 + wave;
    f32x4* xr = (f32x4*)(x + (size_t)row * DM) + lane; const f32x4* gr = (const f32x4*)g + lane; f32x4 v[4]; float s = 0.f;
#pragma unroll
    for (int j = 0; j < 4; ++j) { v[j] = xr[64 * j]; s += (v[j].x * v[j].x + v[j].y * v[j].y) + (v[j].z * v[j].z + v[j].w * v[j].w); }
    s = wave_sum(s); const float rstd = 1.0f / sqrtf(s * (1.0f / DM) + EPS);
#pragma unroll
    for (int j = 0; j < 4; ++j) { const f32x4 gg = gr[64 * j]; xr[64 * j] = v[j] * rstd * gg; }
}

__device__ __forceinline__ float gelu_tanh(float x) { const float u = 0.7978845608028654f * (x + 0.044715f * x * x * x); return 0.5f * x * (1.0f + tanhf(u)); }
__global__ void __launch_bounds__(128) k_ncompress(const bf16* PROJ, const bf16* CW1K, const bf16* CW1V, const bf16* CW2K, const bf16* CW2V, const float* CMPB, bf16* KCMP, bf16* VCMP) {
    __shared__ float a[2048]; __shared__ float hid[128];
    const int t = threadIdx.x; int id = blockIdx.x; const int c = id % 512; id /= 512; const int g = id % 2; id /= 2; const int b = id % 2; const int kv = id / 2;
    bf16* outp = (kv ? VCMP : KCMP) + ((size_t)((b * 2 + g) * 512 + c)) * 64;
    if (c >= NCMP) { if (t < 64) outp[t] = 0; return; }
    const int col = (kv ? C_VC : C_KC) + g * 64;
    for (int i = t; i < 2048; i += 128) { const int j = i >> 6, d = i & 63; a[i] = bf2f(PROJ[(size_t)(b * SEQ + 16 * c + j) * NP0 + col + d]); }
    __syncthreads();
    const bf16* w1 = (kv ? CW1V : CW1K) + (size_t)t * 2048; float s = CMPB[kv * 128 + t];
    for (int k = 0; k < 2048; ++k) s += a[k] * bf2f(w1[k]);
    hid[t] = bf2f(f2bf(gelu_tanh(s)));
    __syncthreads();
    if (t < 64) { const bf16* w2 = (kv ? CW2V : CW2K) + (size_t)t * 128; float o = 0.f; for (int n = 0; n < 128; ++n) o += hid[n] * bf2f(w2[n]); outp[t] = (bf16)f2bf(o); }
}

template <int NV> struct NAcc { float m, l, o[NV]; };
template <int NV> __device__ __forceinline__ void nacc_init(NAcc<NV>& a) { a.m = -1e30f; a.l = 0.f;
#pragma unroll
    for (int j = 0; j < NV; ++j) a.o[j] = 0.f; }
__device__ __forceinline__ void load_q64(float (&q)[64], const bf16* qp) {
#pragma unroll
    for (int i = 0; i < 8; ++i) { const v4u u = ((const v4u*)qp)[i];
        q[8 * i + 0] = bf2f(u.x & 0xffff); q[8 * i + 1] = bf2f(u.x >> 16); q[8 * i + 2] = bf2f(u.y & 0xffff); q[8 * i + 3] = bf2f(u.y >> 16);
        q[8 * i + 4] = bf2f(u.z & 0xffff); q[8 * i + 5] = bf2f(u.z >> 16); q[8 * i + 6] = bf2f(u.w & 0xffff); q[8 * i + 7] = bf2f(u.w >> 16); }
}
__device__ __forceinline__ float dot64(const float (&q)[64], const bf16* kp) {
    float s = 0.f;
#pragma unroll
    for (int i = 0; i < 8; ++i) { const v4u u = ((const v4u*)kp)[i];
        s += q[8 * i + 0] * bf2f(u.x & 0xffff) + q[8 * i + 1] * bf2f(u.x >> 16) + q[8 * i + 2] * bf2f(u.y & 0xffff) + q[8 * i + 3] * bf2f(u.y >> 16)
           + q[8 * i + 4] * bf2f(u.z & 0xffff) + q[8 * i + 5] * bf2f(u.z >> 16) + q[8 * i + 6] * bf2f(u.w & 0xffff) + q[8 * i + 7] * bf2f(u.w >> 16); }
    return s;
}
template <int NV> __device__ __forceinline__ void ntile(NAcc<NV>& a, const float (&q)[64], const bf16* kp, const bf16* vp, bool valid, float bias, int lane) {
    const float s = valid ? dot64(q, kp) + bias : -INFINITY;
    const float tm = wave_max(s);
    const float mn = fmaxf(a.m, tm), f = exp2f(a.m - mn), p = exp2f(s - mn);
    a.l = a.l * f + wave_sum(p); a.m = mn;
#pragma unroll
    for (int j = 0; j < NV; ++j) a.o[j] *= f;
    const unsigned long long vpi = (unsigned long long)(uintptr_t)vp;
    const unsigned vlo = (unsigned)vpi, vhi = (unsigned)(vpi >> 32);
    for (int k = 0; k < 64; ++k) {
        const float pk = __shfl(p, k);
        const unsigned lo = __shfl(vlo, k), hi = __shfl(vhi, k);
        if (pk != 0.f) { const bf16* vr = (const bf16*)(uintptr_t)(((unsigned long long)hi << 32) | lo);
#pragma unroll
            for (int j = 0; j < NV; ++j) a.o[j] += pk * bf2f(vr[lane + 64 * j]); }
    }
}

__global__ void __launch_bounds__(256) k_nnsa(const bf16* PROJ, const bf16* KCMP, const bf16* VCMP, const float* GATES, const float* BIASL, bf16* OC) {
    __shared__ float sc[4][512]; __shared__ float imph[4][128]; __shared__ float score[128]; __shared__ int sel[16];
    const int tid = threadIdx.x, lane = tid & 63, r = tid >> 6;
    int id = blockIdx.x; const int t = id % SEQ; id /= SEQ; const int g = id % 2; const int b = id / 2;
    const int hh = g * 4 + r; const size_t row = (size_t)b * SEQ + t;
    const float* bl = BIASL + hh * 128;
    float q[64]; load_q64(q, PROJ + row * NP0 + C_Q + hh * 64);
    const int nvis = t >= 31 ? ((t - 31) / 16 + 1 < NCMP ? (t - 31) / 16 + 1 : NCMP) : 0;
    const bf16* kc = KCMP + (size_t)((b * 2 + g) * 512) * 64; const bf16* vc = VCMP + (size_t)((b * 2 + g) * 512) * 64;
    float mx = -INFINITY;
    for (int c0 = 0; c0 < nvis; c0 += 64) { const int c = c0 + lane; float s = -INFINITY;
        if (c < nvis) { int rel = t - (16 * c + 31); rel = rel > 127 ? 127 : rel; s = dot64(q, kc + (size_t)c * 64) + bl[rel]; }
        sc[r][c] = s; mx = fmaxf(mx, s); }
    mx = wave_max(mx);
    float ls = 0.f;
    for (int c0 = 0; c0 < nvis; c0 += 64) { const int c = c0 + lane; const float p = exp2f(sc[r][c] - mx); sc[r][c] = p; ls += p; }
    ls = wave_sum(ls);
    const float rl = ls > 0.f ? 1.0f / ls : 0.f;
    for (int c = lane; c < 512; c += 64) sc[r][c] = (c < nvis && c < ((nvis + 63) & ~63)) ? sc[r][c] * rl : 0.f;
    __builtin_amdgcn_s_waitcnt(0xC07F);
    float oc = 0.f;
    for (int c = 0; c < nvis; ++c) oc += sc[r][c] * bf2f(vc[(size_t)c * 64 + lane]);
    for (int n = lane; n < 128; n += 64) { float a = ((sc[r][4 * n] + sc[r][4 * n + 1]) + sc[r][4 * n + 2]) + 0.5f * (4 * n + 3 < 512 ? sc[r][4 * n + 3] : 0.f); if (n > 0) a += 0.5f * sc[r][4 * n - 1]; imph[r][n] = a; }
    __syncthreads();
    const int cur = t >> 6;
    if (tid < 128) { const int n = tid; const float imp = (imph[0][n] + imph[1][n]) + (imph[2][n] + imph[3][n]);
        const bool elig = n <= cur, forced = (n == 0) || (n == cur) || (n == cur - 1);
        score[n] = elig ? imp + (forced ? 1000.f : 0.f) : -1.0f; }
    __syncthreads();
    if (tid < 128) { const int n = tid; const float v = score[n]; int rank = 0;
        for (int j = 0; j < 128; ++j) { const float u = score[j]; rank += (u > v || (u == v && j < n)) ? 1 : 0; }
        if (rank < 16) sel[rank] = n; }
    __syncthreads();
    NAcc<1> as; nacc_init(as);
    for (int i = 0; i < 16; ++i) { const int n = sel[i]; const int pos = 64 * n + lane; const int rel = t - pos; const size_t kr = (size_t)b * SEQ + pos;
        if (64 * n > t) continue;
        ntile<1>(as, q, PROJ + kr * NP0 + C_KS + g * 64, PROJ + kr * NP0 + C_VS + g * 64, rel >= 0, bl[rel < 0 ? 0 : (rel > 127 ? 127 : rel)], lane); }
    NAcc<1> aw; nacc_init(aw);
    for (int n = cur - 8; n <= cur; ++n) { if (n < 0) continue; const int pos = 64 * n + lane; const int rel = t - pos; const size_t kr = (size_t)b * SEQ + pos;
        ntile<1>(aw, q, PROJ + kr * NP0 + C_KW + g * 64, PROJ + kr * NP0 + C_VW + g * 64, rel >= 0 && rel < 512, bl[rel < 0 ? 0 : (rel > 127 ? 127 : rel)], lane); }
    const float g0 = GATES[row * 24 + hh], g1 = GATES[row * 24 + 8 + hh], g2 = GATES[row * 24 + 16 + hh];
    const float os = as.l > 0.f ? as.o[0] / as.l : 0.f, ow = aw.l > 0.f ? aw.o[0] / aw.l : 0.f;
    OC[row * DM + hh * 64 + lane] = (bf16)f2bf(g0 * oc + g1 * os + g2 * ow);
}

__global__ void __launch_bounds__(128) k_ndiff(const bf16* PROJ, const float* BIASL, const float* lq1, const float* lk1, const float* lq2, const float* lk2, const float* subln, bf16* OC) {
    __shared__ float o2[128];
    const int tid = threadIdx.x, lane = tid & 63, mp = tid >> 6;
    int id = blockIdx.x; const int h = id % 4; id /= 4; const int t = id % SEQ; const int b = id / SEQ;
    const size_t row = (size_t)b * SEQ + t; const float* bl = BIASL + (8 + h) * 128;
    float q[64]; load_q64(q, PROJ + row * NP0 + C_DQ + h * 128 + mp * 64);
    NAcc<2> a; nacc_init(a);
    for (int p0 = 0; p0 <= t; p0 += 64) { const int pos = p0 + lane; const int rel = t - pos; const size_t kr = (size_t)b * SEQ + pos;
        ntile<2>(a, q, PROJ + kr * NP0 + C_DK + h * 128 + mp * 64, PROJ + kr * NP0 + C_DV + h * 128, rel >= 0, bl[rel < 0 ? 0 : (rel > 127 ? 127 : rel)], lane); }
    const float il = 1.0f / a.l; float v0 = a.o[0] * il, v1 = a.o[1] * il;
    if (mp == 1) { o2[lane] = v0; o2[lane + 64] = v1; }
    __syncthreads();
    if (mp == 0) {
        const float lam = expf(wave_sum(lq1[lane] * lk1[lane])) - expf(wave_sum(lq2[lane] * lk2[lane])) + 0.2f;
        v0 -= lam * o2[lane]; v1 -= lam * o2[lane + 64];
        const float ss = wave_sum(v0 * v0 + v1 * v1); const float rs = 1.0f / sqrtf(ss * (1.0f / 128.f) + EPS);
        OC[row * DM + 512 + h * 128 + lane] = (bf16)f2bf(v0 * rs * subln[lane] * 0.8f);
        OC[row * DM + 512 + h * 128 + 64 + lane] = (bf16)f2bf(v1 * rs * subln[64 + lane] * 0.8f);
    }
}

__global__ void __launch_bounds__(256) k_nkmean(const bf16* PROJ1, float* KMEAN) {
    const int b = blockIdx.x / 32, n = blockIdx.x % 32;
    for (int col = threadIdx.x; col < 1024; col += 256) { float s = 0.f;
        for (int r = 0; r < 256; ++r) s += bf2f(PROJ1[(size_t)(b * SEQ + n * 256 + r) * NP1 + 1024 + col]);
        KMEAN[((size_t)(b * 16 + (col >> 6)) * 32 + n) * 64 + (col & 63)] = s * (1.0f / 256.f); }
}
__global__ void __launch_bounds__(256) k_nmoba(const bf16* PROJ1, const float* KMEAN, const float* BIASL, bf16* OC) {
    const int tid = threadIdx.x, lane = tid & 63, w = tid >> 6;
    int id = blockIdx.x * 4 + w; const int h = id % 16; id /= 16; const int t = id % SEQ; const int b = id / SEQ;
    const size_t row = (size_t)b * SEQ + t; const float* bl = BIASL + h * 128; const int c = t >> 8;
    float q[64]; load_q64(q, PROJ1 + row * NP1 + h * 64);
    float gate = -1e30f;
    if (lane < 32 && lane < c) { const float* km = KMEAN + ((size_t)(b * 16 + h) * 32 + lane) * 64; float s = 0.f;
#pragma unroll
        for (int d = 0; d < 64; ++d) s += q[d] * km[d];
        gate = s; }
    if (lane >= 32) gate = -INFINITY;
    int rank = 0;
    for (int j = 0; j < 32; ++j) { const float u = __shfl(gate, j); rank += (u > gate || (u == gate && j < lane)) ? 1 : 0; }
    const bool chosen = lane < 32 && rank < 3 && lane < c;
    const unsigned long long cm = __ballot(chosen);
    NAcc<1> a; nacc_init(a);
    for (int n = 0; n < c; ++n) { if (!((cm >> n) & 1ull)) continue;
        for (int j = 0; j < 4; ++j) { const int pos = n * 256 + j * 64 + lane; const int rel = t - pos; const size_t kr = (size_t)b * SEQ + pos;
            ntile<1>(a, q, PROJ1 + kr * NP1 + 1024 + h * 64, PROJ1 + kr * NP1 + 2048 + h * 64, true, bl[rel > 127 ? 127 : rel], lane); } }
    for (int j = 0; j < 4; ++j) { const int pos = c * 256 + j * 64 + lane; const int rel = t - pos; const size_t kr = (size_t)b * SEQ + pos;
        if (c * 256 + j * 64 > t) break;
        ntile<1>(a, q, PROJ1 + kr * NP1 + 1024 + h * 64, PROJ1 + kr * NP1 + 2048 + h * 64, rel >= 0, bl[rel < 0 ? 0 : (rel > 127 ? 127 : rel)], lane); }
    OC[row * DM + h * 64 + lane] = (bf16)f2bf(a.o[0] / a.l);
}

extern "C" void kernel_launch(void* const* d_in, const int* in_sizes, int n_in, void* d_out, int out_size, void* d_ws, size_t ws_size, hipStream_t stream) {
    if (n_in != 22 || out_size != M * DM || ws_size < WS_END) { fprintf(stderr, "kernel_launch: unexpected shapes (n_in %d out %d ws %zu)\n", n_in, out_size, ws_size); return; }
    const float* x = (const float*)d_in[0]; const float* bias_table = (const float*)d_in[1]; const float* norm_mix = (const float*)d_in[2]; const float* norm_mlp = (const float*)d_in[3];
    const float* norm_final = (const float*)d_in[4]; const float* mlp_w1 = (const float*)d_in[5]; const float* mlp_w2 = (const float*)d_in[6]; const float* ev_w_in = (const float*)d_in[7];
    const float* ev_w_out = (const float*)d_in[8]; const float* pos_k = (const float*)d_in[9]; const float* w1_k = (const float*)d_in[10]; const float* w2_k = (const float*)d_in[11];
    const float* pos_v = (const float*)d_in[12]; const float* w1_v = (const float*)d_in[13]; const float* w2_v = (const float*)d_in[14];
    const float* lq1 = (const float*)d_in[15]; const float* lk1 = (const float*)d_in[16]; const float* lq2 = (const float*)d_in[17]; const float* lk2 = (const float*)d_in[18];
    const float* subln = (const float*)d_in[19]; const float* od_w_in = (const float*)d_in[20]; const float* od_w_out = (const float*)d_in[21];
    unsigned char* ws = (unsigned char*)d_ws; float* out = (float*)d_out;
    float* SSA = (float*)(ws + WS_SSA); float* SSB = (float*)(ws + WS_SSB); float* GATES = (float*)(ws + WS_GATES);
    bf16* KCMP = (bf16*)(ws + WS_KCMP); bf16* VCMP = (bf16*)(ws + WS_VCMP); float* CMPB = (float*)(ws + WS_CMPB); float* BIASL = (float*)(ws + WS_BIASL); float* KMEAN = (float*)(ws + WS_KMEAN);
    bf16* WIN0 = (bf16*)(ws + WS_WIN0); bf16* WOUT0 = (bf16*)(ws + WS_WOUT0); bf16* W1_0 = (bf16*)(ws + WS_W1_0); bf16* W2_0 = (bf16*)(ws + WS_W2_0);
    bf16* WIN1 = (bf16*)(ws + WS_WIN1); bf16* WOUT1 = (bf16*)(ws + WS_WOUT1); bf16* W1_1 = (bf16*)(ws + WS_W1_1); bf16* W2_1 = (bf16*)(ws + WS_W2_1);
    bf16* CW1K = (bf16*)(ws + WS_CW1K); bf16* CW1V = (bf16*)(ws + WS_CW1V); bf16* CW2K = (bf16*)(ws + WS_CW2K); bf16* CW2V = (bf16*)(ws + WS_CW2V);
    bf16* XB = (bf16*)(ws + WS_XB); bf16* OC = (bf16*)(ws + WS_OC); bf16* H = (bf16*)(ws + WS_H); bf16* PROJ = (bf16*)(ws + WS_PROJ);

    WJobs jobs{};
    int nj = 0;
    jobs.j[nj++] = WJob{ev_w_in, WIN0, norm_mix, DM, EVEN_PROJ, NP0, 1};
    jobs.j[nj++] = WJob{ev_w_out, WOUT0, nullptr, DM, DM, DM, 0};
    jobs.j[nj++] = WJob{mlp_w1, W1_0, norm_mlp, DM, FF, FF, 0};
    jobs.j[nj++] = WJob{mlp_w2, W2_0, nullptr, FF, DM, DM, 0};
    jobs.j[nj++] = WJob{od_w_in, WIN1, norm_mix + DM, DM, NP1, NP1, 2};
    jobs.j[nj++] = WJob{od_w_out, WOUT1, nullptr, DM, DM, DM, 0};
    jobs.j[nj++] = WJob{mlp_w1 + (size_t)DM * FF, W1_1, norm_mlp + DM, DM, FF, FF, 0};
    jobs.j[nj++] = WJob{mlp_w2 + (size_t)DM * FF, W2_1, nullptr, FF, DM, DM, 0};
    jobs.j[nj++] = WJob{w1_k, CW1K, nullptr, 2048, 128, 128, 0};
    jobs.j[nj++] = WJob{w1_v, CW1V, nullptr, 2048, 128, 128, 0};
    jobs.j[nj++] = WJob{w2_k, CW2K, nullptr, 128, 64, 64, 0};
    jobs.j[nj++] = WJob{w2_v, CW2V, nullptr, 128, 64, 64, 0};
    jobs.n = nj;
    hipLaunchKernelGGL(k_prep_weights, dim3(512), dim3(512), 0, stream, jobs);
    hipLaunchKernelGGL(k_prep_misc, dim3(3), dim3(512), 0, stream, bias_table, pos_k, w1_k, pos_v, w1_v, BIASL, CMPB);
    static bool attr_done = false;
    if (!attr_done) { (void)hipFuncSetAttribute((const void*)k_prep_rows, hipFuncAttributeMaxDynamicSharedMemorySize, 24 * WG_PITCH * 4); attr_done = true; }
    hipLaunchKernelGGL(k_prep_rows, dim3(256), dim3(512), 24 * WG_PITCH * 4, stream, x, norm_mix, ev_w_in, XB, SSA, GATES);
    hipLaunchKernelGGL(k_ngemm<NEpiProj>, dim3(NP0 / 64, M / 64), dim3(256), 0, stream, XB, WIN0, NP0, DM, NEpiProj{PROJ, SSA, NP0, 0});
    hipLaunchKernelGGL(k_ncompress, dim3(2 * 2 * 2 * 512), dim3(128), 0, stream, PROJ, CW1K, CW1V, CW2K, CW2V, CMPB, KCMP, VCMP);
    hipLaunchKernelGGL(k_ndiff, dim3(M * 4), dim3(128), 0, stream, PROJ, BIASL, lq1, lk1, lq2, lk2, subln, OC);
    hipLaunchKernelGGL(k_nnsa, dim3(M * 2), dim3(256), 0, stream, PROJ, KCMP, VCMP, GATES, BIASL, OC);
    hipLaunchKernelGGL(k_ngemm<NEpiRes>, dim3(DM / 64, M / 64), dim3(256), 0, stream, OC, WOUT0, DM, DM, NEpiRes{x, out, XB});
    hipLaunchKernelGGL(k_rowstats, dim3(M / 4), dim3(256), 0, stream, out, SSB);
    hipLaunchKernelGGL(k_ngemm<NEpiMlp1>, dim3(FF / 64, M / 64), dim3(256), 0, stream, XB, W1_0, FF, DM, NEpiMlp1{H, SSB});
    hipLaunchKernelGGL(k_ngemm<NEpiRes>, dim3(DM / 64, M / 64), dim3(256), 0, stream, H, W2_0, DM, FF, NEpiRes{out, out, XB});
    hipLaunchKernelGGL(k_rowstats, dim3(M / 4), dim3(256), 0, stream, out, SSA);
    hipLaunchKernelGGL(k_ngemm<NEpiProj>, dim3(NP1 / 64, M / 64), dim3(256), 0, stream, XB, WIN1, NP1, DM, NEpiProj{PROJ, SSA, NP1, 0});
    hipLaunchKernelGGL(k_nkmean, dim3(64), dim3(256), 0, stream, PROJ, KMEAN);
    hipLaunchKernelGGL(k_nmoba, dim3(M * 16 / 4), dim3(256), 0, stream, PROJ, KMEAN, BIASL, OC);
    hipLaunchKernelGGL(k_ngemm<NEpiRes>, dim3(DM / 64, M / 64), dim3(256), 0, stream, OC, WOUT1, DM, DM, NEpiRes{out, out, XB});
    hipLaunchKernelGGL(k_rowstats, dim3(M / 4), dim3(256), 0, stream, out, SSB);
    hipLaunchKernelGGL(k_ngemm<NEpiMlp1>, dim3(FF / 64, M / 64), dim3(256), 0, stream, XB, W1_1, FF, DM, NEpiMlp1{H, SSB});
    hipLaunchKernelGGL(k_ngemm<NEpiRes>, dim3(DM / 64, M / 64), dim3(256), 0, stream, H, W2_1, DM, FF, NEpiRes{out, out, XB});
    hipLaunchKernelGGL(k_final_norm, dim3(M / 4), dim3(256), 0, stream, out, norm_final);
}
```

```cpp
#include <hip/hip_runtime.h>
#include <hip/hip_cooperative_groups.h>
#include <cstdint>
#include <cstdio>

typedef unsigned short bf16;
typedef unsigned v4u __attribute__((ext_vector_type(4)));
typedef float f32x4 __attribute__((ext_vector_type(4)));

constexpr int BATCH = 2, SEQ = 8192, DM = 1024, M = BATCH * SEQ, FF = 4096;
constexpr int NP0 = 2816, NP1 = 3072, EVEN_PROJ = 2840;
constexpr float EPS = 1e-6f;
constexpr float LOG2E = 1.4426950408889634f, C2 = 0.125f * LOG2E;
constexpr int C_Q = 0, C_KC = 512, C_VC = 640, C_KS = 768, C_VS = 896, C_KW = 1024, C_VW = 1152, C_DQ = 1280, C_DK = 1792, C_DV = 2304;
constexpr int NCMP = 511;

constexpr size_t MiB = 1u << 20;
constexpr size_t WS_CTL = 0;
constexpr size_t WS_SSA = 1 * MiB, WS_SSB = 2 * MiB;
constexpr size_t WS_GATES = 3 * MiB;
constexpr size_t WS_KCMP = 4 * MiB + 512 * 1024, WS_VCMP = WS_KCMP + 256 * 1024;
constexpr size_t WS_CMPB = 5 * MiB;
constexpr size_t WS_BIASL = 5 * MiB + 4096;
constexpr size_t WS_KMEAN = 5 * MiB + 256 * 1024;
constexpr size_t WS_WIN0 = 8 * MiB, WS_WOUT0 = 14 * MiB, WS_W1_0 = 16 * MiB, WS_W2_0 = 24 * MiB;
constexpr size_t WS_WIN1 = 32 * MiB, WS_WOUT1 = 38 * MiB, WS_W1_1 = 40 * MiB, WS_W2_1 = 48 * MiB;
constexpr size_t WS_CW1K = 56 * MiB, WS_CW1V = 56 * MiB + 512 * 1024, WS_CW2K = 57 * MiB, WS_CW2V = 57 * MiB + 64 * 1024;
constexpr size_t WS_XB = 58 * MiB, WS_OC = 90 * MiB, WS_H = 122 * MiB, WS_PROJ = 122 * MiB, WS_END = 250 * MiB;

__device__ __forceinline__ unsigned f2bf(float f) { unsigned u = __builtin_bit_cast(unsigned, f); return (u + 0x7fffu + ((u >> 16) & 1u)) >> 16; }
__device__ __forceinline__ float bf2f(unsigned h) { return __builtin_bit_cast(float, h << 16); }
__device__ __forceinline__ unsigned pk2(float lo, float hi) { return f2bf(lo) | (f2bf(hi) << 16); }
__device__ __forceinline__ float wave_sum(float v) {
#pragma unroll
    for (int o = 1; o < 64; o <<= 1) v += __shfl_xor(v, o);
    return v;
}
__device__ __forceinline__ float wave_max(float v) {
#pragma unroll
    for (int o = 1; o < 64; o <<= 1) v = fmaxf(v, __shfl_xor(v, o));
    return v;
}
__device__ __forceinline__ float rstd_of(const float* SS, int row) {
    const f32x4* p = (const f32x4*)(SS + (size_t)row * 16);
    f32x4 a = p[0], b = p[1], c = p[2], d = p[3];
    float s = ((a.x + a.y) + (a.z + a.w)) + ((b.x + b.y) + (b.z + b.w)) + ((c.x + c.y) + (c.z + c.w)) + ((d.x + d.y) + (d.z + d.w));
    return 1.0f / sqrtf(s * (1.0f / DM) + EPS);
}
__device__ __forceinline__ int t5_bucket(int rel) {
    int n = rel < 0 ? 0 : rel;
    if (n < 16) return n;
    int large = 16 + (int)(logf((float)n / 16.0f) / logf(8.0f) * 16.0f);
    return large < 31 ? large : 31;
}

namespace pg8 {
#define PG8_LAS __attribute__((address_space(3)))
typedef unsigned short bf16_t;
typedef short bf16x8 __attribute__((ext_vector_type(8)));
typedef float f32x4 __attribute__((ext_vector_type(4)));
typedef unsigned u32x4 __attribute__((ext_vector_type(4)));
constexpr int BM = 256, BK = 64, HALF = 128, HTB = HALF * BK * 2  , STAGE_BYTES = 8 * HTB, NXCD = 8, WGM = 8;

__host__ __device__ __forceinline__ int lds_byte(int r, int c) { const int st = (r >> 4) * 2 + (c >> 5), rr = r & 15, cc = c & 31, ob = rr * 64 + cc * 2; return st * 1024 + (ob ^ (((ob >> 9) & 1) << 5)); }
__host__ __device__ __forceinline__ void stage_rc(int b, int& R, int& C) { const int st = b / 1024, sb = b % 1024, swz = sb ^ (((sb >> 9) & 1) << 5); R = (st >> 1) * 16 + swz / 64; C = (st & 1) * 32 + (swz % 64) / 2; }
__host__ __device__ __forceinline__ int perm32(int rho) { const int n = rho >> 4, i = rho & 15; return 8 * (i >> 2) + 4 * n + (i & 3); }

struct Unit { int pm, pn; };
struct Gemm { const bf16_t* A; const bf16_t* Bt; int M, N, K; };

struct StaticOrder {
    int nM, nN, nwg, G, c;
    __host__ __device__ void init(int M, int N, int G_, int c_) { nM = M / BM; nN = N / BM; nwg = nM * nN; G = G_; c = c_; }
    __host__ __device__ bool next(int i, Unit& u) const {
        const long L = (long)i * G + c; if (L >= nwg) return false;
        int wgid = (int)L; { const int q = nwg / NXCD, r = nwg % NXCD, xcd = wgid % NXCD, off = wgid / NXCD; wgid = (xcd < r ? xcd * (q + 1) : r * (q + 1) + (xcd - r) * q) + off; }
        const int nig = WGM * nN, gid = wgid / nig, fm = gid * WGM, gsz = (nM - fm) < WGM ? (nM - fm) : WGM;
        u.pm = fm + ((wgid % nig) % gsz); u.pn = (wgid % nig) / gsz; return true;
    }
    __device__ __forceinline__ void a_ready(const Unit&) const {}
    __device__ __forceinline__ void done(const Unit&) const {}
};
__device__ __forceinline__ unsigned cvt_pk_bf16(float lo, float hi) { unsigned r; asm volatile("v_cvt_pk_bf16_f32 %0, %1, %2" : "=v"(r) : "v"(lo), "v"(hi)); return r; }
typedef float f32x2 __attribute__((ext_vector_type(2)));
template <class Epi, class Sched, bool ALIGN_EPI = false, bool SP2 = false>
__device__ __forceinline__ void gemm_phase(PG8_LAS unsigned char* lds, const Gemm g, const Sched& S, const Epi& E) {
    const int tid = threadIdx.x, wid = __builtin_amdgcn_readfirstlane(tid >> 6), lane = tid & 63, wr = wid >> 2, wc = wid & 3, fr = lane & 15, fq = lane >> 4;
    const int K = g.K, nt = K / BK;
    unsigned voffA[2], voffB[2];
#pragma unroll
    for (int i = 0; i < 2; ++i) { int R, C; stage_rc(tid * 16 + i * 8192, R, C); const int Rb = Epi::PERM ? ((R & ~31) + perm32(R & 31)) : R;
        voffA[i] = (unsigned)(R * K + C) * 2u; voffB[i] = (unsigned)(Rb * K + C) * 2u; }
    const size_t kstep = (size_t)(BK * 2);
    const size_t hstep = (size_t)HALF * K * 2;
    const size_t tstep = 2 * hstep;
    const unsigned ldsw = (unsigned)wid * 1024u;
    const int aoff = lds_byte(wr * 64 + fr, fq * 8), boff = lds_byte(wc * 32 + fr, fq * 8);
#define PG8_SA(b, h) (((b) * 2 + (h)) * HTB)
#define PG8_SB(b, h) ((4 + (b) * 2 + (h)) * HTB)
#define PG8_STAGE(bufoff, gbase, voff) do { _Pragma("unroll") for (int _i = 0; _i < 2; ++_i) \
        __builtin_amdgcn_global_load_lds((const unsigned*)((const char*)(gbase) + (voff)[_i]), (PG8_LAS unsigned*)(lds + (bufoff) + ldsw + _i * 8192), 16, 0, 0); } while (0)
#define PG8_LDA(dst, b, h) do { _Pragma("unroll") for (int m = 0; m < 4; ++m) _Pragma("unroll") for (int k = 0; k < 2; ++k) dst[m][k] = *(const PG8_LAS bf16x8*)(lds + PG8_SA(b, h) + aoff + m * 2048 + k * 1024); } while (0)
#define PG8_LDB(dst, b, h) do { _Pragma("unroll") for (int n = 0; n < 2; ++n) _Pragma("unroll") for (int k = 0; k < 2; ++k) dst[n][k] = *(const PG8_LAS bf16x8*)(lds + PG8_SB(b, h) + boff + n * 2048 + k * 1024); } while (0)
#define PG8_MMA(ai, bj, At, Bt) do { __builtin_amdgcn_s_setprio(1); _Pragma("unroll") for (int m = 0; m < 4; ++m) _Pragma("unroll") for (int n = 0; n < 2; ++n) _Pragma("unroll") for (int k = 0; k < 2; ++k) \
        acc[ai][bj][m][n] = __builtin_amdgcn_mfma_f32_16x16x32_bf16(Bt[n][k], At[m][k], acc[ai][bj][m][n], 0, 0, 0); __builtin_amdgcn_s_setprio(0); } while (0)
#define PG8_WAIT_V(n) asm volatile("s_waitcnt vmcnt(" #n ")" ::: "memory")
#define PG8_WAIT_L(n) asm volatile("s_waitcnt lgkmcnt(" #n ")" ::: "memory")
#define PG8_BAR __builtin_amdgcn_s_barrier()
#define PG8_SCHED __builtin_amdgcn_sched_barrier(0)
    Unit cur, nxt; int ui = 0;
    if (!S.next(0, cur)) return;
    f32x4 acc[2][2][4][2];
#pragma unroll
    for (int a = 0; a < 2; ++a)
#pragma unroll
        for (int b = 0; b < 2; ++b)
#pragma unroll
            for (int m = 0; m < 4; ++m)
#pragma unroll
                for (int n = 0; n < 2; ++n) acc[a][b][m][n] = (f32x4){0.f, 0.f, 0.f, 0.f};
    bf16x8 At[4][2], B0[2][2], B1[2][2];
    const char* cA = (const char*)g.A + (size_t)cur.pm * tstep; const char* cB = (const char*)g.Bt + (size_t)cur.pn * tstep;
    S.a_ready(cur);
    if constexpr (SP2) {
        PG8_STAGE(PG8_SB(0, 0), cB, voffB); PG8_STAGE(PG8_SB(0, 1), cB + hstep, voffB); PG8_STAGE(PG8_SA(0, 0), cA, voffA); PG8_STAGE(PG8_SA(0, 1), cA + hstep, voffA);
        if (wr == 1) PG8_BAR;
        PG8_WAIT_V(2); PG8_BAR;
        PG8_STAGE(PG8_SB(1, 0), cB + kstep, voffB); PG8_STAGE(PG8_SA(1, 0), cA + kstep, voffA); PG8_STAGE(PG8_SB(1, 1), cB + hstep + kstep, voffB);
        PG8_WAIT_V(6); PG8_BAR;
    } else {
        PG8_STAGE(PG8_SB(0, 0), cB, voffB); PG8_STAGE(PG8_SA(0, 0), cA, voffA); PG8_STAGE(PG8_SB(0, 1), cB + hstep, voffB); PG8_STAGE(PG8_SA(0, 1), cA + hstep, voffA);
        if (wr == 1) PG8_BAR;
        PG8_WAIT_V(4); PG8_BAR;
        PG8_STAGE(PG8_SB(1, 0), cB + kstep, voffB); PG8_STAGE(PG8_SA(1, 0), cA + kstep, voffA); PG8_STAGE(PG8_SB(1, 1), cB + hstep + kstep, voffB);
        PG8_WAIT_V(6); PG8_BAR;
    }
    for (;;) {
        const bool has_next = S.next(ui + 1, nxt);
        const char* nA = has_next ? (const char*)g.A + (size_t)nxt.pm * tstep : cA; const char* nB = has_next ? (const char*)g.Bt + (size_t)nxt.pn * tstep : cB;
        for (int t = 0; t < nt; t += 2) {
            const bool last = (t == nt - 2);
            const char* a1 = cA + (size_t)(t + 1) * kstep;
            const char* a2 = last ? nA : cA + (size_t)(t + 2) * kstep; const char* b2 = last ? nB : cB + (size_t)(t + 2) * kstep;
            const char* a3 = a2 + kstep; const char* b3 = b2 + kstep;
            if (last && has_next) S.a_ready(nxt);
            if constexpr (SP2) {
            PG8_LDB(B0, 0, 0); PG8_LDB(B1, 0, 1); PG8_SCHED; PG8_LDA(At, 0, 0); PG8_STAGE(PG8_SA(1, 1), a1 + hstep, voffA);
            PG8_WAIT_V(8); PG8_WAIT_L(0); PG8_BAR; PG8_MMA(0, 0, At, B0); PG8_MMA(0, 1, At, B1); PG8_BAR; PG8_SCHED;
            PG8_LDA(At, 0, 1); PG8_STAGE(PG8_SB(0, 0), b2, voffB); PG8_STAGE(PG8_SB(0, 1), b2 + hstep, voffB); PG8_STAGE(PG8_SA(0, 0), a2, voffA);
            PG8_WAIT_V(8); PG8_WAIT_L(0); PG8_BAR; PG8_MMA(1, 0, At, B0); PG8_MMA(1, 1, At, B1); PG8_BAR; PG8_SCHED;
            PG8_LDB(B0, 1, 0); PG8_LDB(B1, 1, 1); PG8_SCHED; PG8_LDA(At, 1, 0); PG8_STAGE(PG8_SA(0, 1), a2 + hstep, voffA);
            PG8_WAIT_V(8); PG8_WAIT_L(0); PG8_BAR; PG8_MMA(0, 0, At, B0); PG8_MMA(0, 1, At, B1); PG8_BAR; PG8_SCHED;
            PG8_LDA(At, 1, 1); PG8_STAGE(PG8_SB(1, 0), b3, voffB); PG8_STAGE(PG8_SB(1, 1), b3 + hstep, voffB); PG8_STAGE(PG8_SA(1, 0), a3, voffA);
            PG8_WAIT_V(8); PG8_WAIT_L(0); PG8_BAR; PG8_MMA(1, 0, At, B0); PG8_MMA(1, 1, At, B1); PG8_BAR; PG8_SCHED;
            } else {
            PG8_LDB(B0, 0, 0); PG8_SCHED; PG8_LDA(At, 0, 0); PG8_STAGE(PG8_SA(1, 1), a1 + hstep, voffA);
            PG8_WAIT_L(8); PG8_BAR; PG8_WAIT_L(0); PG8_MMA(0, 0, At, B0); PG8_BAR; PG8_SCHED;
            PG8_LDB(B1, 0, 1); PG8_STAGE(PG8_SB(0, 0), b2, voffB);
            PG8_BAR; PG8_WAIT_L(0); PG8_MMA(0, 1, At, B1); PG8_BAR;
            PG8_LDA(At, 0, 1); PG8_STAGE(PG8_SA(0, 0), a2, voffA);
            PG8_BAR; PG8_WAIT_L(0); PG8_MMA(1, 0, At, B0); PG8_BAR; PG8_SCHED;
            PG8_STAGE(PG8_SB(0, 1), b2 + hstep, voffB);
            PG8_WAIT_V(6); PG8_BAR; PG8_MMA(1, 1, At, B1); PG8_BAR;
            PG8_LDB(B0, 1, 0); PG8_SCHED; PG8_LDA(At, 1, 0); PG8_STAGE(PG8_SA(0, 1), a2 + hstep, voffA);
            PG8_WAIT_L(8); PG8_BAR; PG8_WAIT_L(0); PG8_MMA(0, 0, At, B0); PG8_BAR; PG8_SCHED;
            PG8_LDB(B1, 1, 1); PG8_STAGE(PG8_SB(1, 0), b3, voffB);
            PG8_BAR; PG8_WAIT_L(0); PG8_MMA(0, 1, At, B1); PG8_BAR;
            PG8_LDA(At, 1, 1); PG8_STAGE(PG8_SA(1, 0), a3, voffA);
            PG8_BAR; PG8_WAIT_L(0); PG8_MMA(1, 0, At, B0); PG8_BAR; PG8_SCHED;
            PG8_STAGE(PG8_SB(1, 1), b3 + hstep, voffB);
            PG8_WAIT_V(6); PG8_BAR; PG8_MMA(1, 1, At, B1); PG8_BAR;
            }
        }
        if constexpr (ALIGN_EPI) { if (wr == 0) PG8_BAR; }
        if constexpr (!Epi::AFTER_DRAIN) { E(acc, cur, wr, wc, fr, fq); S.done(cur); }
        if (!has_next) break;
#pragma unroll
        for (int a = 0; a < 2; ++a)
#pragma unroll
            for (int b = 0; b < 2; ++b)
#pragma unroll
                for (int m = 0; m < 4; ++m)
#pragma unroll
                    for (int n = 0; n < 2; ++n) acc[a][b][m][n] = (f32x4){0.f, 0.f, 0.f, 0.f};
        cur = nxt; cA = nA; cB = nB; ++ui;
        if constexpr (ALIGN_EPI) { if (wr == 1) PG8_BAR; }
    }
    PG8_WAIT_V(0);
    if constexpr (!ALIGN_EPI) { if (wr == 0) PG8_BAR; }
    PG8_BAR;
    if constexpr (Epi::AFTER_DRAIN) { E.fused(acc, cur, wr, wc, fr, fq, lds, wid, lane); S.done(cur); }
#undef PG8_SA
#undef PG8_SB
#undef PG8_STAGE
#undef PG8_LDA
#undef PG8_LDB
#undef PG8_MMA
#undef PG8_WAIT_V
#undef PG8_WAIT_L
#undef PG8_BAR
#undef PG8_SCHED
}
}

namespace pg8 {
template <int MODE> struct EpiRowScaleBf16 {
    static constexpr bool PERM = true, AFTER_DRAIN = false;
    bf16_t* O; const float* SS; float* KMP; int ldc, kt_lo, kt_hi, pad;
    __device__ __forceinline__ void operator()(const f32x4 (&acc)[2][2][4][2], const Unit& u, int wr, int wc, int fr, int fq) const {
        const int row0 = u.pm * BM + wr * 64 + fr, col0 = u.pn * BM + wc * 32 + 8 * fq;
        const bool do_km = (u.pn >= kt_lo && u.pn < kt_hi);
        float cs[2][8];
#pragma unroll
        for (int bj = 0; bj < 2; ++bj)
#pragma unroll
            for (int e = 0; e < 8; ++e) cs[bj][e] = 0.f;
#pragma unroll
        for (int ai = 0; ai < 2; ++ai)
#pragma unroll
            for (int m = 0; m < 4; ++m) { const int row = row0 + ai * HALF + m * 16; const float rs = rstd_of(SS, row); bf16_t* rowp = O + (size_t)row * ldc + col0;
#pragma unroll
                for (int bj = 0; bj < 2; ++bj) { f32x4 v0 = acc[ai][bj][m][0] * rs, v1 = acc[ai][bj][m][1] * rs;
                    if (MODE == 1) {
#pragma unroll
                        for (int e = 0; e < 4; ++e) { float a = v0[e] > 0.f ? v0[e] : 0.f; v0[e] = a * a; float b = v1[e] > 0.f ? v1[e] : 0.f; v1[e] = b * b; } }
                    if (MODE == 0 && do_km) {
#pragma unroll
                        for (int e = 0; e < 4; ++e) { cs[bj][e] += v0[e]; cs[bj][4 + e] += v1[e]; } }
                    u32x4 w; w.x = cvt_pk_bf16(v0[0], v0[1]); w.y = cvt_pk_bf16(v0[2], v0[3]); w.z = cvt_pk_bf16(v1[0], v1[1]); w.w = cvt_pk_bf16(v1[2], v1[3]);
                    *(u32x4*)(rowp + bj * HALF) = w; } }
        if (MODE == 0 && do_km) {
            const int b = u.pm >> 5, blk = u.pm & 31;
#pragma unroll
            for (int bj = 0; bj < 2; ++bj)
#pragma unroll
                for (int e = 0; e < 8; ++e) { float s = cs[bj][e]; s += __shfl_xor(s, 1); s += __shfl_xor(s, 2); s += __shfl_xor(s, 4); s += __shfl_xor(s, 8);
                    if (fr == 0) { const int kc = (u.pn - kt_lo) * BM + bj * HALF + wc * 32 + 8 * fq + e;
                        KMP[(((size_t)wr * 2 + b) * 16 + (kc >> 6)) * 32 * 64 + (size_t)blk * 64 + (kc & 63)] = s; } }
        }
    }
};
struct EpiResidual {
    static constexpr bool PERM = false, AFTER_DRAIN = false;
    const float* xin; float* xout; bf16_t* xb; float* SS;
    __device__ __forceinline__ void operator()(const f32x4 (&acc)[2][2][4][2], const Unit& u, int wr, int wc, int fr, int fq) const {
        typedef unsigned u32x2v __attribute__((ext_vector_type(2)));
        const int col0 = u.pn * BM + wc * 32 + 4 * fq;
#pragma unroll
        for (int ai = 0; ai < 2; ++ai)
#pragma unroll
            for (int m = 0; m < 4; ++m) { const int row = u.pm * BM + ai * HALF + wr * 64 + m * 16 + fr; const size_t off = (size_t)row * DM + col0; float sq = 0.f;
#pragma unroll
                for (int bj = 0; bj < 2; ++bj)
#pragma unroll
                    for (int n = 0; n < 2; ++n) { const f32x4 bs = *(const f32x4*)(xin + off + bj * HALF + n * 16); const f32x4 o = bs + acc[ai][bj][m][n];
                        *(f32x4*)(xout + off + bj * HALF + n * 16) = o; sq += (o[0] * o[0] + o[1] * o[1]) + (o[2] * o[2] + o[3] * o[3]);
                        u32x2v w; w.x = cvt_pk_bf16(o[0], o[1]); w.y = cvt_pk_bf16(o[2], o[3]); *(u32x2v*)(xb + off + bj * HALF + n * 16) = w; }
                sq += __shfl_xor(sq, 16); sq += __shfl_xor(sq, 32);
                if (fq == 0) SS[(size_t)row * 16 + u.pn * 4 + wc] = sq; }
    }
};
}

namespace cg = cooperative_groups;
constexpr int NTHR = 512;
constexpr int LDS_BYTES = 147456;
constexpr size_t WS_KMP = 6 * MiB;
#ifndef USE_PG8
#define USE_PG8 1
#endif

struct Args { const float* in[22]; float* out; unsigned char* ws; int ph_lo, ph_hi; };

struct PP {
    const float *x, *bias_table, *norm_mix, *norm_mlp, *norm_final, *mlp_w1, *mlp_w2, *ev_w_in, *ev_w_out, *pos_k, *w1_k, *w2_k, *pos_v, *w1_v, *w2_v, *lq1, *lk1, *lq2, *lk2, *subln, *od_w_in, *od_w_out;
    float* out; float *SSA, *SSB, *GATES, *CMPB, *BIASL, *KMEAN, *KMP;
    bf16 *KCMP, *VCMP, *WIN0, *WOUT0, *W1_0, *W2_0, *WIN1, *WOUT1, *W1_1, *W2_1, *CW1K, *CW1V, *CW2K, *CW2V, *XB, *OC, *H, *PROJ;
};

struct WJob { const float* W; bf16* WT; const float* kscale; int K, Nsrc, Ndst, kind; };
__device__ __forceinline__ void transpose_item(const WJob& J, int item, float* scr, int lane) {
    const int nblk = J.Ndst / 32, kb = item / nblk, nb = item % nblk, k0 = 64 * kb, n0 = 32 * nb;
    int s0 = n0; float cs = 1.0f;
    if (J.kind == 1) { s0 = n0 < 1280 ? n0 : n0 + 24; if (n0 < 512 || (n0 >= C_DQ && n0 < C_DK)) cs = C2; }
    if (J.kind == 2) { if (n0 < 1024) cs = C2; }
#pragma unroll 8
    for (int i = 0; i < 32; ++i) { const int kk = 2 * i + (lane >> 5); scr[kk * 33 + (lane & 31)] = J.W[(size_t)(k0 + kk) * J.Nsrc + s0 + (lane & 31)]; }
    __builtin_amdgcn_s_waitcnt(0xC07F); asm volatile("" ::: "memory");
    const int c = lane & 7;
    float ks[8];
#pragma unroll
    for (int i = 0; i < 8; ++i) ks[i] = (J.kscale ? J.kscale[k0 + 8 * c + i] : 1.0f) * cs;
#pragma unroll
    for (int j = 0; j < 4; ++j) { const int n = (lane >> 3) + 8 * j; const float* s = scr + (8 * c) * 33 + n;
        v4u o; o.x = pk2(s[0 * 33] * ks[0], s[1 * 33] * ks[1]); o.y = pk2(s[2 * 33] * ks[2], s[3 * 33] * ks[3]); o.z = pk2(s[4 * 33] * ks[4], s[5 * 33] * ks[5]); o.w = pk2(s[6 * 33] * ks[6], s[7 * 33] * ks[7]);
        *(v4u*)(J.WT + (size_t)(n0 + n) * J.K + k0 + 8 * c) = o; }
    __builtin_amdgcn_s_waitcnt(0xC07F); asm volatile("" ::: "memory");
}
__device__ __forceinline__ void job_items(const WJob& J, int& base, int gw, int NGW, float* scr, int lane) {
    const int nit = (J.K / 64) * (J.Ndst / 32);
    const int first = ((gw - base) % NGW + NGW) % NGW;
    for (int it = first; it < nit; it += NGW) transpose_item(J, it, scr, lane);
    base += nit;
}
constexpr int WG_PITCH = 1028;
__device__ __forceinline__ void p0_prologue(const PP& p, char* lds, int tid, int bid, int G) {
    const int lane = tid & 63, wave = tid >> 6;
    {
        float* scr = (float*)lds + wave * 64 * 33;
        const int gw = bid * 8 + wave, NGW = G * 8; int base = 0;
        job_items(WJob{p.ev_w_in, p.WIN0, p.norm_mix, DM, EVEN_PROJ, NP0, 1}, base, gw, NGW, scr, lane);
        job_items(WJob{p.ev_w_out, p.WOUT0, nullptr, DM, DM, DM, 0}, base, gw, NGW, scr, lane);
        job_items(WJob{p.mlp_w1, p.W1_0, p.norm_mlp, DM, FF, FF, 0}, base, gw, NGW, scr, lane);
        job_items(WJob{p.mlp_w2, p.W2_0, nullptr, FF, DM, DM, 0}, base, gw, NGW, scr, lane);
        job_items(WJob{p.od_w_in, p.WIN1, p.norm_mix + DM, DM, NP1, NP1, 2}, base, gw, NGW, scr, lane);
        job_items(WJob{p.od_w_out, p.WOUT1, nullptr, DM, DM, DM, 0}, base, gw, NGW, scr, lane);
        job_items(WJob{p.mlp_w1 + (size_t)DM * FF, p.W1_1, p.norm_mlp + DM, DM, FF, FF, 0}, base, gw, NGW, scr, lane);
        job_items(WJob{p.mlp_w2 + (size_t)DM * FF, p.W2_1, nullptr, FF, DM, DM, 0}, base, gw, NGW, scr, lane);
        job_items(WJob{p.w1_k, p.CW1K, nullptr, 2048, 128, 128, 0}, base, gw, NGW, scr, lane);
        job_items(WJob{p.w1_v, p.CW1V, nullptr, 2048, 128, 128, 0}, base, gw, NGW, scr, lane);
        job_items(WJob{p.w2_k, p.CW2K, nullptr, 128, 64, 64, 0}, base, gw, NGW, scr, lane);
        job_items(WJob{p.w2_v, p.CW2V, nullptr, 128, 64, 64, 0}, base, gw, NGW, scr, lane);
    }
    __syncthreads();
    if (bid == 0) { for (int i = tid; i < 16 * 128; i += NTHR) { const int h = i >> 7, rel = i & 127; p.BIASL[i] = p.bias_table[t5_bucket(rel) * 16 + h] * LOG2E; } }
    if (bid == 1 % G || bid == 2 % G) {
        for (int which = 0; which < 2; ++which) { if (bid != (1 + which) % G) continue;
            const float* pos = which == 0 ? p.pos_k : p.pos_v; const float* w1 = which == 0 ? p.w1_k : p.w1_v;
            float* part = (float*)lds; const int n = tid & 127, pr = tid >> 7; float s = 0.f;
            for (int kk = pr * 512; kk < pr * 512 + 512; ++kk) s += pos[kk] * w1[(size_t)kk * 128 + n];
            part[pr * 128 + n] = s; __syncthreads();
            if (tid < 128) p.CMPB[which * 128 + tid] = (part[tid] + part[128 + tid]) + (part[256 + tid] + part[384 + tid]);
            __syncthreads(); }
    }
    __syncthreads();
    float* wg = (float*)lds;
    for (int idx = tid; idx < 24 * 1024; idx += NTHR) { const int k = idx / 24, j = idx % 24; wg[j * WG_PITCH + k] = p.ev_w_in[(size_t)k * EVEN_PROJ + 1280 + j] * p.norm_mix[k]; }
    __syncthreads();
    for (int row = bid * 8 + wave; row < M; row += G * 8) {
        const f32x4* xr = (const f32x4*)(p.x + (size_t)row * DM) + lane;
        f32x4 v[4]; float s = 0.f;
#pragma unroll
        for (int j = 0; j < 4; ++j) { v[j] = xr[64 * j]; s += (v[j].x * v[j].x + v[j].y * v[j].y) + (v[j].z * v[j].z + v[j].w * v[j].w); }
        s = wave_sum(s);
        const float rstd = 1.0f / sqrtf(s * (1.0f / DM) + EPS);
        unsigned long long* o8 = (unsigned long long*)(p.XB + (size_t)row * DM) + lane;
#pragma unroll
        for (int j = 0; j < 4; ++j) o8[64 * j] = (unsigned long long)pk2(v[j].x, v[j].y) | ((unsigned long long)pk2(v[j].z, v[j].w) << 32);
        if (lane < 16) p.SSA[(size_t)row * 16 + lane] = lane == 0 ? s : 0.f;
        float gsum = 0.f;
#pragma unroll 1
        for (int g = 0; g < 24; ++g) {
            float a = 0.f;
#pragma unroll
            for (int j = 0; j < 4; ++j) { const f32x4 w = *(const f32x4*)(wg + g * WG_PITCH + 256 * j + 4 * lane); a += (v[j].x * w.x + v[j].y * w.y) + (v[j].z * w.z + v[j].w * w.w); }
            a = wave_sum(a);
            if (lane == g) gsum = a;
        }
        if (lane < 24) p.GATES[(size_t)row * 24 + lane] = 1.0f / (1.0f + expf(-gsum * rstd));
    }
    __syncthreads();
}

struct NEpiProj { bf16* out; const float* SS; int ldc;
    __device__ __forceinline__ float rowscale(int row) const { return rstd_of(SS, row); }
    __device__ __forceinline__ float tile4(int row, int col, const float (&a)[4], float rs) const {
#pragma unroll
        for (int j = 0; j < 4; ++j) out[(size_t)row * ldc + col + j] = (bf16)f2bf(a[j] * rs);
        return 0.f; }
    __device__ __forceinline__ void rowstat(int, int, float) const {} };
struct NEpiRes { const float* xin; float* xout; bf16* xb; float* SS;
    __device__ __forceinline__ float rowscale(int) const { return 1.f; }
    __device__ __forceinline__ float tile4(int row, int col, const float (&a)[4], float) const { float sq = 0.f;
#pragma unroll
        for (int j = 0; j < 4; ++j) { const float v = xin[(size_t)row * DM + col + j] + a[j]; xout[(size_t)row * DM + col + j] = v; xb[(size_t)row * DM + col + j] = (bf16)f2bf(v); sq += v * v; }
        return sq; }
    __device__ __forceinline__ void rowstat(int row, int slot, float s) const { SS[(size_t)row * 16 + slot] = s; } };
struct NEpiMlp1 { bf16* H; const float* SS;
    __device__ __forceinline__ float rowscale(int row) const { return rstd_of(SS, row); }
    __device__ __forceinline__ float tile4(int row, int col, const float (&a)[4], float rs) const {
#pragma unroll
        for (int j = 0; j < 4; ++j) { float v = a[j] * rs; v = v > 0.f ? v : 0.f; H[(size_t)row * FF + col + j] = (bf16)f2bf(v * v); }
        return 0.f; }
    __device__ __forceinline__ void rowstat(int, int, float) const {} };

template <class Epi>
__device__ __forceinline__ void ngemm_phase(char* lds, const bf16* A, const bf16* Bt, int N, int K, const Epi& E, int tid, int bid, int G) {
    const int sub = tid >> 8, t = tid & 255, tx = t & 15, ty = t >> 4;
    float* As = (float*)lds + sub * (2 * 32 * 65); float* Bs = As + 32 * 65;
    const int nbx = N / 64, npairs = nbx * (M / 64) / 2;
    const int lr = t >> 2, lk = (t & 3) * 8;
    for (int it = bid; it < npairs; it += G) {
        const int tile = it * 2 + sub; const int m0 = (tile / nbx) * 64, n0 = (tile % nbx) * 64;
        float acc[4][4] = {};
        for (int k0 = 0; k0 < K; k0 += 32) {
            const v4u a = *(const v4u*)(A + (size_t)(m0 + lr) * K + k0 + lk);
            const v4u b = *(const v4u*)(Bt + (size_t)(n0 + lr) * K + k0 + lk);
            __syncthreads();
            const unsigned au[4] = {a.x, a.y, a.z, a.w}, bu[4] = {b.x, b.y, b.z, b.w};
#pragma unroll
            for (int i = 0; i < 4; ++i) { As[(lk + 2 * i) * 65 + lr] = bf2f(au[i] & 0xffff); As[(lk + 2 * i + 1) * 65 + lr] = bf2f(au[i] >> 16); Bs[(lk + 2 * i) * 65 + lr] = bf2f(bu[i] & 0xffff); Bs[(lk + 2 * i + 1) * 65 + lr] = bf2f(bu[i] >> 16); }
            __syncthreads();
#pragma unroll 8
            for (int k = 0; k < 32; ++k) {
                float av[4], bv[4];
#pragma unroll
                for (int i = 0; i < 4; ++i) { av[i] = As[k * 65 + ty * 4 + i]; bv[i] = Bs[k * 65 + tx * 4 + i]; }
#pragma unroll
                for (int i = 0; i < 4; ++i)
#pragma unroll
                    for (int j = 0; j < 4; ++j) acc[i][j] += av[i] * bv[j];
            }
        }
#pragma unroll
        for (int i = 0; i < 4; ++i) { const int row = m0 + ty * 4 + i; const float rs = E.rowscale(row);
            float sq = E.tile4(row, n0 + tx * 4, acc[i], rs);
            sq += __shfl_xor(sq, 1); sq += __shfl_xor(sq, 2); sq += __shfl_xor(sq, 4); sq += __shfl_xor(sq, 8);
            if (tx == 0) E.rowstat(row, n0 / 64, sq); }
    }
    __syncthreads();
}

__device__ __forceinline__ float gelu_tanh(float x) { const float u = 0.7978845608028654f * (x + 0.044715f * x * x * x); return 0.5f * x * (1.0f + tanhf(u)); }
__device__ __forceinline__ void ncompress_phase(const PP& p, char* lds, int tid, int bid, int G) {
    const int sub = tid >> 7, t = tid & 127;
    float* a = (float*)lds + sub * (2048 + 128); float* hid = a + 2048;
    for (int it = bid; it < 1024; it += G) {
        int id = it * 4 + sub; const int c = id % 512; id /= 512; const int g = id % 2; id /= 2; const int b = id % 2; const int kv = id / 2;
        bf16* outp = (kv ? p.VCMP : p.KCMP) + ((size_t)((b * 2 + g) * 512 + c)) * 64;
        const bool live = c < NCMP; const int cc = live ? c : 0;
        const int col = (kv ? C_VC : C_KC) + g * 64;
        __syncthreads();
        for (int i = t; i < 2048; i += 128) { const int j = i >> 6, d = i & 63; a[i] = bf2f(p.PROJ[(size_t)(b * SEQ + 16 * cc + j) * NP0 + col + d]); }
        __syncthreads();
        const bf16* w1 = (kv ? p.CW1V : p.CW1K) + (size_t)t * 2048; float s = p.CMPB[kv * 128 + t];
        for (int k = 0; k < 2048; k += 8) { const v4u u = *(const v4u*)(w1 + k);
            s += a[k] * bf2f(u.x & 0xffff) + a[k + 1] * bf2f(u.x >> 16) + a[k + 2] * bf2f(u.y & 0xffff) + a[k + 3] * bf2f(u.y >> 16) + a[k + 4] * bf2f(u.z & 0xffff) + a[k + 5] * bf2f(u.z >> 16) + a[k + 6] * bf2f(u.w & 0xffff) + a[k + 7] * bf2f(u.w >> 16); }
        hid[t] = bf2f(f2bf(gelu_tanh(s)));
        __syncthreads();
        if (t < 64) { const bf16* w2 = (kv ? p.CW2V : p.CW2K) + (size_t)t * 128; float o = 0.f; for (int n = 0; n < 128; ++n) o += hid[n] * bf2f(w2[n]); outp[t] = live ? (bf16)f2bf(o) : (bf16)0; }
    }
    __syncthreads();
}

template <int NV> struct NAcc { float m, l, o[NV]; };
template <int NV> __device__ __forceinline__ void nacc_init(NAcc<NV>& a) { a.m = -1e30f; a.l = 0.f;
#pragma unroll
    for (int j = 0; j < NV; ++j) a.o[j] = 0.f; }
__device__ __forceinline__ void load_q64(float (&q)[64], const bf16* qp) {
#pragma unroll
    for (int i = 0; i < 8; ++i) { const v4u u = ((const v4u*)qp)[i];
        q[8 * i + 0] = bf2f(u.x & 0xffff); q[8 * i + 1] = bf2f(u.x >> 16); q[8 * i + 2] = bf2f(u.y & 0xffff); q[8 * i + 3] = bf2f(u.y >> 16);
        q[8 * i + 4] = bf2f(u.z & 0xffff); q[8 * i + 5] = bf2f(u.z >> 16); q[8 * i + 6] = bf2f(u.w & 0xffff); q[8 * i + 7] = bf2f(u.w >> 16); }
}
__device__ __forceinline__ float dot64(const float (&q)[64], const bf16* kp) {
    float s = 0.f;
#pragma unroll
    for (int i = 0; i < 8; ++i) { const v4u u = ((const v4u*)kp)[i];
        s += q[8 * i + 0] * bf2f(u.x & 0xffff) + q[8 * i + 1] * bf2f(u.x >> 16) + q[8 * i + 2] * bf2f(u.y & 0xffff) + q[8 * i + 3] * bf2f(u.y >> 16)
           + q[8 * i + 4] * bf2f(u.z & 0xffff) + q[8 * i + 5] * bf2f(u.z >> 16) + q[8 * i + 6] * bf2f(u.w & 0xffff) + q[8 * i + 7] * bf2f(u.w >> 16); }
    return s;
}
template <int NV> __device__ __forceinline__ void ntile(NAcc<NV>& a, const float (&q)[64], const bf16* kp, const bf16* vp, bool valid, float bias, int lane) {
    const float s = valid ? dot64(q, kp) + bias : -INFINITY;
    const float tm = wave_max(s);
    const float mn = fmaxf(a.m, tm), f = exp2f(a.m - mn), pr = exp2f(s - mn);
    a.l = a.l * f + wave_sum(pr); a.m = mn;
#pragma unroll
    for (int j = 0; j < NV; ++j) a.o[j] *= f;
    const unsigned long long vpi = (unsigned long long)(uintptr_t)vp;
    const unsigned vlo = (unsigned)vpi, vhi = (unsigned)(vpi >> 32);
    for (int k = 0; k < 64; ++k) {
        const float pk = __shfl(pr, k);
        const unsigned lo = __shfl(vlo, k), hi = __shfl(vhi, k);
        if (pk != 0.f) { const bf16* vr = (const bf16*)(uintptr_t)(((unsigned long long)hi << 32) | lo);
#pragma unroll
            for (int j = 0; j < NV; ++j) a.o[j] += pk * bf2f(vr[lane + 64 * j]); }
    }
}

__device__ __forceinline__ void nnsa_phase(const PP& p, char* lds, int tid, int bid, int G) {
    const int sub = tid >> 8, t256 = tid & 255, lane = tid & 63, r = t256 >> 6;
    float* base = (float*)lds + sub * (4 * 512 + 4 * 128 + 128 + 16);
    float* sc = base + r * 512; float* imph = base + 4 * 512; float* score = imph + 4 * 128; int* sel = (int*)(score + 128);
    for (int it = bid; it < M * 2 / 2; it += G) {
        int id = it * 2 + sub; const int t = id % SEQ; id /= SEQ; const int g = id % 2; const int b = id / 2;
        const int hh = g * 4 + r; const size_t row = (size_t)b * SEQ + t;
        const float* bl = p.BIASL + hh * 128;
        float q[64]; load_q64(q, p.PROJ + row * NP0 + C_Q + hh * 64);
        const int nvis = t >= 31 ? ((t - 31) / 16 + 1 < NCMP ? (t - 31) / 16 + 1 : NCMP) : 0;
        const bf16* kc = p.KCMP + (size_t)((b * 2 + g) * 512) * 64; const bf16* vc = p.VCMP + (size_t)((b * 2 + g) * 512) * 64;
        __syncthreads();
        float mx = -INFINITY;
        for (int c0 = 0; c0 < nvis; c0 += 64) { const int c = c0 + lane; float s = -INFINITY;
            if (c < nvis) { int rel = t - (16 * c + 31); rel = rel > 127 ? 127 : rel; s = dot64(q, kc + (size_t)c * 64) + bl[rel]; }
            sc[c] = s; mx = fmaxf(mx, s); }
        mx = wave_max(mx);
        float ls = 0.f;
        for (int c0 = 0; c0 < nvis; c0 += 64) { const int c = c0 + lane; const float e = exp2f(sc[c] - mx); sc[c] = e; ls += e; }
        ls = wave_sum(ls);
        const float rl = ls > 0.f ? 1.0f / ls : 0.f;
        for (int c = lane; c < 512; c += 64) sc[c] = c < nvis ? sc[c] * rl : 0.f;
        float oc = 0.f;
        for (int c = 0; c < nvis; ++c) oc += sc[c] * bf2f(vc[(size_t)c * 64 + lane]);
        for (int n = lane; n < 128; n += 64) { float a = ((sc[4 * n] + sc[4 * n + 1]) + sc[4 * n + 2]) + 0.5f * sc[4 * n + 3]; if (n > 0) a += 0.5f * sc[4 * n - 1]; imph[r * 128 + n] = a; }
        __syncthreads();
        const int cur = t >> 6;
        if (t256 < 128) { const int n = t256; const float imp = (imph[n] + imph[128 + n]) + (imph[256 + n] + imph[384 + n]);
            const bool elig = n <= cur, forced = (n == 0) || (n == cur) || (n == cur - 1);
            score[n] = elig ? imp + (forced ? 1000.f : 0.f) : -1.0f; }
        __syncthreads();
        if (t256 < 128) { const int n = t256; const float v = score[n]; int rank = 0;
            for (int j = 0; j < 128; ++j) { const float u = score[j]; rank += (u > v || (u == v && j < n)) ? 1 : 0; }
            if (rank < 16) sel[rank] = n; }
        __syncthreads();
        NAcc<1> as; nacc_init(as);
        for (int i = 0; i < 16; ++i) { const int n = sel[i]; const int pos = 64 * n + lane; const int rel = t - pos; const size_t kr = (size_t)b * SEQ + pos;
            if (64 * n > t) continue;
            ntile<1>(as, q, p.PROJ + kr * NP0 + C_KS + g * 64, p.PROJ + kr * NP0 + C_VS + g * 64, rel >= 0, bl[rel < 0 ? 0 : (rel > 127 ? 127 : rel)], lane); }
        NAcc<1> aw; nacc_init(aw);
        for (int n = cur - 8; n <= cur; ++n) { if (n < 0) continue; const int pos = 64 * n + lane; const int rel = t - pos; const size_t kr = (size_t)b * SEQ + pos;
            ntile<1>(aw, q, p.PROJ + kr * NP0 + C_KW + g * 64, p.PROJ + kr * NP0 + C_VW + g * 64, rel >= 0 && rel < 512, bl[rel < 0 ? 0 : (rel > 127 ? 127 : rel)], lane); }
        const float g0 = p.GATES[row * 24 + hh], g1 = p.GATES[row * 24 + 8 + hh], g2 = p.GATES[row * 24 + 16 + hh];
        const float os = as.l > 0.f ? as.o[0] / as.l : 0.f, ow = aw.l > 0.f ? aw.o[0] / aw.l : 0.f;
        p.OC[row * DM + hh * 64 + lane] = (bf16)f2bf(g0 * oc + g1 * os + g2 * ow);
    }
    __syncthreads();
}

__device__ __forceinline__ void ndiff_phase(const PP& p, char* lds, int tid, int bid, int G) {
    const int sub = tid >> 7, lane = tid & 63, mp = (tid >> 6) & 1;
    float* o2 = (float*)lds + sub * 128;
    for (int it = bid; it < M * 4 / 4; it += G) {
        int id = it * 4 + sub; const int h = id % 4; id /= 4; const int t = id % SEQ; const int b = id / SEQ;
        const size_t row = (size_t)b * SEQ + t; const float* bl = p.BIASL + (8 + h) * 128;
        float q[64]; load_q64(q, p.PROJ + row * NP0 + C_DQ + h * 128 + mp * 64);
        NAcc<2> a; nacc_init(a);
        for (int p0 = 0; p0 <= t; p0 += 64) { const int pos = p0 + lane; const int rel = t - pos; const size_t kr = (size_t)b * SEQ + pos;
            ntile<2>(a, q, p.PROJ + kr * NP0 + C_DK + h * 128 + mp * 64, p.PROJ + kr * NP0 + C_DV + h * 128, rel >= 0, bl[rel < 0 ? 0 : (rel > 127 ? 127 : rel)], lane); }
        const float il = 1.0f / a.l; float v0 = a.o[0] * il, v1 = a.o[1] * il;
        __syncthreads();
        if (mp == 1) { o2[lane] = v0; o2[lane + 64] = v1; }
        __syncthreads();
        if (mp == 0) {
            const float lam = expf(wave_sum(p.lq1[lane] * p.lk1[lane])) - expf(wave_sum(p.lq2[lane] * p.lk2[lane])) + 0.2f;
            v0 -= lam * o2[lane]; v1 -= lam * o2[lane + 64];
            const float ss = wave_sum(v0 * v0 + v1 * v1); const float rs = 1.0f / sqrtf(ss * (1.0f / 128.f) + EPS);
            p.OC[row * DM + 512 + h * 128 + lane] = (bf16)f2bf(v0 * rs * p.subln[lane] * 0.8f);
            p.OC[row * DM + 512 + h * 128 + 64 + lane] = (bf16)f2bf(v1 * rs * p.subln[64 + lane] * 0.8f);
        }
    }
    __syncthreads();
}

__device__ __forceinline__ void nkmean_phase(const PP& p, int tid, int bid, int G) {
    for (int it = bid; it < 64 * 2; it += G) { const int bb = it >> 1, half = it & 1; const int b = bb / 32, n = bb % 32; const int col = half * 512 + tid; float s = 0.f;
        for (int r = 0; r < 256; ++r) s += bf2f(p.PROJ[(size_t)(b * SEQ + n * 256 + r) * NP1 + 1024 + col]);
        p.KMEAN[((size_t)(b * 16 + (col >> 6)) * 32 + n) * 64 + (col & 63)] = s * (1.0f / 256.f); }
}
__device__ __forceinline__ void kmean_from_partials(const PP& p, int tid, int bid, int G) {
    for (int i = bid * NTHR + tid; i < 2 * 16 * 32 * 64; i += G * NTHR) p.KMEAN[i] = (p.KMP[i] + p.KMP[2 * 16 * 32 * 64 + i]) * (1.0f / 256.f);
}
__device__ __forceinline__ void nmoba_phase(const PP& p, int tid, int bid, int G) {
    const int lane = tid & 63, w = tid >> 6;
    for (int it = bid; it < M * 16 / 8; it += G) {
        int id = it * 8 + w; const int h = id % 16; id /= 16; const int t = id % SEQ; const int b = id / SEQ;
        const size_t row = (size_t)b * SEQ + t; const float* bl = p.BIASL + h * 128; const int c = t >> 8;
        float q[64]; load_q64(q, p.PROJ + row * NP1 + h * 64);
        float gate = -1e30f;
        if (lane < 32 && lane < c) { const float* km = p.KMEAN + ((size_t)(b * 16 + h) * 32 + lane) * 64; float s = 0.f;
#pragma unroll
            for (int d = 0; d < 64; ++d) s += q[d] * km[d];
            gate = s; }
        if (lane >= 32) gate = -INFINITY;
        int rank = 0;
        for (int j = 0; j < 32; ++j) { const float u = __shfl(gate, j); rank += (u > gate || (u == gate && j < lane)) ? 1 : 0; }
        const bool chosen = lane < 32 && rank < 3 && lane < c;
        const unsigned long long cm = __ballot(chosen);
        NAcc<1> a; nacc_init(a);
        for (int n = 0; n < c; ++n) { if (!((cm >> n) & 1ull)) continue;
            for (int j = 0; j < 4; ++j) { const int pos = n * 256 + j * 64 + lane; const int rel = t - pos; const size_t kr = (size_t)b * SEQ + pos;
                ntile<1>(a, q, p.PROJ + kr * NP1 + 1024 + h * 64, p.PROJ + kr * NP1 + 2048 + h * 64, true, bl[rel > 127 ? 127 : rel], lane); } }
        for (int j = 0; j < 4; ++j) { const int pos = c * 256 + j * 64 + lane; const int rel = t - pos; const size_t kr = (size_t)b * SEQ + pos;
            if (c * 256 + j * 64 > t) break;
            ntile<1>(a, q, p.PROJ + kr * NP1 + 1024 + h * 64, p.PROJ + kr * NP1 + 2048 + h * 64, rel >= 0, bl[rel < 0 ? 0 : (rel > 127 ? 127 : rel)], lane); }
        p.OC[row * DM + h * 64 + lane] = (bf16)f2bf(a.o[0] / a.l);
    }
}
__device__ __forceinline__ void final_norm_phase(const PP& p, int tid, int bid, int G) {
    const int lane = tid & 63, wave = tid >> 6;
    for (int row = bid * 8 + wave; row < M; row += G * 8) {
        f32x4* xr = (f32x4*)(p.out + (size_t)row * DM) + lane; const f32x4* gr = (const f32x4*)p.norm_final + lane; f32x4 v[4]; float s = 0.f;
#pragma unroll
        for (int j = 0; j < 4; ++j) { v[j] = xr[64 * j]; s += (v[j].x * v[j].x + v[j].y * v[j].y) + (v[j].z * v[j].z + v[j].w * v[j].w); }
        s = wave_sum(s); const float rstd = 1.0f / sqrtf(s * (1.0f / DM) + EPS);
#pragma unroll
        for (int j = 0; j < 4; ++j) { const f32x4 gg = gr[64 * j]; xr[64 * j] = v[j] * rstd * gg; }
    }
}

template <int MODE> __device__ __forceinline__ void gemm_rowscale(char* lds, const bf16* A, const bf16* Bt, int N, int K, bf16* O, const float* SS, float* KMP, int kt_lo, int kt_hi, int tid, int bid, int G) {
#if USE_PG8
    pg8::Gemm g{A, Bt, M, N, K}; pg8::StaticOrder S; S.init(M, N, G, bid);
    pg8::EpiRowScaleBf16<MODE> E{O, SS, KMP, N, kt_lo, kt_hi, 0};
    pg8::gemm_phase<pg8::EpiRowScaleBf16<MODE>, pg8::StaticOrder, true, true>((PG8_LAS unsigned char*)lds, g, S, E);
#else
    if (MODE == 0) ngemm_phase(lds, A, Bt, N, K, NEpiProj{O, SS, N}, tid, bid, G); else ngemm_phase(lds, A, Bt, N, K, NEpiMlp1{O, SS}, tid, bid, G);
#endif
}
__device__ __forceinline__ void gemm_residual(char* lds, const bf16* A, const bf16* Bt, int K, const float* xin, float* xout, bf16* xb, float* SS, int tid, int bid, int G) {
#if USE_PG8
    pg8::Gemm g{A, Bt, M, DM, K}; pg8::StaticOrder S; S.init(M, DM, G, bid);
    pg8::EpiResidual E{xin, xout, xb, SS};
    pg8::gemm_phase<pg8::EpiResidual, pg8::StaticOrder, true, true>((PG8_LAS unsigned char*)lds, g, S, E);
#else
    ngemm_phase(lds, A, Bt, DM, K, NEpiRes{xin, xout, xb, SS}, tid, bid, G);
#endif
}

constexpr int NPHASE = 13;
__global__ void __launch_bounds__(NTHR, 2) mk_fwd(Args args) {
    extern __shared__ __attribute__((aligned(16))) char lds[];
    cg::grid_group grid = cg::this_grid();
    const int tid = threadIdx.x, bid = blockIdx.x, G = gridDim.x;
    unsigned char* ws = args.ws;
    PP p;
    p.x = args.in[0]; p.bias_table = args.in[1]; p.norm_mix = args.in[2]; p.norm_mlp = args.in[3]; p.norm_final = args.in[4]; p.mlp_w1 = args.in[5]; p.mlp_w2 = args.in[6];
    p.ev_w_in = args.in[7]; p.ev_w_out = args.in[8]; p.pos_k = args.in[9]; p.w1_k = args.in[10]; p.w2_k = args.in[11]; p.pos_v = args.in[12]; p.w1_v = args.in[13]; p.w2_v = args.in[14];
    p.lq1 = args.in[15]; p.lk1 = args.in[16]; p.lq2 = args.in[17]; p.lk2 = args.in[18]; p.subln = args.in[19]; p.od_w_in = args.in[20]; p.od_w_out = args.in[21];
    p.out = args.out;
    p.SSA = (float*)(ws + WS_SSA); p.SSB = (float*)(ws + WS_SSB); p.GATES = (float*)(ws + WS_GATES); p.CMPB = (float*)(ws + WS_CMPB); p.BIASL = (float*)(ws + WS_BIASL);
    p.KMEAN = (float*)(ws + WS_KMEAN); p.KMP = (float*)(ws + WS_KMP);
    p.KCMP = (bf16*)(ws + WS_KCMP); p.VCMP = (bf16*)(ws + WS_VCMP);
    p.WIN0 = (bf16*)(ws + WS_WIN0); p.WOUT0 = (bf16*)(ws + WS_WOUT0); p.W1_0 = (bf16*)(ws + WS_W1_0); p.W2_0 = (bf16*)(ws + WS_W2_0);
    p.WIN1 = (bf16*)(ws + WS_WIN1); p.WOUT1 = (bf16*)(ws + WS_WOUT1); p.W1_1 = (bf16*)(ws + WS_W1_1); p.W2_1 = (bf16*)(ws + WS_W2_1);
    p.CW1K = (bf16*)(ws + WS_CW1K); p.CW1V = (bf16*)(ws + WS_CW1V); p.CW2K = (bf16*)(ws + WS_CW2K); p.CW2V = (bf16*)(ws + WS_CW2V);
    p.XB = (bf16*)(ws + WS_XB); p.OC = (bf16*)(ws + WS_OC); p.H = (bf16*)(ws + WS_H); p.PROJ = (bf16*)(ws + WS_PROJ);
    const int lo = args.ph_lo, hi = args.ph_hi;
#define IN(k) (lo <= (k) && (k) < hi)
#define SEAM(k) do { if (IN(k) && IN((k) + 1)) grid.sync(); } while (0)

    if (IN(0)) { p0_prologue(p, lds, tid, bid, G); }
    SEAM(0);
    if (IN(1)) { gemm_rowscale<0>(lds, p.XB, p.WIN0, NP0, DM, p.PROJ, p.SSA, nullptr, 0, 0, tid, bid, G); }
    SEAM(1);
    if (IN(2)) { ncompress_phase(p, lds, tid, bid, G); ndiff_phase(p, lds, tid, bid, G); }
    SEAM(2);
    if (IN(3)) { nnsa_phase(p, lds, tid, bid, G); }
    SEAM(3);
    if (IN(4)) { gemm_residual(lds, p.OC, p.WOUT0, DM, p.x, p.out, p.XB, p.SSB, tid, bid, G); }
    SEAM(4);
    if (IN(5)) { gemm_rowscale<1>(lds, p.XB, p.W1_0, FF, DM, p.H, p.SSB, nullptr, 0, 0, tid, bid, G); }
    SEAM(5);
    if (IN(6)) { gemm_residual(lds, p.H, p.W2_0, FF, p.out, p.out, p.XB, p.SSA, tid, bid, G); }
    SEAM(6);
    if (IN(7)) {
#if USE_PG8
        gemm_rowscale<0>(lds, p.XB, p.WIN1, NP1, DM, p.PROJ, p.SSA, p.KMP, 4, 8, tid, bid, G);
#else
        gemm_rowscale<0>(lds, p.XB, p.WIN1, NP1, DM, p.PROJ, p.SSA, nullptr, 0, 0, tid, bid, G);
        grid.sync();
        nkmean_phase(p, tid, bid, G);
#endif
    }
    SEAM(7);
    if (IN(8)) {
#if USE_PG8
        kmean_from_partials(p, tid, bid, G); grid.sync();
#endif
        nmoba_phase(p, tid, bid, G); }
    SEAM(8);
    if (IN(9)) { gemm_residual(lds, p.OC, p.WOUT1, DM, p.out, p.out, p.XB, p.SSB, tid, bid, G); }
    SEAM(9);
    if (IN(10)) { gemm_rowscale<1>(lds, p.XB, p.W1_1, FF, DM, p.H, p.SSB, nullptr, 0, 0, tid, bid, G); }
    SEAM(10);
    if (IN(11)) { gemm_residual(lds, p.H, p.W2_1, FF, p.out, p.out, p.XB, p.SSA, tid, bid, G); }
    SEAM(11);
    if (IN(12)) { final_norm_phase(p, tid, bid, G); }
#undef IN
#undef SEAM
}

extern "C" void kernel_launch(void* const* d_in, const int* in_sizes, int n_in, void* d_out, int out_size, void* d_ws, size_t ws_size, hipStream_t stream) {
    static int grid = 0;
    if (grid == 0) {
        if (n_in != 22 || out_size != M * DM || ws_size < WS_END) { fprintf(stderr, "kernel_launch: unexpected shapes (n_in %d out %d ws %zu)\n", n_in, out_size, ws_size); grid = -1; return; }
        int dev = 0, cus = 0, per_cu = 0;
        if (hipGetDevice(&dev) != hipSuccess || hipDeviceGetAttribute(&cus, hipDeviceAttributeMultiprocessorCount, dev) != hipSuccess) { grid = -1; return; }
        if (hipFuncSetAttribute((const void*)mk_fwd, hipFuncAttributeMaxDynamicSharedMemorySize, LDS_BYTES) != hipSuccess) { fprintf(stderr, "kernel_launch: hipFuncSetAttribute failed\n"); grid = -1; return; }
        if (hipOccupancyMaxActiveBlocksPerMultiprocessor(&per_cu, (const void*)mk_fwd, NTHR, LDS_BYTES) != hipSuccess || per_cu < 1) { fprintf(stderr, "kernel_launch: occupancy query says %d blocks per CU\n", per_cu); (void)hipGetLastError(); grid = -1; return; }
        grid = cus * 1;
    }
    if (grid < 0) return;
    Args a{};
    for (int i = 0; i < 22; ++i) a.in[i] = (const float*)d_in[i];
    a.out = (float*)d_out; a.ws = (unsigned char*)d_ws; a.ph_lo = 0; a.ph_hi = NPHASE;
    void* kargs[] = {&a};
    hipError_t e = hipLaunchCooperativeKernel((const void*)mk_fwd, dim3(grid), dim3(NTHR), kargs, LDS_BYTES, stream);
    if (e != hipSuccess) fprintf(stderr, "kernel_launch: cooperative launch failed: %s (grid %d)\n", hipGetErrorString(e), grid);
}
```

```cpp
#include <hip/hip_runtime.h>
#include <hip/hip_cooperative_groups.h>
#include <cstdint>
#include <cstdio>

typedef unsigned short bf16;
typedef unsigned v4u __attribute__((ext_vector_type(4)));
typedef float f32x4 __attribute__((ext_vector_type(4)));

constexpr int BATCH = 2, SEQ = 8192, DM = 1024, M = BATCH * SEQ, FF = 4096;
constexpr int NP0 = 2816, NP1 = 3072, EVEN_PROJ = 2840;
constexpr float EPS = 1e-6f;
constexpr float LOG2E = 1.4426950408889634f, C2 = 0.125f * LOG2E;
constexpr int C_Q = 0, C_KC = 512, C_VC = 640, C_KS = 768, C_VS = 896, C_KW = 1024, C_VW = 1152, C_DQ = 1280, C_DK = 1792, C_DV = 2304;
constexpr int NCMP = 511;

constexpr size_t MiB = 1u << 20;
constexpr size_t WS_CTL = 0;
constexpr size_t WS_SSA = 1 * MiB, WS_SSB = 2 * MiB;
constexpr size_t WS_GATES = 3 * MiB;
constexpr size_t WS_KCMP = 4 * MiB + 512 * 1024, WS_VCMP = WS_KCMP + 256 * 1024;
constexpr size_t WS_CMPB = 5 * MiB;
constexpr size_t WS_BIASL = 5 * MiB + 4096;
constexpr size_t WS_KMEAN = 5 * MiB + 256 * 1024;
constexpr size_t WS_WIN0 = 8 * MiB, WS_WOUT0 = 14 * MiB, WS_W1_0 = 16 * MiB, WS_W2_0 = 24 * MiB;
constexpr size_t WS_WIN1 = 32 * MiB, WS_WOUT1 = 38 * MiB, WS_W1_1 = 40 * MiB, WS_W2_1 = 48 * MiB;
constexpr size_t WS_CW1K = 56 * MiB, WS_CW1V = 56 * MiB + 512 * 1024, WS_CW2K = 57 * MiB, WS_CW2V = 57 * MiB + 64 * 1024;
constexpr size_t WS_XB = 58 * MiB, WS_OC = 90 * MiB, WS_H = 122 * MiB, WS_PROJ = 122 * MiB, WS_END = 250 * MiB;

__device__ __forceinline__ unsigned f2bf(float f) { unsigned u = __builtin_bit_cast(unsigned, f); return (u + 0x7fffu + ((u >> 16) & 1u)) >> 16; }
__device__ __forceinline__ float bf2f(unsigned h) { return __builtin_bit_cast(float, h << 16); }
__device__ __forceinline__ unsigned pk2(float lo, float hi) { return f2bf(lo) | (f2bf(hi) << 16); }
__device__ __forceinline__ float wave_sum(float v) {
#pragma unroll
    for (int o = 1; o < 64; o <<= 1) v += __shfl_xor(v, o);
    return v;
}
__device__ __forceinline__ float wave_max(float v) {
#pragma unroll
    for (int o = 1; o < 64; o <<= 1) v = fmaxf(v, __shfl_xor(v, o));
    return v;
}
__device__ __forceinline__ float rstd_of(const float* SS, int row) {
    const f32x4* p = (const f32x4*)(SS + (size_t)row * 16);
    f32x4 a = p[0], b = p[1], c = p[2], d = p[3];
    float s = ((a.x + a.y) + (a.z + a.w)) + ((b.x + b.y) + (b.z + b.w)) + ((c.x + c.y) + (c.z + c.w)) + ((d.x + d.y) + (d.z + d.w));
    return 1.0f / sqrtf(s * (1.0f / DM) + EPS);
}
__device__ __forceinline__ int t5_bucket(int rel) {
    int n = rel < 0 ? 0 : rel;
    if (n < 16) return n;
    int large = 16 + (int)(logf((float)n / 16.0f) / logf(8.0f) * 16.0f);
    return large < 31 ? large : 31;
}

namespace pg8 {
#define PG8_LAS __attribute__((address_space(3)))
typedef unsigned short bf16_t;
typedef short bf16x8 __attribute__((ext_vector_type(8)));
typedef float f32x4 __attribute__((ext_vector_type(4)));
typedef unsigned u32x4 __attribute__((ext_vector_type(4)));
constexpr int BM = 256, BK = 64, HALF = 128, HTB = HALF * BK * 2  , STAGE_BYTES = 8 * HTB, NXCD = 8, WGM = 8;

__host__ __device__ __forceinline__ int lds_byte(int r, int c) { const int st = (r >> 4) * 2 + (c >> 5), rr = r & 15, cc = c & 31, ob = rr * 64 + cc * 2; return st * 1024 + (ob ^ (((ob >> 9) & 1) << 5)); }
__host__ __device__ __forceinline__ void stage_rc(int b, int& R, int& C) { const int st = b / 1024, sb = b % 1024, swz = sb ^ (((sb >> 9) & 1) << 5); R = (st >> 1) * 16 + swz / 64; C = (st & 1) * 32 + (swz % 64) / 2; }
__host__ __device__ __forceinline__ int perm32(int rho) { const int n = rho >> 4, i = rho & 15; return 8 * (i >> 2) + 4 * n + (i & 3); }

struct Unit { int pm, pn; };
struct Gemm { const bf16_t* A; const bf16_t* Bt; int M, N, K; };

struct StaticOrder {
    int nM, nN, nwg, G, c;
    __host__ __device__ void init(int M, int N, int G_, int c_) { nM = M / BM; nN = N / BM; nwg = nM * nN; G = G_; c = c_; }
    __host__ __device__ bool next(int i, Unit& u) const {
        const long L = (long)i * G + c; if (L >= nwg) return false;
        int wgid = (int)L; { const int q = nwg / NXCD, r = nwg % NXCD, xcd = wgid % NXCD, off = wgid / NXCD; wgid = (xcd < r ? xcd * (q + 1) : r * (q + 1) + (xcd - r) * q) + off; }
        const int nig = WGM * nN, gid = wgid / nig, fm = gid * WGM, gsz = (nM - fm) < WGM ? (nM - fm) : WGM;
        u.pm = fm + ((wgid % nig) % gsz); u.pn = (wgid % nig) / gsz; return true;
    }
    __device__ __forceinline__ void a_ready(const Unit&) const {}
    __device__ __forceinline__ void done(const Unit&) const {}
};
__device__ __forceinline__ unsigned cvt_pk_bf16(float lo, float hi) { unsigned r; asm volatile("v_cvt_pk_bf16_f32 %0, %1, %2" : "=v"(r) : "v"(lo), "v"(hi)); return r; }
typedef float f32x2 __attribute__((ext_vector_type(2)));
template <class Epi, class Sched, bool ALIGN_EPI = false, bool SP2 = false>
__device__ __forceinline__ void gemm_phase(PG8_LAS unsigned char* lds, const Gemm g, const Sched& S, const Epi& E) {
    const int tid = threadIdx.x, wid = __builtin_amdgcn_readfirstlane(tid >> 6), lane = tid & 63, wr = wid >> 2, wc = wid & 3, fr = lane & 15, fq = lane >> 4;
    const int K = g.K, nt = K / BK;
    unsigned voffA[2], voffB[2];
#pragma unroll
    for (int i = 0; i < 2; ++i) { int R, C; stage_rc(tid * 16 + i * 8192, R, C); const int Rb = Epi::PERM ? ((R & ~31) + perm32(R & 31)) : R;
        voffA[i] = (unsigned)(R * K + C) * 2u; voffB[i] = (unsigned)(Rb * K + C) * 2u; }
    const size_t kstep = (size_t)(BK * 2);
    const size_t hstep = (size_t)HALF * K * 2;
    const size_t tstep = 2 * hstep;
    const unsigned ldsw = (unsigned)wid * 1024u;
    const int aoff = lds_byte(wr * 64 + fr, fq * 8), boff = lds_byte(wc * 32 + fr, fq * 8);
#define PG8_SA(b, h) (((b) * 2 + (h)) * HTB)
#define PG8_SB(b, h) ((4 + (b) * 2 + (h)) * HTB)
#define PG8_STAGE(bufoff, gbase, voff) do { _Pragma("unroll") for (int _i = 0; _i < 2; ++_i) \
        __builtin_amdgcn_global_load_lds((const unsigned*)((const char*)(gbase) + (voff)[_i]), (PG8_LAS unsigned*)(lds + (bufoff) + ldsw + _i * 8192), 16, 0, 0); } while (0)
#define PG8_LDA(dst, b, h) do { _Pragma("unroll") for (int m = 0; m < 4; ++m) _Pragma("unroll") for (int k = 0; k < 2; ++k) dst[m][k] = *(const PG8_LAS bf16x8*)(lds + PG8_SA(b, h) + aoff + m * 2048 + k * 1024); } while (0)
#define PG8_LDB(dst, b, h) do { _Pragma("unroll") for (int n = 0; n < 2; ++n) _Pragma("unroll") for (int k = 0; k < 2; ++k) dst[n][k] = *(const PG8_LAS bf16x8*)(lds + PG8_SB(b, h) + boff + n * 2048 + k * 1024); } while (0)
#define PG8_MMA(ai, bj, At, Bt) do { __builtin_amdgcn_s_setprio(1); _Pragma("unroll") for (int m = 0; m < 4; ++m) _Pragma("unroll") for (int n = 0; n < 2; ++n) _Pragma("unroll") for (int k = 0; k < 2; ++k) \
        acc[ai][bj][m][n] = __builtin_amdgcn_mfma_f32_16x16x32_bf16(Bt[n][k], At[m][k], acc[ai][bj][m][n], 0, 0, 0); __builtin_amdgcn_s_setprio(0); } while (0)
#define PG8_WAIT_V(n) asm volatile("s_waitcnt vmcnt(" #n ")" ::: "memory")
#define PG8_WAIT_L(n) asm volatile("s_waitcnt lgkmcnt(" #n ")" ::: "memory")
#define PG8_BAR __builtin_amdgcn_s_barrier()
#define PG8_SCHED __builtin_amdgcn_sched_barrier(0)
    Unit cur, nxt; int ui = 0;
    if (!S.next(0, cur)) return;
    f32x4 acc[2][2][4][2];
#pragma unroll
    for (int a = 0; a < 2; ++a)
#pragma unroll
        for (int b = 0; b < 2; ++b)
#pragma unroll
            for (int m = 0; m < 4; ++m)
#pragma unroll
                for (int n = 0; n < 2; ++n) acc[a][b][m][n] = (f32x4){0.f, 0.f, 0.f, 0.f};
    bf16x8 At[4][2], B0[2][2], B1[2][2];
    const char* cA = (const char*)g.A + (size_t)cur.pm * tstep; const char* cB = (const char*)g.Bt + (size_t)cur.pn * tstep;
    S.a_ready(cur);
    if constexpr (SP2) {
        PG8_STAGE(PG8_SB(0, 0), cB, voffB); PG8_STAGE(PG8_SB(0, 1), cB + hstep, voffB); PG8_STAGE(PG8_SA(0, 0), cA, voffA); PG8_STAGE(PG8_SA(0, 1), cA + hstep, voffA);
        if (wr == 1) PG8_BAR;
        PG8_WAIT_V(2); PG8_BAR;
        PG8_STAGE(PG8_SB(1, 0), cB + kstep, voffB); PG8_STAGE(PG8_SA(1, 0), cA + kstep, voffA); PG8_STAGE(PG8_SB(1, 1), cB + hstep + kstep, voffB);
        PG8_WAIT_V(6); PG8_BAR;
    } else {
        PG8_STAGE(PG8_SB(0, 0), cB, voffB); PG8_STAGE(PG8_SA(0, 0), cA, voffA); PG8_STAGE(PG8_SB(0, 1), cB + hstep, voffB); PG8_STAGE(PG8_SA(0, 1), cA + hstep, voffA);
        if (wr == 1) PG8_BAR;
        PG8_WAIT_V(4); PG8_BAR;
        PG8_STAGE(PG8_SB(1, 0), cB + kstep, voffB); PG8_STAGE(PG8_SA(1, 0), cA + kstep, voffA); PG8_STAGE(PG8_SB(1, 1), cB + hstep + kstep, voffB);
        PG8_WAIT_V(6); PG8_BAR;
    }
    for (;;) {
        const bool has_next = S.next(ui + 1, nxt);
        const char* nA = has_next ? (const char*)g.A + (size_t)nxt.pm * tstep : cA; const char* nB = has_next ? (const char*)g.Bt + (size_t)nxt.pn * tstep : cB;
        for (int t = 0; t < nt; t += 2) {
            const bool last = (t == nt - 2);
            const char* a1 = cA + (size_t)(t + 1) * kstep;
            const char* a2 = last ? nA : cA + (size_t)(t + 2) * kstep; const char* b2 = last ? nB : cB + (size_t)(t + 2) * kstep;
            const char* a3 = a2 + kstep; const char* b3 = b2 + kstep;
            if (last && has_next) S.a_ready(nxt);
            if constexpr (SP2) {
            PG8_LDB(B0, 0, 0); PG8_LDB(B1, 0, 1); PG8_SCHED; PG8_LDA(At, 0, 0); PG8_STAGE(PG8_SA(1, 1), a1 + hstep, voffA);
            PG8_WAIT_V(8); PG8_WAIT_L(0); PG8_BAR; PG8_MMA(0, 0, At, B0); PG8_MMA(0, 1, At, B1); PG8_BAR; PG8_SCHED;
            PG8_LDA(At, 0, 1); PG8_STAGE(PG8_SB(0, 0), b2, voffB); PG8_STAGE(PG8_SB(0, 1), b2 + hstep, voffB); PG8_STAGE(PG8_SA(0, 0), a2, voffA);
            PG8_WAIT_V(8); PG8_WAIT_L(0); PG8_BAR; PG8_MMA(1, 0, At, B0); PG8_MMA(1, 1, At, B1); PG8_BAR; PG8_SCHED;
            PG8_LDB(B0, 1, 0); PG8_LDB(B1, 1, 1); PG8_SCHED; PG8_LDA(At, 1, 0); PG8_STAGE(PG8_SA(0, 1), a2 + hstep, voffA);
            PG8_WAIT_V(8); PG8_WAIT_L(0); PG8_BAR; PG8_MMA(0, 0, At, B0); PG8_MMA(0, 1, At, B1); PG8_BAR; PG8_SCHED;
            PG8_LDA(At, 1, 1); PG8_STAGE(PG8_SB(1, 0), b3, voffB); PG8_STAGE(PG8_SB(1, 1), b3 + hstep, voffB); PG8_STAGE(PG8_SA(1, 0), a3, voffA);
            PG8_WAIT_V(8); PG8_WAIT_L(0); PG8_BAR; PG8_MMA(1, 0, At, B0); PG8_MMA(1, 1, At, B1); PG8_BAR; PG8_SCHED;
            } else {
            PG8_LDB(B0, 0, 0); PG8_SCHED; PG8_LDA(At, 0, 0); PG8_STAGE(PG8_SA(1, 1), a1 + hstep, voffA);
            PG8_WAIT_L(8); PG8_BAR; PG8_WAIT_L(0); PG8_MMA(0, 0, At, B0); PG8_BAR; PG8_SCHED;
            PG8_LDB(B1, 0, 1); PG8_STAGE(PG8_SB(0, 0), b2, voffB);
            PG8_BAR; PG8_WAIT_L(0); PG8_MMA(0, 1, At, B1); PG8_BAR;
            PG8_LDA(At, 0, 1); PG8_STAGE(PG8_SA(0, 0), a2, voffA);
            PG8_BAR; PG8_WAIT_L(0); PG8_MMA(1, 0, At, B0); PG8_BAR; PG8_SCHED;
            PG8_STAGE(PG8_SB(0, 1), b2 + hstep, voffB);
            PG8_WAIT_V(6); PG8_BAR; PG8_MMA(1, 1, At, B1); PG8_BAR;
            PG8_LDB(B0, 1, 0); PG8_SCHED; PG8_LDA(At, 1, 0); PG8_STAGE(PG8_SA(0, 1), a2 + hstep, voffA);
            PG8_WAIT_L(8); PG8_BAR; PG8_WAIT_L(0); PG8_MMA(0, 0, At, B0); PG8_BAR; PG8_SCHED;
            PG8_LDB(B1, 1, 1); PG8_STAGE(PG8_SB(1, 0), b3, voffB);
            PG8_BAR; PG8_WAIT_L(0); PG8_MMA(0, 1, At, B1); PG8_BAR;
            PG8_LDA(At, 1, 1); PG8_STAGE(PG8_SA(1, 0), a3, voffA);
            PG8_BAR; PG8_WAIT_L(0); PG8_MMA(1, 0, At, B0); PG8_BAR; PG8_SCHED;
            PG8_STAGE(PG8_SB(1, 1), b3 + hstep, voffB);
            PG8_WAIT_V(6); PG8_BAR; PG8_MMA(1, 1, At, B1); PG8_BAR;
            }
        }
        if constexpr (ALIGN_EPI) { if (wr == 0) PG8_BAR; }
        if constexpr (!Epi::AFTER_DRAIN) { E(acc, cur, wr, wc, fr, fq); S.done(cur); }
        if (!has_next) break;
#pragma unroll
        for (int a = 0; a < 2; ++a)
#pragma unroll
            for (int b = 0; b < 2; ++b)
#pragma unroll
                for (int m = 0; m < 4; ++m)
#pragma unroll
                    for (int n = 0; n < 2; ++n) acc[a][b][m][n] = (f32x4){0.f, 0.f, 0.f, 0.f};
        cur = nxt; cA = nA; cB = nB; ++ui;
        if constexpr (ALIGN_EPI) { if (wr == 1) PG8_BAR; }
    }
    PG8_WAIT_V(0);
    if constexpr (!ALIGN_EPI) { if (wr == 0) PG8_BAR; }
    PG8_BAR;
    if constexpr (Epi::AFTER_DRAIN) { E.fused(acc, cur, wr, wc, fr, fq, lds, wid, lane); S.done(cur); }
#undef PG8_SA
#undef PG8_SB
#undef PG8_STAGE
#undef PG8_LDA
#undef PG8_LDB
#undef PG8_MMA
#undef PG8_WAIT_V
#undef PG8_WAIT_L
#undef PG8_BAR
#undef PG8_SCHED
}
}

namespace pg8 {
template <int MODE> struct EpiRowScaleBf16 {
    static constexpr bool PERM = true, AFTER_DRAIN = false;
    bf16_t* O; const float* SS; float* KMP; int ldc, kt_lo, kt_hi, pad;
    __device__ __forceinline__ void operator()(const f32x4 (&acc)[2][2][4][2], const Unit& u, int wr, int wc, int fr, int fq) const {
        const int row0 = u.pm * BM + wr * 64 + fr, col0 = u.pn * BM + wc * 32 + 8 * fq;
        const bool do_km = (u.pn >= kt_lo && u.pn < kt_hi);
        float cs[2][8];
#pragma unroll
        for (int bj = 0; bj < 2; ++bj)
#pragma unroll
            for (int e = 0; e < 8; ++e) cs[bj][e] = 0.f;
#pragma unroll
        for (int ai = 0; ai < 2; ++ai)
#pragma unroll
            for (int m = 0; m < 4; ++m) { const int row = row0 + ai * HALF + m * 16; const float rs = rstd_of(SS, row); bf16_t* rowp = O + (size_t)row * ldc + col0;
#pragma unroll
                for (int bj = 0; bj < 2; ++bj) { f32x4 v0 = acc[ai][bj][m][0] * rs, v1 = acc[ai][bj][m][1] * rs;
                    if (MODE == 1) {
#pragma unroll
                        for (int e = 0; e < 4; ++e) { float a = v0[e] > 0.f ? v0[e] : 0.f; v0[e] = a * a; float b = v1[e] > 0.f ? v1[e] : 0.f; v1[e] = b * b; } }
                    if (MODE == 0 && do_km) {
#pragma unroll
                        for (int e = 0; e < 4; ++e) { cs[bj][e] += v0[e]; cs[bj][4 + e] += v1[e]; } }
                    u32x4 w; w.x = cvt_pk_bf16(v0[0], v0[1]); w.y = cvt_pk_bf16(v0[2], v0[3]); w.z = cvt_pk_bf16(v1[0], v1[1]); w.w = cvt_pk_bf16(v1[2], v1[3]);
                    *(u32x4*)(rowp + bj * HALF) = w; } }
        if (MODE == 0 && do_km) {
            const int b = u.pm >> 5, blk = u.pm & 31;
#pragma unroll
            for (int bj = 0; bj < 2; ++bj)
#pragma unroll
                for (int e = 0; e < 8; ++e) { float s = cs[bj][e]; s += __shfl_xor(s, 1); s += __shfl_xor(s, 2); s += __shfl_xor(s, 4); s += __shfl_xor(s, 8);
                    if (fr == 0) { const int kc = (u.pn - kt_lo) * BM + bj * HALF + wc * 32 + 8 * fq + e;
                        KMP[(((size_t)wr * 2 + b) * 16 + (kc >> 6)) * 32 * 64 + (size_t)blk * 64 + (kc & 63)] = s; } }
        }
    }
};
struct EpiResidual {
    static constexpr bool PERM = false, AFTER_DRAIN = false;
    const float* xin; float* xout; bf16_t* xb; float* SS;
    __device__ __forceinline__ void operator()(const f32x4 (&acc)[2][2][4][2], const Unit& u, int wr, int wc, int fr, int fq) const {
        typedef unsigned u32x2v __attribute__((ext_vector_type(2)));
        const int col0 = u.pn * BM + wc * 32 + 4 * fq;
#pragma unroll
        for (int ai = 0; ai < 2; ++ai)
#pragma unroll
            for (int m = 0; m < 4; ++m) { const int row = u.pm * BM + ai * HALF + wr * 64 + m * 16 + fr; const size_t off = (size_t)row * DM + col0; float sq = 0.f;
#pragma unroll
                for (int bj = 0; bj < 2; ++bj)
#pragma unroll
                    for (int n = 0; n < 2; ++n) { const f32x4 bs = *(const f32x4*)(xin + off + bj * HALF + n * 16); const f32x4 o = bs + acc[ai][bj][m][n];
                        *(f32x4*)(xout + off + bj * HALF + n * 16) = o; sq += (o[0] * o[0] + o[1] * o[1]) + (o[2] * o[2] + o[3] * o[3]);
                        u32x2v w; w.x = cvt_pk_bf16(o[0], o[1]); w.y = cvt_pk_bf16(o[2], o[3]); *(u32x2v*)(xb + off + bj * HALF + n * 16) = w; }
                sq += __shfl_xor(sq, 16); sq += __shfl_xor(sq, 32);
                if (fq == 0) SS[(size_t)row * 16 + u.pn * 4 + wc] = sq; }
    }
};
}

namespace cg = cooperative_groups;
constexpr int NTHR = 512;
constexpr int LDS_BYTES = 147456;
constexpr size_t WS_KMP = 6 * MiB;
#ifndef USE_MFMA_MOBA
#define USE_MFMA_MOBA 1
#endif
#ifndef USE_MFMA_DIFF
#define USE_MFMA_DIFF 1
#endif
#ifndef USE_MFMA_NSA
#define USE_MFMA_NSA 1
#endif
#ifndef USE_PG8
#define USE_PG8 1
#endif

struct Args { const float* in[22]; float* out; unsigned char* ws; int ph_lo, ph_hi; };

struct PP {
    const float *x, *bias_table, *norm_mix, *norm_mlp, *norm_final, *mlp_w1, *mlp_w2, *ev_w_in, *ev_w_out, *pos_k, *w1_k, *w2_k, *pos_v, *w1_v, *w2_v, *lq1, *lk1, *lq2, *lk2, *subln, *od_w_in, *od_w_out;
    float* out; float *SSA, *SSB, *GATES, *CMPB, *BIASL, *KMEAN, *KMP;
    bf16 *KCMP, *VCMP, *WIN0, *WOUT0, *W1_0, *W2_0, *WIN1, *WOUT1, *W1_1, *W2_1, *CW1K, *CW1V, *CW2K, *CW2V, *XB, *OC, *H, *PROJ;
};

struct WJob { const float* W; bf16* WT; const float* kscale; int K, Nsrc, Ndst, kind; };
__device__ __forceinline__ void transpose_item(const WJob& J, int item, float* scr, int lane) {
    const int nblk = J.Ndst / 32, kb = item / nblk, nb = item % nblk, k0 = 64 * kb, n0 = 32 * nb;
    int s0 = n0; float cs = 1.0f;
    if (J.kind == 1) { s0 = n0 < 1280 ? n0 : n0 + 24; if (n0 < 512 || (n0 >= C_DQ && n0 < C_DK)) cs = C2; }
    if (J.kind == 2) { if (n0 < 1024) cs = C2; }
#pragma unroll 8
    for (int i = 0; i < 32; ++i) { const int kk = 2 * i + (lane >> 5); scr[kk * 33 + (lane & 31)] = J.W[(size_t)(k0 + kk) * J.Nsrc + s0 + (lane & 31)]; }
    __builtin_amdgcn_s_waitcnt(0xC07F); asm volatile("" ::: "memory");
    const int c = lane & 7;
    float ks[8];
#pragma unroll
    for (int i = 0; i < 8; ++i) ks[i] = (J.kscale ? J.kscale[k0 + 8 * c + i] : 1.0f) * cs;
#pragma unroll
    for (int j = 0; j < 4; ++j) { const int n = (lane >> 3) + 8 * j; const float* s = scr + (8 * c) * 33 + n;
        v4u o; o.x = pk2(s[0 * 33] * ks[0], s[1 * 33] * ks[1]); o.y = pk2(s[2 * 33] * ks[2], s[3 * 33] * ks[3]); o.z = pk2(s[4 * 33] * ks[4], s[5 * 33] * ks[5]); o.w = pk2(s[6 * 33] * ks[6], s[7 * 33] * ks[7]);
        *(v4u*)(J.WT + (size_t)(n0 + n) * J.K + k0 + 8 * c) = o; }
    __builtin_amdgcn_s_waitcnt(0xC07F); asm volatile("" ::: "memory");
}
__device__ __forceinline__ void job_items(const WJob& J, int& base, int gw, int NGW, float* scr, int lane) {
    const int nit = (J.K / 64) * (J.Ndst / 32);
    const int first = ((gw - base) % NGW + NGW) % NGW;
    for (int it = first; it < nit; it += NGW) transpose_item(J, it, scr, lane);
    base += nit;
}
constexpr int WG_PITCH = 1028;
__device__ __forceinline__ void p0_prologue(const PP& p, char* lds, int tid, int bid, int G) {
    const int lane = tid & 63, wave = tid >> 6;
    {
        float* scr = (float*)lds + wave * 64 * 33;
        const int gw = bid * 8 + wave, NGW = G * 8; int base = 0;
        job_items(WJob{p.ev_w_in, p.WIN0, p.norm_mix, DM, EVEN_PROJ, NP0, 1}, base, gw, NGW, scr, lane);
        job_items(WJob{p.ev_w_out, p.WOUT0, nullptr, DM, DM, DM, 0}, base, gw, NGW, scr, lane);
        job_items(WJob{p.mlp_w1, p.W1_0, p.norm_mlp, DM, FF, FF, 0}, base, gw, NGW, scr, lane);
        job_items(WJob{p.mlp_w2, p.W2_0, nullptr, FF, DM, DM, 0}, base, gw, NGW, scr, lane);
        job_items(WJob{p.od_w_in, p.WIN1, p.norm_mix + DM, DM, NP1, NP1, 2}, base, gw, NGW, scr, lane);
        job_items(WJob{p.od_w_out, p.WOUT1, nullptr, DM, DM, DM, 0}, base, gw, NGW, scr, lane);
        job_items(WJob{p.mlp_w1 + (size_t)DM * FF, p.W1_1, p.norm_mlp + DM, DM, FF, FF, 0}, base, gw, NGW, scr, lane);
        job_items(WJob{p.mlp_w2 + (size_t)DM * FF, p.W2_1, nullptr, FF, DM, DM, 0}, base, gw, NGW, scr, lane);
        job_items(WJob{p.w1_k, p.CW1K, nullptr, 2048, 128, 128, 0}, base, gw, NGW, scr, lane);
        job_items(WJob{p.w1_v, p.CW1V, nullptr, 2048, 128, 128, 0}, base, gw, NGW, scr, lane);
        job_items(WJob{p.w2_k, p.CW2K, nullptr, 128, 64, 64, 0}, base, gw, NGW, scr, lane);
        job_items(WJob{p.w2_v, p.CW2V, nullptr, 128, 64, 64, 0}, base, gw, NGW, scr, lane);
    }
    __syncthreads();
    if (bid == 0) { for (int i = tid; i < 16 * 128; i += NTHR) { const int h = i >> 7, rel = i & 127; p.BIASL[i] = p.bias_table[t5_bucket(rel) * 16 + h] * LOG2E; } }
    if (bid == 1 % G || bid == 2 % G) {
        for (int which = 0; which < 2; ++which) { if (bid != (1 + which) % G) continue;
            const float* pos = which == 0 ? p.pos_k : p.pos_v; const float* w1 = which == 0 ? p.w1_k : p.w1_v;
            float* part = (float*)lds; const int n = tid & 127, pr = tid >> 7; float s = 0.f;
            for (int kk = pr * 512; kk < pr * 512 + 512; ++kk) s += pos[kk] * w1[(size_t)kk * 128 + n];
            part[pr * 128 + n] = s; __syncthreads();
            if (tid < 128) p.CMPB[which * 128 + tid] = (part[tid] + part[128 + tid]) + (part[256 + tid] + part[384 + tid]);
            __syncthreads(); }
    }
    __syncthreads();
    float* wg = (float*)lds;
    for (int idx = tid; idx < 24 * 1024; idx += NTHR) { const int k = idx / 24, j = idx % 24; wg[j * WG_PITCH + k] = p.ev_w_in[(size_t)k * EVEN_PROJ + 1280 + j] * p.norm_mix[k]; }
    __syncthreads();
    for (int row = bid * 8 + wave; row < M; row += G * 8) {
        const f32x4* xr = (const f32x4*)(p.x + (size_t)row * DM) + lane;
        f32x4 v[4]; float s = 0.f;
#pragma unroll
        for (int j = 0; j < 4; ++j) { v[j] = xr[64 * j]; s += (v[j].x * v[j].x + v[j].y * v[j].y) + (v[j].z * v[j].z + v[j].w * v[j].w); }
        s = wave_sum(s);
        const float rstd = 1.0f / sqrtf(s * (1.0f / DM) + EPS);
        unsigned long long* o8 = (unsigned long long*)(p.XB + (size_t)row * DM) + lane;
#pragma unroll
        for (int j = 0; j < 4; ++j) o8[64 * j] = (unsigned long long)pk2(v[j].x, v[j].y) | ((unsigned long long)pk2(v[j].z, v[j].w) << 32);
        if (lane < 16) p.SSA[(size_t)row * 16 + lane] = lane == 0 ? s : 0.f;
        float gsum = 0.f;
#pragma unroll 1
        for (int g = 0; g < 24; ++g) {
            float a = 0.f;
#pragma unroll
            for (int j = 0; j < 4; ++j) { const f32x4 w = *(const f32x4*)(wg + g * WG_PITCH + 256 * j + 4 * lane); a += (v[j].x * w.x + v[j].y * w.y) + (v[j].z * w.z + v[j].w * w.w); }
            a = wave_sum(a);
            if (lane == g) gsum = a;
        }
        if (lane < 24) p.GATES[(size_t)row * 24 + lane] = 1.0f / (1.0f + expf(-gsum * rstd));
    }
    __syncthreads();
}

struct NEpiProj { bf16* out; const float* SS; int ldc;
    __device__ __forceinline__ float rowscale(int row) const { return rstd_of(SS, row); }
    __device__ __forceinline__ float tile4(int row, int col, const float (&a)[4], float rs) const {
#pragma unroll
        for (int j = 0; j < 4; ++j) out[(size_t)row * ldc + col + j] = (bf16)f2bf(a[j] * rs);
        return 0.f; }
    __device__ __forceinline__ void rowstat(int, int, float) const {} };
struct NEpiRes { const float* xin; float* xout; bf16* xb; float* SS;
    __device__ __forceinline__ float rowscale(int) const { return 1.f; }
    __device__ __forceinline__ float tile4(int row, int col, const float (&a)[4], float) const { float sq = 0.f;
#pragma unroll
        for (int j = 0; j < 4; ++j) { const float v = xin[(size_t)row * DM + col + j] + a[j]; xout[(size_t)row * DM + col + j] = v; xb[(size_t)row * DM + col + j] = (bf16)f2bf(v); sq += v * v; }
        return sq; }
    __device__ __forceinline__ void rowstat(int row, int slot, float s) const { SS[(size_t)row * 16 + slot] = s; } };
struct NEpiMlp1 { bf16* H; const float* SS;
    __device__ __forceinline__ float rowscale(int row) const { return rstd_of(SS, row); }
    __device__ __forceinline__ float tile4(int row, int col, const float (&a)[4], float rs) const {
#pragma unroll
        for (int j = 0; j < 4; ++j) { float v = a[j] * rs; v = v > 0.f ? v : 0.f; H[(size_t)row * FF + col + j] = (bf16)f2bf(v * v); }
        return 0.f; }
    __device__ __forceinline__ void rowstat(int, int, float) const {} };

template <class Epi>
__device__ __forceinline__ void ngemm_phase(char* lds, const bf16* A, const bf16* Bt, int N, int K, const Epi& E, int tid, int bid, int G) {
    const int sub = tid >> 8, t = tid & 255, tx = t & 15, ty = t >> 4;
    float* As = (float*)lds + sub * (2 * 32 * 65); float* Bs = As + 32 * 65;
    const int nbx = N / 64, npairs = nbx * (M / 64) / 2;
    const int lr = t >> 2, lk = (t & 3) * 8;
    for (int it = bid; it < npairs; it += G) {
        const int tile = it * 2 + sub; const int m0 = (tile / nbx) * 64, n0 = (tile % nbx) * 64;
        float acc[4][4] = {};
        for (int k0 = 0; k0 < K; k0 += 32) {
            const v4u a = *(const v4u*)(A + (size_t)(m0 + lr) * K + k0 + lk);
            const v4u b = *(const v4u*)(Bt + (size_t)(n0 + lr) * K + k0 + lk);
            __syncthreads();
            const unsigned au[4] = {a.x, a.y, a.z, a.w}, bu[4] = {b.x, b.y, b.z, b.w};
#pragma unroll
            for (int i = 0; i < 4; ++i) { As[(lk + 2 * i) * 65 + lr] = bf2f(au[i] & 0xffff); As[(lk + 2 * i + 1) * 65 + lr] = bf2f(au[i] >> 16); Bs[(lk + 2 * i) * 65 + lr] = bf2f(bu[i] & 0xffff); Bs[(lk + 2 * i + 1) * 65 + lr] = bf2f(bu[i] >> 16); }
            __syncthreads();
#pragma unroll 8
            for (int k = 0; k < 32; ++k) {
                float av[4], bv[4];
#pragma unroll
                for (int i = 0; i < 4; ++i) { av[i] = As[k * 65 + ty * 4 + i]; bv[i] = Bs[k * 65 + tx * 4 + i]; }
#pragma unroll
                for (int i = 0; i < 4; ++i)
#pragma unroll
                    for (int j = 0; j < 4; ++j) acc[i][j] += av[i] * bv[j];
            }
        }
#pragma unroll
        for (int i = 0; i < 4; ++i) { const int row = m0 + ty * 4 + i; const float rs = E.rowscale(row);
            float sq = E.tile4(row, n0 + tx * 4, acc[i], rs);
            sq += __shfl_xor(sq, 1); sq += __shfl_xor(sq, 2); sq += __shfl_xor(sq, 4); sq += __shfl_xor(sq, 8);
            if (tx == 0) E.rowstat(row, n0 / 64, sq); }
    }
    __syncthreads();
}

__device__ __forceinline__ float gelu_tanh(float x) { const float u = 0.7978845608028654f * (x + 0.044715f * x * x * x); return 0.5f * x * (1.0f + tanhf(u)); }
__device__ __forceinline__ void ncompress_phase(const PP& p, char* lds, int tid, int bid, int G) {
    const int sub = tid >> 7, t = tid & 127;
    float* a = (float*)lds + sub * (2048 + 128); float* hid = a + 2048;
    for (int it = bid; it < 1024; it += G) {
        int id = it * 4 + sub; const int c = id % 512; id /= 512; const int g = id % 2; id /= 2; const int b = id % 2; const int kv = id / 2;
        bf16* outp = (kv ? p.VCMP : p.KCMP) + ((size_t)((b * 2 + g) * 512 + c)) * 64;
        const bool live = c < NCMP; const int cc = live ? c : 0;
        const int col = (kv ? C_VC : C_KC) + g * 64;
        __syncthreads();
        for (int i = t; i < 2048; i += 128) { const int j = i >> 6, d = i & 63; a[i] = bf2f(p.PROJ[(size_t)(b * SEQ + 16 * cc + j) * NP0 + col + d]); }
        __syncthreads();
        const bf16* w1 = (kv ? p.CW1V : p.CW1K) + (size_t)t * 2048; float s = p.CMPB[kv * 128 + t];
        for (int k = 0; k < 2048; k += 8) { const v4u u = *(const v4u*)(w1 + k);
            s += a[k] * bf2f(u.x & 0xffff) + a[k + 1] * bf2f(u.x >> 16) + a[k + 2] * bf2f(u.y & 0xffff) + a[k + 3] * bf2f(u.y >> 16) + a[k + 4] * bf2f(u.z & 0xffff) + a[k + 5] * bf2f(u.z >> 16) + a[k + 6] * bf2f(u.w & 0xffff) + a[k + 7] * bf2f(u.w >> 16); }
        hid[t] = bf2f(f2bf(gelu_tanh(s)));
        __syncthreads();
        if (t < 64) { const bf16* w2 = (kv ? p.CW2V : p.CW2K) + (size_t)t * 128; float o = 0.f; for (int n = 0; n < 128; ++n) o += hid[n] * bf2f(w2[n]); outp[t] = live ? (bf16)f2bf(o) : (bf16)0; }
    }
    __syncthreads();
}

template <int NV> struct NAcc { float m, l, o[NV]; };
template <int NV> __device__ __forceinline__ void nacc_init(NAcc<NV>& a) { a.m = -1e30f; a.l = 0.f;
#pragma unroll
    for (int j = 0; j < NV; ++j) a.o[j] = 0.f; }
__device__ __forceinline__ void load_q64(float (&q)[64], const bf16* qp) {
#pragma unroll
    for (int i = 0; i < 8; ++i) { const v4u u = ((const v4u*)qp)[i];
        q[8 * i + 0] = bf2f(u.x & 0xffff); q[8 * i + 1] = bf2f(u.x >> 16); q[8 * i + 2] = bf2f(u.y & 0xffff); q[8 * i + 3] = bf2f(u.y >> 16);
        q[8 * i + 4] = bf2f(u.z & 0xffff); q[8 * i + 5] = bf2f(u.z >> 16); q[8 * i + 6] = bf2f(u.w & 0xffff); q[8 * i + 7] = bf2f(u.w >> 16); }
}
__device__ __forceinline__ float dot64(const float (&q)[64], const bf16* kp) {
    float s = 0.f;
#pragma unroll
    for (int i = 0; i < 8; ++i) { const v4u u = ((const v4u*)kp)[i];
        s += q[8 * i + 0] * bf2f(u.x & 0xffff) + q[8 * i + 1] * bf2f(u.x >> 16) + q[8 * i + 2] * bf2f(u.y & 0xffff) + q[8 * i + 3] * bf2f(u.y >> 16)
           + q[8 * i + 4] * bf2f(u.z & 0xffff) + q[8 * i + 5] * bf2f(u.z >> 16) + q[8 * i + 6] * bf2f(u.w & 0xffff) + q[8 * i + 7] * bf2f(u.w >> 16); }
    return s;
}
template <int NV> __device__ __forceinline__ void ntile(NAcc<NV>& a, const float (&q)[64], const bf16* kp, const bf16* vp, bool valid, float bias, int lane) {
    const float s = valid ? dot64(q, kp) + bias : -INFINITY;
    const float tm = wave_max(s);
    const float mn = fmaxf(a.m, tm), f = exp2f(a.m - mn), pr = exp2f(s - mn);
    a.l = a.l * f + wave_sum(pr); a.m = mn;
#pragma unroll
    for (int j = 0; j < NV; ++j) a.o[j] *= f;
    const unsigned long long vpi = (unsigned long long)(uintptr_t)vp;
    const unsigned vlo = (unsigned)vpi, vhi = (unsigned)(vpi >> 32);
    for (int k = 0; k < 64; ++k) {
        const float pk = __shfl(pr, k);
        const unsigned lo = __shfl(vlo, k), hi = __shfl(vhi, k);
        if (pk != 0.f) { const bf16* vr = (const bf16*)(uintptr_t)(((unsigned long long)hi << 32) | lo);
#pragma unroll
            for (int j = 0; j < NV; ++j) a.o[j] += pk * bf2f(vr[lane + 64 * j]); }
    }
}

__device__ __forceinline__ void nnsa_phase(const PP& p, char* lds, int tid, int bid, int G) {
    const int sub = tid >> 8, t256 = tid & 255, lane = tid & 63, r = t256 >> 6;
    float* base = (float*)lds + sub * (4 * 512 + 4 * 128 + 128 + 16);
    float* sc = base + r * 512; float* imph = base + 4 * 512; float* score = imph + 4 * 128; int* sel = (int*)(score + 128);
    for (int it = bid; it < M * 2 / 2; it += G) {
        int id = it * 2 + sub; const int t = id % SEQ; id /= SEQ; const int g = id % 2; const int b = id / 2;
        const int hh = g * 4 + r; const size_t row = (size_t)b * SEQ + t;
        const float* bl = p.BIASL + hh * 128;
        float q[64]; load_q64(q, p.PROJ + row * NP0 + C_Q + hh * 64);
        const int nvis = t >= 31 ? ((t - 31) / 16 + 1 < NCMP ? (t - 31) / 16 + 1 : NCMP) : 0;
        const bf16* kc = p.KCMP + (size_t)((b * 2 + g) * 512) * 64; const bf16* vc = p.VCMP + (size_t)((b * 2 + g) * 512) * 64;
        __syncthreads();
        float mx = -INFINITY;
        for (int c0 = 0; c0 < nvis; c0 += 64) { const int c = c0 + lane; float s = -INFINITY;
            if (c < nvis) { int rel = t - (16 * c + 31); rel = rel > 127 ? 127 : rel; s = dot64(q, kc + (size_t)c * 64) + bl[rel]; }
            sc[c] = s; mx = fmaxf(mx, s); }
        mx = wave_max(mx);
        float ls = 0.f;
        for (int c0 = 0; c0 < nvis; c0 += 64) { const int c = c0 + lane; const float e = exp2f(sc[c] - mx); sc[c] = e; ls += e; }
        ls = wave_sum(ls);
        const float rl = ls > 0.f ? 1.0f / ls : 0.f;
        for (int c = lane; c < 512; c += 64) sc[c] = c < nvis ? sc[c] * rl : 0.f;
        float oc = 0.f;
        for (int c = 0; c < nvis; ++c) oc += sc[c] * bf2f(vc[(size_t)c * 64 + lane]);
        for (int n = lane; n < 128; n += 64) { float a = ((sc[4 * n] + sc[4 * n + 1]) + sc[4 * n + 2]) + 0.5f * sc[4 * n + 3]; if (n > 0) a += 0.5f * sc[4 * n - 1]; imph[r * 128 + n] = a; }
        __syncthreads();
        const int cur = t >> 6;
        if (t256 < 128) { const int n = t256; const float imp = (imph[n] + imph[128 + n]) + (imph[256 + n] + imph[384 + n]);
            const bool elig = n <= cur, forced = (n == 0) || (n == cur) || (n == cur - 1);
            score[n] = elig ? imp + (forced ? 1000.f : 0.f) : -1.0f; }
        __syncthreads();
        if (t256 < 128) { const int n = t256; const float v = score[n]; int rank = 0;
            for (int j = 0; j < 128; ++j) { const float u = score[j]; rank += (u > v || (u == v && j < n)) ? 1 : 0; }
            if (rank < 16) sel[rank] = n; }
        __syncthreads();
        NAcc<1> as; nacc_init(as);
        for (int i = 0; i < 16; ++i) { const int n = sel[i]; const int pos = 64 * n + lane; const int rel = t - pos; const size_t kr = (size_t)b * SEQ + pos;
            if (64 * n > t) continue;
            ntile<1>(as, q, p.PROJ + kr * NP0 + C_KS + g * 64, p.PROJ + kr * NP0 + C_VS + g * 64, rel >= 0, bl[rel < 0 ? 0 : (rel > 127 ? 127 : rel)], lane); }
        NAcc<1> aw; nacc_init(aw);
        for (int n = cur - 8; n <= cur; ++n) { if (n < 0) continue; const int pos = 64 * n + lane; const int rel = t - pos; const size_t kr = (size_t)b * SEQ + pos;
            ntile<1>(aw, q, p.PROJ + kr * NP0 + C_KW + g * 64, p.PROJ + kr * NP0 + C_VW + g * 64, rel >= 0 && rel < 512, bl[rel < 0 ? 0 : (rel > 127 ? 127 : rel)], lane); }
        const float g0 = p.GATES[row * 24 + hh], g1 = p.GATES[row * 24 + 8 + hh], g2 = p.GATES[row * 24 + 16 + hh];
        const float os = as.l > 0.f ? as.o[0] / as.l : 0.f, ow = aw.l > 0.f ? aw.o[0] / aw.l : 0.f;
        p.OC[row * DM + hh * 64 + lane] = (bf16)f2bf(g0 * oc + g1 * os + g2 * ow);
    }
    __syncthreads();
}

__device__ __forceinline__ void ndiff_phase(const PP& p, char* lds, int tid, int bid, int G) {
    const int sub = tid >> 7, lane = tid & 63, mp = (tid >> 6) & 1;
    float* o2 = (float*)lds + sub * 128;
    for (int it = bid; it < M * 4 / 4; it += G) {
        int id = it * 4 + sub; const int h = id % 4; id /= 4; const int t = id % SEQ; const int b = id / SEQ;
        const size_t row = (size_t)b * SEQ + t; const float* bl = p.BIASL + (8 + h) * 128;
        float q[64]; load_q64(q, p.PROJ + row * NP0 + C_DQ + h * 128 + mp * 64);
        NAcc<2> a; nacc_init(a);
        for (int p0 = 0; p0 <= t; p0 += 64) { const int pos = p0 + lane; const int rel = t - pos; const size_t kr = (size_t)b * SEQ + pos;
            ntile<2>(a, q, p.PROJ + kr * NP0 + C_DK + h * 128 + mp * 64, p.PROJ + kr * NP0 + C_DV + h * 128, rel >= 0, bl[rel < 0 ? 0 : (rel > 127 ? 127 : rel)], lane); }
        const float il = 1.0f / a.l; float v0 = a.o[0] * il, v1 = a.o[1] * il;
        __syncthreads();
        if (mp == 1) { o2[lane] = v0; o2[lane + 64] = v1; }
        __syncthreads();
        if (mp == 0) {
            const float lam = expf(wave_sum(p.lq1[lane] * p.lk1[lane])) - expf(wave_sum(p.lq2[lane] * p.lk2[lane])) + 0.2f;
            v0 -= lam * o2[lane]; v1 -= lam * o2[lane + 64];
            const float ss = wave_sum(v0 * v0 + v1 * v1); const float rs = 1.0f / sqrtf(ss * (1.0f / 128.f) + EPS);
            p.OC[row * DM + 512 + h * 128 + lane] = (bf16)f2bf(v0 * rs * p.subln[lane] * 0.8f);
            p.OC[row * DM + 512 + h * 128 + 64 + lane] = (bf16)f2bf(v1 * rs * p.subln[64 + lane] * 0.8f);
        }
    }
    __syncthreads();
}

__device__ __forceinline__ void nkmean_phase(const PP& p, int tid, int bid, int G) {
    for (int it = bid; it < 64 * 2; it += G) { const int bb = it >> 1, half = it & 1; const int b = bb / 32, n = bb % 32; const int col = half * 512 + tid; float s = 0.f;
        for (int r = 0; r < 256; ++r) s += bf2f(p.PROJ[(size_t)(b * SEQ + n * 256 + r) * NP1 + 1024 + col]);
        p.KMEAN[((size_t)(b * 16 + (col >> 6)) * 32 + n) * 64 + (col & 63)] = s * (1.0f / 256.f); }
}
__device__ __forceinline__ void kmean_from_partials(const PP& p, int tid, int bid, int G) {
    for (int i = bid * NTHR + tid; i < 2 * 16 * 32 * 64; i += G * NTHR) p.KMEAN[i] = (p.KMP[i] + p.KMP[2 * 16 * 32 * 64 + i]) * (1.0f / 256.f);
}
__device__ __forceinline__ void nmoba_phase(const PP& p, int tid, int bid, int G) {
    const int lane = tid & 63, w = tid >> 6;
    for (int it = bid; it < M * 16 / 8; it += G) {
        int id = it * 8 + w; const int h = id % 16; id /= 16; const int t = id % SEQ; const int b = id / SEQ;
        const size_t row = (size_t)b * SEQ + t; const float* bl = p.BIASL + h * 128; const int c = t >> 8;
        float q[64]; load_q64(q, p.PROJ + row * NP1 + h * 64);
        float gate = -1e30f;
        if (lane < 32 && lane < c) { const float* km = p.KMEAN + ((size_t)(b * 16 + h) * 32 + lane) * 64; float s = 0.f;
#pragma unroll
            for (int d = 0; d < 64; ++d) s += q[d] * km[d];
            gate = s; }
        if (lane >= 32) gate = -INFINITY;
        int rank = 0;
        for (int j = 0; j < 32; ++j) { const float u = __shfl(gate, j); rank += (u > gate || (u == gate && j < lane)) ? 1 : 0; }
        const bool chosen = lane < 32 && rank < 3 && lane < c;
        const unsigned long long cm = __ballot(chosen);
        NAcc<1> a; nacc_init(a);
        for (int n = 0; n < c; ++n) { if (!((cm >> n) & 1ull)) continue;
            for (int j = 0; j < 4; ++j) { const int pos = n * 256 + j * 64 + lane; const int rel = t - pos; const size_t kr = (size_t)b * SEQ + pos;
                ntile<1>(a, q, p.PROJ + kr * NP1 + 1024 + h * 64, p.PROJ + kr * NP1 + 2048 + h * 64, true, bl[rel > 127 ? 127 : rel], lane); } }
        for (int j = 0; j < 4; ++j) { const int pos = c * 256 + j * 64 + lane; const int rel = t - pos; const size_t kr = (size_t)b * SEQ + pos;
            if (c * 256 + j * 64 > t) break;
            ntile<1>(a, q, p.PROJ + kr * NP1 + 1024 + h * 64, p.PROJ + kr * NP1 + 2048 + h * 64, rel >= 0, bl[rel < 0 ? 0 : (rel > 127 ? 127 : rel)], lane); }
        p.OC[row * DM + h * 64 + lane] = (bf16)f2bf(a.o[0] / a.l);
    }
}
__device__ __forceinline__ void final_norm_phase(const PP& p, int tid, int bid, int G) {
    const int lane = tid & 63, wave = tid >> 6;
    for (int row = bid * 8 + wave; row < M; row += G * 8) {
        f32x4* xr = (f32x4*)(p.out + (size_t)row * DM) + lane; const f32x4* gr = (const f32x4*)p.norm_final + lane; f32x4 v[4]; float s = 0.f;
#pragma unroll
        for (int j = 0; j < 4; ++j) { v[j] = xr[64 * j]; s += (v[j].x * v[j].x + v[j].y * v[j].y) + (v[j].z * v[j].z + v[j].w * v[j].w); }
        s = wave_sum(s); const float rstd = 1.0f / sqrtf(s * (1.0f / DM) + EPS);
#pragma unroll
        for (int j = 0; j < 4; ++j) { const f32x4 gg = gr[64 * j]; xr[64 * j] = v[j] * rstd * gg; }
    }
}


namespace att {
#define LAS3 __attribute__((address_space(3)))
typedef short bf16x8 __attribute__((ext_vector_type(8)));
typedef short s16x4 __attribute__((ext_vector_type(4)));
typedef short v4i16_t __attribute__((ext_vector_type(4)));
typedef float f32x16 __attribute__((ext_vector_type(16)));
typedef unsigned u32x4 __attribute__((ext_vector_type(4)));
typedef LAS3 const char* lds_cptr;
constexpr float THR = 8.f, NEGBIG = -1e30f;
constexpr int L_RING = 0, L_OST = 98304, L_WSF = 131072, L_BIAS = 133120, L_MISC = 141312;

__device__ __forceinline__ int crow(int r, int hi) { return (r & 3) + 8 * (r >> 2) + 4 * hi; }
__device__ __forceinline__ void glds16(const void* gsrc, unsigned lds_dst) { unsigned keep;
    asm volatile("s_mov_b32 %0, m0\n\ts_mov_b32 m0, %2\n\ts_nop 0\n\tglobal_load_lds_dwordx4 %1, off\n\ts_mov_b32 m0, %0" : "=&s"(keep) : "v"(gsrc), "s"(lds_dst) : "memory"); }
#define ATT_WAIT_BAR(N) asm volatile("s_waitcnt vmcnt(" #N ") lgkmcnt(0)\n\ts_barrier" ::: "memory")
#define ATT_BAR() asm volatile("s_waitcnt lgkmcnt(0)\n\ts_barrier" ::: "memory")
typedef float f32x2_t __attribute__((ext_vector_type(2))); typedef __bf16 bf16x2_t __attribute__((ext_vector_type(2)));
__device__ __forceinline__ unsigned cvtpk(float lo, float hi) { f32x2_t v = {lo, hi}; bf16x2_t b = __builtin_convertvector(v, bf16x2_t); return __builtin_bit_cast(unsigned, b); }
__device__ __forceinline__ s16x4 vtr(lds_cptr p) { return __builtin_bit_cast(s16x4, __builtin_amdgcn_ds_read_tr16_b64_v4i16((LAS3 v4i16_t*)p)); }
#define ATT_MX3(a, b, c) __builtin_fmaxf(__builtin_fmaxf((a), (b)), (c))
__device__ __forceinline__ float rowmax(const f32x16& p0, const f32x16& p1) {
    float a = ATT_MX3(p0[0], p0[1], p1[0]), b = ATT_MX3(p0[2], p0[3], p1[1]); a = ATT_MX3(a, p1[2], p1[3]);
#pragma unroll
    for (int r = 4; r < 16; r += 4) { a = ATT_MX3(a, p0[r], p0[r + 1]); b = ATT_MX3(b, p0[r + 2], p0[r + 3]); a = ATT_MX3(a, p1[r], p1[r + 1]); b = ATT_MX3(b, p1[r + 2], p1[r + 3]); }
    float m = __builtin_fmaxf(a, b); auto rr = __builtin_amdgcn_permlane32_swap(__float_as_uint(m), __float_as_uint(m), false, false);
    return __builtin_fmaxf(__uint_as_float(rr[0]), __uint_as_float(rr[1]));
}
__device__ __forceinline__ float halfsum(float v) { auto rr = __builtin_amdgcn_permlane32_swap(__float_as_uint(v), __float_as_uint(v), false, false); return __uint_as_float(rr[0]) + __uint_as_float(rr[1]); }

template <int ND> struct St { float mhat, l; f32x16 o[ND]; };
template <int ND> __device__ __forceinline__ void st_init(St<ND>& s) { s.mhat = NEGBIG; s.l = 0.f;
#pragma unroll
    for (int d = 0; d < ND; ++d) s.o[d] = f32x16{}; }

__device__ __forceinline__ void qk_tile(f32x16& p0, f32x16& p1, lds_cptr kp, const bf16x8 (&qr)[4], float cinit) {
    f32x16 c;
#pragma unroll
    for (int r = 0; r < 16; ++r) c[r] = cinit;
#pragma unroll
    for (int d0 = 0; d0 < 4; ++d0) {
        const bf16x8 b0 = *(const LAS3 bf16x8*)(kp + d0 * 2048);
        const bf16x8 b1 = *(const LAS3 bf16x8*)(kp + d0 * 2048 + 512);
        if (d0 == 0) { p0 = __builtin_amdgcn_mfma_f32_32x32x16_bf16(b0, qr[0], c, 0, 0, 0); p1 = __builtin_amdgcn_mfma_f32_32x32x16_bf16(b1, qr[0], c, 0, 0, 0); }
        else { p0 = __builtin_amdgcn_mfma_f32_32x32x16_bf16(b0, qr[d0], p0, 0, 0, 0); p1 = __builtin_amdgcn_mfma_f32_32x32x16_bf16(b1, qr[d0], p1, 0, 0, 0); }
    }
}
template <int ND, int MODE>
__device__ __forceinline__ void softmax_pv(St<ND>& st, f32x16& p0, f32x16& p1, lds_cptr vp, LAS3 float* wsf, int r32, int hi, float rl) {
    if (MODE != 2) {
        const float rm = rowmax(p0, p1);
        if (__any(rm > st.mhat + THR)) {
            const float mn = __builtin_fmaxf(st.mhat, rm); const float f = __builtin_amdgcn_exp2f(st.mhat - mn);
            st.l *= f; st.mhat = mn;
            if (MODE == 0) {
                if (hi == 0) wsf[r32] = f;
#pragma unroll
                for (int r = 0; r < 16; ++r) { const float fr = wsf[crow(r, hi)];
#pragma unroll
                    for (int d = 0; d < ND; ++d) st.o[d][r] *= fr; }
            }
        }
    }
    const float mh = st.mhat; float s0 = 0.f, s1 = 0.f;
#pragma unroll
    for (int r = 0; r < 16; ++r) { p0[r] = __builtin_amdgcn_exp2f(p0[r] - mh); p1[r] = __builtin_amdgcn_exp2f(p1[r] - mh); s0 += p0[r]; s1 += p1[r]; }
    if (MODE != 2) st.l += s0 + s1;
    if (MODE == 2) {
#pragma unroll
        for (int r = 0; r < 16; ++r) { p0[r] *= rl; p1[r] *= rl; }
    }
    if (MODE == 1) return;
    u32x4 pw[4];
#pragma unroll
    for (int k = 0; k < 2; ++k)
#pragma unroll
        for (int j = 0; j < 4; ++j) { pw[k][j] = cvtpk(p0[8 * k + 2 * j], p0[8 * k + 2 * j + 1]); pw[2 + k][j] = cvtpk(p1[8 * k + 2 * j], p1[8 * k + 2 * j + 1]); }
#pragma unroll
    for (int d0 = 0; d0 < ND; ++d0) {
#pragma unroll
        for (int ks = 0; ks < 4; ++ks) {
            const s16x4 lo = vtr(vp + d0 * 4096 + ks * 1024), hh = vtr(vp + d0 * 4096 + ks * 1024 + 512);
            const bf16x8 vf = (bf16x8){lo[0], lo[1], lo[2], lo[3], hh[0], hh[1], hh[2], hh[3]};
            st.o[d0] = __builtin_amdgcn_mfma_f32_32x32x16_bf16(__builtin_bit_cast(bf16x8, pw[ks]), vf, st.o[d0], 0, 0, 0);
        }
    }
}
template <bool WIN>
__device__ __forceinline__ void fix_near(f32x16& p0, f32x16& p1, int tq, int kbase, int kstep, const LAS3 float* bl, int hi) {
#pragma unroll
    for (int r = 0; r < 16; ++r) {
        const int rel0 = tq - (kbase + kstep * crow(r, hi)), rel1 = rel0 - 32 * kstep;
        const float b0 = bl[rel0 < 0 ? 0 : (rel0 > 127 ? 127 : rel0)], b1 = bl[rel1 < 0 ? 0 : (rel1 > 127 ? 127 : rel1)];
        const bool k0 = rel0 >= 0 && (!WIN || rel0 < 512), k1 = rel1 >= 0 && (!WIN || rel1 < 512);
        p0[r] = k0 ? p0[r] + b0 : -INFINITY; p1[r] = k1 ? p1[r] + b1 : -INFINITY;
    }
}
__device__ __forceinline__ void kill_tile(f32x16& p0, f32x16& p1, bool keep) {
#pragma unroll
    for (int r = 0; r < 16; ++r) { p0[r] = keep ? p0[r] : -INFINITY; p1[r] = keep ? p1[r] : -INFINITY; }
}
template <int NKM, int ND>
__device__ __forceinline__ void issue_tile(const bf16* kg, int kpitch, const bf16* vg, int vpitch, int krow0, unsigned slot, int wid, int lane) {
#pragma unroll
    for (int m = 0; m < NKM; ++m) glds16(kg + (size_t)(krow0 + lane) * kpitch + m * 64 + wid * 8, (unsigned)__builtin_amdgcn_readfirstlane(slot + m * 8192 + wid * 1024));
#pragma unroll
    for (int j = 0; j < ND / 2; ++j) { const int pi = wid + 8 * j;
        glds16(vg + (size_t)(krow0 + 16 * (pi & 3) + (lane >> 2)) * vpitch + (pi >> 2) * 32 + (lane & 3) * 8, (unsigned)__builtin_amdgcn_readfirstlane(slot + NKM * 8192 + pi * 1024)); }
}
template <int NKM, int ND, class KRow, class Body>
__device__ __forceinline__ void run_stream(char* lds, const bf16* kg, int kpitch, const bf16* vg, int vpitch, int n, KRow krow, Body body, int wid, int lane) {
    constexpr int SLOTB = NKM * 8192 + ND * 4096;
    const unsigned lds0 = (unsigned)(uintptr_t)lds + L_RING;
    ATT_BAR();
    if (n <= 0) return;
    issue_tile<NKM, ND>(kg, kpitch, vg, vpitch, krow(0), lds0, wid, lane);
    if (n > 1) issue_tile<NKM, ND>(kg, kpitch, vg, vpitch, krow(1), lds0 + SLOTB, wid, lane);
    int s_cur = 0, s_nxt = SLOTB, s_nn = 2 * SLOTB;
    for (int k = 0; k < n; ++k) {
        if (k + 1 < n) { if (NKM + ND / 2 == 2) ATT_WAIT_BAR(2); else if (NKM + ND / 2 == 3) ATT_WAIT_BAR(3); else ATT_WAIT_BAR(4); }
        else ATT_WAIT_BAR(0);
        if (k + 2 < n) issue_tile<NKM, ND>(kg, kpitch, vg, vpitch, krow(k + 2), lds0 + s_nn, wid, lane);
        body(k, L_RING + s_cur);
        const int t = s_cur; s_cur = s_nxt; s_nxt = s_nn; s_nn = t;
    }
}
__device__ __forceinline__ void rowfac(float (&fr)[16], float f, LAS3 float* wsf, int r32, int hi) {
    if (hi == 0) wsf[r32] = f;
#pragma unroll
    for (int r = 0; r < 16; ++r) fr[r] = wsf[crow(r, hi)];
}
template <int ND>
__device__ __forceinline__ void stage_o(const f32x16 (&o)[ND], LAS3 bf16* stg, int r32, int hi) {
#pragma unroll
    for (int r = 0; r < 16; ++r) { const int orow = crow(r, hi);
#pragma unroll
        for (int d0 = 0; d0 < ND; ++d0) stg[orow * (32 * ND) + d0 * 32 + r32] = (bf16)f2bf(o[d0][r]); }
}

constexpr int MB_KM = 49152, MB_RM = 57344, MB_UNI = 58368, MB_G = 58432;
__device__ __forceinline__ void moba_unit(const PP& p, char* lds, int b, int h, int c, int tid) {
    const int lane = tid & 63, r32 = lane & 31, hi = lane >> 5; const int wid = __builtin_amdgcn_readfirstlane(tid >> 6);
    LAS3 char* l3 = (LAS3 char*)lds;
    LAS3 float* KM = (LAS3 float*)(l3 + MB_KM); LAS3 unsigned* RM = (LAS3 unsigned*)(l3 + MB_RM); LAS3 unsigned* UNI = (LAS3 unsigned*)(l3 + MB_UNI); LAS3 float* Gs = (LAS3 float*)(l3 + MB_G);
    LAS3 float* wsf = (LAS3 float*)(l3 + L_WSF) + wid * 64; const LAS3 float* bl = (const LAS3 float*)(l3 + L_BIAS) + h * 128;
    const size_t rowbase = (size_t)b * SEQ; const int q0 = c * 256;
    const bf16* Qg = p.PROJ + rowbase * NP1 + h * 64; const bf16* Kg = p.PROJ + rowbase * NP1 + 1024 + h * 64; const bf16* Vg = p.PROJ + rowbase * NP1 + 2048 + h * 64;
    ATT_BAR();
    { const f32x4 v = *(const f32x4*)(p.KMEAN + ((size_t)(b * 16 + h) * 32) * 64 + tid * 4); *(LAS3 f32x4*)(KM + tid * 4) = v; if (tid == 0) UNI[0] = 0u; }
    ATT_BAR();
    { const int row = tid >> 1, half = tid & 1; float q[64]; load_q64(q, Qg + (size_t)(q0 + row) * NP1);
#pragma unroll 1
      for (int n = half * 16; n < half * 16 + 16; ++n) { float s = 0.f;
#pragma unroll
          for (int d = 0; d < 64; d += 4) { const f32x4 k4 = *(const LAS3 f32x4*)(KM + n * 64 + d); s += (q[d] * k4.x + q[d + 1] * k4.y) + (q[d + 2] * k4.z + q[d + 3] * k4.w); }
          Gs[row * 33 + n] = s; } }
    ATT_BAR();
    if (tid < 256) { unsigned mask;
        if (c <= 3) mask = (1u << c) - 1u;
        else { float v1 = -INFINITY, v2 = -INFINITY, v3 = -INFINITY; int i1 = 0, i2 = 0, i3 = 0;
            for (int n = 0; n < c; ++n) { const float g = Gs[tid * 33 + n];
                if (g > v1) { v3 = v2; i3 = i2; v2 = v1; i2 = i1; v1 = g; i1 = n; } else if (g > v2) { v3 = v2; i3 = i2; v2 = g; i2 = n; } else if (g > v3) { v3 = g; i3 = n; } }
            mask = (1u << i1) | (1u << i2) | (1u << i3); }
        RM[tid] = mask; __hip_atomic_fetch_or(UNI, mask, __ATOMIC_RELAXED, __HIP_MEMORY_SCOPE_WORKGROUP); }
    ATT_BAR();
    const unsigned uni = UNI[0]; const int tq = q0 + wid * 32 + r32; const unsigned mymask = RM[wid * 32 + r32];
    const int npast = __builtin_popcount(uni), ntile = 4 * npast + 4;
    bf16x8 qr[4];
#pragma unroll
    for (int d0 = 0; d0 < 4; ++d0) qr[d0] = *(const bf16x8*)(Qg + (size_t)tq * NP1 + d0 * 16 + hi * 8);
    St<2> st; st_init(st);
    auto blk_of = [&](int k) -> int { const int i = k >> 2; if (i >= npast) return c; unsigned u = uni; for (int j = 0; j < i; ++j) u &= u - 1u; return __builtin_ctz(u); };
    auto krow = [&](int k) -> int { return blk_of(k) * 256 + (k & 3) * 64; };
    const float bfar = bl[127];
    auto body = [&](int k, int slot) {
        const int n = blk_of(k), j = k & 3; const int kbase = n * 256 + j * 64;
        const bool own = n == c;
        const bool sel = own ? true : ((mymask >> n) & 1u) != 0u;
        if (own ? (kbase > q0 + wid * 32 + 31) : !__any(sel)) return;
        const bool near = own || (n == c - 1 && j >= 2);
        f32x16 p0, p1;
        qk_tile(p0, p1, (lds_cptr)l3 + slot + hi * 1024 + r32 * 16, qr, near ? 0.f : bfar);
        if (near) fix_near<false>(p0, p1, tq, kbase, 1, bl, hi);
        if (!own) kill_tile(p0, p1, sel);
        softmax_pv<2, 0>(st, p0, p1, (lds_cptr)l3 + slot + 8192 + ((lane >> 4) & 1) * 32 + (lane & 3) * 8 + (4 * hi + ((lane & 15) >> 2)) * 64, wsf, r32, hi, 0.f);
    };
    run_stream<1, 2>(lds, Kg, NP1, Vg, NP1, ntile, krow, body, wid, lane);
    const float lt = halfsum(st.l); float fr[16]; rowfac(fr, lt > 0.f ? 1.0f / lt : 0.f, wsf, r32, hi);
#pragma unroll
    for (int r = 0; r < 16; ++r) { st.o[0][r] *= fr[r]; st.o[1][r] *= fr[r]; }
    LAS3 bf16* stg = (LAS3 bf16*)(l3 + L_OST) + wid * 2048;
    stage_o<2>(st.o, stg, r32, hi);
    bf16* Ow = p.OC + (rowbase + q0 + wid * 32) * DM + h * 64;
#pragma unroll
    for (int i = 0; i < 4; ++i) { const int row = i * 8 + (lane >> 3), ch = lane & 7; const u32x4 v = *(const LAS3 u32x4*)(stg + row * 64 + ch * 8); *(u32x4*)(Ow + (size_t)row * DM + ch * 8) = v; }
}
__device__ __forceinline__ void copy_bias_lds(const PP& p, char* lds, int tid) {
    LAS3 float* B = (LAS3 float*)((LAS3 char*)lds + L_BIAS);
    for (int i = tid; i < 16 * 128; i += NTHR) B[i] = p.BIASL[i];
}
__device__ __forceinline__ void moba_phase(const PP& p, char* lds, int tid, int bid, int G) {
    copy_bias_lds(p, lds, tid);
    const int vcu = (G % 8 == 0) ? (bid % 8) * (G / 8) + bid / 8 : bid;
    if (G == 256) { const int bh = vcu >> 3, s = vcu & 7;
        for (int i = 0; i < 4; ++i) { const int c = i == 0 ? 31 - s : (i == 1 ? 16 + s : (i == 2 ? 15 - s : s)); moba_unit(p, lds, bh >> 4, bh & 15, c, tid); } }
    else { for (int u = bid; u < 1024; u += G) moba_unit(p, lds, (u >> 5) >> 4, (u >> 5) & 15, 31 - (u & 31), tid); }
    ATT_BAR();
}

__device__ __forceinline__ void diff_unit(const PP& p, char* lds, int b, int h, int qt, int tid) {
    const int lane = tid & 63, r32 = lane & 31, hi = lane >> 5; const int wid = __builtin_amdgcn_readfirstlane(tid >> 6); const int mp = wid >> 2, wq = wid & 3;
    LAS3 char* l3 = (LAS3 char*)lds;
    LAS3 float* wsf = (LAS3 float*)(l3 + L_WSF) + wid * 64; const LAS3 float* bl = (const LAS3 float*)(l3 + L_BIAS) + (8 + h) * 128;
    const size_t rowbase = (size_t)b * SEQ; const int q0 = qt * 128; const int tq = q0 + wq * 32 + r32;
    const bf16* Qg = p.PROJ + rowbase * NP0 + C_DQ + h * 128 + mp * 64; const bf16* Kg = p.PROJ + rowbase * NP0 + C_DK + h * 128; const bf16* Vg = p.PROJ + rowbase * NP0 + C_DV + h * 128;
    bf16x8 qr[4];
#pragma unroll
    for (int d0 = 0; d0 < 4; ++d0) qr[d0] = *(const bf16x8*)(Qg + (size_t)tq * NP0 + d0 * 16 + hi * 8);
    St<4> st; st_init(st);
    const int NT = 2 * (qt + 1); const float bfar = bl[127];
    auto krow = [&](int k) -> int { return 64 * k; };
    auto body = [&](int k, int slot) {
        const int kbase = 64 * k;
        if (kbase > q0 + wq * 32 + 31) return;
        const bool near = k >= NT - 4;
        f32x16 p0, p1;
        qk_tile(p0, p1, (lds_cptr)l3 + slot + mp * 8192 + hi * 1024 + r32 * 16, qr, near ? 0.f : bfar);
        if (near) fix_near<false>(p0, p1, tq, kbase, 1, bl, hi);
        softmax_pv<4, 0>(st, p0, p1, (lds_cptr)l3 + slot + 16384 + ((lane >> 4) & 1) * 32 + (lane & 3) * 8 + (4 * hi + ((lane & 15) >> 2)) * 64, wsf, r32, hi, 0.f);
    };
    run_stream<2, 4>(lds, Kg, NP0, Vg, NP0, NT, krow, body, wid, lane);
    const float lt = halfsum(st.l); float fr[16]; rowfac(fr, lt > 0.f ? 1.0f / lt : 0.f, wsf, r32, hi);
    ATT_BAR();
    LAS3 float* OL = (LAS3 float*)l3 + (size_t)mp * 128 * 128;
#pragma unroll
    for (int r = 0; r < 16; ++r) { const int row = wq * 32 + crow(r, hi);
#pragma unroll
        for (int d0 = 0; d0 < 4; ++d0) OL[row * 128 + d0 * 32 + r32] = st.o[d0][r] * fr[r]; }
    ATT_BAR();
    {   const float lam = expf(wave_sum(p.lq1[lane] * p.lk1[lane])) - expf(wave_sum(p.lq2[lane] * p.lk2[lane])) + 0.2f;
        const int row = tid >> 2, part = tid & 3; const LAS3 float* o1 = (const LAS3 float*)l3 + row * 128 + part * 32; const LAS3 float* o2 = o1 + 128 * 128;
        float v[32]; float ss = 0.f;
#pragma unroll
        for (int j = 0; j < 32; j += 4) { const f32x4 a = *(const LAS3 f32x4*)(o1 + j), c = *(const LAS3 f32x4*)(o2 + j);
            v[j] = a.x - lam * c.x; v[j + 1] = a.y - lam * c.y; v[j + 2] = a.z - lam * c.z; v[j + 3] = a.w - lam * c.w;
            ss += (v[j] * v[j] + v[j + 1] * v[j + 1]) + (v[j + 2] * v[j + 2] + v[j + 3] * v[j + 3]); }
        ss += __shfl_xor(ss, 1); ss += __shfl_xor(ss, 2);
        const float rs = 0.8f / sqrtf(ss * (1.0f / 128.f) + EPS);
        bf16* dst = p.OC + (rowbase + q0 + row) * DM + 512 + h * 128 + part * 32; const float* sg = p.subln + part * 32;
#pragma unroll
        for (int j = 0; j < 32; j += 8) { u32x4 w;
            w.x = pk2(v[j] * rs * sg[j], v[j + 1] * rs * sg[j + 1]); w.y = pk2(v[j + 2] * rs * sg[j + 2], v[j + 3] * rs * sg[j + 3]);
            w.z = pk2(v[j + 4] * rs * sg[j + 4], v[j + 5] * rs * sg[j + 5]); w.w = pk2(v[j + 6] * rs * sg[j + 6], v[j + 7] * rs * sg[j + 7]);
            *(u32x4*)(dst + j) = w; }
    }
}
__device__ __forceinline__ void diff_phase(const PP& p, char* lds, int tid, int bid, int G) {
    copy_bias_lds(p, lds, tid);
    const int vcu = (G % 8 == 0) ? (bid % 8) * (G / 8) + bid / 8 : bid;
    if (G == 256) { const int bh = vcu >> 5, s = vcu & 31; diff_unit(p, lds, bh >> 2, bh & 3, 63 - s, tid); diff_unit(p, lds, bh >> 2, bh & 3, s, tid); }
    else { for (int u = bid; u < 512; u += G) diff_unit(p, lds, (u >> 6) >> 2, (u >> 6) & 3, 63 - (u & 63), tid); }
    ATT_BAR();
}

constexpr int NS_IMP = 49152, NS_SELM = 81920, NS_UNI = 82944, NS_TL = 82960;
__device__ __forceinline__ void nsa_unit(const PP& p, char* lds, int b, int g, int cur, int tid) {
    const int lane = tid & 63, r32 = lane & 31, hi = lane >> 5; const int wid = __builtin_amdgcn_readfirstlane(tid >> 6);
    LAS3 char* l3 = (LAS3 char*)lds;
    LAS3 float* IMP = (LAS3 float*)(l3 + NS_IMP); LAS3 unsigned* SELM = (LAS3 unsigned*)(l3 + NS_SELM); LAS3 unsigned* UNI = (LAS3 unsigned*)(l3 + NS_UNI); LAS3 int* TL = (LAS3 int*)(l3 + NS_TL);
    const int tokl = wid * 8 + (r32 >> 2), head = r32 & 3, hh = g * 4 + head;
    LAS3 float* wsf = (LAS3 float*)(l3 + L_WSF) + wid * 64; const LAS3 float* bl = (const LAS3 float*)(l3 + L_BIAS) + hh * 128;
    const size_t rowbase = (size_t)b * SEQ; const int t0 = cur * 64; const int tq = t0 + tokl; const int twmin = t0 + wid * 8, twmax = twmin + 7;
    const bf16* Qg = p.PROJ + (rowbase + tq) * NP0 + C_Q + hh * 64;
    bf16x8 qr[4];
#pragma unroll
    for (int d0 = 0; d0 < 4; ++d0) qr[d0] = *(const bf16x8*)(Qg + d0 * 16 + hi * 8);
    const float* gp = p.GATES + (rowbase + tq) * 24 + hh; const float g0 = gp[0], g1 = gp[8], g2 = gp[16];
    const float bfar = bl[127];
    const int vlane = ((lane >> 4) & 1) * 32 + (lane & 3) * 8 + (4 * hi + ((lane & 15) >> 2)) * 64;
    ATT_BAR();
    for (int i = tid; i < 64 * 128; i += NTHR) IMP[i] = 0.f;
    if (tid < 4) UNI[tid] = 0u;
    const int nvis = (4 * cur + 3) < NCMP ? (4 * cur + 3) : NCMP; const int ntc = (nvis + 63) >> 6;
    const bf16* KC = p.KCMP + (size_t)((b * 2 + g) * 512) * 64; const bf16* VC = p.VCMP + (size_t)((b * 2 + g) * 512) * 64;
    auto krow64 = [&](int k) -> int { return 64 * k; };
    St<2> sc; st_init(sc);
    auto cmp_scores = [&](f32x16& p0, f32x16& p1, int k, int slot) -> bool {
        const int c0 = 64 * k;
        if (16 * c0 + 31 > twmax) return false;
        const bool near = (twmin - (16 * (c0 + 63) + 31)) < 128;
        qk_tile(p0, p1, (lds_cptr)l3 + slot + hi * 1024 + r32 * 16, qr, near ? 0.f : bfar);
        if (near) fix_near<false>(p0, p1, tq, 16 * c0 + 31, 16, bl, hi);
        return true;
    };
    auto body1 = [&](int k, int slot) { f32x16 p0, p1; if (!cmp_scores(p0, p1, k, slot)) return; softmax_pv<2, 1>(sc, p0, p1, (lds_cptr)l3, wsf, r32, hi, 0.f); };
    run_stream<1, 2>(lds, KC, 64, VC, 64, ntc, krow64, body1, wid, lane);
    const float lc = halfsum(sc.l); const float rlc = lc > 0.f ? 1.0f / lc : 0.f;
    St<2> so; st_init(so); so.mhat = sc.mhat;
    auto body2 = [&](int k, int slot) { f32x16 p0, p1; if (!cmp_scores(p0, p1, k, slot)) return;
        softmax_pv<2, 2>(so, p0, p1, (lds_cptr)l3 + slot + 8192 + vlane, wsf, r32, hi, rlc);
#pragma unroll
        for (int R = 0; R < 4; ++R) {
            float a0 = ((p0[4 * R] + p0[4 * R + 1]) + p0[4 * R + 2]) + 0.5f * p0[4 * R + 3], s0 = 0.5f * p0[4 * R + 3];
            float a1 = ((p1[4 * R] + p1[4 * R + 1]) + p1[4 * R + 2]) + 0.5f * p1[4 * R + 3], s1 = 0.5f * p1[4 * R + 3];
            a0 += __shfl_xor(a0, 1); a0 += __shfl_xor(a0, 2); s0 += __shfl_xor(s0, 1); s0 += __shfl_xor(s0, 2);
            a1 += __shfl_xor(a1, 1); a1 += __shfl_xor(a1, 2); s1 += __shfl_xor(s1, 1); s1 += __shfl_xor(s1, 2);
            const int n0 = 16 * k + 2 * R + hi, n1 = n0 + 8;
            if (head == 0) { LAS3 float* ip = IMP + tokl * 128;
                __hip_atomic_fetch_add(ip + n0, a0, __ATOMIC_RELAXED, __HIP_MEMORY_SCOPE_WORKGROUP); __hip_atomic_fetch_add(ip + n0 + 1, s0, __ATOMIC_RELAXED, __HIP_MEMORY_SCOPE_WORKGROUP);
                __hip_atomic_fetch_add(ip + n1, a1, __ATOMIC_RELAXED, __HIP_MEMORY_SCOPE_WORKGROUP); if (n1 + 1 < 128) __hip_atomic_fetch_add(ip + n1 + 1, s1, __ATOMIC_RELAXED, __HIP_MEMORY_SCOPE_WORKGROUP); }
        }
    };
    run_stream<1, 2>(lds, KC, 64, VC, 64, ntc, krow64, body2, wid, lane);
    __builtin_amdgcn_s_waitcnt(0xC07F); asm volatile("" ::: "memory");
#pragma unroll 1
    for (int tk = 0; tk < 8; ++tk) { const int tl = wid * 8 + tk; unsigned long long mlo = 0ull, mhi = 0ull;
        if (cur < 16) { mlo = (2ull << cur) - 1ull; }
        else { mlo = 1ull; if (cur - 1 < 64) mlo |= 1ull << (cur - 1); else mhi |= 1ull << (cur - 1 - 64); if (cur < 64) mlo |= 1ull << cur; else mhi |= 1ull << (cur - 64);
            float v0 = (lane >= 1 && lane <= cur - 2) ? IMP[tl * 128 + lane] : -1.f, v1 = (lane + 64 <= cur - 2) ? IMP[tl * 128 + 64 + lane] : -1.f;
#pragma unroll 1
            for (int rd = 0; rd < 13; ++rd) { const float m = wave_max(fmaxf(v0, v1)); const unsigned long long b0 = __ballot(v0 == m);
                if (b0) { const int l = __ffsll((long long)b0) - 1; mlo |= 1ull << l; if (lane == l) v0 = -2.f; }
                else { const unsigned long long b1 = __ballot(v1 == m); const int l = __ffsll((long long)b1) - 1; mhi |= 1ull << l; if (lane == l) v1 = -2.f; } } }
        if (lane == 0) { const unsigned m0 = (unsigned)mlo, m1 = (unsigned)(mlo >> 32), m2 = (unsigned)mhi, m3 = (unsigned)(mhi >> 32);
            SELM[tl * 4 + 0] = m0; SELM[tl * 4 + 1] = m1; SELM[tl * 4 + 2] = m2; SELM[tl * 4 + 3] = m3;
            __hip_atomic_fetch_or(UNI + 0, m0, __ATOMIC_RELAXED, __HIP_MEMORY_SCOPE_WORKGROUP); __hip_atomic_fetch_or(UNI + 1, m1, __ATOMIC_RELAXED, __HIP_MEMORY_SCOPE_WORKGROUP);
            __hip_atomic_fetch_or(UNI + 2, m2, __ATOMIC_RELAXED, __HIP_MEMORY_SCOPE_WORKGROUP); __hip_atomic_fetch_or(UNI + 3, m3, __ATOMIC_RELAXED, __HIP_MEMORY_SCOPE_WORKGROUP); }
    }
    ATT_BAR();
    if (tid == 0) { int cnt = 0;
        for (int w = 0; w < 4; ++w) { unsigned u = UNI[w]; while (u) { const int bit = __builtin_ctz(u); u &= u - 1u; TL[1 + cnt] = w * 32 + bit; ++cnt; } }
        TL[0] = cnt; }
    ATT_BAR();
    const int nsel = TL[0];
    LAS3 float* otl = (LAS3 float*)(l3 + (wid < 4 ? NS_IMP + wid * 8192 : L_OST + (wid - 4) * 8192));
    { float fr[16]; rowfac(fr, g0, wsf, r32, hi);
#pragma unroll
      for (int r = 0; r < 16; ++r) { otl[crow(r, hi) * 64 + r32] = so.o[0][r] * fr[r]; otl[crow(r, hi) * 64 + 32 + r32] = so.o[1][r] * fr[r]; } }
    const unsigned long long mylo = (unsigned long long)SELM[tokl * 4 + 0] | ((unsigned long long)SELM[tokl * 4 + 1] << 32), myhi = (unsigned long long)SELM[tokl * 4 + 2] | ((unsigned long long)SELM[tokl * 4 + 3] << 32);
    { St<2> ss; st_init(ss);
      const bf16* KS = p.PROJ + rowbase * NP0 + C_KS + g * 64; const bf16* VS = p.PROJ + rowbase * NP0 + C_VS + g * 64;
      auto krow3 = [&](int k) -> int { return 64 * TL[1 + k]; };
      auto body3 = [&](int k, int slot) { const int n = TL[1 + k]; const int kbase = 64 * n;
          const bool sel = (((n < 64 ? mylo : myhi) >> (n & 63)) & 1ull) != 0ull;
          if (!__any(sel)) return;
          const bool near = n >= cur - 2;
          f32x16 p0, p1; qk_tile(p0, p1, (lds_cptr)l3 + slot + hi * 1024 + r32 * 16, qr, near ? 0.f : bfar);
          if (near) fix_near<false>(p0, p1, tq, kbase, 1, bl, hi);
          kill_tile(p0, p1, sel);
          softmax_pv<2, 0>(ss, p0, p1, (lds_cptr)l3 + slot + 8192 + vlane, wsf, r32, hi, 0.f); };
      run_stream<1, 2>(lds, KS, NP0, VS, NP0, nsel, krow3, body3, wid, lane);
      const float ls = halfsum(ss.l); float fr[16]; rowfac(fr, ls > 0.f ? g1 / ls : 0.f, wsf, r32, hi);
#pragma unroll
      for (int r = 0; r < 16; ++r) { otl[crow(r, hi) * 64 + r32] += ss.o[0][r] * fr[r]; otl[crow(r, hi) * 64 + 32 + r32] += ss.o[1][r] * fr[r]; } }
    { St<2> sw; st_init(sw);
      const bf16* KW = p.PROJ + rowbase * NP0 + C_KW + g * 64; const bf16* VW = p.PROJ + rowbase * NP0 + C_VW + g * 64;
      const int nlo = cur >= 8 ? cur - 8 : 0;
      auto krow4 = [&](int k) -> int { return 64 * (nlo + k); };
      auto body4 = [&](int k, int slot) { const int n = nlo + k; const int kbase = 64 * n;
          const bool near = (n >= cur - 2) || (n == cur - 8);
          f32x16 p0, p1; qk_tile(p0, p1, (lds_cptr)l3 + slot + hi * 1024 + r32 * 16, qr, near ? 0.f : bfar);
          if (near) fix_near<true>(p0, p1, tq, kbase, 1, bl, hi);
          softmax_pv<2, 0>(sw, p0, p1, (lds_cptr)l3 + slot + 8192 + vlane, wsf, r32, hi, 0.f); };
      run_stream<1, 2>(lds, KW, NP0, VW, NP0, cur - nlo + 1, krow4, body4, wid, lane);
      const float lw = halfsum(sw.l); float fr[16]; rowfac(fr, lw > 0.f ? g2 / lw : 0.f, wsf, r32, hi);
#pragma unroll
      for (int r = 0; r < 16; ++r) { otl[crow(r, hi) * 64 + r32] += sw.o[0][r] * fr[r]; otl[crow(r, hi) * 64 + 32 + r32] += sw.o[1][r] * fr[r]; } }
    bf16* Ow = p.OC + (rowbase + t0 + wid * 8) * DM + g * 256;
#pragma unroll
    for (int i = 0; i < 4; ++i) { const int row = i * 8 + (lane >> 3), ch = lane & 7; const f32x4 a = *(const LAS3 f32x4*)(otl + row * 64 + ch * 8), c = *(const LAS3 f32x4*)(otl + row * 64 + ch * 8 + 4);
        u32x4 v; v.x = pk2(a.x, a.y); v.y = pk2(a.z, a.w); v.z = pk2(c.x, c.y); v.w = pk2(c.z, c.w); *(u32x4*)(Ow + (size_t)(row >> 2) * DM + (row & 3) * 64 + ch * 8) = v; }
}
__device__ __forceinline__ void nsa_phase(const PP& p, char* lds, int tid, int bid, int G) {
    copy_bias_lds(p, lds, tid);
    const int vcu = (G % 8 == 0) ? (bid % 8) * (G / 8) + bid / 8 : bid;
    if (G == 256) { const int bg = vcu >> 6, s = vcu & 63; nsa_unit(p, lds, bg >> 1, bg & 1, 127 - s, tid); nsa_unit(p, lds, bg >> 1, bg & 1, s, tid); }
    else { for (int u = bid; u < 512; u += G) nsa_unit(p, lds, (u >> 7) >> 1, (u >> 7) & 1, 127 - (u & 127), tid); }
    ATT_BAR();
}
}
template <int MODE> __device__ __forceinline__ void gemm_rowscale(char* lds, const bf16* A, const bf16* Bt, int N, int K, bf16* O, const float* SS, float* KMP, int kt_lo, int kt_hi, int tid, int bid, int G) {
#if USE_PG8
    pg8::Gemm g{A, Bt, M, N, K}; pg8::StaticOrder S; S.init(M, N, G, bid);
    pg8::EpiRowScaleBf16<MODE> E{O, SS, KMP, N, kt_lo, kt_hi, 0};
    pg8::gemm_phase<pg8::EpiRowScaleBf16<MODE>, pg8::StaticOrder, true, true>((PG8_LAS unsigned char*)lds, g, S, E);
#else
    if (MODE == 0) ngemm_phase(lds, A, Bt, N, K, NEpiProj{O, SS, N}, tid, bid, G); else ngemm_phase(lds, A, Bt, N, K, NEpiMlp1{O, SS}, tid, bid, G);
#endif
}
__device__ __forceinline__ void gemm_residual(char* lds, const bf16* A, const bf16* Bt, int K, const float* xin, float* xout, bf16* xb, float* SS, int tid, int bid, int G) {
#if USE_PG8
    pg8::Gemm g{A, Bt, M, DM, K}; pg8::StaticOrder S; S.init(M, DM, G, bid);
    pg8::EpiResidual E{xin, xout, xb, SS};
    pg8::gemm_phase<pg8::EpiResidual, pg8::StaticOrder, true, true>((PG8_LAS unsigned char*)lds, g, S, E);
#else
    ngemm_phase(lds, A, Bt, DM, K, NEpiRes{xin, xout, xb, SS}, tid, bid, G);
#endif
}

constexpr int NPHASE = 13;
__global__ void __launch_bounds__(NTHR, 2) mk_fwd(Args args) {
    extern __shared__ __attribute__((aligned(16))) char lds[];
    cg::grid_group grid = cg::this_grid();
    const int tid = threadIdx.x, bid = blockIdx.x, G = gridDim.x;
    unsigned char* ws = args.ws;
    PP p;
    p.x = args.in[0]; p.bias_table = args.in[1]; p.norm_mix = args.in[2]; p.norm_mlp = args.in[3]; p.norm_final = args.in[4]; p.mlp_w1 = args.in[5]; p.mlp_w2 = args.in[6];
    p.ev_w_in = args.in[7]; p.ev_w_out = args.in[8]; p.pos_k = args.in[9]; p.w1_k = args.in[10]; p.w2_k = args.in[11]; p.pos_v = args.in[12]; p.w1_v = args.in[13]; p.w2_v = args.in[14];
    p.lq1 = args.in[15]; p.lk1 = args.in[16]; p.lq2 = args.in[17]; p.lk2 = args.in[18]; p.subln = args.in[19]; p.od_w_in = args.in[20]; p.od_w_out = args.in[21];
    p.out = args.out;
    p.SSA = (float*)(ws + WS_SSA); p.SSB = (float*)(ws + WS_SSB); p.GATES = (float*)(ws + WS_GATES); p.CMPB = (float*)(ws + WS_CMPB); p.BIASL = (float*)(ws + WS_BIASL);
    p.KMEAN = (float*)(ws + WS_KMEAN); p.KMP = (float*)(ws + WS_KMP);
    p.KCMP = (bf16*)(ws + WS_KCMP); p.VCMP = (bf16*)(ws + WS_VCMP);
    p.WIN0 = (bf16*)(ws + WS_WIN0); p.WOUT0 = (bf16*)(ws + WS_WOUT0); p.W1_0 = (bf16*)(ws + WS_W1_0); p.W2_0 = (bf16*)(ws + WS_W2_0);
    p.WIN1 = (bf16*)(ws + WS_WIN1); p.WOUT1 = (bf16*)(ws + WS_WOUT1); p.W1_1 = (bf16*)(ws + WS_W1_1); p.W2_1 = (bf16*)(ws + WS_W2_1);
    p.CW1K = (bf16*)(ws + WS_CW1K); p.CW1V = (bf16*)(ws + WS_CW1V); p.CW2K = (bf16*)(ws + WS_CW2K); p.CW2V = (bf16*)(ws + WS_CW2V);
    p.XB = (bf16*)(ws + WS_XB); p.OC = (bf16*)(ws + WS_OC); p.H = (bf16*)(ws + WS_H); p.PROJ = (bf16*)(ws + WS_PROJ);
    const int lo = args.ph_lo, hi = args.ph_hi;
#define IN(k) (lo <= (k) && (k) < hi)
#define SEAM(k) do { if (IN(k) && IN((k) + 1)) grid.sync(); } while (0)

    if (IN(0)) { p0_prologue(p, lds, tid, bid, G); }
    SEAM(0);
    if (IN(1)) { gemm_rowscale<0>(lds, p.XB, p.WIN0, NP0, DM, p.PROJ, p.SSA, nullptr, 0, 0, tid, bid, G); }
    SEAM(1);
    if (IN(2)) { ncompress_phase(p, lds, tid, bid, G);
#if USE_MFMA_DIFF
        att::diff_phase(p, lds, tid, bid, G);
#else
        ndiff_phase(p, lds, tid, bid, G);
#endif
    }
    SEAM(2);
    if (IN(3)) {
#if USE_MFMA_NSA
        att::nsa_phase(p, lds, tid, bid, G);
#else
        nnsa_phase(p, lds, tid, bid, G);
#endif
    }
    SEAM(3);
    if (IN(4)) { gemm_residual(lds, p.OC, p.WOUT0, DM, p.x, p.out, p.XB, p.SSB, tid, bid, G); }
    SEAM(4);
    if (IN(5)) { gemm_rowscale<1>(lds, p.XB, p.W1_0, FF, DM, p.H, p.SSB, nullptr, 0, 0, tid, bid, G); }
    SEAM(5);
    if (IN(6)) { gemm_residual(lds, p.H, p.W2_0, FF, p.out, p.out, p.XB, p.SSA, tid, bid, G); }
    SEAM(6);
    if (IN(7)) {
#if USE_PG8
        gemm_rowscale<0>(lds, p.XB, p.WIN1, NP1, DM, p.PROJ, p.SSA, p.KMP, 4, 8, tid, bid, G);
#else
        gemm_rowscale<0>(lds, p.XB, p.WIN1, NP1, DM, p.PROJ, p.SSA, nullptr, 0, 0, tid, bid, G);
        grid.sync();
        nkmean_phase(p, tid, bid, G);
#endif
    }
    SEAM(7);
    if (IN(8)) {
#if USE_PG8
        kmean_from_partials(p, tid, bid, G); grid.sync();
#endif
#if USE_MFMA_MOBA
        att::moba_phase(p, lds, tid, bid, G);
#else
        nmoba_phase(p, tid, bid, G);
#endif
    }
    SEAM(8);
    if (IN(9)) { gemm_residual(lds, p.OC, p.WOUT1, DM, p.out, p.out, p.XB, p.SSB, tid, bid, G); }
    SEAM(9);
    if (IN(10)) { gemm_rowscale<1>(lds, p.XB, p.W1_1, FF, DM, p.H, p.SSB, nullptr, 0, 0, tid, bid, G); }
    SEAM(10);
    if (IN(11)) { gemm_residual(lds, p.H, p.W2_1, FF, p.out, p.out, p.XB, p.SSA, tid, bid, G); }
    SEAM(11);
    if (IN(12)) { final_norm_phase(p, tid, bid, G); }
#undef IN
#undef SEAM
}

extern "C" void kernel_launch(void* const* d_in, const int* in_sizes, int n_in, void* d_out, int out_size, void* d_ws, size_t ws_size, hipStream_t stream) {
    static int grid = 0;
    if (grid == 0) {
        if (n_in != 22 || out_size != M * DM || ws_size < WS_END) { fprintf(stderr, "kernel_launch: unexpected shapes (n_in %d out %d ws %zu)\n", n_in, out_size, ws_size); grid = -1; return; }
        int dev = 0, cus = 0, per_cu = 0;
        if (hipGetDevice(&dev) != hipSuccess || hipDeviceGetAttribute(&cus, hipDeviceAttributeMultiprocessorCount, dev) != hipSuccess) { grid = -1; return; }
        if (hipFuncSetAttribute((const void*)mk_fwd, hipFuncAttributeMaxDynamicSharedMemorySize, LDS_BYTES) != hipSuccess) { fprintf(stderr, "kernel_launch: hipFuncSetAttribute failed\n"); grid = -1; return; }
        if (hipOccupancyMaxActiveBlocksPerMultiprocessor(&per_cu, (const void*)mk_fwd, NTHR, LDS_BYTES) != hipSuccess || per_cu < 1) { fprintf(stderr, "kernel_launch: occupancy query says %d blocks per CU\n", per_cu); (void)hipGetLastError(); grid = -1; return; }
        grid = cus * 1;
    }
    if (grid < 0) return;
    Args a{};
    for (int i = 0; i < 22; ++i) a.in[i] = (const float*)d_in[i];
    a.out = (float*)d_out; a.ws = (unsigned char*)d_ws; a.ph_lo = 0; a.ph_hi = NPHASE;
    void* kargs[] = {&a};
    hipError_t e = hipLaunchCooperativeKernel((const void*)mk_fwd, dim3(grid), dim3(NTHR), kargs, LDS_BYTES, stream);
    if (e != hipSuccess) fprintf(stderr, "kernel_launch: cooperative launch failed: %s (grid %d)\n", hipGetErrorString(e), grid);
}
```

```cpp
#include <hip/hip_runtime.h>
#include <hip/hip_cooperative_groups.h>
#include <cstdint>
#include <cstdio>

typedef unsigned short bf16;
typedef unsigned v4u __attribute__((ext_vector_type(4)));
typedef float f32x4 __attribute__((ext_vector_type(4)));

constexpr int BATCH = 2, SEQ = 8192, DM = 1024, M = BATCH * SEQ, FF = 4096;
constexpr int NP0 = 2816, NP1 = 3072, EVEN_PROJ = 2840;
constexpr float EPS = 1e-6f;
constexpr float LOG2E = 1.4426950408889634f, C2 = 0.125f * LOG2E;
constexpr int C_Q = 0, C_KC = 512, C_VC = 640, C_KS = 768, C_VS = 896, C_KW = 1024, C_VW = 1152, C_DQ = 1280, C_DK = 1792, C_DV = 2304;
constexpr int NCMP = 511;

constexpr size_t MiB = 1u << 20;
constexpr size_t WS_CTL = 0;
constexpr size_t WS_SSA = 1 * MiB, WS_SSB = 2 * MiB;
constexpr size_t WS_GATES = 3 * MiB;
constexpr size_t WS_KCMP = 4 * MiB + 512 * 1024, WS_VCMP = WS_KCMP + 256 * 1024;
constexpr size_t WS_CMPB = 5 * MiB;
constexpr size_t WS_BIASL = 5 * MiB + 4096;
constexpr size_t WS_KMEAN = 5 * MiB + 256 * 1024;
constexpr size_t WS_WIN0 = 8 * MiB, WS_WOUT0 = 14 * MiB, WS_W1_0 = 16 * MiB, WS_W2_0 = 24 * MiB;
constexpr size_t WS_WIN1 = 32 * MiB, WS_WOUT1 = 38 * MiB, WS_W1_1 = 40 * MiB, WS_W2_1 = 48 * MiB;
constexpr size_t WS_CW1K = 56 * MiB, WS_CW1V = 56 * MiB + 512 * 1024, WS_CW2K = 57 * MiB, WS_CW2V = 57 * MiB + 64 * 1024;
constexpr size_t WS_XB = 58 * MiB, WS_OC = 90 * MiB, WS_H = 122 * MiB, WS_PROJ = 122 * MiB, WS_END = 250 * MiB;

__device__ __forceinline__ unsigned f2bf(float f) { unsigned u = __builtin_bit_cast(unsigned, f); return (u + 0x7fffu + ((u >> 16) & 1u)) >> 16; }
__device__ __forceinline__ float bf2f(unsigned h) { return __builtin_bit_cast(float, h << 16); }
__device__ __forceinline__ unsigned pk2(float lo, float hi) { return f2bf(lo) | (f2bf(hi) << 16); }
__device__ __forceinline__ float wave_sum(float v) {
#pragma unroll
    for (int o = 1; o < 64; o <<= 1) v += __shfl_xor(v, o);
    return v;
}
__device__ __forceinline__ float wave_max(float v) {
#pragma unroll
    for (int o = 1; o < 64; o <<= 1) v = fmaxf(v, __shfl_xor(v, o));
    return v;
}
__device__ __forceinline__ float rstd_of(const float* SS, int row) {
    const f32x4* p = (const f32x4*)(SS + (size_t)row * 16);
    f32x4 a = p[0], b = p[1], c = p[2], d = p[3];
    float s = ((a.x + a.y) + (a.z + a.w)) + ((b.x + b.y) + (b.z + b.w)) + ((c.x + c.y) + (c.z + c.w)) + ((d.x + d.y) + (d.z + d.w));
    return 1.0f / sqrtf(s * (1.0f / DM) + EPS);
}
__device__ __forceinline__ int t5_bucket(int rel) {
    int n = rel < 0 ? 0 : rel;
    if (n < 16) return n;
    int large = 16 + (int)(logf((float)n / 16.0f) / logf(8.0f) * 16.0f);
    return large < 31 ? large : 31;
}

namespace pg8 {
#define PG8_LAS __attribute__((address_space(3)))
typedef unsigned short bf16_t;
typedef short bf16x8 __attribute__((ext_vector_type(8)));
typedef float f32x4 __attribute__((ext_vector_type(4)));
typedef unsigned u32x4 __attribute__((ext_vector_type(4)));
constexpr int BM = 256, BK = 64, HALF = 128, HTB = HALF * BK * 2  , STAGE_BYTES = 8 * HTB, NXCD = 8, WGM = 8;

__host__ __device__ __forceinline__ int lds_byte(int r, int c) { const int st = (r >> 4) * 2 + (c >> 5), rr = r & 15, cc = c & 31, ob = rr * 64 + cc * 2; return st * 1024 + (ob ^ (((ob >> 9) & 1) << 5)); }
__host__ __device__ __forceinline__ void stage_rc(int b, int& R, int& C) { const int st = b / 1024, sb = b % 1024, swz = sb ^ (((sb >> 9) & 1) << 5); R = (st >> 1) * 16 + swz / 64; C = (st & 1) * 32 + (swz % 64) / 2; }
__host__ __device__ __forceinline__ int perm32(int rho) { const int n = rho >> 4, i = rho & 15; return 8 * (i >> 2) + 4 * n + (i & 3); }

struct Unit { int pm, pn; };
struct Gemm { const bf16_t* A; const bf16_t* Bt; int M, N, K; };

struct StaticOrder {
    int nM, nN, nwg, G, c;
    __host__ __device__ void init(int M, int N, int G_, int c_) { nM = M / BM; nN = N / BM; nwg = nM * nN; G = G_; c = c_; }
    __host__ __device__ bool next(int i, Unit& u) const {
        const long L = (long)i * G + c; if (L >= nwg) return false;
        int wgid = (int)L; { const int q = nwg / NXCD, r = nwg % NXCD, xcd = wgid % NXCD, off = wgid / NXCD; wgid = (xcd < r ? xcd * (q + 1) : r * (q + 1) + (xcd - r) * q) + off; }
        const int nig = WGM * nN, gid = wgid / nig, fm = gid * WGM, gsz = (nM - fm) < WGM ? (nM - fm) : WGM;
        u.pm = fm + ((wgid % nig) % gsz); u.pn = (wgid % nig) / gsz; return true;
    }
    __device__ __forceinline__ void a_ready(const Unit&) const {}
    __device__ __forceinline__ void done(const Unit&) const {}
};
__device__ __forceinline__ unsigned cvt_pk_bf16(float lo, float hi) { unsigned r; asm volatile("v_cvt_pk_bf16_f32 %0, %1, %2" : "=v"(r) : "v"(lo), "v"(hi)); return r; }
typedef float f32x2 __attribute__((ext_vector_type(2)));
template <class Epi, class Sched, bool ALIGN_EPI = false, bool SP2 = false>
__device__ __forceinline__ void gemm_phase(PG8_LAS unsigned char* lds, const Gemm g, const Sched& S, const Epi& E) {
    const int tid = threadIdx.x, wid = __builtin_amdgcn_readfirstlane(tid >> 6), lane = tid & 63, wr = wid >> 2, wc = wid & 3, fr = lane & 15, fq = lane >> 4;
    const int K = g.K, nt = K / BK;
    unsigned voffA[2], voffB[2];
#pragma unroll
    for (int i = 0; i < 2; ++i) { int R, C; stage_rc(tid * 16 + i * 8192, R, C); const int Rb = Epi::PERM ? ((R & ~31) + perm32(R & 31)) : R;
        voffA[i] = (unsigned)(R * K + C) * 2u; voffB[i] = (unsigned)(Rb * K + C) * 2u; }
    const size_t kstep = (size_t)(BK * 2);
    const size_t hstep = (size_t)HALF * K * 2;
    const size_t tstep = 2 * hstep;
    const unsigned ldsw = (unsigned)wid * 1024u;
    const int aoff = lds_byte(wr * 64 + fr, fq * 8), boff = lds_byte(wc * 32 + fr, fq * 8);
#define PG8_SA(b, h) (((b) * 2 + (h)) * HTB)
#define PG8_SB(b, h) ((4 + (b) * 2 + (h)) * HTB)
#define PG8_STAGE(bufoff, gbase, voff) do { _Pragma("unroll") for (int _i = 0; _i < 2; ++_i) \
        __builtin_amdgcn_global_load_lds((const unsigned*)((const char*)(gbase) + (voff)[_i]), (PG8_LAS unsigned*)(lds + (bufoff) + ldsw + _i * 8192), 16, 0, 0); } while (0)
#define PG8_LDA(dst, b, h) do { _Pragma("unroll") for (int m = 0; m < 4; ++m) _Pragma("unroll") for (int k = 0; k < 2; ++k) dst[m][k] = *(const PG8_LAS bf16x8*)(lds + PG8_SA(b, h) + aoff + m * 2048 + k * 1024); } while (0)
#define PG8_LDB(dst, b, h) do { _Pragma("unroll") for (int n = 0; n < 2; ++n) _Pragma("unroll") for (int k = 0; k < 2; ++k) dst[n][k] = *(const PG8_LAS bf16x8*)(lds + PG8_SB(b, h) + boff + n * 2048 + k * 1024); } while (0)
#define PG8_MMA(ai, bj, At, Bt) do { __builtin_amdgcn_s_setprio(1); _Pragma("unroll") for (int m = 0; m < 4; ++m) _Pragma("unroll") for (int n = 0; n < 2; ++n) _Pragma("unroll") for (int k = 0; k < 2; ++k) \
        acc[ai][bj][m][n] = __builtin_amdgcn_mfma_f32_16x16x32_bf16(Bt[n][k], At[m][k], acc[ai][bj][m][n], 0, 0, 0); __builtin_amdgcn_s_setprio(0); } while (0)
#define PG8_WAIT_V(n) asm volatile("s_waitcnt vmcnt(" #n ")" ::: "memory")
#define PG8_WAIT_L(n) asm volatile("s_waitcnt lgkmcnt(" #n ")" ::: "memory")
#define PG8_BAR __builtin_amdgcn_s_barrier()
#define PG8_SCHED __builtin_amdgcn_sched_barrier(0)
    Unit cur, nxt; int ui = 0;
    if (!S.next(0, cur)) return;
    f32x4 acc[2][2][4][2];
#pragma unroll
    for (int a = 0; a < 2; ++a)
#pragma unroll
        for (int b = 0; b < 2; ++b)
#pragma unroll
            for (int m = 0; m < 4; ++m)
#pragma unroll
                for (int n = 0; n < 2; ++n) acc[a][b][m][n] = (f32x4){0.f, 0.f, 0.f, 0.f};
    bf16x8 At[4][2], B0[2][2], B1[2][2];
    const char* cA = (const char*)g.A + (size_t)cur.pm * tstep; const char* cB = (const char*)g.Bt + (size_t)cur.pn * tstep;
    S.a_ready(cur);
    if constexpr (SP2) {
        PG8_STAGE(PG8_SB(0, 0), cB, voffB); PG8_STAGE(PG8_SB(0, 1), cB + hstep, voffB); PG8_STAGE(PG8_SA(0, 0), cA, voffA); PG8_STAGE(PG8_SA(0, 1), cA + hstep, voffA);
        if (wr == 1) PG8_BAR;
        PG8_WAIT_V(2); PG8_BAR;
        PG8_STAGE(PG8_SB(1, 0), cB + kstep, voffB); PG8_STAGE(PG8_SA(1, 0), cA + kstep, voffA); PG8_STAGE(PG8_SB(1, 1), cB + hstep + kstep, voffB);
        PG8_WAIT_V(6); PG8_BAR;
    } else {
        PG8_STAGE(PG8_SB(0, 0), cB, voffB); PG8_STAGE(PG8_SA(0, 0), cA, voffA); PG8_STAGE(PG8_SB(0, 1), cB + hstep, voffB); PG8_STAGE(PG8_SA(0, 1), cA + hstep, voffA);
        if (wr == 1) PG8_BAR;
        PG8_WAIT_V(4); PG8_BAR;
        PG8_STAGE(PG8_SB(1, 0), cB + kstep, voffB); PG8_STAGE(PG8_SA(1, 0), cA + kstep, voffA); PG8_STAGE(PG8_SB(1, 1), cB + hstep + kstep, voffB);
        PG8_WAIT_V(6); PG8_BAR;
    }
    for (;;) {
        const bool has_next = S.next(ui + 1, nxt);
        const char* nA = has_next ? (const char*)g.A + (size_t)nxt.pm * tstep : cA; const char* nB = has_next ? (const char*)g.Bt + (size_t)nxt.pn * tstep : cB;
        for (int t = 0; t < nt; t += 2) {
            const bool last = (t == nt - 2);
            const char* a1 = cA + (size_t)(t + 1) * kstep;
            const char* a2 = last ? nA : cA + (size_t)(t + 2) * kstep; const char* b2 = last ? nB : cB + (size_t)(t + 2) * kstep;
            const char* a3 = a2 + kstep; const char* b3 = b2 + kstep;
            if (last && has_next) S.a_ready(nxt);
            if constexpr (SP2) {
            PG8_LDB(B0, 0, 0); PG8_LDB(B1, 0, 1); PG8_SCHED; PG8_LDA(At, 0, 0); PG8_STAGE(PG8_SA(1, 1), a1 + hstep, voffA);
            PG8_WAIT_V(8); PG8_WAIT_L(0); PG8_BAR; PG8_MMA(0, 0, At, B0); PG8_MMA(0, 1, At, B1); PG8_BAR; PG8_SCHED;
            PG8_LDA(At, 0, 1); PG8_STAGE(PG8_SB(0, 0), b2, voffB); PG8_STAGE(PG8_SB(0, 1), b2 + hstep, voffB); PG8_STAGE(PG8_SA(0, 0), a2, voffA);
            PG8_WAIT_V(8); PG8_WAIT_L(0); PG8_BAR; PG8_MMA(1, 0, At, B0); PG8_MMA(1, 1, At, B1); PG8_BAR; PG8_SCHED;
            PG8_LDB(B0, 1, 0); PG8_LDB(B1, 1, 1); PG8_SCHED; PG8_LDA(At, 1, 0); PG8_STAGE(PG8_SA(0, 1), a2 + hstep, voffA);
            PG8_WAIT_V(8); PG8_WAIT_L(0); PG8_BAR; PG8_MMA(0, 0, At, B0); PG8_MMA(0, 1, At, B1); PG8_BAR; PG8_SCHED;
            PG8_LDA(At, 1, 1); PG8_STAGE(PG8_SB(1, 0), b3, voffB); PG8_STAGE(PG8_SB(1, 1), b3 + hstep, voffB); PG8_STAGE(PG8_SA(1, 0), a3, voffA);
            PG8_WAIT_V(8); PG8_WAIT_L(0); PG8_BAR; PG8_MMA(1, 0, At, B0); PG8_MMA(1, 1, At, B1); PG8_BAR; PG8_SCHED;
            } else {
            PG8_LDB(B0, 0, 0); PG8_SCHED; PG8_LDA(At, 0, 0); PG8_STAGE(PG8_SA(1, 1), a1 + hstep, voffA);
            PG8_WAIT_L(8); PG8_BAR; PG8_WAIT_L(0); PG8_MMA(0, 0, At, B0); PG8_BAR; PG8_SCHED;
            PG8_LDB(B1, 0, 1); PG8_STAGE(PG8_SB(0, 0), b2, voffB);
            PG8_BAR; PG8_WAIT_L(0); PG8_MMA(0, 1, At, B1); PG8_BAR;
            PG8_LDA(At, 0, 1); PG8_STAGE(PG8_SA(0, 0), a2, voffA);
            PG8_BAR; PG8_WAIT_L(0); PG8_MMA(1, 0, At, B0); PG8_BAR; PG8_SCHED;
            PG8_STAGE(PG8_SB(0, 1), b2 + hstep, voffB);
            PG8_WAIT_V(6); PG8_BAR; PG8_MMA(1, 1, At, B1); PG8_BAR;
            PG8_LDB(B0, 1, 0); PG8_SCHED; PG8_LDA(At, 1, 0); PG8_STAGE(PG8_SA(0, 1), a2 + hstep, voffA);
            PG8_WAIT_L(8); PG8_BAR; PG8_WAIT_L(0); PG8_MMA(0, 0, At, B0); PG8_BAR; PG8_SCHED;
            PG8_LDB(B1, 1, 1); PG8_STAGE(PG8_SB(1, 0), b3, voffB);
            PG8_BAR; PG8_WAIT_L(0); PG8_MMA(0, 1, At, B1); PG8_BAR;
            PG8_LDA(At, 1, 1); PG8_STAGE(PG8_SA(1, 0), a3, voffA);
            PG8_BAR; PG8_WAIT_L(0); PG8_MMA(1, 0, At, B0); PG8_BAR; PG8_SCHED;
            PG8_STAGE(PG8_SB(1, 1), b3 + hstep, voffB);
            PG8_WAIT_V(6); PG8_BAR; PG8_MMA(1, 1, At, B1); PG8_BAR;
            }
        }
        if constexpr (ALIGN_EPI) { if (wr == 0) PG8_BAR; }
        if constexpr (!Epi::AFTER_DRAIN) { E(acc, cur, wr, wc, fr, fq); S.done(cur); }
        if (!has_next) break;
#pragma unroll
        for (int a = 0; a < 2; ++a)
#pragma unroll
            for (int b = 0; b < 2; ++b)
#pragma unroll
                for (int m = 0; m < 4; ++m)
#pragma unroll
                    for (int n = 0; n < 2; ++n) acc[a][b][m][n] = (f32x4){0.f, 0.f, 0.f, 0.f};
        cur = nxt; cA = nA; cB = nB; ++ui;
        if constexpr (ALIGN_EPI) { if (wr == 1) PG8_BAR; }
    }
    PG8_WAIT_V(0);
    if constexpr (!ALIGN_EPI) { if (wr == 0) PG8_BAR; }
    PG8_BAR;
    if constexpr (Epi::AFTER_DRAIN) { E.fused(acc, cur, wr, wc, fr, fq, lds, wid, lane); S.done(cur); }
#undef PG8_SA
#undef PG8_SB
#undef PG8_STAGE
#undef PG8_LDA
#undef PG8_LDB
#undef PG8_MMA
#undef PG8_WAIT_V
#undef PG8_WAIT_L
#undef PG8_BAR
#undef PG8_SCHED
}
}

namespace pg8 {
template <int MODE> struct EpiRowScaleBf16 {
    static constexpr bool PERM = true, AFTER_DRAIN = false;
    bf16_t* O; const float* SS; float* KMP; int ldc, kt_lo, kt_hi, pad;
    __device__ __forceinline__ void operator()(const f32x4 (&acc)[2][2][4][2], const Unit& u, int wr, int wc, int fr, int fq) const {
        const int row0 = u.pm * BM + wr * 64 + fr, col0 = u.pn * BM + wc * 32 + 8 * fq;
        const bool do_km = (u.pn >= kt_lo && u.pn < kt_hi);
        float cs[2][8];
#pragma unroll
        for (int bj = 0; bj < 2; ++bj)
#pragma unroll
            for (int e = 0; e < 8; ++e) cs[bj][e] = 0.f;
#pragma unroll
        for (int ai = 0; ai < 2; ++ai)
#pragma unroll
            for (int m = 0; m < 4; ++m) { const int row = row0 + ai * HALF + m * 16; const float rs = rstd_of(SS, row); bf16_t* rowp = O + (size_t)row * ldc + col0;
#pragma unroll
                for (int bj = 0; bj < 2; ++bj) { f32x4 v0 = acc[ai][bj][m][0] * rs, v1 = acc[ai][bj][m][1] * rs;
                    if (MODE == 1) {
#pragma unroll
                        for (int e = 0; e < 4; ++e) { float a = v0[e] > 0.f ? v0[e] : 0.f; v0[e] = a * a; float b = v1[e] > 0.f ? v1[e] : 0.f; v1[e] = b * b; } }
                    if (MODE == 0 && do_km) {
#pragma unroll
                        for (int e = 0; e < 4; ++e) { cs[bj][e] += v0[e]; cs[bj][4 + e] += v1[e]; } }
                    u32x4 w; w.x = cvt_pk_bf16(v0[0], v0[1]); w.y = cvt_pk_bf16(v0[2], v0[3]); w.z = cvt_pk_bf16(v1[0], v1[1]); w.w = cvt_pk_bf16(v1[2], v1[3]);
                    *(u32x4*)(rowp + bj * HALF) = w; } }
        if (MODE == 0 && do_km) {
            const int b = u.pm >> 5, blk = u.pm & 31;
#pragma unroll
            for (int bj = 0; bj < 2; ++bj)
#pragma unroll
                for (int e = 0; e < 8; ++e) { float s = cs[bj][e]; s += __shfl_xor(s, 1); s += __shfl_xor(s, 2); s += __shfl_xor(s, 4); s += __shfl_xor(s, 8);
                    if (fr == 0) { const int kc = (u.pn - kt_lo) * BM + bj * HALF + wc * 32 + 8 * fq + e;
                        KMP[(((size_t)wr * 2 + b) * 16 + (kc >> 6)) * 32 * 64 + (size_t)blk * 64 + (kc & 63)] = s; } }
        }
    }
};
struct EpiResidual {
    static constexpr bool PERM = false, AFTER_DRAIN = false;
    const float* xin; float* xout; bf16_t* xb; float* SS;
    __device__ __forceinline__ void operator()(const f32x4 (&acc)[2][2][4][2], const Unit& u, int wr, int wc, int fr, int fq) const {
        typedef unsigned u32x2v __attribute__((ext_vector_type(2)));
        const int col0 = u.pn * BM + wc * 32 + 4 * fq;
#pragma unroll
        for (int ai = 0; ai < 2; ++ai)
#pragma unroll
            for (int m = 0; m < 4; ++m) { const int row = u.pm * BM + ai * HALF + wr * 64 + m * 16 + fr; const size_t off = (size_t)row * DM + col0; float sq = 0.f;
#pragma unroll
                for (int bj = 0; bj < 2; ++bj)
#pragma unroll
                    for (int n = 0; n < 2; ++n) { const f32x4 bs = *(const f32x4*)(xin + off + bj * HALF + n * 16); const f32x4 o = bs + acc[ai][bj][m][n];
                        *(f32x4*)(xout + off + bj * HALF + n * 16) = o; sq += (o[0] * o[0] + o[1] * o[1]) + (o[2] * o[2] + o[3] * o[3]);
                        u32x2v w; w.x = cvt_pk_bf16(o[0], o[1]); w.y = cvt_pk_bf16(o[2], o[3]); *(u32x2v*)(xb + off + bj * HALF + n * 16) = w; }
                sq += __shfl_xor(sq, 16); sq += __shfl_xor(sq, 32);
                if (fq == 0) SS[(size_t)row * 16 + u.pn * 4 + wc] = sq; }
    }
};
}

namespace cg = cooperative_groups;
constexpr int NTHR = 512;
constexpr int LDS_BYTES = 147456;
constexpr size_t WS_KMP = 6 * MiB;
#ifndef USE_MFMA_MOBA
#define USE_MFMA_MOBA 1
#endif
#ifndef USE_MFMA_DIFF
#define USE_MFMA_DIFF 1
#endif
#ifndef USE_MFMA_NSA
#define USE_MFMA_NSA 1
#endif
#ifndef USE_PG8
#define USE_PG8 1
#endif

struct Args { const float* in[22]; float* out; unsigned char* ws; int ph_lo, ph_hi; };

struct PP {
    const float *x, *bias_table, *norm_mix, *norm_mlp, *norm_final, *mlp_w1, *mlp_w2, *ev_w_in, *ev_w_out, *pos_k, *w1_k, *w2_k, *pos_v, *w1_v, *w2_v, *lq1, *lk1, *lq2, *lk2, *subln, *od_w_in, *od_w_out;
    float* out; float *SSA, *SSB, *GATES, *CMPB, *BIASL, *KMEAN, *KMP;
    bf16 *KCMP, *VCMP, *WIN0, *WOUT0, *W1_0, *W2_0, *WIN1, *WOUT1, *W1_1, *W2_1, *CW1K, *CW1V, *CW2K, *CW2V, *XB, *OC, *H, *PROJ;
};

struct WJob { const float* W; bf16* WT; const float* kscale; int K, Nsrc, Ndst, kind; };
__device__ __forceinline__ void transpose_item(const WJob& J, int item, float* scr, int lane) {
    const int nblk = J.Ndst / 32, kb = item / nblk, nb = item % nblk, k0 = 64 * kb, n0 = 32 * nb;
    int s0 = n0; float cs = 1.0f;
    if (J.kind == 1) { s0 = n0 < 1280 ? n0 : n0 + 24; if (n0 < 512 || (n0 >= C_DQ && n0 < C_DK)) cs = C2; }
    if (J.kind == 2) { if (n0 < 1024) cs = C2; }
#pragma unroll 8
    for (int i = 0; i < 32; ++i) { const int kk = 2 * i + (lane >> 5); scr[kk * 33 + (lane & 31)] = J.W[(size_t)(k0 + kk) * J.Nsrc + s0 + (lane & 31)]; }
    __builtin_amdgcn_s_waitcnt(0xC07F); asm volatile("" ::: "memory");
    const int c = lane & 7;
    float ks[8];
#pragma unroll
    for (int i = 0; i < 8; ++i) ks[i] = (J.kscale ? J.kscale[k0 + 8 * c + i] : 1.0f) * cs;
#pragma unroll
    for (int j = 0; j < 4; ++j) { const int n = (lane >> 3) + 8 * j; const float* s = scr + (8 * c) * 33 + n;
        v4u o; o.x = pk2(s[0 * 33] * ks[0], s[1 * 33] * ks[1]); o.y = pk2(s[2 * 33] * ks[2], s[3 * 33] * ks[3]); o.z = pk2(s[4 * 33] * ks[4], s[5 * 33] * ks[5]); o.w = pk2(s[6 * 33] * ks[6], s[7 * 33] * ks[7]);
        *(v4u*)(J.WT + (size_t)(n0 + n) * J.K + k0 + 8 * c) = o; }
    __builtin_amdgcn_s_waitcnt(0xC07F); asm volatile("" ::: "memory");
}
__device__ __forceinline__ void job_items(const WJob& J, int& base, int gw, int NGW, float* scr, int lane) {
    const int nit = (J.K / 64) * (J.Ndst / 32);
    const int first = ((gw - base) % NGW + NGW) % NGW;
    for (int it = first; it < nit; it += NGW) transpose_item(J, it, scr, lane);
    base += nit;
}
constexpr int WG_PITCH = 1028;
__device__ __forceinline__ void p0_prologue(const PP& p, char* lds, int tid, int bid, int G) {
    const int lane = tid & 63, wave = tid >> 6;
    {
        float* scr = (float*)lds + wave * 64 * 33;
        const int gw = bid * 8 + wave, NGW = G * 8; int base = 0;
        job_items(WJob{p.ev_w_in, p.WIN0, p.norm_mix, DM, EVEN_PROJ, NP0, 1}, base, gw, NGW, scr, lane);
        job_items(WJob{p.ev_w_out, p.WOUT0, nullptr, DM, DM, DM, 0}, base, gw, NGW, scr, lane);
        job_items(WJob{p.mlp_w1, p.W1_0, p.norm_mlp, DM, FF, FF, 0}, base, gw, NGW, scr, lane);
        job_items(WJob{p.mlp_w2, p.W2_0, nullptr, FF, DM, DM, 0}, base, gw, NGW, scr, lane);
        job_items(WJob{p.od_w_in, p.WIN1, p.norm_mix + DM, DM, NP1, NP1, 2}, base, gw, NGW, scr, lane);
        job_items(WJob{p.od_w_out, p.WOUT1, nullptr, DM, DM, DM, 0}, base, gw, NGW, scr, lane);
        job_items(WJob{p.mlp_w1 + (size_t)DM * FF, p.W1_1, p.norm_mlp + DM, DM, FF, FF, 0}, base, gw, NGW, scr, lane);
        job_items(WJob{p.mlp_w2 + (size_t)DM * FF, p.W2_1, nullptr, FF, DM, DM, 0}, base, gw, NGW, scr, lane);
        job_items(WJob{p.w1_k, p.CW1K, nullptr, 2048, 128, 128, 0}, base, gw, NGW, scr, lane);
        job_items(WJob{p.w1_v, p.CW1V, nullptr, 2048, 128, 128, 0}, base, gw, NGW, scr, lane);
        job_items(WJob{p.w2_k, p.CW2K, nullptr, 128, 64, 64, 0}, base, gw, NGW, scr, lane);
        job_items(WJob{p.w2_v, p.CW2V, nullptr, 128, 64, 64, 0}, base, gw, NGW, scr, lane);
    }
    __syncthreads();
    if (bid == 0) { for (int i = tid; i < 16 * 128; i += NTHR) { const int h = i >> 7, rel = i & 127; p.BIASL[i] = p.bias_table[t5_bucket(rel) * 16 + h] * LOG2E; } }
    if (bid == 1 % G || bid == 2 % G) {
        for (int which = 0; which < 2; ++which) { if (bid != (1 + which) % G) continue;
            const float* pos = which == 0 ? p.pos_k : p.pos_v; const float* w1 = which == 0 ? p.w1_k : p.w1_v;
            float* part = (float*)lds; const int n = tid & 127, pr = tid >> 7; float s = 0.f;
            for (int kk = pr * 512; kk < pr * 512 + 512; ++kk) s += pos[kk] * w1[(size_t)kk * 128 + n];
            part[pr * 128 + n] = s; __syncthreads();
            if (tid < 128) p.CMPB[which * 128 + tid] = (part[tid] + part[128 + tid]) + (part[256 + tid] + part[384 + tid]);
            __syncthreads(); }
    }
    __syncthreads();
    float* wg = (float*)lds;
    for (int idx = tid; idx < 24 * 1024; idx += NTHR) { const int k = idx / 24, j = idx % 24; wg[j * WG_PITCH + k] = p.ev_w_in[(size_t)k * EVEN_PROJ + 1280 + j] * p.norm_mix[k]; }
    __syncthreads();
    for (int row = bid * 8 + wave; row < M; row += G * 8) {
        const f32x4* xr = (const f32x4*)(p.x + (size_t)row * DM) + lane;
        f32x4 v[4]; float s = 0.f;
#pragma unroll
        for (int j = 0; j < 4; ++j) { v[j] = xr[64 * j]; s += (v[j].x * v[j].x + v[j].y * v[j].y) + (v[j].z * v[j].z + v[j].w * v[j].w); }
        s = wave_sum(s);
        const float rstd = 1.0f / sqrtf(s * (1.0f / DM) + EPS);
        unsigned long long* o8 = (unsigned long long*)(p.XB + (size_t)row * DM) + lane;
#pragma unroll
        for (int j = 0; j < 4; ++j) o8[64 * j] = (unsigned long long)pk2(v[j].x, v[j].y) | ((unsigned long long)pk2(v[j].z, v[j].w) << 32);
        if (lane < 16) p.SSA[(size_t)row * 16 + lane] = lane == 0 ? s : 0.f;
        float gsum = 0.f;
#pragma unroll 1
        for (int g = 0; g < 24; ++g) {
            float a = 0.f;
#pragma unroll
            for (int j = 0; j < 4; ++j) { const f32x4 w = *(const f32x4*)(wg + g * WG_PITCH + 256 * j + 4 * lane); a += (v[j].x * w.x + v[j].y * w.y) + (v[j].z * w.z + v[j].w * w.w); }
            a = wave_sum(a);
            if (lane == g) gsum = a;
        }
        if (lane < 24) p.GATES[(size_t)row * 24 + lane] = 1.0f / (1.0f + expf(-gsum * rstd));
    }
    __syncthreads();
}

struct NEpiProj { bf16* out; const float* SS; int ldc;
    __device__ __forceinline__ float rowscale(int row) const { return rstd_of(SS, row); }
    __device__ __forceinline__ float tile4(int row, int col, const float (&a)[4], float rs) const {
#pragma unroll
        for (int j = 0; j < 4; ++j) out[(size_t)row * ldc + col + j] = (bf16)f2bf(a[j] * rs);
        return 0.f; }
    __device__ __forceinline__ void rowstat(int, int, float) const {} };
struct NEpiRes { const float* xin; float* xout; bf16* xb; float* SS;
    __device__ __forceinline__ float rowscale(int) const { return 1.f; }
    __device__ __forceinline__ float tile4(int row, int col, const float (&a)[4], float) const { float sq = 0.f;
#pragma unroll
        for (int j = 0; j < 4; ++j) { const float v = xin[(size_t)row * DM + col + j] + a[j]; xout[(size_t)row * DM + col + j] = v; xb[(size_t)row * DM + col + j] = (bf16)f2bf(v); sq += v * v; }
        return sq; }
    __device__ __forceinline__ void rowstat(int row, int slot, float s) const { SS[(size_t)row * 16 + slot] = s; } };
struct NEpiMlp1 { bf16* H; const float* SS;
    __device__ __forceinline__ float rowscale(int row) const { return rstd_of(SS, row); }
    __device__ __forceinline__ float tile4(int row, int col, const float (&a)[4], float rs) const {
#pragma unroll
        for (int j = 0; j < 4; ++j) { float v = a[j] * rs; v = v > 0.f ? v : 0.f; H[(size_t)row * FF + col + j] = (bf16)f2bf(v * v); }
        return 0.f; }
    __device__ __forceinline__ void rowstat(int, int, float) const {} };

template <class Epi>
__device__ __forceinline__ void ngemm_phase(char* lds, const bf16* A, const bf16* Bt, int N, int K, const Epi& E, int tid, int bid, int G) {
    const int sub = tid >> 8, t = tid & 255, tx = t & 15, ty = t >> 4;
    float* As = (float*)lds + sub * (2 * 32 * 65); float* Bs = As + 32 * 65;
    const int nbx = N / 64, npairs = nbx * (M / 64) / 2;
    const int lr = t >> 2, lk = (t & 3) * 8;
    for (int it = bid; it < npairs; it += G) {
        const int tile = it * 2 + sub; const int m0 = (tile / nbx) * 64, n0 = (tile % nbx) * 64;
        float acc[4][4] = {};
        for (int k0 = 0; k0 < K; k0 += 32) {
            const v4u a = *(const v4u*)(A + (size_t)(m0 + lr) * K + k0 + lk);
            const v4u b = *(const v4u*)(Bt + (size_t)(n0 + lr) * K + k0 + lk);
            __syncthreads();
            const unsigned au[4] = {a.x, a.y, a.z, a.w}, bu[4] = {b.x, b.y, b.z, b.w};
#pragma unroll
            for (int i = 0; i < 4; ++i) { As[(lk + 2 * i) * 65 + lr] = bf2f(au[i] & 0xffff); As[(lk + 2 * i + 1) * 65 + lr] = bf2f(au[i] >> 16); Bs[(lk + 2 * i) * 65 + lr] = bf2f(bu[i] & 0xffff); Bs[(lk + 2 * i + 1) * 65 + lr] = bf2f(bu[i] >> 16); }
            __syncthreads();
#pragma unroll 8
            for (int k = 0; k < 32; ++k) {
                float av[4], bv[4];
#pragma unroll
                for (int i = 0; i < 4; ++i) { av[i] = As[k * 65 + ty * 4 + i]; bv[i] = Bs[k * 65 + tx * 4 + i]; }
#pragma unroll
                for (int i = 0; i < 4; ++i)
#pragma unroll
                    for (int j = 0; j < 4; ++j) acc[i][j] += av[i] * bv[j];
            }
        }
#pragma unroll
        for (int i = 0; i < 4; ++i) { const int row = m0 + ty * 4 + i; const float rs = E.rowscale(row);
            float sq = E.tile4(row, n0 + tx * 4, acc[i], rs);
            sq += __shfl_xor(sq, 1); sq += __shfl_xor(sq, 2); sq += __shfl_xor(sq, 4); sq += __shfl_xor(sq, 8);
            if (tx == 0) E.rowstat(row, n0 / 64, sq); }
    }
    __syncthreads();
}

__device__ __forceinline__ float gelu_tanh(float x) { const float u = 0.7978845608028654f * (x + 0.044715f * x * x * x); return 0.5f * x * (1.0f + tanhf(u)); }
__device__ __forceinline__ void ncompress_phase(const PP& p, char* lds, int tid, int bid, int G) {
    const int sub = tid >> 7, t = tid & 127;
    float* a = (float*)lds + sub * (2048 + 128); float* hid = a + 2048;
    for (int it = bid; it < 1024; it += G) {
        int id = it * 4 + sub; const int c = id % 512; id /= 512; const int g = id % 2; id /= 2; const int b = id % 2; const int kv = id / 2;
        bf16* outp = (kv ? p.VCMP : p.KCMP) + ((size_t)((b * 2 + g) * 512 + c)) * 64;
        const bool live = c < NCMP; const int cc = live ? c : 0;
        const int col = (kv ? C_VC : C_KC) + g * 64;
        __syncthreads();
        for (int i = t; i < 2048; i += 128) { const int j = i >> 6, d = i & 63; a[i] = bf2f(p.PROJ[(size_t)(b * SEQ + 16 * cc + j) * NP0 + col + d]); }
        __syncthreads();
        const bf16* w1 = (kv ? p.CW1V : p.CW1K) + (size_t)t * 2048; float s = p.CMPB[kv * 128 + t];
        for (int k = 0; k < 2048; k += 8) { const v4u u = *(const v4u*)(w1 + k);
            s += a[k] * bf2f(u.x & 0xffff) + a[k + 1] * bf2f(u.x >> 16) + a[k + 2] * bf2f(u.y & 0xffff) + a[k + 3] * bf2f(u.y >> 16) + a[k + 4] * bf2f(u.z & 0xffff) + a[k + 5] * bf2f(u.z >> 16) + a[k + 6] * bf2f(u.w & 0xffff) + a[k + 7] * bf2f(u.w >> 16); }
        hid[t] = bf2f(f2bf(gelu_tanh(s)));
        __syncthreads();
        if (t < 64) { const bf16* w2 = (kv ? p.CW2V : p.CW2K) + (size_t)t * 128; float o = 0.f; for (int n = 0; n < 128; ++n) o += hid[n] * bf2f(w2[n]); outp[t] = live ? (bf16)f2bf(o) : (bf16)0; }
    }
    __syncthreads();
}

template <int NV> struct NAcc { float m, l, o[NV]; };
template <int NV> __device__ __forceinline__ void nacc_init(NAcc<NV>& a) { a.m = -1e30f; a.l = 0.f;
#pragma unroll
    for (int j = 0; j < NV; ++j) a.o[j] = 0.f; }
__device__ __forceinline__ void load_q64(float (&q)[64], const bf16* qp) {
#pragma unroll
    for (int i = 0; i < 8; ++i) { const v4u u = ((const v4u*)qp)[i];
        q[8 * i + 0] = bf2f(u.x & 0xffff); q[8 * i + 1] = bf2f(u.x >> 16); q[8 * i + 2] = bf2f(u.y & 0xffff); q[8 * i + 3] = bf2f(u.y >> 16);
        q[8 * i + 4] = bf2f(u.z & 0xffff); q[8 * i + 5] = bf2f(u.z >> 16); q[8 * i + 6] = bf2f(u.w & 0xffff); q[8 * i + 7] = bf2f(u.w >> 16); }
}
__device__ __forceinline__ float dot64(const float (&q)[64], const bf16* kp) {
    float s = 0.f;
#pragma unroll
    for (int i = 0; i < 8; ++i) { const v4u u = ((const v4u*)kp)[i];
        s += q[8 * i + 0] * bf2f(u.x & 0xffff) + q[8 * i + 1] * bf2f(u.x >> 16) + q[8 * i + 2] * bf2f(u.y & 0xffff) + q[8 * i + 3] * bf2f(u.y >> 16)
           + q[8 * i + 4] * bf2f(u.z & 0xffff) + q[8 * i + 5] * bf2f(u.z >> 16) + q[8 * i + 6] * bf2f(u.w & 0xffff) + q[8 * i + 7] * bf2f(u.w >> 16); }
    return s;
}
template <int NV> __device__ __forceinline__ void ntile(NAcc<NV>& a, const float (&q)[64], const bf16* kp, const bf16* vp, bool valid, float bias, int lane) {
    const float s = valid ? dot64(q, kp) + bias : -INFINITY;
    const float tm = wave_max(s);
    const float mn = fmaxf(a.m, tm), f = exp2f(a.m - mn), pr = exp2f(s - mn);
    a.l = a.l * f + wave_sum(pr); a.m = mn;
#pragma unroll
    for (int j = 0; j < NV; ++j) a.o[j] *= f;
    const unsigned long long vpi = (unsigned long long)(uintptr_t)vp;
    const unsigned vlo = (unsigned)vpi, vhi = (unsigned)(vpi >> 32);
    for (int k = 0; k < 64; ++k) {
        const float pk = __shfl(pr, k);
        const unsigned lo = __shfl(vlo, k), hi = __shfl(vhi, k);
        if (pk != 0.f) { const bf16* vr = (const bf16*)(uintptr_t)(((unsigned long long)hi << 32) | lo);
#pragma unroll
            for (int j = 0; j < NV; ++j) a.o[j] += pk * bf2f(vr[lane + 64 * j]); }
    }
}

__device__ __forceinline__ void nnsa_phase(const PP& p, char* lds, int tid, int bid, int G) {
    const int sub = tid >> 8, t256 = tid & 255, lane = tid & 63, r = t256 >> 6;
    float* base = (float*)lds + sub * (4 * 512 + 4 * 128 + 128 + 16);
    float* sc = base + r * 512; float* imph = base + 4 * 512; float* score = imph + 4 * 128; int* sel = (int*)(score + 128);
    for (int it = bid; it < M * 2 / 2; it += G) {
        int id = it * 2 + sub; const int t = id % SEQ; id /= SEQ; const int g = id % 2; const int b = id / 2;
        const int hh = g * 4 + r; const size_t row = (size_t)b * SEQ + t;
        const float* bl = p.BIASL + hh * 128;
        float q[64]; load_q64(q, p.PROJ + row * NP0 + C_Q + hh * 64);
        const int nvis = t >= 31 ? ((t - 31) / 16 + 1 < NCMP ? (t - 31) / 16 + 1 : NCMP) : 0;
        const bf16* kc = p.KCMP + (size_t)((b * 2 + g) * 512) * 64; const bf16* vc = p.VCMP + (size_t)((b * 2 + g) * 512) * 64;
        __syncthreads();
        float mx = -INFINITY;
        for (int c0 = 0; c0 < nvis; c0 += 64) { const int c = c0 + lane; float s = -INFINITY;
            if (c < nvis) { int rel = t - (16 * c + 31); rel = rel > 127 ? 127 : rel; s = dot64(q, kc + (size_t)c * 64) + bl[rel]; }
            sc[c] = s; mx = fmaxf(mx, s); }
        mx = wave_max(mx);
        float ls = 0.f;
        for (int c0 = 0; c0 < nvis; c0 += 64) { const int c = c0 + lane; const float e = exp2f(sc[c] - mx); sc[c] = e; ls += e; }
        ls = wave_sum(ls);
        const float rl = ls > 0.f ? 1.0f / ls : 0.f;
        for (int c = lane; c < 512; c += 64) sc[c] = c < nvis ? sc[c] * rl : 0.f;
        float oc = 0.f;
        for (int c = 0; c < nvis; ++c) oc += sc[c] * bf2f(vc[(size_t)c * 64 + lane]);
        for (int n = lane; n < 128; n += 64) { float a = ((sc[4 * n] + sc[4 * n + 1]) + sc[4 * n + 2]) + 0.5f * sc[4 * n + 3]; if (n > 0) a += 0.5f * sc[4 * n - 1]; imph[r * 128 + n] = a; }
        __syncthreads();
        const int cur = t >> 6;
        if (t256 < 128) { const int n = t256; const float imp = (imph[n] + imph[128 + n]) + (imph[256 + n] + imph[384 + n]);
            const bool elig = n <= cur, forced = (n == 0) || (n == cur) || (n == cur - 1);
            score[n] = elig ? imp + (forced ? 1000.f : 0.f) : -1.0f; }
        __syncthreads();
        if (t256 < 128) { const int n = t256; const float v = score[n]; int rank = 0;
            for (int j = 0; j < 128; ++j) { const float u = score[j]; rank += (u > v || (u == v && j < n)) ? 1 : 0; }
            if (rank < 16) sel[rank] = n; }
        __syncthreads();
        NAcc<1> as; nacc_init(as);
        for (int i = 0; i < 16; ++i) { const int n = sel[i]; const int pos = 64 * n + lane; const int rel = t - pos; const size_t kr = (size_t)b * SEQ + pos;
            if (64 * n > t) continue;
            ntile<1>(as, q, p.PROJ + kr * NP0 + C_KS + g * 64, p.PROJ + kr * NP0 + C_VS + g * 64, rel >= 0, bl[rel < 0 ? 0 : (rel > 127 ? 127 : rel)], lane); }
        NAcc<1> aw; nacc_init(aw);
        for (int n = cur - 8; n <= cur; ++n) { if (n < 0) continue; const int pos = 64 * n + lane; const int rel = t - pos; const size_t kr = (size_t)b * SEQ + pos;
            ntile<1>(aw, q, p.PROJ + kr * NP0 + C_KW + g * 64, p.PROJ + kr * NP0 + C_VW + g * 64, rel >= 0 && rel < 512, bl[rel < 0 ? 0 : (rel > 127 ? 127 : rel)], lane); }
        const float g0 = p.GATES[row * 24 + hh], g1 = p.GATES[row * 24 + 8 + hh], g2 = p.GATES[row * 24 + 16 + hh];
        const float os = as.l > 0.f ? as.o[0] / as.l : 0.f, ow = aw.l > 0.f ? aw.o[0] / aw.l : 0.f;
        p.OC[row * DM + hh * 64 + lane] = (bf16)f2bf(g0 * oc + g1 * os + g2 * ow);
    }
    __syncthreads();
}

__device__ __forceinline__ void ndiff_phase(const PP& p, char* lds, int tid, int bid, int G) {
    const int sub = tid >> 7, lane = tid & 63, mp = (tid >> 6) & 1;
    float* o2 = (float*)lds + sub * 128;
    for (int it = bid; it < M * 4 / 4; it += G) {
        int id = it * 4 + sub; const int h = id % 4; id /= 4; const int t = id % SEQ; const int b = id / SEQ;
        const size_t row = (size_t)b * SEQ + t; const float* bl = p.BIASL + (8 + h) * 128;
        float q[64]; load_q64(q, p.PROJ + row * NP0 + C_DQ + h * 128 + mp * 64);
        NAcc<2> a; nacc_init(a);
        for (int p0 = 0; p0 <= t; p0 += 64) { const int pos = p0 + lane; const int rel = t - pos; const size_t kr = (size_t)b * SEQ + pos;
            ntile<2>(a, q, p.PROJ + kr * NP0 + C_DK + h * 128 + mp * 64, p.PROJ + kr * NP0 + C_DV + h * 128, rel >= 0, bl[rel < 0 ? 0 : (rel > 127 ? 127 : rel)], lane); }
        const float il = 1.0f / a.l; float v0 = a.o[0] * il, v1 = a.o[1] * il;
        __syncthreads();
        if (mp == 1) { o2[lane] = v0; o2[lane + 64] = v1; }
        __syncthreads();
        if (mp == 0) {
            const float lam = expf(wave_sum(p.lq1[lane] * p.lk1[lane])) - expf(wave_sum(p.lq2[lane] * p.lk2[lane])) + 0.2f;
            v0 -= lam * o2[lane]; v1 -= lam * o2[lane + 64];
            const float ss = wave_sum(v0 * v0 + v1 * v1); const float rs = 1.0f / sqrtf(ss * (1.0f / 128.f) + EPS);
            p.OC[row * DM + 512 + h * 128 + lane] = (bf16)f2bf(v0 * rs * p.subln[lane] * 0.8f);
            p.OC[row * DM + 512 + h * 128 + 64 + lane] = (bf16)f2bf(v1 * rs * p.subln[64 + lane] * 0.8f);
        }
    }
    __syncthreads();
}

__device__ __forceinline__ void nkmean_phase(const PP& p, int tid, int bid, int G) {
    for (int it = bid; it < 64 * 2; it += G) { const int bb = it >> 1, half = it & 1; const int b = bb / 32, n = bb % 32; const int col = half * 512 + tid; float s = 0.f;
        for (int r = 0; r < 256; ++r) s += bf2f(p.PROJ[(size_t)(b * SEQ + n * 256 + r) * NP1 + 1024 + col]);
        p.KMEAN[((size_t)(b * 16 + (col >> 6)) * 32 + n) * 64 + (col & 63)] = s * (1.0f / 256.f); }
}
__device__ __forceinline__ void kmean_from_partials(const PP& p, int tid, int bid, int G) {
    for (int i = bid * NTHR + tid; i < 2 * 16 * 32 * 64; i += G * NTHR) p.KMEAN[i] = (p.KMP[i] + p.KMP[2 * 16 * 32 * 64 + i]) * (1.0f / 256.f);
}
__device__ __forceinline__ void nmoba_phase(const PP& p, int tid, int bid, int G) {
    const int lane = tid & 63, w = tid >> 6;
    for (int it = bid; it < M * 16 / 8; it += G) {
        int id = it * 8 + w; const int h = id % 16; id /= 16; const int t = id % SEQ; const int b = id / SEQ;
        const size_t row = (size_t)b * SEQ + t; const float* bl = p.BIASL + h * 128; const int c = t >> 8;
        float q[64]; load_q64(q, p.PROJ + row * NP1 + h * 64);
        float gate = -1e30f;
        if (lane < 32 && lane < c) { const float* km = p.KMEAN + ((size_t)(b * 16 + h) * 32 + lane) * 64; float s = 0.f;
#pragma unroll
            for (int d = 0; d < 64; ++d) s += q[d] * km[d];
            gate = s; }
        if (lane >= 32) gate = -INFINITY;
        int rank = 0;
        for (int j = 0; j < 32; ++j) { const float u = __shfl(gate, j); rank += (u > gate || (u == gate && j < lane)) ? 1 : 0; }
        const bool chosen = lane < 32 && rank < 3 && lane < c;
        const unsigned long long cm = __ballot(chosen);
        NAcc<1> a; nacc_init(a);
        for (int n = 0; n < c; ++n) { if (!((cm >> n) & 1ull)) continue;
            for (int j = 0; j < 4; ++j) { const int pos = n * 256 + j * 64 + lane; const int rel = t - pos; const size_t kr = (size_t)b * SEQ + pos;
                ntile<1>(a, q, p.PROJ + kr * NP1 + 1024 + h * 64, p.PROJ + kr * NP1 + 2048 + h * 64, true, bl[rel > 127 ? 127 : rel], lane); } }
        for (int j = 0; j < 4; ++j) { const int pos = c * 256 + j * 64 + lane; const int rel = t - pos; const size_t kr = (size_t)b * SEQ + pos;
            if (c * 256 + j * 64 > t) break;
            ntile<1>(a, q, p.PROJ + kr * NP1 + 1024 + h * 64, p.PROJ + kr * NP1 + 2048 + h * 64, rel >= 0, bl[rel < 0 ? 0 : (rel > 127 ? 127 : rel)], lane); }
        p.OC[row * DM + h * 64 + lane] = (bf16)f2bf(a.o[0] / a.l);
    }
}
__device__ __forceinline__ void final_norm_phase(const PP& p, int tid, int bid, int G) {
    const int lane = tid & 63, wave = tid >> 6;
    for (int row = bid * 8 + wave; row < M; row += G * 8) {
        f32x4* xr = (f32x4*)(p.out + (size_t)row * DM) + lane; const f32x4* gr = (const f32x4*)p.norm_final + lane; f32x4 v[4]; float s = 0.f;
#pragma unroll
        for (int j = 0; j < 4; ++j) { v[j] = xr[64 * j]; s += (v[j].x * v[j].x + v[j].y * v[j].y) + (v[j].z * v[j].z + v[j].w * v[j].w); }
        s = wave_sum(s); const float rstd = 1.0f / sqrtf(s * (1.0f / DM) + EPS);
#pragma unroll
        for (int j = 0; j < 4; ++j) { const f32x4 gg = gr[64 * j]; xr[64 * j] = v[j] * rstd * gg; }
    }
}


namespace att {
#define LAS3 __attribute__((address_space(3)))
typedef short bf16x8 __attribute__((ext_vector_type(8)));
typedef short s16x4 __attribute__((ext_vector_type(4)));
typedef short v4i16_t __attribute__((ext_vector_type(4)));
typedef float f32x16 __attribute__((ext_vector_type(16)));
typedef unsigned u32x4 __attribute__((ext_vector_type(4)));
typedef LAS3 const char* lds_cptr;
constexpr float THR = 8.f, NEGBIG = -1e30f;
constexpr int L_RING = 0, L_OST = 98304, L_WSF = 131072, L_BIAS = 133120, L_MISC = 141312;

__device__ __forceinline__ int crow(int r, int hi) { return (r & 3) + 8 * (r >> 2) + 4 * hi; }
__device__ __forceinline__ void glds16(const void* gsrc, unsigned lds_dst) { unsigned keep;
    asm volatile("s_mov_b32 %0, m0\n\ts_mov_b32 m0, %2\n\ts_nop 0\n\tglobal_load_lds_dwordx4 %1, off\n\ts_mov_b32 m0, %0" : "=&s"(keep) : "v"(gsrc), "s"(lds_dst) : "memory"); }
#define ATT_WAIT_BAR(N) asm volatile("s_waitcnt vmcnt(" #N ") lgkmcnt(0)\n\ts_barrier" ::: "memory")
#define ATT_BAR() asm volatile("s_waitcnt lgkmcnt(0)\n\ts_barrier" ::: "memory")
typedef float f32x2_t __attribute__((ext_vector_type(2))); typedef __bf16 bf16x2_t __attribute__((ext_vector_type(2)));
__device__ __forceinline__ unsigned cvtpk(float lo, float hi) { f32x2_t v = {lo, hi}; bf16x2_t b = __builtin_convertvector(v, bf16x2_t); return __builtin_bit_cast(unsigned, b); }
__device__ __forceinline__ s16x4 vtr(lds_cptr p) { return __builtin_bit_cast(s16x4, __builtin_amdgcn_ds_read_tr16_b64_v4i16((LAS3 v4i16_t*)p)); }
#define ATT_MX3(a, b, c) __builtin_fmaxf(__builtin_fmaxf((a), (b)), (c))
__device__ __forceinline__ float rowmax(const f32x16& p0, const f32x16& p1) {
    float a = ATT_MX3(p0[0], p0[1], p1[0]), b = ATT_MX3(p0[2], p0[3], p1[1]); a = ATT_MX3(a, p1[2], p1[3]);
#pragma unroll
    for (int r = 4; r < 16; r += 4) { a = ATT_MX3(a, p0[r], p0[r + 1]); b = ATT_MX3(b, p0[r + 2], p0[r + 3]); a = ATT_MX3(a, p1[r], p1[r + 1]); b = ATT_MX3(b, p1[r + 2], p1[r + 3]); }
    float m = __builtin_fmaxf(a, b); auto rr = __builtin_amdgcn_permlane32_swap(__float_as_uint(m), __float_as_uint(m), false, false);
    return __builtin_fmaxf(__uint_as_float(rr[0]), __uint_as_float(rr[1]));
}
__device__ __forceinline__ float halfsum(float v) { auto rr = __builtin_amdgcn_permlane32_swap(__float_as_uint(v), __float_as_uint(v), false, false); return __uint_as_float(rr[0]) + __uint_as_float(rr[1]); }

template <int ND> struct St { float mhat, l; f32x16 o[ND]; };
template <int ND> __device__ __forceinline__ void st_init(St<ND>& s) { s.mhat = NEGBIG; s.l = 0.f;
#pragma unroll
    for (int d = 0; d < ND; ++d) s.o[d] = f32x16{}; }

__device__ __forceinline__ void qk_tile(f32x16& p0, f32x16& p1, lds_cptr kp, const bf16x8 (&qr)[4], float cinit) {
    f32x16 c;
#pragma unroll
    for (int r = 0; r < 16; ++r) c[r] = cinit;
#pragma unroll
    for (int d0 = 0; d0 < 4; ++d0) {
        const bf16x8 b0 = *(const LAS3 bf16x8*)(kp + d0 * 2048);
        const bf16x8 b1 = *(const LAS3 bf16x8*)(kp + d0 * 2048 + 512);
        if (d0 == 0) { p0 = __builtin_amdgcn_mfma_f32_32x32x16_bf16(b0, qr[0], c, 0, 0, 0); p1 = __builtin_amdgcn_mfma_f32_32x32x16_bf16(b1, qr[0], c, 0, 0, 0); }
        else { p0 = __builtin_amdgcn_mfma_f32_32x32x16_bf16(b0, qr[d0], p0, 0, 0, 0); p1 = __builtin_amdgcn_mfma_f32_32x32x16_bf16(b1, qr[d0], p1, 0, 0, 0); }
    }
}
template <int ND, int MODE>
__device__ __forceinline__ void softmax_pv(St<ND>& st, f32x16& p0, f32x16& p1, lds_cptr vp, LAS3 float* wsf, int r32, int hi, float rl) {
    if (MODE != 2) {
        const float rm = rowmax(p0, p1);
        if (__any(rm > st.mhat + THR)) {
            const float mn = __builtin_fmaxf(st.mhat, rm); const float f = __builtin_amdgcn_exp2f(st.mhat - mn);
            st.l *= f; st.mhat = mn;
            if (MODE == 0) {
                if (hi == 0) wsf[r32] = f;
#pragma unroll
                for (int r = 0; r < 16; ++r) { const float fr = wsf[crow(r, hi)];
#pragma unroll
                    for (int d = 0; d < ND; ++d) st.o[d][r] *= fr; }
            }
        }
    }
    const float mh = st.mhat; float s0 = 0.f, s1 = 0.f;
#pragma unroll
    for (int r = 0; r < 16; ++r) { p0[r] = __builtin_amdgcn_exp2f(p0[r] - mh); p1[r] = __builtin_amdgcn_exp2f(p1[r] - mh); s0 += p0[r]; s1 += p1[r]; }
    if (MODE != 2) st.l += s0 + s1;
    if (MODE == 2) {
#pragma unroll
        for (int r = 0; r < 16; ++r) { p0[r] *= rl; p1[r] *= rl; }
    }
    if (MODE == 1) return;
    u32x4 pw[4];
#pragma unroll
    for (int k = 0; k < 2; ++k)
#pragma unroll
        for (int j = 0; j < 4; ++j) { pw[k][j] = cvtpk(p0[8 * k + 2 * j], p0[8 * k + 2 * j + 1]); pw[2 + k][j] = cvtpk(p1[8 * k + 2 * j], p1[8 * k + 2 * j + 1]); }
#pragma unroll
    for (int d0 = 0; d0 < ND; ++d0) {
#pragma unroll
        for (int ks = 0; ks < 4; ++ks) {
            const s16x4 lo = vtr(vp + d0 * 4096 + ks * 1024), hh = vtr(vp + d0 * 4096 + ks * 1024 + 512);
            const bf16x8 vf = (bf16x8){lo[0], lo[1], lo[2], lo[3], hh[0], hh[1], hh[2], hh[3]};
            st.o[d0] = __builtin_amdgcn_mfma_f32_32x32x16_bf16(__builtin_bit_cast(bf16x8, pw[ks]), vf, st.o[d0], 0, 0, 0);
        }
    }
}
template <bool WIN>
__device__ __forceinline__ void fix_near(f32x16& p0, f32x16& p1, int tq, int kbase, int kstep, const LAS3 float* bl, int hi) {
#pragma unroll
    for (int r = 0; r < 16; ++r) {
        const int rel0 = tq - (kbase + kstep * crow(r, hi)), rel1 = rel0 - 32 * kstep;
        const float b0 = bl[rel0 < 0 ? 0 : (rel0 > 127 ? 127 : rel0)], b1 = bl[rel1 < 0 ? 0 : (rel1 > 127 ? 127 : rel1)];
        const bool k0 = rel0 >= 0 && (!WIN || rel0 < 512), k1 = rel1 >= 0 && (!WIN || rel1 < 512);
        p0[r] = k0 ? p0[r] + b0 : -INFINITY; p1[r] = k1 ? p1[r] + b1 : -INFINITY;
    }
}
__device__ __forceinline__ void kill_tile(f32x16& p0, f32x16& p1, bool keep) {
#pragma unroll
    for (int r = 0; r < 16; ++r) { p0[r] = keep ? p0[r] : -INFINITY; p1[r] = keep ? p1[r] : -INFINITY; }
}
template <int NKM, int ND>
__device__ __forceinline__ void issue_tile(const bf16* kg, int kpitch, const bf16* vg, int vpitch, int krow0, unsigned slot, int wid, int lane) {
#pragma unroll
    for (int m = 0; m < NKM; ++m) glds16(kg + (size_t)(krow0 + lane) * kpitch + m * 64 + wid * 8, (unsigned)__builtin_amdgcn_readfirstlane(slot + m * 8192 + wid * 1024));
#pragma unroll
    for (int j = 0; j < ND / 2; ++j) { const int pi = wid + 8 * j;
        glds16(vg + (size_t)(krow0 + 16 * (pi & 3) + (lane >> 2)) * vpitch + (pi >> 2) * 32 + (lane & 3) * 8, (unsigned)__builtin_amdgcn_readfirstlane(slot + NKM * 8192 + pi * 1024)); }
}
template <int NKM, int ND, class KRow, class Body>
__device__ __forceinline__ void run_stream(char* lds, const bf16* kg, int kpitch, const bf16* vg, int vpitch, int n, KRow krow, Body body, int wid, int lane) {
    constexpr int SLOTB = NKM * 8192 + ND * 4096;
    const unsigned lds0 = (unsigned)(uintptr_t)lds + L_RING;
    ATT_BAR();
    if (n <= 0) return;
    issue_tile<NKM, ND>(kg, kpitch, vg, vpitch, krow(0), lds0, wid, lane);
    if (n > 1) issue_tile<NKM, ND>(kg, kpitch, vg, vpitch, krow(1), lds0 + SLOTB, wid, lane);
    int s_cur = 0, s_nxt = SLOTB, s_nn = 2 * SLOTB;
    for (int k = 0; k < n; ++k) {
        if (k + 1 < n) { if (NKM + ND / 2 == 2) ATT_WAIT_BAR(2); else if (NKM + ND / 2 == 3) ATT_WAIT_BAR(3); else ATT_WAIT_BAR(4); }
        else ATT_WAIT_BAR(0);
        if (k + 2 < n) issue_tile<NKM, ND>(kg, kpitch, vg, vpitch, krow(k + 2), lds0 + s_nn, wid, lane);
        body(k, L_RING + s_cur);
        const int t = s_cur; s_cur = s_nxt; s_nxt = s_nn; s_nn = t;
    }
}
__device__ __forceinline__ void rowfac(float (&fr)[16], float f, LAS3 float* wsf, int r32, int hi) {
    if (hi == 0) wsf[r32] = f;
#pragma unroll
    for (int r = 0; r < 16; ++r) fr[r] = wsf[crow(r, hi)];
}
template <int ND>
__device__ __forceinline__ void stage_o(const f32x16 (&o)[ND], LAS3 bf16* stg, int r32, int hi) {
#pragma unroll
    for (int r = 0; r < 16; ++r) { const int orow = crow(r, hi);
#pragma unroll
        for (int d0 = 0; d0 < ND; ++d0) stg[orow * (32 * ND) + d0 * 32 + r32] = (bf16)f2bf(o[d0][r]); }
}

constexpr int MB_KM = 49152, MB_RM = 57344, MB_UNI = 58368, MB_G = 58432;
__device__ __forceinline__ void moba_unit(const PP& p, char* lds, int b, int h, int c, int tid) {
    const int lane = tid & 63, r32 = lane & 31, hi = lane >> 5; const int wid = __builtin_amdgcn_readfirstlane(tid >> 6);
    LAS3 char* l3 = (LAS3 char*)lds;
    LAS3 float* KM = (LAS3 float*)(l3 + MB_KM); LAS3 unsigned* RM = (LAS3 unsigned*)(l3 + MB_RM); LAS3 unsigned* UNI = (LAS3 unsigned*)(l3 + MB_UNI); LAS3 float* Gs = (LAS3 float*)(l3 + MB_G);
    LAS3 float* wsf = (LAS3 float*)(l3 + L_WSF) + wid * 64; const LAS3 float* bl = (const LAS3 float*)(l3 + L_BIAS) + h * 128;
    const size_t rowbase = (size_t)b * SEQ; const int q0 = c * 256;
    const bf16* Qg = p.PROJ + rowbase * NP1 + h * 64; const bf16* Kg = p.PROJ + rowbase * NP1 + 1024 + h * 64; const bf16* Vg = p.PROJ + rowbase * NP1 + 2048 + h * 64;
    ATT_BAR();
    { const f32x4 v = *(const f32x4*)(p.KMEAN + ((size_t)(b * 16 + h) * 32) * 64 + tid * 4); *(LAS3 f32x4*)(KM + tid * 4) = v; if (tid == 0) UNI[0] = 0u; }
    ATT_BAR();
    { const int row = tid >> 1, half = tid & 1; float q[64]; load_q64(q, Qg + (size_t)(q0 + row) * NP1);
#pragma unroll 1
      for (int n = half * 16; n < half * 16 + 16; ++n) { float s = 0.f;
#pragma unroll
          for (int d = 0; d < 64; d += 4) { const f32x4 k4 = *(const LAS3 f32x4*)(KM + n * 64 + d); s += (q[d] * k4.x + q[d + 1] * k4.y) + (q[d + 2] * k4.z + q[d + 3] * k4.w); }
          Gs[row * 33 + n] = s; } }
    ATT_BAR();
    if (tid < 256) { unsigned mask;
        if (c <= 3) mask = (1u << c) - 1u;
        else { float v1 = -INFINITY, v2 = -INFINITY, v3 = -INFINITY; int i1 = 0, i2 = 0, i3 = 0;
            for (int n = 0; n < c; ++n) { const float g = Gs[tid * 33 + n];
                if (g > v1) { v3 = v2; i3 = i2; v2 = v1; i2 = i1; v1 = g; i1 = n; } else if (g > v2) { v3 = v2; i3 = i2; v2 = g; i2 = n; } else if (g > v3) { v3 = g; i3 = n; } }
            mask = (1u << i1) | (1u << i2) | (1u << i3); }
        RM[tid] = mask; __hip_atomic_fetch_or(UNI, mask, __ATOMIC_RELAXED, __HIP_MEMORY_SCOPE_WORKGROUP); }
    ATT_BAR();
    const unsigned uni = UNI[0]; const int tq = q0 + wid * 32 + r32; const unsigned mymask = RM[wid * 32 + r32];
    const int npast = __builtin_popcount(uni), ntile = 4 * npast + 4;
    bf16x8 qr[4];
#pragma unroll
    for (int d0 = 0; d0 < 4; ++d0) qr[d0] = *(const bf16x8*)(Qg + (size_t)tq * NP1 + d0 * 16 + hi * 8);
    St<2> st; st_init(st);
    auto blk_of = [&](int k) -> int { const int i = k >> 2; if (i >= npast) return c; unsigned u = uni; for (int j = 0; j < i; ++j) u &= u - 1u; return __builtin_ctz(u); };
    auto krow = [&](int k) -> int { return blk_of(k) * 256 + (k & 3) * 64; };
    const float bfar = bl[127];
    auto body = [&](int k, int slot) {
        const int n = blk_of(k), j = k & 3; const int kbase = n * 256 + j * 64;
        const bool own = n == c;
        const bool sel = own ? true : ((mymask >> n) & 1u) != 0u;
        if (own ? (kbase > q0 + wid * 32 + 31) : !__any(sel)) return;
        const bool near = own || (n == c - 1 && j >= 2);
        f32x16 p0, p1;
        qk_tile(p0, p1, (lds_cptr)l3 + slot + hi * 1024 + r32 * 16, qr, near ? 0.f : bfar);
        if (near) fix_near<false>(p0, p1, tq, kbase, 1, bl, hi);
        if (!own) kill_tile(p0, p1, sel);
        softmax_pv<2, 0>(st, p0, p1, (lds_cptr)l3 + slot + 8192 + ((lane >> 4) & 1) * 32 + (lane & 3) * 8 + (4 * hi + ((lane & 15) >> 2)) * 64, wsf, r32, hi, 0.f);
    };
    run_stream<1, 2>(lds, Kg, NP1, Vg, NP1, ntile, krow, body, wid, lane);
    const float lt = halfsum(st.l); float fr[16]; rowfac(fr, lt > 0.f ? 1.0f / lt : 0.f, wsf, r32, hi);
#pragma unroll
    for (int r = 0; r < 16; ++r) { st.o[0][r] *= fr[r]; st.o[1][r] *= fr[r]; }
    LAS3 bf16* stg = (LAS3 bf16*)(l3 + L_OST) + wid * 2048;
    stage_o<2>(st.o, stg, r32, hi);
    bf16* Ow = p.OC + (rowbase + q0 + wid * 32) * DM + h * 64;
#pragma unroll
    for (int i = 0; i < 4; ++i) { const int row = i * 8 + (lane >> 3), ch = lane & 7; const u32x4 v = *(const LAS3 u32x4*)(stg + row * 64 + ch * 8); *(u32x4*)(Ow + (size_t)row * DM + ch * 8) = v; }
}
__device__ __forceinline__ void copy_bias_lds(const PP& p, char* lds, int tid) {
    LAS3 float* B = (LAS3 float*)((LAS3 char*)lds + L_BIAS);
    for (int i = tid; i < 16 * 128; i += NTHR) B[i] = p.BIASL[i];
}
__device__ __forceinline__ void moba_phase(const PP& p, char* lds, int tid, int bid, int G) {
    copy_bias_lds(p, lds, tid);
    const int vcu = (G % 8 == 0) ? (bid % 8) * (G / 8) + bid / 8 : bid;
    if (G == 256) { const int bh = vcu >> 3, s = vcu & 7;
        for (int i = 0; i < 4; ++i) { const int c = i == 0 ? 31 - s : (i == 1 ? 16 + s : (i == 2 ? 15 - s : s)); moba_unit(p, lds, bh >> 4, bh & 15, c, tid); } }
    else { for (int u = bid; u < 1024; u += G) moba_unit(p, lds, (u >> 5) >> 4, (u >> 5) & 15, 31 - (u & 31), tid); }
    ATT_BAR();
}

__device__ __forceinline__ void diff_unit(const PP& p, char* lds, int b, int h, int qt, int tid) {
    const int lane = tid & 63, r32 = lane & 31, hi = lane >> 5; const int wid = __builtin_amdgcn_readfirstlane(tid >> 6); const int mp = wid >> 2, wq = wid & 3;
    LAS3 char* l3 = (LAS3 char*)lds;
    LAS3 float* wsf = (LAS3 float*)(l3 + L_WSF) + wid * 64; const LAS3 float* bl = (const LAS3 float*)(l3 + L_BIAS) + (8 + h) * 128;
    const size_t rowbase = (size_t)b * SEQ; const int q0 = qt * 128; const int tq = q0 + wq * 32 + r32;
    const bf16* Qg = p.PROJ + rowbase * NP0 + C_DQ + h * 128 + mp * 64; const bf16* Kg = p.PROJ + rowbase * NP0 + C_DK + h * 128; const bf16* Vg = p.PROJ + rowbase * NP0 + C_DV + h * 128;
    bf16x8 qr[4];
#pragma unroll
    for (int d0 = 0; d0 < 4; ++d0) qr[d0] = *(const bf16x8*)(Qg + (size_t)tq * NP0 + d0 * 16 + hi * 8);
    St<4> st; st_init(st);
    const int NT = 2 * (qt + 1); const float bfar = bl[127];
    auto krow = [&](int k) -> int { return 64 * k; };
    auto body = [&](int k, int slot) {
        const int kbase = 64 * k;
        if (kbase > q0 + wq * 32 + 31) return;
        const bool near = k >= NT - 4;
        f32x16 p0, p1;
        qk_tile(p0, p1, (lds_cptr)l3 + slot + mp * 8192 + hi * 1024 + r32 * 16, qr, near ? 0.f : bfar);
        if (near) fix_near<false>(p0, p1, tq, kbase, 1, bl, hi);
        softmax_pv<4, 0>(st, p0, p1, (lds_cptr)l3 + slot + 16384 + ((lane >> 4) & 1) * 32 + (lane & 3) * 8 + (4 * hi + ((lane & 15) >> 2)) * 64, wsf, r32, hi, 0.f);
    };
    run_stream<2, 4>(lds, Kg, NP0, Vg, NP0, NT, krow, body, wid, lane);
    const float lt = halfsum(st.l); float fr[16]; rowfac(fr, lt > 0.f ? 1.0f / lt : 0.f, wsf, r32, hi);
    ATT_BAR();
    LAS3 float* OL = (LAS3 float*)l3 + (size_t)mp * 128 * 128;
#pragma unroll
    for (int r = 0; r < 16; ++r) { const int row = wq * 32 + crow(r, hi);
#pragma unroll
        for (int d0 = 0; d0 < 4; ++d0) OL[row * 128 + d0 * 32 + r32] = st.o[d0][r] * fr[r]; }
    ATT_BAR();
    {   const float lam = expf(wave_sum(p.lq1[lane] * p.lk1[lane])) - expf(wave_sum(p.lq2[lane] * p.lk2[lane])) + 0.2f;
        const int row = tid >> 2, part = tid & 3; const LAS3 float* o1 = (const LAS3 float*)l3 + row * 128 + part * 32; const LAS3 float* o2 = o1 + 128 * 128;
        float v[32]; float ss = 0.f;
#pragma unroll
        for (int j = 0; j < 32; j += 4) { const f32x4 a = *(const LAS3 f32x4*)(o1 + j), c = *(const LAS3 f32x4*)(o2 + j);
            v[j] = a.x - lam * c.x; v[j + 1] = a.y - lam * c.y; v[j + 2] = a.z - lam * c.z; v[j + 3] = a.w - lam * c.w;
            ss += (v[j] * v[j] + v[j + 1] * v[j + 1]) + (v[j + 2] * v[j + 2] + v[j + 3] * v[j + 3]); }
        ss += __shfl_xor(ss, 1); ss += __shfl_xor(ss, 2);
        const float rs = 0.8f / sqrtf(ss * (1.0f / 128.f) + EPS);
        bf16* dst = p.OC + (rowbase + q0 + row) * DM + 512 + h * 128 + part * 32; const float* sg = p.subln + part * 32;
#pragma unroll
        for (int j = 0; j < 32; j += 8) { u32x4 w;
            w.x = pk2(v[j] * rs * sg[j], v[j + 1] * rs * sg[j + 1]); w.y = pk2(v[j + 2] * rs * sg[j + 2], v[j + 3] * rs * sg[j + 3]);
            w.z = pk2(v[j + 4] * rs * sg[j + 4], v[j + 5] * rs * sg[j + 5]); w.w = pk2(v[j + 6] * rs * sg[j + 6], v[j + 7] * rs * sg[j + 7]);
            *(u32x4*)(dst + j) = w; }
    }
}
__device__ __forceinline__ void diff_phase(const PP& p, char* lds, int tid, int bid, int G) {
    copy_bias_lds(p, lds, tid);
    const int vcu = (G % 8 == 0) ? (bid % 8) * (G / 8) + bid / 8 : bid;
    if (G == 256) { const int bh = vcu >> 5, s = vcu & 31; diff_unit(p, lds, bh >> 2, bh & 3, 63 - s, tid); diff_unit(p, lds, bh >> 2, bh & 3, s, tid); }
    else { for (int u = bid; u < 512; u += G) diff_unit(p, lds, (u >> 6) >> 2, (u >> 6) & 3, 63 - (u & 63), tid); }
    ATT_BAR();
}

constexpr int NS_IMP = 49152, NS_SELM = 81920, NS_UNI = 82944, NS_TL = 82960;
__device__ __forceinline__ void nsa_unit(const PP& p, char* lds, int b, int g, int cur, int tid) {
    const int lane = tid & 63, r32 = lane & 31, hi = lane >> 5; const int wid = __builtin_amdgcn_readfirstlane(tid >> 6);
    LAS3 char* l3 = (LAS3 char*)lds;
    LAS3 float* IMP = (LAS3 float*)(l3 + NS_IMP); LAS3 unsigned* SELM = (LAS3 unsigned*)(l3 + NS_SELM); LAS3 unsigned* UNI = (LAS3 unsigned*)(l3 + NS_UNI); LAS3 int* TL = (LAS3 int*)(l3 + NS_TL);
    const int tokl = wid * 8 + (r32 >> 2), head = r32 & 3, hh = g * 4 + head;
    LAS3 float* wsf = (LAS3 float*)(l3 + L_WSF) + wid * 64; const LAS3 float* bl = (const LAS3 float*)(l3 + L_BIAS) + hh * 128;
    const size_t rowbase = (size_t)b * SEQ; const int t0 = cur * 64; const int tq = t0 + tokl; const int twmin = t0 + wid * 8, twmax = twmin + 7;
    const bf16* Qg = p.PROJ + (rowbase + tq) * NP0 + C_Q + hh * 64;
    bf16x8 qr[4];
#pragma unroll
    for (int d0 = 0; d0 < 4; ++d0) qr[d0] = *(const bf16x8*)(Qg + d0 * 16 + hi * 8);
    const float* gp = p.GATES + (rowbase + tq) * 24 + hh; const float g0 = gp[0], g1 = gp[8], g2 = gp[16];
    const float bfar = bl[127];
    const int vlane = ((lane >> 4) & 1) * 32 + (lane & 3) * 8 + (4 * hi + ((lane & 15) >> 2)) * 64;
    ATT_BAR();
    for (int i = tid; i < 64 * 128; i += NTHR) IMP[i] = 0.f;
    if (tid < 4) UNI[tid] = 0u;
    const int nvis = (4 * cur + 3) < NCMP ? (4 * cur + 3) : NCMP; const int ntc = (nvis + 63) >> 6;
    const bf16* KC = p.KCMP + (size_t)((b * 2 + g) * 512) * 64; const bf16* VC = p.VCMP + (size_t)((b * 2 + g) * 512) * 64;
    auto krow64 = [&](int k) -> int { return 64 * k; };
    St<2> sc; st_init(sc);
    auto cmp_scores = [&](f32x16& p0, f32x16& p1, int k, int slot) -> bool {
        const int c0 = 64 * k;
        if (16 * c0 + 31 > twmax) return false;
        const bool near = (twmin - (16 * (c0 + 63) + 31)) < 128;
        qk_tile(p0, p1, (lds_cptr)l3 + slot + hi * 1024 + r32 * 16, qr, near ? 0.f : bfar);
        if (near) fix_near<false>(p0, p1, tq, 16 * c0 + 31, 16, bl, hi);
        return true;
    };
    auto body1 = [&](int k, int slot) { f32x16 p0, p1; if (!cmp_scores(p0, p1, k, slot)) return; softmax_pv<2, 1>(sc, p0, p1, (lds_cptr)l3, wsf, r32, hi, 0.f); };
    run_stream<1, 2>(lds, KC, 64, VC, 64, ntc, krow64, body1, wid, lane);
    const float lc = halfsum(sc.l); const float rlc = lc > 0.f ? 1.0f / lc : 0.f;
    St<2> so; st_init(so); so.mhat = sc.mhat;
    auto body2 = [&](int k, int slot) { f32x16 p0, p1; if (!cmp_scores(p0, p1, k, slot)) return;
        softmax_pv<2, 2>(so, p0, p1, (lds_cptr)l3 + slot + 8192 + vlane, wsf, r32, hi, rlc);
#pragma unroll
        for (int R = 0; R < 4; ++R) {
            float a0 = ((p0[4 * R] + p0[4 * R + 1]) + p0[4 * R + 2]) + 0.5f * p0[4 * R + 3], s0 = 0.5f * p0[4 * R + 3];
            float a1 = ((p1[4 * R] + p1[4 * R + 1]) + p1[4 * R + 2]) + 0.5f * p1[4 * R + 3], s1 = 0.5f * p1[4 * R + 3];
            a0 += __shfl_xor(a0, 1); a0 += __shfl_xor(a0, 2); s0 += __shfl_xor(s0, 1); s0 += __shfl_xor(s0, 2);
            a1 += __shfl_xor(a1, 1); a1 += __shfl_xor(a1, 2); s1 += __shfl_xor(s1, 1); s1 += __shfl_xor(s1, 2);
            const int n0 = 16 * k + 2 * R + hi, n1 = n0 + 8;
            if (head == 0) { LAS3 float* ip = IMP + tokl * 128;
                __hip_atomic_fetch_add(ip + n0, a0, __ATOMIC_RELAXED, __HIP_MEMORY_SCOPE_WORKGROUP); __hip_atomic_fetch_add(ip + n0 + 1, s0, __ATOMIC_RELAXED, __HIP_MEMORY_SCOPE_WORKGROUP);
                __hip_atomic_fetch_add(ip + n1, a1, __ATOMIC_RELAXED, __HIP_MEMORY_SCOPE_WORKGROUP); if (n1 + 1 < 128) __hip_atomic_fetch_add(ip + n1 + 1, s1, __ATOMIC_RELAXED, __HIP_MEMORY_SCOPE_WORKGROUP); }
        }
    };
    run_stream<1, 2>(lds, KC, 64, VC, 64, ntc, krow64, body2, wid, lane);
    __builtin_amdgcn_s_waitcnt(0xC07F); asm volatile("" ::: "memory");
#pragma unroll 1
    for (int tk = 0; tk < 8; ++tk) { const int tl = wid * 8 + tk; unsigned long long mlo = 0ull, mhi = 0ull;
        if (cur < 16) { mlo = (2ull << cur) - 1ull; }
        else { mlo = 1ull; if (cur - 1 < 64) mlo |= 1ull << (cur - 1); else mhi |= 1ull << (cur - 1 - 64); if (cur < 64) mlo |= 1ull << cur; else mhi |= 1ull << (cur - 64);
            float v0 = (lane >= 1 && lane <= cur - 2) ? IMP[tl * 128 + lane] : -1.f, v1 = (lane + 64 <= cur - 2) ? IMP[tl * 128 + 64 + lane] : -1.f;
#pragma unroll 1
            for (int rd = 0; rd < 13; ++rd) { const float m = wave_max(fmaxf(v0, v1)); const unsigned long long b0 = __ballot(v0 == m);
                if (b0) { const int l = __ffsll((long long)b0) - 1; mlo |= 1ull << l; if (lane == l) v0 = -2.f; }
                else { const unsigned long long b1 = __ballot(v1 == m); const int l = __ffsll((long long)b1) - 1; mhi |= 1ull << l; if (lane == l) v1 = -2.f; } } }
        if (lane == 0) { const unsigned m0 = (unsigned)mlo, m1 = (unsigned)(mlo >> 32), m2 = (unsigned)mhi, m3 = (unsigned)(mhi >> 32);
            SELM[tl * 4 + 0] = m0; SELM[tl * 4 + 1] = m1; SELM[tl * 4 + 2] = m2; SELM[tl * 4 + 3] = m3;
            __hip_atomic_fetch_or(UNI + 0, m0, __ATOMIC_RELAXED, __HIP_MEMORY_SCOPE_WORKGROUP); __hip_atomic_fetch_or(UNI + 1, m1, __ATOMIC_RELAXED, __HIP_MEMORY_SCOPE_WORKGROUP);
            __hip_atomic_fetch_or(UNI + 2, m2, __ATOMIC_RELAXED, __HIP_MEMORY_SCOPE_WORKGROUP); __hip_atomic_fetch_or(UNI + 3, m3, __ATOMIC_RELAXED, __HIP_MEMORY_SCOPE_WORKGROUP); }
    }
    ATT_BAR();
    if (tid == 0) { int cnt = 0;
        for (int w = 0; w < 4; ++w) { unsigned u = UNI[w]; while (u) { const int bit = __builtin_ctz(u); u &= u - 1u; TL[1 + cnt] = w * 32 + bit; ++cnt; } }
        TL[0] = cnt; }
    ATT_BAR();
    const int nsel = TL[0];
    LAS3 float* otl = (LAS3 float*)(l3 + (wid < 4 ? NS_IMP + wid * 8192 : L_OST + (wid - 4) * 8192));
    { float fr[16]; rowfac(fr, g0, wsf, r32, hi);
#pragma unroll
      for (int r = 0; r < 16; ++r) { otl[crow(r, hi) * 64 + r32] = so.o[0][r] * fr[r]; otl[crow(r, hi) * 64 + 32 + r32] = so.o[1][r] * fr[r]; } }
    const unsigned long long mylo = (unsigned long long)SELM[tokl * 4 + 0] | ((unsigned long long)SELM[tokl * 4 + 1] << 32), myhi = (unsigned long long)SELM[tokl * 4 + 2] | ((unsigned long long)SELM[tokl * 4 + 3] << 32);
    { St<2> ss; st_init(ss);
      const bf16* KS = p.PROJ + rowbase * NP0 + C_KS + g * 64; const bf16* VS = p.PROJ + rowbase * NP0 + C_VS + g * 64;
      auto krow3 = [&](int k) -> int { return 64 * TL[1 + k]; };
      auto body3 = [&](int k, int slot) { const int n = TL[1 + k]; const int kbase = 64 * n;
          const bool sel = (((n < 64 ? mylo : myhi) >> (n & 63)) & 1ull) != 0ull;
          if (!__any(sel)) return;
          const bool near = n >= cur - 2;
          f32x16 p0, p1; qk_tile(p0, p1, (lds_cptr)l3 + slot + hi * 1024 + r32 * 16, qr, near ? 0.f : bfar);
          if (near) fix_near<false>(p0, p1, tq, kbase, 1, bl, hi);
          kill_tile(p0, p1, sel);
          softmax_pv<2, 0>(ss, p0, p1, (lds_cptr)l3 + slot + 8192 + vlane, wsf, r32, hi, 0.f); };
      run_stream<1, 2>(lds, KS, NP0, VS, NP0, nsel, krow3, body3, wid, lane);
      const float ls = halfsum(ss.l); float fr[16]; rowfac(fr, ls > 0.f ? g1 / ls : 0.f, wsf, r32, hi);
#pragma unroll
      for (int r = 0; r < 16; ++r) { otl[crow(r, hi) * 64 + r32] += ss.o[0][r] * fr[r]; otl[crow(r, hi) * 64 + 32 + r32] += ss.o[1][r] * fr[r]; } }
    { St<2> sw; st_init(sw);
      const bf16* KW = p.PROJ + rowbase * NP0 + C_KW + g * 64; const bf16* VW = p.PROJ + rowbase * NP0 + C_VW + g * 64;
      const int nlo = cur >= 8 ? cur - 8 : 0;
      auto krow4 = [&](int k) -> int { return 64 * (nlo + k); };
      auto body4 = [&](int k, int slot) { const int n = nlo + k; const int kbase = 64 * n;
          const bool near = (n >= cur - 2) || (n == cur - 8);
          f32x16 p0, p1; qk_tile(p0, p1, (lds_cptr)l3 + slot + hi * 1024 + r32 * 16, qr, near ? 0.f : bfar);
          if (near) fix_near<true>(p0, p1, tq, kbase, 1, bl, hi);
          softmax_pv<2, 0>(sw, p0, p1, (lds_cptr)l3 + slot + 8192 + vlane, wsf, r32, hi, 0.f); };
      run_stream<1, 2>(lds, KW, NP0, VW, NP0, cur - nlo + 1, krow4, body4, wid, lane);
      const float lw = halfsum(sw.l); float fr[16]; rowfac(fr, lw > 0.f ? g2 / lw : 0.f, wsf, r32, hi);
#pragma unroll
      for (int r = 0; r < 16; ++r) { otl[crow(r, hi) * 64 + r32] += sw.o[0][r] * fr[r]; otl[crow(r, hi) * 64 + 32 + r32] += sw.o[1][r] * fr[r]; } }
    bf16* Ow = p.OC + (rowbase + t0 + wid * 8) * DM + g * 256;
#pragma unroll
    for (int i = 0; i < 4; ++i) { const int row = i * 8 + (lane >> 3), ch = lane & 7; const f32x4 a = *(const LAS3 f32x4*)(otl + row * 64 + ch * 8), c = *(const LAS3 f32x4*)(otl + row * 64 + ch * 8 + 4);
        u32x4 v; v.x = pk2(a.x, a.y); v.y = pk2(a.z, a.w); v.z = pk2(c.x, c.y); v.w = pk2(c.z, c.w); *(u32x4*)(Ow + (size_t)(row >> 2) * DM + (row & 3) * 64 + ch * 8) = v; }
}
__device__ __forceinline__ void nsa_phase(const PP& p, char* lds, int tid, int bid, int G) {
    copy_bias_lds(p, lds, tid);
    const int vcu = (G % 8 == 0) ? (bid % 8) * (G / 8) + bid / 8 : bid;
    if (G == 256) { const int bg = vcu >> 6, s = vcu & 63; nsa_unit(p, lds, bg >> 1, bg & 1, 127 - s, tid); nsa_unit(p, lds, bg >> 1, bg & 1, s, tid); }
    else { for (int u = bid; u < 512; u += G) nsa_unit(p, lds, (u >> 7) >> 1, (u >> 7) & 1, 127 - (u & 127), tid); }
    ATT_BAR();
}
}

#define LAS __attribute__((address_space(3)))
#define XB_TMO      128
#define XB_XCNT(j)  (256  + 64 * (j))
#define XB_XSUB(j)  (1280 + 64 * (j))
#define XB_XGEN(j)  (2304 + 64 * (j))
#define XB_TOP      3328
#define XB_TOPGEN   3392
#define XCD_BAR_WORDS 3456
#define XB_SPIN_CAP (1u << 18)

__device__ __forceinline__ unsigned xb_ld(unsigned* p)              { return __hip_atomic_load(p, __ATOMIC_RELAXED, __HIP_MEMORY_SCOPE_AGENT); }
__device__ __forceinline__ unsigned xb_add(unsigned* p, unsigned v) { return __hip_atomic_fetch_add(p, v, __ATOMIC_RELAXED, __HIP_MEMORY_SCOPE_AGENT); }
__device__ __forceinline__ unsigned xb_xcc_id() { return (unsigned)__builtin_amdgcn_s_getreg((3 << 11) | 20) & 0xFu; }
#define XB_SPIN(cond, bar) do { unsigned _sp = 0; while (cond) { __builtin_amdgcn_s_sleep(1); \
    if ((++_sp & 255u) == 0u) { if (xb_ld(&(bar)[XB_TMO])) break; if (_sp > XB_SPIN_CAP) { atomicAdd(&(bar)[XB_TMO], 1u); break; } } } } while (0)

struct XcdBarrier {
    unsigned* bar; unsigned x;
    volatile LAS unsigned* st;
};

__device__ __forceinline__ XcdBarrier xcd_barrier_post(unsigned* bar, volatile LAS unsigned* st) {
    XcdBarrier b; b.bar = bar; b.x = xb_xcc_id(); b.st = st;
    if (threadIdx.x == 0) (void)xb_add(&bar[XB_XCNT(b.x)], 1u);
    return b;
}
__device__ __forceinline__ void xcd_barrier_complete(unsigned* bar, unsigned x, unsigned& nloc, unsigned& nx) {
    const unsigned G = gridDim.x * gridDim.y * gridDim.z;
    unsigned sum, cnt, mine, sp = 0u;
    for (;;) {
        sum = 0u; cnt = 0u; mine = 0u;
#pragma unroll
        for (unsigned j = 0; j < 16; ++j) { const unsigned c = xb_ld(&bar[XB_XCNT(j)]); sum += c; cnt += (c > 0u) ? 1u : 0u; mine = (j == x) ? c : mine; }
        if (sum == G) break;
        __builtin_amdgcn_s_sleep(1);
        if ((++sp & 255u) == 0u) { if (xb_ld(&bar[XB_TMO])) break; if (sp > XB_SPIN_CAP) { atomicAdd(&bar[XB_TMO], 1u); break; } }
    }
    nloc = mine > 0u ? mine : 1u; nx = cnt > 0u ? cnt : 1u;
}

__device__ __forceinline__ void xcd_barrier(const XcdBarrier& b) {
    asm volatile("s_waitcnt vmcnt(0)" ::: "memory");
    __syncthreads();
    if (threadIdx.x == 0) {
        unsigned* bar = b.bar;
        __builtin_amdgcn_s_waitcnt(0);
        unsigned nloc = b.st[0], nx = b.st[1];
        if (nloc == 0u) { xcd_barrier_complete(bar, b.x, nloc, nx); b.st[0] = nloc; b.st[1] = nx; }
        const unsigned old = xb_add(&bar[XB_XSUB(b.x)], 1u);
        const unsigned gen = old / nloc;
        if (old + 1u == (gen + 1u) * nloc) {
            __builtin_amdgcn_fence(__ATOMIC_RELEASE, "agent");
            asm volatile("s_waitcnt vmcnt(0)" ::: "memory");
            const unsigned og = xb_add(&bar[XB_TOP], 1u);
            const unsigned tg = og / nx;
            if (og + 1u == (tg + 1u) * nx) xb_add(&bar[XB_TOPGEN], 1u);
            else XB_SPIN(xb_ld(&bar[XB_TOPGEN]) == tg, bar);
            __builtin_amdgcn_fence(__ATOMIC_ACQUIRE, "agent");
            xb_add(&bar[XB_XGEN(b.x)], 1u);
            asm volatile("s_waitcnt vmcnt(0)" ::: "memory");
        } else {
            XB_SPIN(xb_ld(&bar[XB_XGEN(b.x)]) == gen, bar);
            __builtin_amdgcn_fence(__ATOMIC_ACQUIRE, "agent");
            asm volatile("s_waitcnt vmcnt(0)" ::: "memory");
        }
    }
    __syncthreads();
}
template <int MODE> __device__ __forceinline__ void gemm_rowscale(char* lds, const bf16* A, const bf16* Bt, int N, int K, bf16* O, const float* SS, float* KMP, int kt_lo, int kt_hi, int tid, int bid, int G) {
#if USE_PG8
    pg8::Gemm g{A, Bt, M, N, K}; pg8::StaticOrder S; S.init(M, N, G, bid);
    pg8::EpiRowScaleBf16<MODE> E{O, SS, KMP, N, kt_lo, kt_hi, 0};
    pg8::gemm_phase<pg8::EpiRowScaleBf16<MODE>, pg8::StaticOrder, true, true>((PG8_LAS unsigned char*)lds, g, S, E);
#else
    if (MODE == 0) ngemm_phase(lds, A, Bt, N, K, NEpiProj{O, SS, N}, tid, bid, G); else ngemm_phase(lds, A, Bt, N, K, NEpiMlp1{O, SS}, tid, bid, G);
#endif
}
__device__ __forceinline__ void gemm_residual(char* lds, const bf16* A, const bf16* Bt, int K, const float* xin, float* xout, bf16* xb, float* SS, int tid, int bid, int G) {
#if USE_PG8
    pg8::Gemm g{A, Bt, M, DM, K}; pg8::StaticOrder S; S.init(M, DM, G, bid);
    pg8::EpiResidual E{xin, xout, xb, SS};
    pg8::gemm_phase<pg8::EpiResidual, pg8::StaticOrder, true, true>((PG8_LAS unsigned char*)lds, g, S, E);
#else
    ngemm_phase(lds, A, Bt, DM, K, NEpiRes{xin, xout, xb, SS}, tid, bid, G);
#endif
}

constexpr int NPHASE = 13;
__global__ void __launch_bounds__(NTHR, 2) mk_fwd(Args args) {
    extern __shared__ __attribute__((aligned(16))) char lds[];
    cg::grid_group grid = cg::this_grid();
    const int tid = threadIdx.x, bid = blockIdx.x, G = gridDim.x;
    unsigned char* ws = args.ws;
    PP p;
    p.x = args.in[0]; p.bias_table = args.in[1]; p.norm_mix = args.in[2]; p.norm_mlp = args.in[3]; p.norm_final = args.in[4]; p.mlp_w1 = args.in[5]; p.mlp_w2 = args.in[6];
    p.ev_w_in = args.in[7]; p.ev_w_out = args.in[8]; p.pos_k = args.in[9]; p.w1_k = args.in[10]; p.w2_k = args.in[11]; p.pos_v = args.in[12]; p.w1_v = args.in[13]; p.w2_v = args.in[14];
    p.lq1 = args.in[15]; p.lk1 = args.in[16]; p.lq2 = args.in[17]; p.lk2 = args.in[18]; p.subln = args.in[19]; p.od_w_in = args.in[20]; p.od_w_out = args.in[21];
    p.out = args.out;
    p.SSA = (float*)(ws + WS_SSA); p.SSB = (float*)(ws + WS_SSB); p.GATES = (float*)(ws + WS_GATES); p.CMPB = (float*)(ws + WS_CMPB); p.BIASL = (float*)(ws + WS_BIASL);
    p.KMEAN = (float*)(ws + WS_KMEAN); p.KMP = (float*)(ws + WS_KMP);
    p.KCMP = (bf16*)(ws + WS_KCMP); p.VCMP = (bf16*)(ws + WS_VCMP);
    p.WIN0 = (bf16*)(ws + WS_WIN0); p.WOUT0 = (bf16*)(ws + WS_WOUT0); p.W1_0 = (bf16*)(ws + WS_W1_0); p.W2_0 = (bf16*)(ws + WS_W2_0);
    p.WIN1 = (bf16*)(ws + WS_WIN1); p.WOUT1 = (bf16*)(ws + WS_WOUT1); p.W1_1 = (bf16*)(ws + WS_W1_1); p.W2_1 = (bf16*)(ws + WS_W2_1);
    p.CW1K = (bf16*)(ws + WS_CW1K); p.CW1V = (bf16*)(ws + WS_CW1V); p.CW2K = (bf16*)(ws + WS_CW2K); p.CW2V = (bf16*)(ws + WS_CW2V);
    p.XB = (bf16*)(ws + WS_XB); p.OC = (bf16*)(ws + WS_OC); p.H = (bf16*)(ws + WS_H); p.PROJ = (bf16*)(ws + WS_PROJ);
    volatile LAS unsigned* xst = (volatile LAS unsigned*)((LAS char*)lds + att::L_MISC);
    if (tid == 0) { xst[0] = 0u; xst[1] = 0u; }
    __syncthreads();
    XcdBarrier xbar = xcd_barrier_post((unsigned*)(ws + WS_CTL), xst);
    const int lo = args.ph_lo, hi = args.ph_hi;
#define IN(k) (lo <= (k) && (k) < hi)
#define SEAM(k) do { if (IN(k) && IN((k) + 1)) { if ((k) == 0) grid.sync(); else xcd_barrier(xbar); } } while (0)

    if (IN(0)) { p0_prologue(p, lds, tid, bid, G); }
    SEAM(0);
    if (IN(1)) { gemm_rowscale<0>(lds, p.XB, p.WIN0, NP0, DM, p.PROJ, p.SSA, nullptr, 0, 0, tid, bid, G); }
    SEAM(1);
    if (IN(2)) { ncompress_phase(p, lds, tid, bid, G);
#if USE_MFMA_DIFF
        att::diff_phase(p, lds, tid, bid, G);
#else
        ndiff_phase(p, lds, tid, bid, G);
#endif
    }
    SEAM(2);
    if (IN(3)) {
#if USE_MFMA_NSA
        att::nsa_phase(p, lds, tid, bid, G);
#else
        nnsa_phase(p, lds, tid, bid, G);
#endif
    }
    SEAM(3);
    if (IN(4)) { gemm_residual(lds, p.OC, p.WOUT0, DM, p.x, p.out, p.XB, p.SSB, tid, bid, G); }
    SEAM(4);
    if (IN(5)) { gemm_rowscale<1>(lds, p.XB, p.W1_0, FF, DM, p.H, p.SSB, nullptr, 0, 0, tid, bid, G); }
    SEAM(5);
    if (IN(6)) { gemm_residual(lds, p.H, p.W2_0, FF, p.out, p.out, p.XB, p.SSA, tid, bid, G); }
    SEAM(6);
    if (IN(7)) {
#if USE_PG8
        gemm_rowscale<0>(lds, p.XB, p.WIN1, NP1, DM, p.PROJ, p.SSA, p.KMP, 4, 8, tid, bid, G);
#else
        gemm_rowscale<0>(lds, p.XB, p.WIN1, NP1, DM, p.PROJ, p.SSA, nullptr, 0, 0, tid, bid, G);
        grid.sync();
        nkmean_phase(p, tid, bid, G);
#endif
    }
    SEAM(7);
    if (IN(8)) {
#if USE_PG8
        kmean_from_partials(p, tid, bid, G); xcd_barrier(xbar);
#endif
#if USE_MFMA_MOBA
        att::moba_phase(p, lds, tid, bid, G);
#else
        nmoba_phase(p, tid, bid, G);
#endif
    }
    SEAM(8);
    if (IN(9)) { gemm_residual(lds, p.OC, p.WOUT1, DM, p.out, p.out, p.XB, p.SSB, tid, bid, G); }
    SEAM(9);
    if (IN(10)) { gemm_rowscale<1>(lds, p.XB, p.W1_1, FF, DM, p.H, p.SSB, nullptr, 0, 0, tid, bid, G); }
    SEAM(10);
    if (IN(11)) { gemm_residual(lds, p.H, p.W2_1, FF, p.out, p.out, p.XB, p.SSA, tid, bid, G); }
    SEAM(11);
    if (IN(12)) { final_norm_phase(p, tid, bid, G); }
#undef IN
#undef SEAM
}

extern "C" void kernel_launch(void* const* d_in, const int* in_sizes, int n_in, void* d_out, int out_size, void* d_ws, size_t ws_size, hipStream_t stream) {
    static int grid = 0;
    if (grid == 0) {
        if (n_in != 22 || out_size != M * DM || ws_size < WS_END) { fprintf(stderr, "kernel_launch: unexpected shapes (n_in %d out %d ws %zu)\n", n_in, out_size, ws_size); grid = -1; return; }
        int dev = 0, cus = 0, per_cu = 0;
        if (hipGetDevice(&dev) != hipSuccess || hipDeviceGetAttribute(&cus, hipDeviceAttributeMultiprocessorCount, dev) != hipSuccess) { grid = -1; return; }
        if (hipFuncSetAttribute((const void*)mk_fwd, hipFuncAttributeMaxDynamicSharedMemorySize, LDS_BYTES) != hipSuccess) { fprintf(stderr, "kernel_launch: hipFuncSetAttribute failed\n"); grid = -1; return; }
        if (hipOccupancyMaxActiveBlocksPerMultiprocessor(&per_cu, (const void*)mk_fwd, NTHR, LDS_BYTES) != hipSuccess || per_cu < 1) { fprintf(stderr, "kernel_launch: occupancy query says %d blocks per CU\n", per_cu); (void)hipGetLastError(); grid = -1; return; }
        grid = cus * 1;
    }
    if (grid < 0) return;
    if (hipMemsetAsync((char*)d_ws + WS_CTL, 0, 65536, stream) != hipSuccess) { fprintf(stderr, "kernel_launch: memset failed\n"); return; }
    Args a{};
    for (int i = 0; i < 22; ++i) a.in[i] = (const float*)d_in[i];
    a.out = (float*)d_out; a.ws = (unsigned char*)d_ws; a.ph_lo = 0; a.ph_hi = NPHASE;
    void* kargs[] = {&a};
    hipError_t e = hipLaunchCooperativeKernel((const void*)mk_fwd, dim3(grid), dim3(NTHR), kargs, LDS_BYTES, stream);
    if (e != hipSuccess) fprintf(stderr, "kernel_launch: cooperative launch failed: %s (grid %d)\n", hipGetErrorString(e), grid);
}
```

```cpp
#include <hip/hip_runtime.h>
#include <hip/hip_cooperative_groups.h>
#include <cstdint>
#include <cstdio>

typedef unsigned short bf16;
typedef unsigned v4u __attribute__((ext_vector_type(4)));
typedef float f32x4 __attribute__((ext_vector_type(4)));

constexpr int BATCH = 2, SEQ = 8192, DM = 1024, M = BATCH * SEQ, FF = 4096;
constexpr int NP0 = 2816, NP1 = 3072, EVEN_PROJ = 2840;
constexpr float EPS = 1e-6f;
constexpr float LOG2E = 1.4426950408889634f, C2 = 0.125f * LOG2E;
constexpr int C_Q = 0, C_KC = 512, C_VC = 640, C_KS = 768, C_VS = 896, C_KW = 1024, C_VW = 1152, C_DQ = 1280, C_DK = 1792, C_DV = 2304;
constexpr int NCMP = 511;

constexpr size_t MiB = 1u << 20;
constexpr size_t WS_CTL = 0;
constexpr size_t WS_SSA = 1 * MiB, WS_SSB = 2 * MiB;
constexpr size_t WS_GATES = 3 * MiB;
constexpr size_t WS_KCMP = 4 * MiB + 512 * 1024, WS_VCMP = WS_KCMP + 256 * 1024;
constexpr size_t WS_CMPB = 5 * MiB;
constexpr size_t WS_BIASL = 5 * MiB + 16384;
constexpr size_t WS_KMEAN = 5 * MiB + 256 * 1024;
constexpr size_t WS_WIN0 = 8 * MiB, WS_WOUT0 = 14 * MiB, WS_W1_0 = 16 * MiB, WS_W2_0 = 24 * MiB;
constexpr size_t WS_WIN1 = 32 * MiB, WS_WOUT1 = 38 * MiB, WS_W1_1 = 40 * MiB, WS_W2_1 = 48 * MiB;
constexpr size_t WS_CW1K = 56 * MiB, WS_CW1V = 56 * MiB + 512 * 1024, WS_CW2K = 57 * MiB, WS_CW2V = 57 * MiB + 64 * 1024;
constexpr size_t WS_XB = 58 * MiB, WS_OC = 90 * MiB, WS_H = 122 * MiB, WS_PROJ = 122 * MiB, WS_END = 250 * MiB;

__device__ __forceinline__ unsigned f2bf(float f) { unsigned u = __builtin_bit_cast(unsigned, f); return (u + 0x7fffu + ((u >> 16) & 1u)) >> 16; }
__device__ __forceinline__ float bf2f(unsigned h) { return __builtin_bit_cast(float, h << 16); }
__device__ __forceinline__ unsigned pk2(float lo, float hi) { return f2bf(lo) | (f2bf(hi) << 16); }
__device__ __forceinline__ float wave_sum(float v) {
#pragma unroll
    for (int o = 1; o < 64; o <<= 1) v += __shfl_xor(v, o);
    return v;
}
__device__ __forceinline__ float wave_max(float v) {
#pragma unroll
    for (int o = 1; o < 64; o <<= 1) v = fmaxf(v, __shfl_xor(v, o));
    return v;
}
__device__ __forceinline__ float rstd_of(const float* SS, int row) {
    const f32x4* p = (const f32x4*)(SS + (size_t)row * 16);
    f32x4 a = p[0], b = p[1], c = p[2], d = p[3];
    float s = ((a.x + a.y) + (a.z + a.w)) + ((b.x + b.y) + (b.z + b.w)) + ((c.x + c.y) + (c.z + c.w)) + ((d.x + d.y) + (d.z + d.w));
    return 1.0f / sqrtf(s * (1.0f / DM) + EPS);
}
__device__ __forceinline__ int t5_bucket(int rel) {
    int n = rel < 0 ? 0 : rel;
    if (n < 16) return n;
    int large = 16 + (int)(logf((float)n / 16.0f) / logf(8.0f) * 16.0f);
    return large < 31 ? large : 31;
}

namespace pg8 {
#define PG8_LAS __attribute__((address_space(3)))
typedef unsigned short bf16_t;
typedef short bf16x8 __attribute__((ext_vector_type(8)));
typedef float f32x4 __attribute__((ext_vector_type(4)));
typedef unsigned u32x4 __attribute__((ext_vector_type(4)));
constexpr int BM = 256, BK = 64, HALF = 128, HTB = HALF * BK * 2  , STAGE_BYTES = 8 * HTB, NXCD = 8, WGM = 8;

__host__ __device__ __forceinline__ int lds_byte(int r, int c) { const int st = (r >> 4) * 2 + (c >> 5), rr = r & 15, cc = c & 31, ob = rr * 64 + cc * 2; return st * 1024 + (ob ^ (((ob >> 9) & 1) << 5)); }
__host__ __device__ __forceinline__ void stage_rc(int b, int& R, int& C) { const int st = b / 1024, sb = b % 1024, swz = sb ^ (((sb >> 9) & 1) << 5); R = (st >> 1) * 16 + swz / 64; C = (st & 1) * 32 + (swz % 64) / 2; }
__host__ __device__ __forceinline__ int perm32(int rho) { const int n = rho >> 4, i = rho & 15; return 8 * (i >> 2) + 4 * n + (i & 3); }

struct Unit { int pm, pn; };
struct Gemm { const bf16_t* A; const bf16_t* Bt; int M, N, K; };

struct StaticOrder {
    int nM, nN, nwg, G, c;
    __host__ __device__ void init(int M, int N, int G_, int c_) { nM = M / BM; nN = N / BM; nwg = nM * nN; G = G_; c = c_; }
    __host__ __device__ bool next(int i, Unit& u) const {
        const long L = (long)i * G + c; if (L >= nwg) return false;
        int wgid = (int)L; { const int q = nwg / NXCD, r = nwg % NXCD, xcd = wgid % NXCD, off = wgid / NXCD; wgid = (xcd < r ? xcd * (q + 1) : r * (q + 1) + (xcd - r) * q) + off; }
        const int nig = WGM * nN, gid = wgid / nig, fm = gid * WGM, gsz = (nM - fm) < WGM ? (nM - fm) : WGM;
        u.pm = fm + ((wgid % nig) % gsz); u.pn = (wgid % nig) / gsz; return true;
    }
    __device__ __forceinline__ void a_ready(const Unit&) const {}
    __device__ __forceinline__ void done(const Unit&) const {}
};
__device__ __forceinline__ unsigned cvt_pk_bf16(float lo, float hi) { unsigned r; asm volatile("v_cvt_pk_bf16_f32 %0, %1, %2" : "=v"(r) : "v"(lo), "v"(hi)); return r; }
typedef float f32x2 __attribute__((ext_vector_type(2)));
template <class Epi, class Sched, bool ALIGN_EPI = false, bool SP2 = false>
__device__ __forceinline__ void gemm_phase(PG8_LAS unsigned char* lds, const Gemm g, const Sched& S, const Epi& E) {
    const int tid = threadIdx.x, wid = __builtin_amdgcn_readfirstlane(tid >> 6), lane = tid & 63, wr = wid >> 2, wc = wid & 3, fr = lane & 15, fq = lane >> 4;
    const int K = g.K, nt = K / BK;
    unsigned voffA[2], voffB[2];
#pragma unroll
    for (int i = 0; i < 2; ++i) { int R, C; stage_rc(tid * 16 + i * 8192, R, C); const int Rb = Epi::PERM ? ((R & ~31) + perm32(R & 31)) : R;
        voffA[i] = (unsigned)(R * K + C) * 2u; voffB[i] = (unsigned)(Rb * K + C) * 2u; }
    const size_t kstep = (size_t)(BK * 2);
    const size_t hstep = (size_t)HALF * K * 2;
    const size_t tstep = 2 * hstep;
    const unsigned ldsw = (unsigned)wid * 1024u;
    const int aoff = lds_byte(wr * 64 + fr, fq * 8), boff = lds_byte(wc * 32 + fr, fq * 8);
#define PG8_SA(b, h) (((b) * 2 + (h)) * HTB)
#define PG8_SB(b, h) ((4 + (b) * 2 + (h)) * HTB)
#define PG8_STAGE(bufoff, gbase, voff) do { _Pragma("unroll") for (int _i = 0; _i < 2; ++_i) \
        __builtin_amdgcn_global_load_lds((const unsigned*)((const char*)(gbase) + (voff)[_i]), (PG8_LAS unsigned*)(lds + (bufoff) + ldsw + _i * 8192), 16, 0, 0); } while (0)
#define PG8_LDA(dst, b, h) do { _Pragma("unroll") for (int m = 0; m < 4; ++m) _Pragma("unroll") for (int k = 0; k < 2; ++k) dst[m][k] = *(const PG8_LAS bf16x8*)(lds + PG8_SA(b, h) + aoff + m * 2048 + k * 1024); } while (0)
#define PG8_LDB(dst, b, h) do { _Pragma("unroll") for (int n = 0; n < 2; ++n) _Pragma("unroll") for (int k = 0; k < 2; ++k) dst[n][k] = *(const PG8_LAS bf16x8*)(lds + PG8_SB(b, h) + boff + n * 2048 + k * 1024); } while (0)
#define PG8_MMA(ai, bj, At, Bt) do { __builtin_amdgcn_s_setprio(1); _Pragma("unroll") for (int m = 0; m < 4; ++m) _Pragma("unroll") for (int n = 0; n < 2; ++n) _Pragma("unroll") for (int k = 0; k < 2; ++k) \
        acc[ai][bj][m][n] = __builtin_amdgcn_mfma_f32_16x16x32_bf16(Bt[n][k], At[m][k], acc[ai][bj][m][n], 0, 0, 0); __builtin_amdgcn_s_setprio(0); } while (0)
#define PG8_WAIT_V(n) asm volatile("s_waitcnt vmcnt(" #n ")" ::: "memory")
#define PG8_WAIT_L(n) asm volatile("s_waitcnt lgkmcnt(" #n ")" ::: "memory")
#define PG8_BAR __builtin_amdgcn_s_barrier()
#define PG8_SCHED __builtin_amdgcn_sched_barrier(0)
    Unit cur, nxt; int ui = 0;
    if (!S.next(0, cur)) return;
    f32x4 acc[2][2][4][2];
#pragma unroll
    for (int a = 0; a < 2; ++a)
#pragma unroll
        for (int b = 0; b < 2; ++b)
#pragma unroll
            for (int m = 0; m < 4; ++m)
#pragma unroll
                for (int n = 0; n < 2; ++n) acc[a][b][m][n] = (f32x4){0.f, 0.f, 0.f, 0.f};
    bf16x8 At[4][2], B0[2][2], B1[2][2];
    const char* cA = (const char*)g.A + (size_t)cur.pm * tstep; const char* cB = (const char*)g.Bt + (size_t)cur.pn * tstep;
    S.a_ready(cur);
    if constexpr (SP2) {
        PG8_STAGE(PG8_SB(0, 0), cB, voffB); PG8_STAGE(PG8_SB(0, 1), cB + hstep, voffB); PG8_STAGE(PG8_SA(0, 0), cA, voffA); PG8_STAGE(PG8_SA(0, 1), cA + hstep, voffA);
        if constexpr (Epi::HAS_PRE) E.pre(tid);
        if (wr == 1) PG8_BAR;
        PG8_WAIT_V(2); PG8_BAR;
        PG8_STAGE(PG8_SB(1, 0), cB + kstep, voffB); PG8_STAGE(PG8_SA(1, 0), cA + kstep, voffA); PG8_STAGE(PG8_SB(1, 1), cB + hstep + kstep, voffB);
        PG8_WAIT_V(6); PG8_BAR;
    } else {
        PG8_STAGE(PG8_SB(0, 0), cB, voffB); PG8_STAGE(PG8_SA(0, 0), cA, voffA); PG8_STAGE(PG8_SB(0, 1), cB + hstep, voffB); PG8_STAGE(PG8_SA(0, 1), cA + hstep, voffA);
        if (wr == 1) PG8_BAR;
        PG8_WAIT_V(4); PG8_BAR;
        PG8_STAGE(PG8_SB(1, 0), cB + kstep, voffB); PG8_STAGE(PG8_SA(1, 0), cA + kstep, voffA); PG8_STAGE(PG8_SB(1, 1), cB + hstep + kstep, voffB);
        PG8_WAIT_V(6); PG8_BAR;
    }
    for (;;) {
        const bool has_next = S.next(ui + 1, nxt);
        const char* nA = has_next ? (const char*)g.A + (size_t)nxt.pm * tstep : cA; const char* nB = has_next ? (const char*)g.Bt + (size_t)nxt.pn * tstep : cB;
        for (int t = 0; t < nt; t += 2) {
            const bool last = (t == nt - 2);
            const char* a1 = cA + (size_t)(t + 1) * kstep;
            const char* a2 = last ? nA : cA + (size_t)(t + 2) * kstep; const char* b2 = last ? nB : cB + (size_t)(t + 2) * kstep;
            const char* a3 = a2 + kstep; const char* b3 = b2 + kstep;
            if (last && has_next) S.a_ready(nxt);
            if constexpr (SP2) {
            PG8_LDB(B0, 0, 0); PG8_LDB(B1, 0, 1); PG8_SCHED; PG8_LDA(At, 0, 0); PG8_STAGE(PG8_SA(1, 1), a1 + hstep, voffA);
            PG8_WAIT_V(8); PG8_WAIT_L(0); PG8_BAR; PG8_MMA(0, 0, At, B0); PG8_MMA(0, 1, At, B1); PG8_BAR; PG8_SCHED;
            PG8_LDA(At, 0, 1); PG8_STAGE(PG8_SB(0, 0), b2, voffB); PG8_STAGE(PG8_SB(0, 1), b2 + hstep, voffB); PG8_STAGE(PG8_SA(0, 0), a2, voffA);
            PG8_WAIT_V(8); PG8_WAIT_L(0); PG8_BAR; PG8_MMA(1, 0, At, B0); PG8_MMA(1, 1, At, B1); PG8_BAR; PG8_SCHED;
            PG8_LDB(B0, 1, 0); PG8_LDB(B1, 1, 1); PG8_SCHED; PG8_LDA(At, 1, 0); PG8_STAGE(PG8_SA(0, 1), a2 + hstep, voffA);
            PG8_WAIT_V(8); PG8_WAIT_L(0); PG8_BAR; PG8_MMA(0, 0, At, B0); PG8_MMA(0, 1, At, B1); PG8_BAR; PG8_SCHED;
            PG8_LDA(At, 1, 1); PG8_STAGE(PG8_SB(1, 0), b3, voffB); PG8_STAGE(PG8_SB(1, 1), b3 + hstep, voffB); PG8_STAGE(PG8_SA(1, 0), a3, voffA);
            PG8_WAIT_V(8); PG8_WAIT_L(0); PG8_BAR; PG8_MMA(1, 0, At, B0); PG8_MMA(1, 1, At, B1); PG8_BAR; PG8_SCHED;
            } else {
            PG8_LDB(B0, 0, 0); PG8_SCHED; PG8_LDA(At, 0, 0); PG8_STAGE(PG8_SA(1, 1), a1 + hstep, voffA);
            PG8_WAIT_L(8); PG8_BAR; PG8_WAIT_L(0); PG8_MMA(0, 0, At, B0); PG8_BAR; PG8_SCHED;
            PG8_LDB(B1, 0, 1); PG8_STAGE(PG8_SB(0, 0), b2, voffB);
            PG8_BAR; PG8_WAIT_L(0); PG8_MMA(0, 1, At, B1); PG8_BAR;
            PG8_LDA(At, 0, 1); PG8_STAGE(PG8_SA(0, 0), a2, voffA);
            PG8_BAR; PG8_WAIT_L(0); PG8_MMA(1, 0, At, B0); PG8_BAR; PG8_SCHED;
            PG8_STAGE(PG8_SB(0, 1), b2 + hstep, voffB);
            PG8_WAIT_V(6); PG8_BAR; PG8_MMA(1, 1, At, B1); PG8_BAR;
            PG8_LDB(B0, 1, 0); PG8_SCHED; PG8_LDA(At, 1, 0); PG8_STAGE(PG8_SA(0, 1), a2 + hstep, voffA);
            PG8_WAIT_L(8); PG8_BAR; PG8_WAIT_L(0); PG8_MMA(0, 0, At, B0); PG8_BAR; PG8_SCHED;
            PG8_LDB(B1, 1, 1); PG8_STAGE(PG8_SB(1, 0), b3, voffB);
            PG8_BAR; PG8_WAIT_L(0); PG8_MMA(0, 1, At, B1); PG8_BAR;
            PG8_LDA(At, 1, 1); PG8_STAGE(PG8_SA(1, 0), a3, voffA);
            PG8_BAR; PG8_WAIT_L(0); PG8_MMA(1, 0, At, B0); PG8_BAR; PG8_SCHED;
            PG8_STAGE(PG8_SB(1, 1), b3 + hstep, voffB);
            PG8_WAIT_V(6); PG8_BAR; PG8_MMA(1, 1, At, B1); PG8_BAR;
            }
        }
        if constexpr (ALIGN_EPI) { if (wr == 0) PG8_BAR; }
        if constexpr (!Epi::AFTER_DRAIN) { E(acc, cur, wr, wc, fr, fq); S.done(cur); }
        if (!has_next) break;
#pragma unroll
        for (int a = 0; a < 2; ++a)
#pragma unroll
            for (int b = 0; b < 2; ++b)
#pragma unroll
                for (int m = 0; m < 4; ++m)
#pragma unroll
                    for (int n = 0; n < 2; ++n) acc[a][b][m][n] = (f32x4){0.f, 0.f, 0.f, 0.f};
        cur = nxt; cA = nA; cB = nB; ++ui;
        if constexpr (ALIGN_EPI) { if (wr == 1) PG8_BAR; }
    }
    PG8_WAIT_V(0);
    if constexpr (!ALIGN_EPI) { if (wr == 0) PG8_BAR; }
    PG8_BAR;
    if constexpr (Epi::AFTER_DRAIN) { E.fused(acc, cur, wr, wc, fr, fq, lds, wid, lane); S.done(cur); }
#undef PG8_SA
#undef PG8_SB
#undef PG8_STAGE
#undef PG8_LDA
#undef PG8_LDB
#undef PG8_MMA
#undef PG8_WAIT_V
#undef PG8_WAIT_L
#undef PG8_BAR
#undef PG8_SCHED
}
}

namespace pg8 {
template <int MODE> struct EpiRowScaleBf16 {
    static constexpr bool PERM = true, AFTER_DRAIN = false, HAS_PRE = true;
    bf16_t* O; const float* SS; float* KMP; float* GATES; int ldc, kt_lo, kt_hi, gate_tile; PG8_LAS float* rsl; int rs_pm;
    __device__ __forceinline__ void pre(int tid) const { if (rsl && tid < 256) rsl[tid] = rstd_of(SS, rs_pm * 256 + tid); }
    __device__ __forceinline__ void operator()(const f32x4 (&acc)[2][2][4][2], const Unit& u, int wr, int wc, int fr, int fq) const {
        const int row0 = u.pm * BM + wr * 64 + fr, col0 = u.pn * BM + wc * 32 + 8 * fq;
        if (MODE == 0 && u.pn == gate_tile) {
            if (wc == 0 && fq < 3) {
#pragma unroll
                for (int ai = 0; ai < 2; ++ai)
#pragma unroll
                    for (int m = 0; m < 4; ++m) { const int row = row0 + ai * HALF + m * 16; const float rs = (rsl && u.pm == rs_pm) ? rsl[wr * 64 + fr + ai * HALF + m * 16] : rstd_of(SS, row); float* gp = GATES + (size_t)row * 24 + 8 * fq;
                        f32x4 g0 = acc[ai][0][m][0] * rs, g1 = acc[ai][0][m][1] * rs;
#pragma unroll
                        for (int e = 0; e < 4; ++e) { g0[e] = 1.0f / (1.0f + __expf(-g0[e])); g1[e] = 1.0f / (1.0f + __expf(-g1[e])); }
                        *(f32x4*)gp = g0; *(f32x4*)(gp + 4) = g1; }
            }
            return;
        }
        const bool do_km = (u.pn >= kt_lo && u.pn < kt_hi);
        float cs[2][8];
#pragma unroll
        for (int bj = 0; bj < 2; ++bj)
#pragma unroll
            for (int e = 0; e < 8; ++e) cs[bj][e] = 0.f;
#pragma unroll
        for (int ai = 0; ai < 2; ++ai) {
            float rsv[4];
#pragma unroll
            for (int m = 0; m < 4; ++m) rsv[m] = (rsl && u.pm == rs_pm) ? rsl[wr * 64 + fr + ai * HALF + m * 16] : rstd_of(SS, row0 + ai * HALF + m * 16);
#pragma unroll
            for (int m = 0; m < 4; ++m) { const int row = row0 + ai * HALF + m * 16; const float rs = rsv[m]; bf16_t* rowp = O + (size_t)row * ldc + col0;
#pragma unroll
                for (int bj = 0; bj < 2; ++bj) { f32x4 v0 = acc[ai][bj][m][0] * rs, v1 = acc[ai][bj][m][1] * rs;
                    if (MODE == 1) {
#pragma unroll
                        for (int e = 0; e < 4; ++e) { float a = v0[e] > 0.f ? v0[e] : 0.f; v0[e] = a * a; float b = v1[e] > 0.f ? v1[e] : 0.f; v1[e] = b * b; } }
                    if (MODE == 0 && do_km) {
#pragma unroll
                        for (int e = 0; e < 4; ++e) { cs[bj][e] += v0[e]; cs[bj][4 + e] += v1[e]; } }
                    u32x4 w; w.x = cvt_pk_bf16(v0[0], v0[1]); w.y = cvt_pk_bf16(v0[2], v0[3]); w.z = cvt_pk_bf16(v1[0], v1[1]); w.w = cvt_pk_bf16(v1[2], v1[3]);
                    *(u32x4*)(rowp + bj * HALF) = w; } }
        }
        if (MODE == 0 && do_km) {
            const int b = u.pm >> 5, blk = u.pm & 31;
#pragma unroll
            for (int bj = 0; bj < 2; ++bj)
#pragma unroll
                for (int e = 0; e < 8; ++e) { float s = cs[bj][e]; s += __shfl_xor(s, 1); s += __shfl_xor(s, 2); s += __shfl_xor(s, 4); s += __shfl_xor(s, 8);
                    if (fr == 0) { const int kc = (u.pn - kt_lo) * BM + bj * HALF + wc * 32 + 8 * fq + e;
                        KMP[(((size_t)wr * 2 + b) * 16 + (kc >> 6)) * 32 * 64 + (size_t)blk * 64 + (kc & 63)] = s; } }
        }
    }
};
__device__ __forceinline__ float pg8_sum_fq(float v) {
    auto a = __builtin_amdgcn_permlane16_swap(__float_as_uint(v), __float_as_uint(v), false, false); const float s = __uint_as_float(a[0]) + __uint_as_float(a[1]);
    auto b = __builtin_amdgcn_permlane32_swap(__float_as_uint(s), __float_as_uint(s), false, false); return __uint_as_float(b[0]) + __uint_as_float(b[1]);
}
template <bool INBF> struct EpiResidual {
    static constexpr bool PERM = true, AFTER_DRAIN = false, HAS_PRE = false;
    const float* xin32; bf16_t* xb; float* SS;
    __device__ __forceinline__ void operator()(const f32x4 (&acc)[2][2][4][2], const Unit& u, int wr, int wc, int fr, int fq) const {
        const int col0 = u.pn * BM + wc * 32 + 8 * fq;
#pragma unroll
        for (int ai = 0; ai < 2; ++ai) {
            f32x4 bs[4][2][2];
#pragma unroll
            for (int m = 0; m < 4; ++m) { const size_t off = (size_t)(u.pm * BM + ai * HALF + wr * 64 + m * 16 + fr) * DM + col0;
#pragma unroll
                for (int bj = 0; bj < 2; ++bj) {
                    if (INBF) { const u32x4 w = *(const u32x4*)(xb + off + bj * HALF);
                        bs[m][bj][0] = (f32x4){__builtin_bit_cast(float, w.x << 16), __builtin_bit_cast(float, w.x & 0xffff0000u), __builtin_bit_cast(float, w.y << 16), __builtin_bit_cast(float, w.y & 0xffff0000u)};
                        bs[m][bj][1] = (f32x4){__builtin_bit_cast(float, w.z << 16), __builtin_bit_cast(float, w.z & 0xffff0000u), __builtin_bit_cast(float, w.w << 16), __builtin_bit_cast(float, w.w & 0xffff0000u)}; }
                    else { bs[m][bj][0] = *(const f32x4*)(xin32 + off + bj * HALF); bs[m][bj][1] = *(const f32x4*)(xin32 + off + bj * HALF + 4); } } }
#pragma unroll
            for (int m = 0; m < 4; ++m) { const int row = u.pm * BM + ai * HALF + wr * 64 + m * 16 + fr; const size_t off = (size_t)row * DM + col0; float sq = 0.f;
#pragma unroll
                for (int bj = 0; bj < 2; ++bj) { const f32x4 o0 = bs[m][bj][0] + acc[ai][bj][m][0], o1 = bs[m][bj][1] + acc[ai][bj][m][1];
                    sq += ((o0[0] * o0[0] + o0[1] * o0[1]) + (o0[2] * o0[2] + o0[3] * o0[3])) + ((o1[0] * o1[0] + o1[1] * o1[1]) + (o1[2] * o1[2] + o1[3] * o1[3]));
                    u32x4 w; w.x = cvt_pk_bf16(o0[0], o0[1]); w.y = cvt_pk_bf16(o0[2], o0[3]); w.z = cvt_pk_bf16(o1[0], o1[1]); w.w = cvt_pk_bf16(o1[2], o1[3]);
                    *(u32x4*)(xb + off + bj * HALF) = w; }
                sq = pg8_sum_fq(sq);
                if (fq == 0) SS[(size_t)row * 16 + u.pn * 4 + wc] = sq; }
        }
    }
};
}

namespace cg = cooperative_groups;
constexpr int NTHR = 512;
constexpr int NP0G = 3072;
constexpr int LDS_BYTES = 147456 + 8704;
constexpr size_t WS_KMP = 6 * MiB;
#ifndef USE_MFMA_MOBA
#define USE_MFMA_MOBA 1
#endif
#ifndef USE_MOBA_ROUTED
#define USE_MOBA_ROUTED 1
#endif
#ifndef USE_MFMA_DIFF
#define USE_MFMA_DIFF 1
#endif
#ifndef USE_MFMA_NSA
#define USE_MFMA_NSA 1
#endif
#ifndef PROBE_DOUBLE
#define PROBE_DOUBLE 0
#endif
#ifndef USE_MFMA_CMP
#define USE_MFMA_CMP 1
#endif
#ifndef GEMM_ALIGN
#define GEMM_ALIGN true
#endif
#ifndef GEMM_SP2
#define GEMM_SP2 true
#endif
#ifndef USE_PG8
#define USE_PG8 1
#endif

struct Args { const float* in[22]; float* out; unsigned char* ws; int ph_lo, ph_hi; };

struct PP {
    const float *x, *bias_table, *norm_mix, *norm_mlp, *norm_final, *mlp_w1, *mlp_w2, *ev_w_in, *ev_w_out, *pos_k, *w1_k, *w2_k, *pos_v, *w1_v, *w2_v, *lq1, *lk1, *lq2, *lk2, *subln, *od_w_in, *od_w_out;
    float* out; float *SSA, *SSB, *GATES, *CMPB, *BIASL, *KMEAN, *KMP;
    bf16 *KCMP, *VCMP, *WIN0, *WOUT0, *W1_0, *W2_0, *WIN1, *WOUT1, *W1_1, *W2_1, *CW1K, *CW1V, *CW2K, *CW2V, *XB, *OC, *H, *PROJ;
};

struct WJob { const float* W; bf16* WT; const float* kscale; int K, Nsrc, Ndst, kind; };
__device__ __forceinline__ void transpose_item(const WJob& J, int item, float* scr, int lane) {
    const int nblk = J.Ndst / 32, kb = item / nblk, nb = item % nblk, k0 = 64 * kb, n0 = 32 * nb;
    int s0 = n0; float cs = 1.0f; int nvalid = 32;
    if (J.kind == 1) { s0 = n0 < 1280 ? n0 : n0 + 24; if (n0 < 512 || (n0 >= C_DQ && n0 < C_DK)) cs = C2;
        if (n0 >= NP0) { s0 = 1280 + (n0 - NP0); nvalid = n0 == NP0 ? 24 : 0; if (nvalid == 0) s0 = 0; } }
    if (J.kind == 2) { if (n0 < 1024) cs = C2; }
#pragma unroll
    for (int i = 0; i < 32; ++i) { const int kk = 2 * i + (lane >> 5); scr[kk * 33 + (lane & 31)] = (lane & 31) < nvalid ? J.W[(size_t)(k0 + kk) * J.Nsrc + s0 + (lane & 31)] : 0.f; }
    __builtin_amdgcn_s_waitcnt(0xC07F); asm volatile("" ::: "memory");
    const int c = lane & 7;
    float ks[8];
#pragma unroll
    for (int i = 0; i < 8; ++i) ks[i] = (J.kscale ? J.kscale[k0 + 8 * c + i] : 1.0f) * cs;
#pragma unroll
    for (int j = 0; j < 4; ++j) { const int n = (lane >> 3) + 8 * j; const float* s = scr + (8 * c) * 33 + n;
        v4u o; o.x = pk2(s[0 * 33] * ks[0], s[1 * 33] * ks[1]); o.y = pk2(s[2 * 33] * ks[2], s[3 * 33] * ks[3]); o.z = pk2(s[4 * 33] * ks[4], s[5 * 33] * ks[5]); o.w = pk2(s[6 * 33] * ks[6], s[7 * 33] * ks[7]);
        if (J.kind == 3) { const int nn = n0 + n, kc = (k0 >> 3) + c;
            *(v4u*)(J.WT + ((((size_t)(nn >> 4) * (J.K >> 5) + (kc >> 2)) * 4 + (kc & 3)) * 16 + (nn & 15)) * 8) = o; }
        else *(v4u*)(J.WT + (size_t)(n0 + n) * J.K + k0 + 8 * c) = o; }
    __builtin_amdgcn_s_waitcnt(0xC07F); asm volatile("" ::: "memory");
}
__device__ __forceinline__ void job_items(const WJob& J, int& base, int gw, int NGW, float* scr, int lane) {
    const int nit = (J.K / 64) * (J.Ndst / 32);
    const int first = ((gw - base) % NGW + NGW) % NGW;
    for (int it = first; it < nit; it += NGW) transpose_item(J, it, scr, lane);
    base += nit;
}
constexpr int WG_PITCH = 1028;
__device__ __forceinline__ void p0_prologue(const PP& p, char* lds, int tid, int bid, int G) {
    const int lane = tid & 63, wave = tid >> 6;
    {
        float* scr = (float*)lds + wave * 64 * 33;
        const int gw = bid * 8 + wave, NGW = G * 8; int base = 0;
        job_items(WJob{p.ev_w_in, p.WIN0, p.norm_mix, DM, EVEN_PROJ, NP0G, 1}, base, gw, NGW, scr, lane);
        job_items(WJob{p.ev_w_out, p.WOUT0, nullptr, DM, DM, DM, 0}, base, gw, NGW, scr, lane);
        job_items(WJob{p.mlp_w1, p.W1_0, p.norm_mlp, DM, FF, FF, 0}, base, gw, NGW, scr, lane);
        job_items(WJob{p.mlp_w2, p.W2_0, nullptr, FF, DM, DM, 0}, base, gw, NGW, scr, lane);
        job_items(WJob{p.od_w_in, p.WIN1, p.norm_mix + DM, DM, NP1, NP1, 2}, base, gw, NGW, scr, lane);
        job_items(WJob{p.od_w_out, p.WOUT1, nullptr, DM, DM, DM, 0}, base, gw, NGW, scr, lane);
        job_items(WJob{p.mlp_w1 + (size_t)DM * FF, p.W1_1, p.norm_mlp + DM, DM, FF, FF, 0}, base, gw, NGW, scr, lane);
        job_items(WJob{p.mlp_w2 + (size_t)DM * FF, p.W2_1, nullptr, FF, DM, DM, 0}, base, gw, NGW, scr, lane);
        job_items(WJob{p.w1_k, p.CW1K, nullptr, 2048, 128, 128, 3}, base, gw, NGW, scr, lane);
        job_items(WJob{p.w1_v, p.CW1V, nullptr, 2048, 128, 128, 3}, base, gw, NGW, scr, lane);
        job_items(WJob{p.w2_k, p.CW2K, nullptr, 128, 64, 64, 0}, base, gw, NGW, scr, lane);
        job_items(WJob{p.w2_v, p.CW2V, nullptr, 128, 64, 64, 0}, base, gw, NGW, scr, lane);
    }
    __syncthreads();
    if (bid == 0) { for (int i = tid; i < 16 * 128; i += NTHR) { const int h = i >> 7, rel = i & 127; p.BIASL[i] = p.bias_table[t5_bucket(rel) * 16 + h] * LOG2E; } }
#pragma unroll 1
    for (int job = 0; job < 16; ++job) { if (bid != (1 + job) % G) continue;
        const int which = job >> 3, prt = job & 7;
        const float* pos = which == 0 ? p.pos_k : p.pos_v; const float* w1 = which == 0 ? p.w1_k : p.w1_v;
        float* part = (float*)lds; const int n = tid & 127, pr = tid >> 7; const int k0 = prt * 256 + pr * 64; float s = 0.f;
#pragma unroll
        for (int j = 0; j < 64; ++j) s += pos[k0 + j] * w1[(size_t)(k0 + j) * 128 + n];
        part[pr * 128 + n] = s; __syncthreads();
        if (tid < 128) p.CMPB[(which * 8 + prt) * 128 + tid] = (part[tid] + part[128 + tid]) + (part[256 + tid] + part[384 + tid]);
        __syncthreads(); }
    __syncthreads();
#pragma unroll 1
    for (int rowb = bid * 8 + wave; rowb < M; rowb += G * 8 * 8) {
        f32x4 v[8][4];
#pragma unroll
        for (int r = 0; r < 8; ++r) { const int row = rowb + r * G * 8;
            if (row < M) { const f32x4* xr = (const f32x4*)(p.x + (size_t)row * DM) + lane;
#pragma unroll
                for (int j = 0; j < 4; ++j) v[r][j] = xr[64 * j]; } }
#pragma unroll
        for (int r = 0; r < 8; ++r) { const int row = rowb + r * G * 8;
            if (row < M) { float s = 0.f;
#pragma unroll
                for (int j = 0; j < 4; ++j) s += (v[r][j].x * v[r][j].x + v[r][j].y * v[r][j].y) + (v[r][j].z * v[r][j].z + v[r][j].w * v[r][j].w);
                s = wave_sum(s);
                unsigned long long* o8 = (unsigned long long*)(p.XB + (size_t)row * DM) + lane;
#pragma unroll
                for (int j = 0; j < 4; ++j) o8[64 * j] = (unsigned long long)pk2(v[r][j].x, v[r][j].y) | ((unsigned long long)pk2(v[r][j].z, v[r][j].w) << 32);
                if (lane < 16) p.SSA[(size_t)row * 16 + lane] = lane == 0 ? s : 0.f; } }
    }
    __syncthreads();
}

struct NEpiProj { bf16* out; const float* SS; int ldc;
    __device__ __forceinline__ float rowscale(int row) const { return rstd_of(SS, row); }
    __device__ __forceinline__ float tile4(int row, int col, const float (&a)[4], float rs) const {
#pragma unroll
        for (int j = 0; j < 4; ++j) out[(size_t)row * ldc + col + j] = (bf16)f2bf(a[j] * rs);
        return 0.f; }
    __device__ __forceinline__ void rowstat(int, int, float) const {} };
struct NEpiRes { const float* xin; float* xout; bf16* xb; float* SS;
    __device__ __forceinline__ float rowscale(int) const { return 1.f; }
    __device__ __forceinline__ float tile4(int row, int col, const float (&a)[4], float) const { float sq = 0.f;
#pragma unroll
        for (int j = 0; j < 4; ++j) { const float v = xin[(size_t)row * DM + col + j] + a[j]; xout[(size_t)row * DM + col + j] = v; xb[(size_t)row * DM + col + j] = (bf16)f2bf(v); sq += v * v; }
        return sq; }
    __device__ __forceinline__ void rowstat(int row, int slot, float s) const { SS[(size_t)row * 16 + slot] = s; } };
struct NEpiMlp1 { bf16* H; const float* SS;
    __device__ __forceinline__ float rowscale(int row) const { return rstd_of(SS, row); }
    __device__ __forceinline__ float tile4(int row, int col, const float (&a)[4], float rs) const {
#pragma unroll
        for (int j = 0; j < 4; ++j) { float v = a[j] * rs; v = v > 0.f ? v : 0.f; H[(size_t)row * FF + col + j] = (bf16)f2bf(v * v); }
        return 0.f; }
    __device__ __forceinline__ void rowstat(int, int, float) const {} };

template <class Epi>
__device__ __forceinline__ void ngemm_phase(char* lds, const bf16* A, const bf16* Bt, int N, int K, const Epi& E, int tid, int bid, int G) {
    const int sub = tid >> 8, t = tid & 255, tx = t & 15, ty = t >> 4;
    float* As = (float*)lds + sub * (2 * 32 * 65); float* Bs = As + 32 * 65;
    const int nbx = N / 64, npairs = nbx * (M / 64) / 2;
    const int lr = t >> 2, lk = (t & 3) * 8;
    for (int it = bid; it < npairs; it += G) {
        const int tile = it * 2 + sub; const int m0 = (tile / nbx) * 64, n0 = (tile % nbx) * 64;
        float acc[4][4] = {};
        for (int k0 = 0; k0 < K; k0 += 32) {
            const v4u a = *(const v4u*)(A + (size_t)(m0 + lr) * K + k0 + lk);
            const v4u b = *(const v4u*)(Bt + (size_t)(n0 + lr) * K + k0 + lk);
            __syncthreads();
            const unsigned au[4] = {a.x, a.y, a.z, a.w}, bu[4] = {b.x, b.y, b.z, b.w};
#pragma unroll
            for (int i = 0; i < 4; ++i) { As[(lk + 2 * i) * 65 + lr] = bf2f(au[i] & 0xffff); As[(lk + 2 * i + 1) * 65 + lr] = bf2f(au[i] >> 16); Bs[(lk + 2 * i) * 65 + lr] = bf2f(bu[i] & 0xffff); Bs[(lk + 2 * i + 1) * 65 + lr] = bf2f(bu[i] >> 16); }
            __syncthreads();
#pragma unroll 8
            for (int k = 0; k < 32; ++k) {
                float av[4], bv[4];
#pragma unroll
                for (int i = 0; i < 4; ++i) { av[i] = As[k * 65 + ty * 4 + i]; bv[i] = Bs[k * 65 + tx * 4 + i]; }
#pragma unroll
                for (int i = 0; i < 4; ++i)
#pragma unroll
                    for (int j = 0; j < 4; ++j) acc[i][j] += av[i] * bv[j];
            }
        }
#pragma unroll
        for (int i = 0; i < 4; ++i) { const int row = m0 + ty * 4 + i; const float rs = E.rowscale(row);
            float sq = E.tile4(row, n0 + tx * 4, acc[i], rs);
            sq += __shfl_xor(sq, 1); sq += __shfl_xor(sq, 2); sq += __shfl_xor(sq, 4); sq += __shfl_xor(sq, 8);
            if (tx == 0) E.rowstat(row, n0 / 64, sq); }
    }
    __syncthreads();
}

__device__ __forceinline__ float gelu_tanh(float x) { const float u = 0.7978845608028654f * (x + 0.044715f * x * x * x); return 0.5f * x * (1.0f + tanhf(u)); }
__device__ __forceinline__ void ncompress_phase(const PP& p, char* lds, int tid, int bid, int G) {
    const int sub = tid >> 7, t = tid & 127;
    float* a = (float*)lds + sub * (2048 + 128); float* hid = a + 2048;
    for (int it = bid; it < 1024; it += G) {
        int id = it * 4 + sub; const int c = id % 512; id /= 512; const int g = id % 2; id /= 2; const int b = id % 2; const int kv = id / 2;
        bf16* outp = (kv ? p.VCMP : p.KCMP) + ((size_t)((b * 2 + g) * 512 + c)) * 64;
        const bool live = c < NCMP; const int cc = live ? c : 0;
        const int col = (kv ? C_VC : C_KC) + g * 64;
        __syncthreads();
        for (int i = t; i < 2048; i += 128) { const int j = i >> 6, d = i & 63; a[i] = bf2f(p.PROJ[(size_t)(b * SEQ + 16 * cc + j) * NP0 + col + d]); }
        __syncthreads();
        const bf16* w1 = (kv ? p.CW1V : p.CW1K) + (size_t)t * 2048; float s = 0.f; for (int j = 0; j < 8; ++j) s += p.CMPB[(kv * 8 + j) * 128 + t];
        for (int k = 0; k < 2048; k += 8) { const v4u u = *(const v4u*)(w1 + k);
            s += a[k] * bf2f(u.x & 0xffff) + a[k + 1] * bf2f(u.x >> 16) + a[k + 2] * bf2f(u.y & 0xffff) + a[k + 3] * bf2f(u.y >> 16) + a[k + 4] * bf2f(u.z & 0xffff) + a[k + 5] * bf2f(u.z >> 16) + a[k + 6] * bf2f(u.w & 0xffff) + a[k + 7] * bf2f(u.w >> 16); }
        hid[t] = bf2f(f2bf(gelu_tanh(s)));
        __syncthreads();
        if (t < 64) { const bf16* w2 = (kv ? p.CW2V : p.CW2K) + (size_t)t * 128; float o = 0.f; for (int n = 0; n < 128; ++n) o += hid[n] * bf2f(w2[n]); outp[t] = live ? (bf16)f2bf(o) : (bf16)0; }
    }
    __syncthreads();
}

template <int NV> struct NAcc { float m, l, o[NV]; };
template <int NV> __device__ __forceinline__ void nacc_init(NAcc<NV>& a) { a.m = -1e30f; a.l = 0.f;
#pragma unroll
    for (int j = 0; j < NV; ++j) a.o[j] = 0.f; }
__device__ __forceinline__ void load_q64(float (&q)[64], const bf16* qp) {
#pragma unroll
    for (int i = 0; i < 8; ++i) { const v4u u = ((const v4u*)qp)[i];
        q[8 * i + 0] = bf2f(u.x & 0xffff); q[8 * i + 1] = bf2f(u.x >> 16); q[8 * i + 2] = bf2f(u.y & 0xffff); q[8 * i + 3] = bf2f(u.y >> 16);
        q[8 * i + 4] = bf2f(u.z & 0xffff); q[8 * i + 5] = bf2f(u.z >> 16); q[8 * i + 6] = bf2f(u.w & 0xffff); q[8 * i + 7] = bf2f(u.w >> 16); }
}
__device__ __forceinline__ float dot64(const float (&q)[64], const bf16* kp) {
    float s = 0.f;
#pragma unroll
    for (int i = 0; i < 8; ++i) { const v4u u = ((const v4u*)kp)[i];
        s += q[8 * i + 0] * bf2f(u.x & 0xffff) + q[8 * i + 1] * bf2f(u.x >> 16) + q[8 * i + 2] * bf2f(u.y & 0xffff) + q[8 * i + 3] * bf2f(u.y >> 16)
           + q[8 * i + 4] * bf2f(u.z & 0xffff) + q[8 * i + 5] * bf2f(u.z >> 16) + q[8 * i + 6] * bf2f(u.w & 0xffff) + q[8 * i + 7] * bf2f(u.w >> 16); }
    return s;
}
template <int NV> __device__ __forceinline__ void ntile(NAcc<NV>& a, const float (&q)[64], const bf16* kp, const bf16* vp, bool valid, float bias, int lane) {
    const float s = valid ? dot64(q, kp) + bias : -INFINITY;
    const float tm = wave_max(s);
    const float mn = fmaxf(a.m, tm), f = exp2f(a.m - mn), pr = exp2f(s - mn);
    a.l = a.l * f + wave_sum(pr); a.m = mn;
#pragma unroll
    for (int j = 0; j < NV; ++j) a.o[j] *= f;
    const unsigned long long vpi = (unsigned long long)(uintptr_t)vp;
    const unsigned vlo = (unsigned)vpi, vhi = (unsigned)(vpi >> 32);
    for (int k = 0; k < 64; ++k) {
        const float pk = __shfl(pr, k);
        const unsigned lo = __shfl(vlo, k), hi = __shfl(vhi, k);
        if (pk != 0.f) { const bf16* vr = (const bf16*)(uintptr_t)(((unsigned long long)hi << 32) | lo);
#pragma unroll
            for (int j = 0; j < NV; ++j) a.o[j] += pk * bf2f(vr[lane + 64 * j]); }
    }
}

__device__ __forceinline__ void nnsa_phase(const PP& p, char* lds, int tid, int bid, int G) {
    const int sub = tid >> 8, t256 = tid & 255, lane = tid & 63, r = t256 >> 6;
    float* base = (float*)lds + sub * (4 * 512 + 4 * 128 + 128 + 16);
    float* sc = base + r * 512; float* imph = base + 4 * 512; float* score = imph + 4 * 128; int* sel = (int*)(score + 128);
    for (int it = bid; it < M * 2 / 2; it += G) {
        int id = it * 2 + sub; const int t = id % SEQ; id /= SEQ; const int g = id % 2; const int b = id / 2;
        const int hh = g * 4 + r; const size_t row = (size_t)b * SEQ + t;
        const float* bl = p.BIASL + hh * 128;
        float q[64]; load_q64(q, p.PROJ + row * NP0 + C_Q + hh * 64);
        const int nvis = t >= 31 ? ((t - 31) / 16 + 1 < NCMP ? (t - 31) / 16 + 1 : NCMP) : 0;
        const bf16* kc = p.KCMP + (size_t)((b * 2 + g) * 512) * 64; const bf16* vc = p.VCMP + (size_t)((b * 2 + g) * 512) * 64;
        __syncthreads();
        float mx = -INFINITY;
        for (int c0 = 0; c0 < nvis; c0 += 64) { const int c = c0 + lane; float s = -INFINITY;
            if (c < nvis) { int rel = t - (16 * c + 31); rel = rel > 127 ? 127 : rel; s = dot64(q, kc + (size_t)c * 64) + bl[rel]; }
            sc[c] = s; mx = fmaxf(mx, s); }
        mx = wave_max(mx);
        float ls = 0.f;
        for (int c0 = 0; c0 < nvis; c0 += 64) { const int c = c0 + lane; const float e = exp2f(sc[c] - mx); sc[c] = e; ls += e; }
        ls = wave_sum(ls);
        const float rl = ls > 0.f ? 1.0f / ls : 0.f;
        for (int c = lane; c < 512; c += 64) sc[c] = c < nvis ? sc[c] * rl : 0.f;
        float oc = 0.f;
        for (int c = 0; c < nvis; ++c) oc += sc[c] * bf2f(vc[(size_t)c * 64 + lane]);
        for (int n = lane; n < 128; n += 64) { float a = ((sc[4 * n] + sc[4 * n + 1]) + sc[4 * n + 2]) + 0.5f * sc[4 * n + 3]; if (n > 0) a += 0.5f * sc[4 * n - 1]; imph[r * 128 + n] = a; }
        __syncthreads();
        const int cur = t >> 6;
        if (t256 < 128) { const int n = t256; const float imp = (imph[n] + imph[128 + n]) + (imph[256 + n] + imph[384 + n]);
            const bool elig = n <= cur, forced = (n == 0) || (n == cur) || (n == cur - 1);
            score[n] = elig ? imp + (forced ? 1000.f : 0.f) : -1.0f; }
        __syncthreads();
        if (t256 < 128) { const int n = t256; const float v = score[n]; int rank = 0;
            for (int j = 0; j < 128; ++j) { const float u = score[j]; rank += (u > v || (u == v && j < n)) ? 1 : 0; }
            if (rank < 16) sel[rank] = n; }
        __syncthreads();
        NAcc<1> as; nacc_init(as);
        for (int i = 0; i < 16; ++i) { const int n = sel[i]; const int pos = 64 * n + lane; const int rel = t - pos; const size_t kr = (size_t)b * SEQ + pos;
            if (64 * n > t) continue;
            ntile<1>(as, q, p.PROJ + kr * NP0 + C_KS + g * 64, p.PROJ + kr * NP0 + C_VS + g * 64, rel >= 0, bl[rel < 0 ? 0 : (rel > 127 ? 127 : rel)], lane); }
        NAcc<1> aw; nacc_init(aw);
        for (int n = cur - 8; n <= cur; ++n) { if (n < 0) continue; const int pos = 64 * n + lane; const int rel = t - pos; const size_t kr = (size_t)b * SEQ + pos;
            ntile<1>(aw, q, p.PROJ + kr * NP0 + C_KW + g * 64, p.PROJ + kr * NP0 + C_VW + g * 64, rel >= 0 && rel < 512, bl[rel < 0 ? 0 : (rel > 127 ? 127 : rel)], lane); }
        const float g0 = p.GATES[row * 24 + hh], g1 = p.GATES[row * 24 + 8 + hh], g2 = p.GATES[row * 24 + 16 + hh];
        const float os = as.l > 0.f ? as.o[0] / as.l : 0.f, ow = aw.l > 0.f ? aw.o[0] / aw.l : 0.f;
        p.OC[row * DM + hh * 64 + lane] = (bf16)f2bf(g0 * oc + g1 * os + g2 * ow);
    }
    __syncthreads();
}

__device__ __forceinline__ void ndiff_phase(const PP& p, char* lds, int tid, int bid, int G) {
    const int sub = tid >> 7, lane = tid & 63, mp = (tid >> 6) & 1;
    float* o2 = (float*)lds + sub * 128;
    for (int it = bid; it < M * 4 / 4; it += G) {
        int id = it * 4 + sub; const int h = id % 4; id /= 4; const int t = id % SEQ; const int b = id / SEQ;
        const size_t row = (size_t)b * SEQ + t; const float* bl = p.BIASL + (8 + h) * 128;
        float q[64]; load_q64(q, p.PROJ + row * NP0 + C_DQ + h * 128 + mp * 64);
        NAcc<2> a; nacc_init(a);
        for (int p0 = 0; p0 <= t; p0 += 64) { const int pos = p0 + lane; const int rel = t - pos; const size_t kr = (size_t)b * SEQ + pos;
            ntile<2>(a, q, p.PROJ + kr * NP0 + C_DK + h * 128 + mp * 64, p.PROJ + kr * NP0 + C_DV + h * 128, rel >= 0, bl[rel < 0 ? 0 : (rel > 127 ? 127 : rel)], lane); }
        const float il = 1.0f / a.l; float v0 = a.o[0] * il, v1 = a.o[1] * il;
        __syncthreads();
        if (mp == 1) { o2[lane] = v0; o2[lane + 64] = v1; }
        __syncthreads();
        if (mp == 0) {
            const float lam = expf(wave_sum(p.lq1[lane] * p.lk1[lane])) - expf(wave_sum(p.lq2[lane] * p.lk2[lane])) + 0.2f;
            v0 -= lam * o2[lane]; v1 -= lam * o2[lane + 64];
            const float ss = wave_sum(v0 * v0 + v1 * v1); const float rs = 1.0f / sqrtf(ss * (1.0f / 128.f) + EPS);
            p.OC[row * DM + 512 + h * 128 + lane] = (bf16)f2bf(v0 * rs * p.subln[lane] * 0.8f);
            p.OC[row * DM + 512 + h * 128 + 64 + lane] = (bf16)f2bf(v1 * rs * p.subln[64 + lane] * 0.8f);
        }
    }
    __syncthreads();
}

__device__ __forceinline__ void nkmean_phase(const PP& p, int tid, int bid, int G) {
    for (int it = bid; it < 64 * 2; it += G) { const int bb = it >> 1, half = it & 1; const int b = bb / 32, n = bb % 32; const int col = half * 512 + tid; float s = 0.f;
        for (int r = 0; r < 256; ++r) s += bf2f(p.PROJ[(size_t)(b * SEQ + n * 256 + r) * NP1 + 1024 + col]);
        p.KMEAN[((size_t)(b * 16 + (col >> 6)) * 32 + n) * 64 + (col & 63)] = s * (1.0f / 256.f); }
}
__device__ __forceinline__ void kmean_from_partials(const PP& p, int tid, int bid, int G) {
    for (int i = bid * NTHR + tid; i < 2 * 16 * 32 * 64; i += G * NTHR) p.KMEAN[i] = (p.KMP[i] + p.KMP[2 * 16 * 32 * 64 + i]) * (1.0f / 256.f);
}
__device__ __forceinline__ void nmoba_phase(const PP& p, int tid, int bid, int G) {
    const int lane = tid & 63, w = tid >> 6;
    for (int it = bid; it < M * 16 / 8; it += G) {
        int id = it * 8 + w; const int h = id % 16; id /= 16; const int t = id % SEQ; const int b = id / SEQ;
        const size_t row = (size_t)b * SEQ + t; const float* bl = p.BIASL + h * 128; const int c = t >> 8;
        float q[64]; load_q64(q, p.PROJ + row * NP1 + h * 64);
        float gate = -1e30f;
        if (lane < 32 && lane < c) { const float* km = p.KMEAN + ((size_t)(b * 16 + h) * 32 + lane) * 64; float s = 0.f;
#pragma unroll
            for (int d = 0; d < 64; ++d) s += q[d] * km[d];
            gate = s; }
        if (lane >= 32) gate = -INFINITY;
        int rank = 0;
        for (int j = 0; j < 32; ++j) { const float u = __shfl(gate, j); rank += (u > gate || (u == gate && j < lane)) ? 1 : 0; }
        const bool chosen = lane < 32 && rank < 3 && lane < c;
        const unsigned long long cm = __ballot(chosen);
        NAcc<1> a; nacc_init(a);
        for (int n = 0; n < c; ++n) { if (!((cm >> n) & 1ull)) continue;
            for (int j = 0; j < 4; ++j) { const int pos = n * 256 + j * 64 + lane; const int rel = t - pos; const size_t kr = (size_t)b * SEQ + pos;
                ntile<1>(a, q, p.PROJ + kr * NP1 + 1024 + h * 64, p.PROJ + kr * NP1 + 2048 + h * 64, true, bl[rel > 127 ? 127 : rel], lane); } }
        for (int j = 0; j < 4; ++j) { const int pos = c * 256 + j * 64 + lane; const int rel = t - pos; const size_t kr = (size_t)b * SEQ + pos;
            if (c * 256 + j * 64 > t) break;
            ntile<1>(a, q, p.PROJ + kr * NP1 + 1024 + h * 64, p.PROJ + kr * NP1 + 2048 + h * 64, rel >= 0, bl[rel < 0 ? 0 : (rel > 127 ? 127 : rel)], lane); }
        p.OC[row * DM + h * 64 + lane] = (bf16)f2bf(a.o[0] / a.l);
    }
}
__device__ __forceinline__ void final_norm_phase(const PP& p, int tid, int bid, int G) {
    const int lane = tid & 63, wave = tid >> 6;
#pragma unroll 4
    for (int row = bid * 8 + wave; row < M; row += G * 8) {
        const unsigned long long* xr = (const unsigned long long*)(p.XB + (size_t)row * DM) + lane; f32x4* orow = (f32x4*)(p.out + (size_t)row * DM) + lane; const f32x4* gr = (const f32x4*)p.norm_final + lane; f32x4 v[4]; float s = 0.f;
#pragma unroll
        for (int j = 0; j < 4; ++j) { const unsigned long long w = xr[64 * j]; const unsigned lo = (unsigned)w, hi = (unsigned)(w >> 32);
            v[j] = (f32x4){bf2f(lo & 0xffff), bf2f(lo >> 16), bf2f(hi & 0xffff), bf2f(hi >> 16)}; s += (v[j].x * v[j].x + v[j].y * v[j].y) + (v[j].z * v[j].z + v[j].w * v[j].w); }
        s = wave_sum(s); const float rstd = 1.0f / sqrtf(s * (1.0f / DM) + EPS);
#pragma unroll
        for (int j = 0; j < 4; ++j) { const f32x4 gg = gr[64 * j]; orow[64 * j] = v[j] * rstd * gg; }
    }
}


namespace att {
#ifndef ATT_PROBE
#define ATT_PROBE 0
#endif
#ifndef ATT_PROBE_PHASE
#define ATT_PROBE_PHASE 8
#endif
#ifndef ATT_PROBE_SEL
#define ATT_PROBE_SEL 0
#endif
#ifndef ATT_PROBE_BLOCK
#define ATT_PROBE_BLOCK 0
#endif
#ifndef ATT_PROBE_WAVE
#define ATT_PROBE_WAVE 0
#endif
#if ATT_PROBE
__device__ unsigned long long g_dbg[16];
#define ATT_T(x) const unsigned long long x = __builtin_amdgcn_s_memtime()
#else
#define ATT_T(x)
#endif
#if ATT_PROBE && (ATT_PROBE_PHASE == 2 || ATT_PROBE_PHASE == 3)
#define ATT_TP(x) ATT_T(x)
#else
#define ATT_TP(x) const unsigned long long x = 0ull
#endif
#if ATT_PROBE && ATT_PROBE_PHASE == 8
#define ATT_TS(x) ATT_T(x)
#else
#define ATT_TS(x) const unsigned long long x = 0ull
#endif
#if ATT_PROBE && ATT_PROBE_PHASE == 3
#define ATT_TN(x) ATT_T(x)
#else
#define ATT_TN(x)
#endif
#define LAS3 __attribute__((address_space(3)))
typedef short bf16x8 __attribute__((ext_vector_type(8)));
typedef short s16x4 __attribute__((ext_vector_type(4)));
typedef short v4i16_t __attribute__((ext_vector_type(4)));
typedef float f32x16 __attribute__((ext_vector_type(16)));
typedef unsigned u32x4 __attribute__((ext_vector_type(4)));
typedef LAS3 const char* lds_cptr;
constexpr float THR = 8.f, NEGBIG = -1e30f;
constexpr int L_RING = 0, L_OST = 98304, L_WSF = 131072, L_BIAS = 133120, L_MISC = 141312;

__device__ __forceinline__ int crow(int r, int hi) { return (r & 3) + 8 * (r >> 2) + 4 * hi; }
__device__ __forceinline__ void glds16(const void* gsrc, unsigned lds_dst) { unsigned keep;
    asm volatile("s_mov_b32 %0, m0\n\ts_mov_b32 m0, %2\n\ts_nop 0\n\tglobal_load_lds_dwordx4 %1, off\n\ts_mov_b32 m0, %0" : "=&s"(keep) : "v"(gsrc), "s"(lds_dst) : "memory"); }
__device__ __forceinline__ void glds16s(const void* sbase, unsigned voff, unsigned lds_dst) { unsigned keep;
    asm volatile("s_nop 4\n\ts_mov_b32 %0, m0\n\ts_mov_b32 m0, %3\n\ts_nop 0\n\tglobal_load_lds_dwordx4 %1, %2\n\ts_mov_b32 m0, %0" : "=&s"(keep) : "v"(voff), "s"(sbase), "s"(lds_dst) : "memory"); }
#define ATT_WAIT_BAR(N) asm volatile("s_waitcnt vmcnt(" #N ") lgkmcnt(0)\n\ts_barrier" ::: "memory")
#define ATT_BAR() asm volatile("s_waitcnt lgkmcnt(0)\n\ts_barrier" ::: "memory")
typedef float f32x2_t __attribute__((ext_vector_type(2))); typedef __bf16 bf16x2_t __attribute__((ext_vector_type(2)));
__device__ __forceinline__ unsigned cvtpk(float lo, float hi) { f32x2_t v = {lo, hi}; bf16x2_t b = __builtin_convertvector(v, bf16x2_t); return __builtin_bit_cast(unsigned, b); }
__device__ __forceinline__ s16x4 vtr(lds_cptr p) { return __builtin_bit_cast(s16x4, __builtin_amdgcn_ds_read_tr16_b64_v4i16((LAS3 v4i16_t*)p)); }
#define ATT_MX3(a, b, c) __builtin_fmaxf(__builtin_fmaxf((a), (b)), (c))
__device__ __forceinline__ float rowmax(const f32x16& p0, const f32x16& p1) {
    float a = ATT_MX3(p0[0], p0[1], p1[0]), b = ATT_MX3(p0[2], p0[3], p1[1]); a = ATT_MX3(a, p1[2], p1[3]);
#pragma unroll
    for (int r = 4; r < 16; r += 4) { a = ATT_MX3(a, p0[r], p0[r + 1]); b = ATT_MX3(b, p0[r + 2], p0[r + 3]); a = ATT_MX3(a, p1[r], p1[r + 1]); b = ATT_MX3(b, p1[r + 2], p1[r + 3]); }
    float m = __builtin_fmaxf(a, b); auto rr = __builtin_amdgcn_permlane32_swap(__float_as_uint(m), __float_as_uint(m), false, false);
    return __builtin_fmaxf(__uint_as_float(rr[0]), __uint_as_float(rr[1]));
}
__device__ __forceinline__ float fadd_s(float a, float b) { float r; asm("v_add_f32_e32 %0, %1, %2" : "=v"(r) : "v"(a), "v"(b)); return r; }
__device__ __forceinline__ float dpp_x1(float v) { return __int_as_float(__builtin_amdgcn_update_dpp(0, __float_as_int(v), 0xB1, 0xF, 0xF, true)); }
__device__ __forceinline__ float dpp_x2(float v) { return __int_as_float(__builtin_amdgcn_update_dpp(0, __float_as_int(v), 0x4E, 0xF, 0xF, true)); }
__device__ __forceinline__ float halfsum(float v) { auto rr = __builtin_amdgcn_permlane32_swap(__float_as_uint(v), __float_as_uint(v), false, false); return __uint_as_float(rr[0]) + __uint_as_float(rr[1]); }

template <int ND> struct St { float mhat, l, cval; f32x16 o[ND]; };
template <int ND> __device__ __forceinline__ void st_init(St<ND>& s, float bfar) { s.mhat = 0.f; s.l = 0.f; s.cval = bfar;
#pragma unroll
    for (int d = 0; d < ND; ++d) s.o[d] = f32x16{}; }
template <int ND> __device__ __forceinline__ void st_setref(St<ND>& s, float bfar, float mhat) { s.mhat = mhat; s.cval = bfar - mhat; }
__device__ __forceinline__ f32x16 splat16(float v) { f32x16 c;
#pragma unroll
    for (int r = 0; r < 16; ++r) c[r] = v;
    return c; }

__device__ __forceinline__ void qk_tile(f32x16& p0, f32x16& p1, lds_cptr kp, const bf16x8 (&qr)[4], float cv) {
    const f32x16 c = splat16(cv);
    bf16x8 kf[8];
#pragma unroll
    for (int d0 = 0; d0 < 4; ++d0) { kf[2 * d0] = *(const LAS3 bf16x8*)(kp + d0 * 2048); kf[2 * d0 + 1] = *(const LAS3 bf16x8*)(kp + d0 * 2048 + 512); }
    __builtin_amdgcn_sched_barrier(0);
    p0 = __builtin_amdgcn_mfma_f32_32x32x16_bf16(kf[0], qr[0], c, 0, 0, 0); p1 = __builtin_amdgcn_mfma_f32_32x32x16_bf16(kf[1], qr[0], c, 0, 0, 0);
#pragma unroll
    for (int d0 = 1; d0 < 4; ++d0) { p0 = __builtin_amdgcn_mfma_f32_32x32x16_bf16(kf[2 * d0], qr[d0], p0, 0, 0, 0); p1 = __builtin_amdgcn_mfma_f32_32x32x16_bf16(kf[2 * d0 + 1], qr[d0], p1, 0, 0, 0); }
}
template <int ND, int MODE, bool MASKED>
__device__ __forceinline__ void softmax_p(St<ND>& st, f32x16& p0, f32x16& p1, u32x4 (&pw)[4], LAS3 float* wsf, int r32, int hi, float rl, bool keep) {
    if (MODE != 2) {
        float rm = rowmax(p0, p1);
        if (MASKED) rm = keep ? rm : -INFINITY;
        const bool fresh = st.l == 0.f;
        const bool mv = rm > THR || (fresh && rm < -20.f && rm > -INFINITY);
        if (__any(mv)) {
            const float dl = mv ? (fresh ? rm : __builtin_fmaxf(rm, 0.f)) : 0.f;
            const float f = fresh ? 1.f : __builtin_amdgcn_exp2f(-dl);
            st.l *= f; st.mhat += dl;
#pragma unroll
            for (int r = 0; r < 16; ++r) { p0[r] -= dl; p1[r] -= dl; }
            st.cval -= dl;
            if (MODE == 0) {
                if (hi == 0) wsf[r32] = f;
#pragma unroll
                for (int r = 0; r < 16; ++r) { const float fr = wsf[crow(r, hi)];
#pragma unroll
                    for (int d = 0; d < ND; ++d) st.o[d][r] *= fr; }
            }
        }
    }
    float s0 = 0.f, s1 = 0.f;
#pragma unroll
    for (int r = 0; r < 16; ++r) { p0[r] = __builtin_amdgcn_exp2f(p0[r]); p1[r] = __builtin_amdgcn_exp2f(p1[r]); s0 += p0[r]; s1 += p1[r]; }
    if (MODE != 2) { const float sm = s0 + s1; st.l += MASKED ? (keep ? sm : 0.f) : sm; }
    if (MODE == 2) {
#pragma unroll
        for (int r = 0; r < 16; ++r) { p0[r] *= rl; p1[r] *= rl; }
    }
    if (MODE == 1) return;
#pragma unroll
    for (int k = 0; k < 2; ++k)
#pragma unroll
        for (int j = 0; j < 4; ++j) { pw[k][j] = cvtpk(p0[8 * k + 2 * j], p0[8 * k + 2 * j + 1]); pw[2 + k][j] = cvtpk(p1[8 * k + 2 * j], p1[8 * k + 2 * j + 1]); }
    if (MASKED) { const unsigned km = keep ? 0xffffffffu : 0u;
#pragma unroll
        for (int k = 0; k < 4; ++k)
#pragma unroll
            for (int j = 0; j < 4; ++j) pw[k][j] &= km; }
}
template <int ND>
__device__ __forceinline__ void pv_acc(St<ND>& st, const u32x4 (&pw)[4], lds_cptr vp) {
#pragma unroll
    for (int d0 = 0; d0 < ND; ++d0) {
        s16x4 lo[4], hh[4];
#pragma unroll
        for (int ks = 0; ks < 4; ++ks) { lo[ks] = vtr(vp + d0 * 4096 + ks * 1024); hh[ks] = vtr(vp + d0 * 4096 + ks * 1024 + 512); }
        __builtin_amdgcn_sched_barrier(0);
#pragma unroll
        for (int ks = 0; ks < 4; ++ks) {
            const bf16x8 vf = (bf16x8){lo[ks][0], lo[ks][1], lo[ks][2], lo[ks][3], hh[ks][0], hh[ks][1], hh[ks][2], hh[ks][3]};
            st.o[d0] = __builtin_amdgcn_mfma_f32_32x32x16_bf16(__builtin_bit_cast(bf16x8, pw[ks]), vf, st.o[d0], 0, 0, 0);
        }
    }
}
template <bool WIN>
__device__ __forceinline__ void fix_near(f32x16& p0, f32x16& p1, int tq, int kbase, int kstep, const LAS3 float* bl, int hi) {
    const int relb = tq - kbase - kstep * 4 * hi;
    float b0[16], b1[16];
#pragma unroll
    for (int r = 0; r < 16; ++r) { const int rel0 = relb - kstep * ((r & 3) + 8 * (r >> 2)), rel1 = rel0 - 32 * kstep;
        b0[r] = bl[rel0 < 0 ? 0 : (rel0 > 127 ? 127 : rel0)]; b1[r] = bl[rel1 < 0 ? 0 : (rel1 > 127 ? 127 : rel1)]; }
#pragma unroll
    for (int r = 0; r < 16; ++r) { asm volatile("" : "+v"(b0[r]), "+v"(b1[r])); }
#pragma unroll
    for (int r = 0; r < 16; ++r) { const int rel0 = relb - kstep * ((r & 3) + 8 * (r >> 2)), rel1 = rel0 - 32 * kstep;
        const bool k0 = rel0 >= 0 && (!WIN || rel0 < 512), k1 = rel1 >= 0 && (!WIN || rel1 < 512);
        p0[r] = k0 ? p0[r] + b0[r] : -INFINITY; p1[r] = k1 ? p1[r] + b1[r] : -INFINITY; }
}
template <bool WIN>
__device__ __forceinline__ void fix_near4(f32x16& p0, f32x16& p1, int tq, int kbase, const LAS3 float* cs, int hi) {
    const int relb = tq - kbase - 4 * hi;
    f32x4 v0[4], v1[4];
#pragma unroll
    for (int q = 0; q < 4; ++q) { const int ua = relb - 8 * q - 3, ub = ua - 32;
        const int a = ua < -3 ? 0 : (ua > 128 ? 131 : ua + 3), b = ub < -3 ? 0 : (ub > 128 ? 131 : ub + 3);
        v0[q] = *(const LAS3 f32x4*)(cs + (a & 3) * 136 + (a & ~3)); v1[q] = *(const LAS3 f32x4*)(cs + (b & 3) * 136 + (b & ~3)); }
#pragma unroll
    for (int q = 0; q < 4; ++q) { asm volatile("" : "+v"(v0[q]), "+v"(v1[q])); }
#pragma unroll
    for (int q = 0; q < 4; ++q)
#pragma unroll
        for (int e2 = 0; e2 < 4; ++e2) { const int rel0 = relb - 8 * q - e2, rel1 = rel0 - 32;
            const bool k0 = rel0 >= 0 && (!WIN || rel0 < 512), k1 = rel1 >= 0 && (!WIN || rel1 < 512);
            p0[4 * q + e2] = k0 ? p0[4 * q + e2] + v0[q][3 - e2] : -INFINITY; p1[4 * q + e2] = k1 ? p1[4 * q + e2] + v1[q][3 - e2] : -INFINITY; }
}
constexpr int L_FIX4 = 147456;
__device__ __forceinline__ void build_fix4(LAS3 float* dst, const LAS3 float* bd, int nheads, int tid) {
    for (int i = tid; i < nheads * 544; i += 512) { const int hd = i / 544, r = i - hd * 544, sft = r / 136, kk = r - sft * 136; const int bi = kk + sft - 3;
        dst[i] = bd[hd * 128 + (bi < 0 ? 0 : (bi > 127 ? 127 : bi))]; }
}
__device__ __forceinline__ void kill_tile(f32x16& p0, f32x16& p1, bool keep) {
#pragma unroll
    for (int r = 0; r < 16; ++r) { p0[r] = keep ? p0[r] : -INFINITY; p1[r] = keep ? p1[r] : -INFINITY; }
}
template <int NKM, int ND>
__device__ __forceinline__ void issue_tile(const bf16* kg, int kpitch, const bf16* vg, int vpitch, int krow0, unsigned slot, int wid, int lane) {
#pragma unroll
    for (int m = 0; m < NKM; ++m) glds16(kg + (size_t)(krow0 + lane) * kpitch + m * 64 + wid * 8, (unsigned)__builtin_amdgcn_readfirstlane(slot + m * 8192 + wid * 1024));
#pragma unroll
    for (int j = 0; j < ND / 2; ++j) { const int pi = wid + 8 * j;
        glds16(vg + (size_t)(krow0 + 16 * (pi & 3) + (lane >> 2)) * vpitch + (pi >> 2) * 32 + (lane & 3) * 8, (unsigned)__builtin_amdgcn_readfirstlane(slot + NKM * 8192 + pi * 1024)); }
}
#ifndef ATT_STAGGER
#define ATT_STAGGER 0
#endif
#if ATT_STAGGER
template <int NKM, int ND, class KRow, class H1, class H2>
__device__ __forceinline__ void run_stream(char* lds, const bf16* kg, int kpitch, const bf16* vg, int vpitch, int n, KRow krow, H1 h1, H2 h2, int wid, int lane) {
    constexpr int SLOTB = NKM * 8192 + ND * 4096;
    const unsigned lds0 = (unsigned)(uintptr_t)lds + L_RING;
    const bool late = wid >= 4;
    ATT_BAR();
    __builtin_amdgcn_s_waitcnt(0x0F70);
    if (n <= 0) return;
    issue_tile<NKM, ND>(kg, kpitch, vg, vpitch, krow(0), lds0, wid, lane);
    if (n > 1) issue_tile<NKM, ND>(kg, kpitch, vg, vpitch, krow(1), lds0 + SLOTB, wid, lane);
#define ATT_WB(more) do { if (more) { if (NKM + ND / 2 == 2) ATT_WAIT_BAR(2); else if (NKM + ND / 2 == 3) ATT_WAIT_BAR(3); else ATT_WAIT_BAR(4); } else ATT_WAIT_BAR(0); } while (0)
    if (late) ATT_WB(n > 1);
    int s_prev = 2 * SLOTB, s_cur = 0, s_nxt = SLOTB;
    for (int k = 0; k < n; ++k) {
        if (late) { ATT_BAR(); if (k + 2 < n) issue_tile<NKM, ND>(kg, kpitch, vg, vpitch, krow(k + 2), lds0 + s_prev, wid, lane); }
        else ATT_WB(k + 1 < n);
        h1(k, L_RING + s_cur);
        if (late) ATT_WB(k + 2 < n);
        else { ATT_BAR(); if (k + 2 < n) issue_tile<NKM, ND>(kg, kpitch, vg, vpitch, krow(k + 2), lds0 + s_prev, wid, lane); }
        h2(k, L_RING + s_cur);
        const int t = s_prev; s_prev = s_cur; s_cur = s_nxt; s_nxt = t;
    }
    if (!late) ATT_BAR();
#undef ATT_WB
}
#else
template <int NKM, int ND, class KRow, class H1, class H2>
__device__ __forceinline__ void run_stream(char* lds, const bf16* kg, int kpitch, const bf16* vg, int vpitch, int n, KRow krow, H1 h1, H2 h2, int wid, int lane) {
    constexpr int SLOTB = NKM * 8192 + ND * 4096;
    const unsigned lds0 = (unsigned)(uintptr_t)lds + L_RING;
    ATT_BAR();
    __builtin_amdgcn_s_waitcnt(0x0F70);
    if (n <= 0) return;
    issue_tile<NKM, ND>(kg, kpitch, vg, vpitch, krow(0), lds0, wid, lane);
    if (n > 1) issue_tile<NKM, ND>(kg, kpitch, vg, vpitch, krow(1), lds0 + SLOTB, wid, lane);
    int s_cur = 0, s_nxt = SLOTB, s_nn = 2 * SLOTB;
#if ATT_PROBE
    unsigned long long tw = 0, t1 = 0, t2 = 0, ti = 0;
#endif
    for (int k = 0; k < n; ++k) {
        ATT_TS(a0);
        if (k + 1 < n) { if (NKM + ND / 2 == 2) ATT_WAIT_BAR(2); else if (NKM + ND / 2 == 3) ATT_WAIT_BAR(3); else ATT_WAIT_BAR(4); }
        else ATT_WAIT_BAR(0);
        ATT_TS(a1);
        if (k + 2 < n) issue_tile<NKM, ND>(kg, kpitch, vg, vpitch, krow(k + 2), lds0 + s_nn, wid, lane);
        ATT_TS(a2);
        h1(k, L_RING + s_cur);
        ATT_TS(a3);
        h2(k, L_RING + s_cur);
#if ATT_PROBE
        asm volatile("s_waitcnt lgkmcnt(0)" ::: "memory");
        ATT_TS(a4);
        tw += a1 - a0; ti += a2 - a1; t1 += a3 - a2; t2 += a4 - a3;
#endif
        const int t = s_cur; s_cur = s_nxt; s_nxt = s_nn; s_nn = t;
    }
#if ATT_PROBE
    if (blockIdx.x == ATT_PROBE_BLOCK && wid == ATT_PROBE_WAVE && lane == 0) { g_dbg[0] += tw; g_dbg[1] += ti; g_dbg[2] += t1; g_dbg[3] += t2; g_dbg[4] += (unsigned long long)n; }
#endif
}
#endif
struct TInfo { int kbase; bool near, win, masked, keep; };
#define ATT_PIN(x) asm volatile("" : "+v"(x))
#define ATT_SB() __builtin_amdgcn_sched_barrier(0)
template <int NKM, int ND, class KRow, class TI>
__device__ __forceinline__ void run_pipe(char* lds, St<ND>& st, const bf16x8 (&qr)[4], const bf16* kg, int kpitch, const bf16* vg, int vpitch, int n, KRow krow, TI tinfo,
                                         int koff, const LAS3 float* bl, int tq, LAS3 float* wsf, int wid, int lane) {
    constexpr int SLOTB = NKM * 8192 + ND * 4096, CNT = NKM + ND / 2;
    static_assert(CNT == 2 || CNT == 4, "wait literals");
    const int r32 = lane & 31, hi = lane >> 5;
    LAS3 char* l3 = (LAS3 char*)lds;
    const unsigned lds0 = (unsigned)(uintptr_t)lds + L_RING;
    const int vlane = NKM * 8192 + ((lane >> 4) & 1) * 32 + (lane & 3) * 8 + (4 * hi + ((lane & 15) >> 2)) * 64;
    const int klane = koff + hi * 1024 + r32 * 16;
    const unsigned kvoff = (unsigned)(lane * kpitch + wid * 8) * 2u;
    const unsigned vvoff = (unsigned)((16 * (wid & 3) + (lane >> 2)) * vpitch + (wid >> 2) * 32 + (lane & 3) * 8) * 2u;
    auto issue = [&](int t, unsigned slot) __attribute__((always_inline)) {
        const int kr = __builtin_amdgcn_readfirstlane(krow(t));
        const bf16* kb = kg + (size_t)kr * kpitch; const bf16* vb = vg + (size_t)kr * vpitch;
#pragma unroll
        for (int m = 0; m < NKM; ++m) glds16s(kb + m * 64, kvoff, (unsigned)__builtin_amdgcn_readfirstlane(slot + m * 8192 + wid * 1024));
#pragma unroll
        for (int j = 0; j < ND / 2; ++j) glds16s(vb + j * 64, vvoff, (unsigned)__builtin_amdgcn_readfirstlane(slot + NKM * 8192 + (wid + 8 * j) * 1024));
    };
    ATT_BAR();
    __builtin_amdgcn_s_waitcnt(0x0F70);
    if (n <= 0) return;
#pragma unroll
    for (int t = 0; t < 3; ++t) if (t < n) issue(t, lds0 + t * SLOTB);
    if (n >= 3) { if (CNT == 2) ATT_WAIT_BAR(4); else ATT_WAIT_BAR(8); } else if (n == 2) { if (CNT == 2) ATT_WAIT_BAR(2); else ATT_WAIT_BAR(4); } else ATT_WAIT_BAR(0);
    f32x16 pA0, pA1, pB0, pB1; TInfo iS = tinfo(0);
    qk_tile(pA0, pA1, (lds_cptr)l3 + L_RING + klane, qr, (iS.masked && !iS.keep) ? -INFINITY : st.cval);
    if (iS.near) { if (iS.win) fix_near4<true>(pA0, pA1, tq, iS.kbase, bl, hi); else fix_near4<false>(pA0, pA1, tq, iS.kbase, bl, hi); }
    float rmS = rowmax(pA0, pA1);
    int s0 = 0, s1 = SLOTB, s2 = 2 * SLOTB, s3 = 3 * SLOTB;
    auto step = [&](int k, f32x16& pS0, f32x16& pS1, f32x16& pN0, f32x16& pN1) __attribute__((always_inline)) {
        const bool hasN = k + 1 < n;
        ATT_TP(a0);
        if (k + 2 < n) { if (CNT == 2) ATT_WAIT_BAR(2); else ATT_WAIT_BAR(4); } else ATT_WAIT_BAR(0);
        ATT_TP(a1);
        ATT_TP(a2);
        bf16x8 kfa[4];
        const lds_cptr kpn = (lds_cptr)l3 + L_RING + s1 + klane;
        TInfo iN = iS;
#pragma unroll
        for (int d0 = 0; d0 < 2; ++d0) { kfa[2 * d0] = *(const LAS3 bf16x8*)(kpn + d0 * 2048); kfa[2 * d0 + 1] = *(const LAS3 bf16x8*)(kpn + d0 * 2048 + 512); }
        if (hasN) iN = tinfo(k + 1);
        {   const float rm = rmS;
            const bool fresh = st.l == 0.f;
            const bool mv = rm > THR || (fresh && rm < -20.f && rm > -INFINITY);
            if (__any(mv)) {
                const float dl = mv ? (fresh ? rm : __builtin_fmaxf(rm, 0.f)) : 0.f;
                const float f = fresh ? 1.f : __builtin_amdgcn_exp2f(-dl);
                st.l *= f; st.mhat += dl;
#pragma unroll
                for (int r = 0; r < 16; ++r) { pS0[r] -= dl; pS1[r] -= dl; }
                st.cval -= dl;
                if (hi == 0) wsf[r32] = f;
#pragma unroll
                for (int r = 0; r < 16; ++r) { const float fr = wsf[crow(r, hi)];
#pragma unroll
                    for (int d = 0; d < ND; ++d) st.o[d][r] *= fr; }
            }
        }
        ATT_SB();
        ATT_TP(a2b);
        {
            const f32x16 c16 = splat16((iN.masked && !iN.keep) ? -INFINITY : st.cval);
#pragma unroll
            for (int i = 0; i < 8; ++i) { const int d0 = i >> 1;
                const bf16x8 kfr = kfa[i & 3];
                if ((i & 1) == 0) pN0 = __builtin_amdgcn_mfma_f32_32x32x16_bf16(kfr, qr[d0], d0 == 0 ? c16 : pN0, 0, 0, 0);
                else pN1 = __builtin_amdgcn_mfma_f32_32x32x16_bf16(kfr, qr[d0], d0 == 0 ? c16 : pN1, 0, 0, 0);
                if (i < 4) kfa[i] = *(const LAS3 bf16x8*)(kpn + ((4 + i) >> 1) * 2048 + ((4 + i) & 1) * 512);
                if (i < 4) {
#pragma unroll
                    for (int e = 0; e < 4; ++e) { float t = __builtin_amdgcn_exp2f(pS0[4 * i + e]); ATT_PIN(t); pS0[4 * i + e] = t; }
                } else {
#pragma unroll
                    for (int e = 0; e < 4; ++e) { float t = __builtin_amdgcn_exp2f(pS1[4 * (i - 4) + e]); ATT_PIN(t); pS1[4 * (i - 4) + e] = t; }
                }
                ATT_SB(); }
        }
        ATT_TP(a2c);
        if (hasN && iN.near) { if (iN.win) fix_near4<true>(pN0, pN1, tq, iN.kbase, bl, hi); else fix_near4<false>(pN0, pN1, tq, iN.kbase, bl, hi); }
        ATT_SB();
        ATT_TP(a3);
        {   const lds_cptr vp = (lds_cptr)l3 + L_RING + s0 + vlane;
            u32x4 pw[4]; s16x4 lo[4], hh[4];
#pragma unroll
            for (int ks = 0; ks < 4; ++ks) { lo[ks] = vtr(vp + ks * 1024); hh[ks] = vtr(vp + ks * 1024 + 512); }
#pragma unroll
            for (int j = 0; j < 4; ++j) pw[0][j] = cvtpk(pS0[2 * j], pS0[2 * j + 1]);
            f32x2_t sa = {0.f, 0.f}, sb = {0.f, 0.f}; float ma = -INFINITY, mb = -INFINITY;
            ATT_SB();
#pragma unroll
            for (int d0 = 0; d0 < ND; ++d0) {
#pragma unroll
                for (int ks = 0; ks < 4; ++ks) {
                    const bf16x8 vf = (bf16x8){lo[ks][0], lo[ks][1], lo[ks][2], lo[ks][3], hh[ks][0], hh[ks][1], hh[ks][2], hh[ks][3]};
                    st.o[d0] = __builtin_amdgcn_mfma_f32_32x32x16_bf16(__builtin_bit_cast(bf16x8, pw[ks]), vf, st.o[d0], 0, 0, 0);
                    if (d0 == 0 && ks < 3) {
                        const int q = ks + 1;
#pragma unroll
                        for (int j = 0; j < 4; ++j) pw[q][j] = (q < 2 ? cvtpk(pS0[8 * q + 2 * j], pS0[8 * q + 2 * j + 1]) : cvtpk(pS1[8 * (q - 2) + 2 * j], pS1[8 * (q - 2) + 2 * j + 1]));
                    }
                    const int g = d0 * 4 + ks;
                    if (g < 4) { sa += (f32x2_t){pS0[4 * g], pS0[4 * g + 1]}; sa += (f32x2_t){pS0[4 * g + 2], pS0[4 * g + 3]}; ATT_PIN(sa);
                        ma = ATT_MX3(ma, pN0[4 * g], pN0[4 * g + 1]); ma = ATT_MX3(ma, pN0[4 * g + 2], pN0[4 * g + 3]); ATT_PIN(ma); }
                    else if (g < 8) { sb += (f32x2_t){pS1[4 * (g - 4)], pS1[4 * (g - 4) + 1]}; sb += (f32x2_t){pS1[4 * (g - 4) + 2], pS1[4 * (g - 4) + 3]}; ATT_PIN(sb);
                        mb = ATT_MX3(mb, pN1[4 * (g - 4)], pN1[4 * (g - 4) + 1]); mb = ATT_MX3(mb, pN1[4 * (g - 4) + 2], pN1[4 * (g - 4) + 3]); ATT_PIN(mb); }
                    if (g == 1 && k + 3 < n) issue(k + 3, lds0 + s3);
                    if (ks == 3 && d0 + 1 < ND) {
#pragma unroll
                        for (int k2 = 0; k2 < 4; ++k2) { lo[k2] = vtr(vp + (d0 + 1) * 4096 + k2 * 1024); hh[k2] = vtr(vp + (d0 + 1) * 4096 + k2 * 1024 + 512); }
                    }
                    ATT_SB();
                }
            }
            const f32x2_t s2 = sa + sb; st.l += s2.x + s2.y;
            { const float m = __builtin_fmaxf(ma, mb); auto rr = __builtin_amdgcn_permlane32_swap(__float_as_uint(m), __float_as_uint(m), false, false);
                rmS = __builtin_fmaxf(__uint_as_float(rr[0]), __uint_as_float(rr[1])); }
        }
#if ATT_PROBE
        asm volatile("s_waitcnt lgkmcnt(0)" ::: "memory");
        ATT_TP(a4);
        if ((ATT_PROBE_PHASE == 2) == (NKM == 2) && blockIdx.x == ATT_PROBE_BLOCK && wid == ATT_PROBE_WAVE && lane == 0) { g_dbg[0] += a1 - a0; g_dbg[1] += a2 - a1; g_dbg[2] += a3 - a2; g_dbg[3] += a4 - a3; g_dbg[4] += 1ull; g_dbg[5] += a2b - a2; g_dbg[6] += a2c - a2b; g_dbg[7] += a3 - a2c; }
#endif
        iS = iN;
        const int t = s0; s0 = s1; s1 = s2; s2 = s3; s3 = t;
    };
    int k = 0;
    for (; k + 2 <= n; k += 2) { step(k, pA0, pA1, pB0, pB1); step(k + 1, pB0, pB1, pA0, pA1); }
    if (k < n) step(k, pA0, pA1, pB0, pB1);
}

__device__ __forceinline__ void rowfac(float (&fr)[16], float f, LAS3 float* wsf, int r32, int hi) {
    if (hi == 0) wsf[r32] = f;
#pragma unroll
    for (int r = 0; r < 16; ++r) fr[r] = wsf[crow(r, hi)];
}
template <int ND>
__device__ __forceinline__ void stage_o(const f32x16 (&o)[ND], LAS3 bf16* stg, int r32, int hi) {
#pragma unroll
    for (int r = 0; r < 16; ++r) { const int orow = crow(r, hi);
#pragma unroll
        for (int d0 = 0; d0 < ND; ++d0) stg[orow * (32 * ND) + d0 * 32 + r32] = (bf16)f2bf(o[d0][r]); }
}

constexpr int MB_KM = 65536, MB_RM = 73728, MB_UNI = 74752, MB_PB = 74756, MB_G = 74944;
__device__ __forceinline__ void moba_unit(const PP& p, char* lds, int b, int h, int c, int tid) {
    const int lane = tid & 63, r32 = lane & 31, hi = lane >> 5; const int wid = __builtin_amdgcn_readfirstlane(tid >> 6);
    LAS3 char* l3 = (LAS3 char*)lds;
    LAS3 float* KM = (LAS3 float*)(l3 + MB_KM); LAS3 unsigned* RM = (LAS3 unsigned*)(l3 + MB_RM); LAS3 unsigned* UNI = (LAS3 unsigned*)(l3 + MB_UNI); LAS3 int* PB = (LAS3 int*)(l3 + MB_PB); LAS3 float* Gs = (LAS3 float*)(l3 + MB_G);
    LAS3 float* wsf = (LAS3 float*)(l3 + L_WSF) + wid * 64; const LAS3 float* bl = (const LAS3 float*)(l3 + L_BIAS) + h * 128;
    ATT_T(u0);
    const size_t rowbase = (size_t)b * SEQ; const int q0 = c * 256;
    const bf16* Qg = p.PROJ + rowbase * NP1 + h * 64; const bf16* Kg = p.PROJ + rowbase * NP1 + 1024 + h * 64; const bf16* Vg = p.PROJ + rowbase * NP1 + 2048 + h * 64;
    ATT_BAR();
    if (tid == 0) UNI[0] = 0u;
    const int tq = q0 + wid * 32 + r32;
    bf16x8 qr[4];
#pragma unroll
    for (int d0 = 0; d0 < 4; ++d0) qr[d0] = *(const bf16x8*)(Qg + (size_t)tq * NP1 + d0 * 16 + hi * 8);
    unsigned mymask;
    {   f32x16 g = f32x16{};
        const float* km0 = p.KMP + ((size_t)(b * 16 + h) * 32 + r32) * 64 + hi * 8; const float* km1 = km0 + (size_t)2 * 16 * 32 * 64;
#pragma unroll
        for (int d0 = 0; d0 < 4; ++d0) {
            const f32x4 a0 = *(const f32x4*)(km0 + d0 * 16), a1 = *(const f32x4*)(km0 + d0 * 16 + 4), c0 = *(const f32x4*)(km1 + d0 * 16), c1 = *(const f32x4*)(km1 + d0 * 16 + 4);
            float v[8] = {a0.x + c0.x, a0.y + c0.y, a0.z + c0.z, a0.w + c0.w, a1.x + c1.x, a1.y + c1.y, a1.z + c1.z, a1.w + c1.w};
            bf16x8 fh, fl;
#pragma unroll
            for (int j = 0; j < 8; ++j) { const float x = v[j] * (1.0f / 256.f); const unsigned hb = f2bf(x); fh[j] = (short)hb; fl[j] = (short)f2bf(x - bf2f(hb)); }
            g = __builtin_amdgcn_mfma_f32_32x32x16_bf16(fh, qr[d0], g, 0, 0, 0);
            g = __builtin_amdgcn_mfma_f32_32x32x16_bf16(fl, qr[d0], g, 0, 0, 0);
        }
        if (c <= 3) mymask = (1u << c) - 1u;
        else {
        float xo[16], xt[16]; float t1 = -INFINITY, t2 = -INFINITY, t3 = -INFINITY;
#pragma unroll
        for (int r = 0; r < 16; ++r) { const float own = g[r];
            auto rr = __builtin_amdgcn_permlane32_swap(__float_as_uint(own), __float_as_uint(own), false, false);
            const float oth = hi ? __uint_as_float(rr[0]) : __uint_as_float(rr[1]);
            xo[r] = crow(r, hi) < c ? own : -INFINITY; xt[r] = crow(r, hi ^ 1) < c ? oth : -INFINITY;
            { const float x = xo[r]; const float n2 = __builtin_amdgcn_fmed3f(t1, x, t2), n3 = __builtin_amdgcn_fmed3f(t2, x, t3); t1 = __builtin_fmaxf(t1, x); t2 = n2; t3 = n3; }
            { const float x = xt[r]; const float n2 = __builtin_amdgcn_fmed3f(t1, x, t2), n3 = __builtin_amdgcn_fmed3f(t2, x, t3); t1 = __builtin_fmaxf(t1, x); t2 = n2; t3 = n3; } }
        unsigned gt = 0u, ge = 0u; const int sh = 4 * hi, sht = 4 * (hi ^ 1);
#pragma unroll
        for (int r = 0; r < 16; ++r) { const unsigned bo = (1u << ((r & 3) + 8 * (r >> 2))) << sh, bt = (1u << ((r & 3) + 8 * (r >> 2))) << sht;
            gt |= xo[r] > t3 ? bo : 0u; ge |= xo[r] >= t3 ? bo : 0u; gt |= xt[r] > t3 ? bt : 0u; ge |= xt[r] >= t3 ? bt : 0u; }
        unsigned eq = ge & ~gt, sel = gt; int need = 3 - __builtin_popcount(gt);
#pragma unroll
        for (int i = 0; i < 3; ++i) { const bool take = need > 0 && eq != 0u; const unsigned low = eq & (0u - eq); sel |= take ? low : 0u; eq = take ? (eq & (eq - 1u)) : eq; need -= take ? 1 : 0; }
        mymask = sel;
        }
        unsigned m = mymask;
#pragma unroll
        for (int o = 1; o < 32; o <<= 1) m |= __shfl_xor(m, o);
        ATT_BAR();
        if (lane == 0) __hip_atomic_fetch_or(UNI, m, __ATOMIC_RELAXED, __HIP_MEMORY_SCOPE_WORKGROUP);
    }
    ATT_BAR();
    if (tid == 0) { unsigned u = UNI[0]; int i = 0; while (u) { PB[i++] = __builtin_ctz(u); u &= u - 1u; } }
    ATT_BAR();
    const unsigned uni = UNI[0];
    const int npast = __builtin_popcount(uni), ntile = 4 * npast + 4;
    const float bfar = ((const LAS3 float*)(l3 + L_MISC + 64))[h];
    St<2> st; st_init(st, bfar);
    auto blk_of = [&](int k) -> int { const int i = k >> 2; return i < npast ? PB[i] : c; };
    auto krow = [&](int k) -> int { return blk_of(k) * 256 + (k & 3) * 64; };
    ATT_T(u1);
    auto tinfo = [&](int k) -> TInfo { const int n = blk_of(k), j = k & 3; TInfo t; t.kbase = n * 256 + j * 64; const bool own = n == c;
        t.near = own || (n == c - 1 && j >= 2); t.win = false; t.masked = !own; t.keep = own ? true : ((mymask >> n) & 1u) != 0u; return t; };
    run_pipe<1, 2>(lds, st, qr, Kg, NP1, Vg, NP1, ntile, krow, tinfo, 0, bl, tq, wsf, wid, lane);
    ATT_T(u2);
    const float lt = halfsum(st.l); float fr[16]; rowfac(fr, lt > 0.f ? 1.0f / lt : 0.f, wsf, r32, hi);
#pragma unroll
    for (int r = 0; r < 16; ++r) { st.o[0][r] *= fr[r]; st.o[1][r] *= fr[r]; }
    LAS3 bf16* stg = (LAS3 bf16*)(l3 + L_OST) + wid * 2048;
    stage_o<2>(st.o, stg, r32, hi);
    bf16* Ow = p.OC + (rowbase + q0 + wid * 32) * DM + h * 64;
#pragma unroll
    for (int i = 0; i < 4; ++i) { const int row = i * 8 + (lane >> 3), ch = lane & 7; const u32x4 v = *(const LAS3 u32x4*)(stg + row * 64 + ch * 8); *(u32x4*)(Ow + (size_t)row * DM + ch * 8) = v; }
#if ATT_PROBE && ATT_PROBE_PHASE == 8
    { ATT_T(u3); if (blockIdx.x == ATT_PROBE_BLOCK && wid == ATT_PROBE_WAVE && lane == 0) { g_dbg[8] += u1 - u0; g_dbg[9] += u2 - u1; g_dbg[10] += u3 - u2; g_dbg[11] += 1ull; } }
#endif
}
__device__ __forceinline__ void copy_bias_lds(const PP& p, char* lds, int tid) {
    LAS3 float* B = (LAS3 float*)((LAS3 char*)lds + L_BIAS); LAS3 float* BF = (LAS3 float*)((LAS3 char*)lds + L_MISC + 64);
    for (int i = tid; i < 16 * 128; i += NTHR) B[i] = p.BIASL[i] - p.BIASL[(i & ~127) + 127];
    if (tid < 16) BF[tid] = p.BIASL[tid * 128 + 127];
}
__device__ __forceinline__ void moba_phase(const PP& p, char* lds, int tid, int bid, int G) {
#if ATT_PROBE && ATT_PROBE_PHASE == 8
    if (bid == ATT_PROBE_BLOCK && tid == ATT_PROBE_WAVE * 64) { for (int i = 0; i < 16; ++i) g_dbg[i] = 0ull; }
#endif
    copy_bias_lds(p, lds, tid);
    const int vcu = (G % 8 == 0) ? (bid % 8) * (G / 8) + bid / 8 : bid;
    const bool bal = G == 256; const int nu = bal ? 4 : (1024 - bid + G - 1) / G;
#pragma unroll 1
    for (int i = 0; i < nu; ++i) { int bh, c;
        if (bal) { const int s_ = vcu & 7; bh = vcu >> 3; c = i == 0 ? 31 - s_ : (i == 1 ? 16 + s_ : (i == 2 ? 15 - s_ : s_)); }
        else { const int u = bid + i * G; bh = u >> 5; c = 31 - (u & 31); }
        moba_unit(p, lds, bh >> 4, bh & 15, c, tid); }
    ATT_BAR();
}

__device__ __forceinline__ void diff_unit(const PP& p, char* lds, int b, int h, int qt, int tid, float lam) {
    const int lane = tid & 63, r32 = lane & 31, hi = lane >> 5; const int wid = __builtin_amdgcn_readfirstlane(tid >> 6); const int mp = wid >> 2, wq = wid & 3;
    LAS3 char* l3 = (LAS3 char*)lds;
    LAS3 float* wsf = (LAS3 float*)(l3 + L_WSF) + wid * 64; const LAS3 float* bl = (const LAS3 float*)(l3 + L_BIAS) + (8 + h) * 128;
    const size_t rowbase = (size_t)b * SEQ; const int q0 = qt * 128; const int tq = q0 + wq * 32 + r32;
    const bf16* Qg = p.PROJ + rowbase * NP0 + C_DQ + h * 128 + mp * 64; const bf16* Kg = p.PROJ + rowbase * NP0 + C_DK + h * 128; const bf16* Vg = p.PROJ + rowbase * NP0 + C_DV + h * 128;
    bf16x8 qr[4];
#pragma unroll
    for (int d0 = 0; d0 < 4; ++d0) qr[d0] = *(const bf16x8*)(Qg + (size_t)tq * NP0 + d0 * 16 + hi * 8);
    const float bfar = ((const LAS3 float*)(l3 + L_MISC + 64))[8 + h];
    St<4> st; st_init(st, bfar);
    const int NT = 2 * (qt + 1);
    auto krow = [&](int k) -> int { return 64 * k; };
    auto tinfo = [&](int k) -> TInfo { TInfo t; t.kbase = 64 * k; t.near = k >= NT - 4; t.win = false; t.masked = false; t.keep = true; return t; };
    LAS3 float* cs4 = (LAS3 float*)(l3 + L_FIX4);
    build_fix4(cs4, (const LAS3 float*)(l3 + L_BIAS) + (8 + h) * 128, 1, tid);
    run_pipe<2, 4>(lds, st, qr, Kg, NP0, Vg, NP0, NT, krow, tinfo, mp * 8192, cs4, tq, wsf, wid, lane);
    const float lt = halfsum(st.l); float fr[16]; rowfac(fr, lt > 0.f ? 1.0f / lt : 0.f, wsf, r32, hi);
    ATT_BAR();
    LAS3 float* OL = (LAS3 float*)l3 + (size_t)mp * 128 * 128;
#pragma unroll
    for (int r = 0; r < 16; ++r) { const int row = wq * 32 + crow(r, hi);
#pragma unroll
        for (int d0 = 0; d0 < 4; ++d0) OL[row * 128 + d0 * 32 + r32] = st.o[d0][r] * fr[r]; }
    ATT_BAR();
    {   const int row = tid >> 2, part = tid & 3; const LAS3 float* o1 = (const LAS3 float*)l3 + row * 128 + part * 32; const LAS3 float* o2 = o1 + 128 * 128;
        float v[32]; float ss = 0.f;
#pragma unroll
        for (int j = 0; j < 32; j += 4) { const f32x4 a = *(const LAS3 f32x4*)(o1 + j), c = *(const LAS3 f32x4*)(o2 + j);
            v[j] = a.x - lam * c.x; v[j + 1] = a.y - lam * c.y; v[j + 2] = a.z - lam * c.z; v[j + 3] = a.w - lam * c.w;
            ss += (v[j] * v[j] + v[j + 1] * v[j + 1]) + (v[j + 2] * v[j + 2] + v[j + 3] * v[j + 3]); }
        ss += dpp_x1(ss); ss += dpp_x2(ss);
        const float rs = 0.8f / sqrtf(ss * (1.0f / 128.f) + EPS);
        bf16* dst = p.OC + (rowbase + q0 + row) * DM + 512 + h * 128 + part * 32; const float* sg = p.subln + part * 32;
#pragma unroll
        for (int j = 0; j < 32; j += 8) { u32x4 w;
            w.x = pk2(v[j] * rs * sg[j], v[j + 1] * rs * sg[j + 1]); w.y = pk2(v[j + 2] * rs * sg[j + 2], v[j + 3] * rs * sg[j + 3]);
            w.z = pk2(v[j + 4] * rs * sg[j + 4], v[j + 5] * rs * sg[j + 5]); w.w = pk2(v[j + 6] * rs * sg[j + 6], v[j + 7] * rs * sg[j + 7]);
            *(u32x4*)(dst + j) = w; }
    }
}
__device__ __forceinline__ void diff_phase(const PP& p, char* lds, int tid, int bid, int G) {
#if ATT_PROBE && ATT_PROBE_PHASE == 2
    if (bid == ATT_PROBE_BLOCK && tid == ATT_PROBE_WAVE * 64) { for (int i = 0; i < 16; ++i) g_dbg[i] = 0ull; }
#endif
    copy_bias_lds(p, lds, tid);
    const int vcu = (G % 8 == 0) ? (bid % 8) * (G / 8) + bid / 8 : bid;
    const bool bal = G == 256; const int nu = bal ? 2 : (512 - bid + G - 1) / G;
    const int lane_ = tid & 63;
    const float lam = __builtin_bit_cast(float, __builtin_amdgcn_readfirstlane(__builtin_bit_cast(int, expf(wave_sum(p.lq1[lane_] * p.lk1[lane_])) - expf(wave_sum(p.lq2[lane_] * p.lk2[lane_])) + 0.2f)));
#pragma unroll 1
    for (int i = 0; i < nu; ++i) { int bh, qt;
        if (bal) { const int s_ = vcu & 31; bh = vcu >> 5; qt = i == 0 ? 63 - s_ : s_; }
        else { const int u = bid + i * G; bh = u >> 6; qt = 63 - (u & 63); }
        diff_unit(p, lds, bh >> 2, bh & 3, qt, tid, lam); }
    ATT_BAR();
}

constexpr int NS_IMP = 65536, NS_SELM = L_MISC + 256, NS_UNI = L_MISC + 1280, NS_TL = L_MISC + 1296;
__device__ __forceinline__ void nsa_unit(const PP& p, char* lds, int b, int g, int cur, int tid) {
    const int lane = tid & 63, r32 = lane & 31, hi = lane >> 5; const int wid = __builtin_amdgcn_readfirstlane(tid >> 6);
    LAS3 char* l3 = (LAS3 char*)lds;
    LAS3 float* IMP = (LAS3 float*)(l3 + NS_IMP); LAS3 unsigned* SELM = (LAS3 unsigned*)(l3 + NS_SELM); LAS3 unsigned* UNI = (LAS3 unsigned*)(l3 + NS_UNI); LAS3 int* TL = (LAS3 int*)(l3 + NS_TL);
    const int tokl = wid * 8 + (r32 >> 2), head = r32 & 3, hh = g * 4 + head;
    LAS3 float* wsf = (LAS3 float*)(l3 + L_WSF) + wid * 64; const LAS3 float* bl = (const LAS3 float*)(l3 + L_BIAS) + hh * 128;
    const size_t rowbase = (size_t)b * SEQ; const int t0 = cur * 64; const int tq = t0 + tokl; const int twmin = t0 + wid * 8, twmax = twmin + 7;
    const bf16* Qg = p.PROJ + (rowbase + tq) * NP0 + C_Q + hh * 64;
    bf16x8 qr[4];
#pragma unroll
    for (int d0 = 0; d0 < 4; ++d0) qr[d0] = *(const bf16x8*)(Qg + d0 * 16 + hi * 8);
    const float* gp = p.GATES + (rowbase + tq) * 24 + hh; const float g0 = gp[0], g1 = gp[8], g2 = gp[16];
    const float bfar = ((const LAS3 float*)(l3 + L_MISC + 64))[hh];
    const int vlane = ((lane >> 4) & 1) * 32 + (lane & 3) * 8 + (4 * hi + ((lane & 15) >> 2)) * 64;
    ATT_TN(n0);
    ATT_BAR();
    for (int i = tid; i < 64 * 128; i += NTHR) IMP[i] = 0.f;
    build_fix4((LAS3 float*)(l3 + L_FIX4), (const LAS3 float*)(l3 + L_BIAS) + g * 4 * 128, 4, tid);
    const LAS3 float* cs4 = (const LAS3 float*)(l3 + L_FIX4) + head * 544;
    if (tid < 4) UNI[tid] = 0u;
    const int nvis = (4 * cur + 3) < NCMP ? (4 * cur + 3) : NCMP; const int ntc = (nvis + 63) >> 6;
    const bf16* KC = p.KCMP + (size_t)((b * 2 + g) * 512) * 64; const bf16* VC = p.VCMP + (size_t)((b * 2 + g) * 512) * 64;
    auto krow64 = [&](int k) -> int { return 64 * k; };
    St<2> sc; st_init(sc, bfar); const float* ccur = &sc.cval;
    auto cmp_scores = [&](f32x16& p0, f32x16& p1, int k, int slot) -> bool {
        const int c0 = 64 * k;
        if (16 * c0 + 31 > twmax) return false;
        const bool near = (twmin - (16 * (c0 + 63) + 31)) < 128;
        qk_tile(p0, p1, (lds_cptr)l3 + slot + hi * 1024 + r32 * 16, qr, *ccur);
        if (near) fix_near<false>(p0, p1, tq, 16 * c0 + 31, 16, bl, hi);
        return true;
    };
    u32x4 pw[4]; bool pend = false;
    auto nop2 = [&](int, int) {};
    auto body1 = [&](int k, int slot) { f32x16 p0, p1; if (!cmp_scores(p0, p1, k, slot)) return; softmax_p<2, 1, false>(sc, p0, p1, pw, wsf, r32, hi, 0.f, true); };
    run_stream<1, 2>(lds, KC, 64, VC, 64, ntc, krow64, body1, nop2, wid, lane);
    ATT_TN(n1);
    const float lc = halfsum(sc.l); const float rlc = lc > 0.f ? 1.0f / lc : 0.f;
    St<2> so; st_init(so, bfar); st_setref(so, bfar, sc.mhat); ccur = &so.cval;
    auto body2 = [&](int k, int slot) { f32x16 p0, p1; pend = false; if (!cmp_scores(p0, p1, k, slot)) return;
        softmax_p<2, 2, false>(so, p0, p1, pw, wsf, r32, hi, rlc, true); pend = true;
#pragma unroll
        for (int R = 0; R < 4; ++R) {
            float a0 = ((p0[4 * R] + p0[4 * R + 1]) + p0[4 * R + 2]) + 0.5f * p0[4 * R + 3], s0 = 0.5f * p0[4 * R + 3];
            float a1 = ((p1[4 * R] + p1[4 * R + 1]) + p1[4 * R + 2]) + 0.5f * p1[4 * R + 3], s1 = 0.5f * p1[4 * R + 3];
            a0 += dpp_x1(a0); a0 += dpp_x2(a0); s0 += dpp_x1(s0); s0 += dpp_x2(s0);
            a1 += dpp_x1(a1); a1 += dpp_x2(a1); s1 += dpp_x1(s1); s1 += dpp_x2(s1);
            const int n0 = 16 * k + 2 * R + hi, n1 = n0 + 8;
            if (head == 0) { LAS3 float* ip = IMP + tokl * 128;
                __hip_atomic_fetch_add(ip + n0, a0, __ATOMIC_RELAXED, __HIP_MEMORY_SCOPE_WORKGROUP); __hip_atomic_fetch_add(ip + n0 + 1, s0, __ATOMIC_RELAXED, __HIP_MEMORY_SCOPE_WORKGROUP);
                __hip_atomic_fetch_add(ip + n1, a1, __ATOMIC_RELAXED, __HIP_MEMORY_SCOPE_WORKGROUP); if (n1 + 1 < 128) __hip_atomic_fetch_add(ip + n1 + 1, s1, __ATOMIC_RELAXED, __HIP_MEMORY_SCOPE_WORKGROUP); }
        }
    };
    auto pv2 = [&](int k, int slot) { if (pend) pv_acc<2>(so, pw, (lds_cptr)l3 + slot + 8192 + vlane); };
    run_stream<1, 2>(lds, KC, 64, VC, 64, ntc, krow64, body2, pv2, wid, lane);
    ATT_TN(n2);
    __builtin_amdgcn_s_waitcnt(0xC07F); asm volatile("" ::: "memory");
#define NSA_TI 4
#pragma unroll 1
    for (int tk4 = 0; tk4 < 8; tk4 += NSA_TI) {
        const bool c0 = lane >= 1 && lane <= cur - 2, c1 = lane + 64 <= cur - 2;
        unsigned u0[NSA_TI], u1[NSA_TI], T[NSA_TI];
#pragma unroll
        for (int j = 0; j < NSA_TI; ++j) { const int tl = wid * 8 + tk4 + j; T[j] = 0u;
            u0[j] = c0 ? __float_as_uint(IMP[tl * 128 + lane]) : 0u; u1[j] = c1 ? __float_as_uint(IMP[tl * 128 + 64 + lane]) : 0u; }
        if (cur >= 16) {
#pragma unroll 1
            for (int bit = 30; bit >= 0; --bit) {
#pragma unroll
                for (int j = 0; j < NSA_TI; ++j) { const unsigned trial = T[j] | (1u << bit);
                    const int cnt = __builtin_popcountll(__ballot(u0[j] >= trial)) + __builtin_popcountll(__ballot(u1[j] >= trial));
                    if (cnt >= 13) T[j] = trial; }
            }
        }
#pragma unroll
        for (int j = 0; j < NSA_TI; ++j) { const int tl = wid * 8 + tk4 + j; unsigned long long mlo = 0ull, mhi = 0ull;
            if (cur < 16) { mlo = (2ull << cur) - 1ull; }
            else { mlo = 1ull; if (cur - 1 < 64) mlo |= 1ull << (cur - 1); else mhi |= 1ull << (cur - 1 - 64); if (cur < 64) mlo |= 1ull << cur; else mhi |= 1ull << (cur - 64);
                const unsigned long long g0 = __ballot(c0 && u0[j] > T[j]), g1 = __ballot(c1 && u1[j] > T[j]);
                unsigned long long e0 = __ballot(c0 && u0[j] == T[j]), e1 = __ballot(c1 && u1[j] == T[j]);
                int need = 13 - (__builtin_popcountll(g0) + __builtin_popcountll(g1));
                unsigned long long t0 = 0ull, t1 = 0ull;
                while (need > 0 && e0) { t0 |= e0 & (0ull - e0); e0 &= e0 - 1ull; --need; }
                while (need > 0 && e1) { t1 |= e1 & (0ull - e1); e1 &= e1 - 1ull; --need; }
                mlo |= g0 | t0; mhi |= g1 | t1; }
            if (lane == 0) { const unsigned m0 = (unsigned)mlo, m1 = (unsigned)(mlo >> 32), m2 = (unsigned)mhi, m3 = (unsigned)(mhi >> 32);
                SELM[tl * 4 + 0] = m0; SELM[tl * 4 + 1] = m1; SELM[tl * 4 + 2] = m2; SELM[tl * 4 + 3] = m3;
                __hip_atomic_fetch_or(UNI + 0, m0, __ATOMIC_RELAXED, __HIP_MEMORY_SCOPE_WORKGROUP); __hip_atomic_fetch_or(UNI + 1, m1, __ATOMIC_RELAXED, __HIP_MEMORY_SCOPE_WORKGROUP);
                __hip_atomic_fetch_or(UNI + 2, m2, __ATOMIC_RELAXED, __HIP_MEMORY_SCOPE_WORKGROUP); __hip_atomic_fetch_or(UNI + 3, m3, __ATOMIC_RELAXED, __HIP_MEMORY_SCOPE_WORKGROUP); }
        }
    }
    ATT_BAR();
    if (wid == 0) {
        const unsigned s0 = (unsigned)__builtin_amdgcn_readfirstlane((int)UNI[0]), s1 = (unsigned)__builtin_amdgcn_readfirstlane((int)UNI[1]);
        const unsigned s2 = (unsigned)__builtin_amdgcn_readfirstlane((int)UNI[2]), s3 = (unsigned)__builtin_amdgcn_readfirstlane((int)UNI[3]);
        const int nlo = __builtin_popcount(s0) + __builtin_popcount(s1);
        const unsigned blo = __builtin_amdgcn_mbcnt_hi(s1, __builtin_amdgcn_mbcnt_lo(s0, 0u)), bhi = __builtin_amdgcn_mbcnt_hi(s3, __builtin_amdgcn_mbcnt_lo(s2, 0u));
        const unsigned mylo = lane < 32 ? s0 >> lane : s1 >> (lane - 32), myhi2 = lane < 32 ? s2 >> lane : s3 >> (lane - 32);
        if (mylo & 1u) TL[1 + blo] = lane;
        if (myhi2 & 1u) TL[1 + nlo + bhi] = 64 + lane;
        if (lane == 0) TL[0] = nlo + __builtin_popcount(s2) + __builtin_popcount(s3); }
    ATT_BAR();
    const int nsel = TL[0];
    LAS3 float* otl = (LAS3 float*)(l3 + (wid < 4 ? NS_IMP + wid * 8192 : L_OST + (wid - 4) * 8192));
    { float fr[16]; rowfac(fr, g0, wsf, r32, hi);
#pragma unroll
      for (int r = 0; r < 16; ++r) { otl[crow(r, hi) * 64 + r32] = so.o[0][r] * fr[r]; otl[crow(r, hi) * 64 + 32 + r32] = so.o[1][r] * fr[r]; } }
    const unsigned long long mylo = (unsigned long long)SELM[tokl * 4 + 0] | ((unsigned long long)SELM[tokl * 4 + 1] << 32), myhi = (unsigned long long)SELM[tokl * 4 + 2] | ((unsigned long long)SELM[tokl * 4 + 3] << 32);
    ATT_TN(n3);
    { St<2> ss; st_init(ss, bfar);
      const bf16* KS = p.PROJ + rowbase * NP0 + C_KS + g * 64; const bf16* VS = p.PROJ + rowbase * NP0 + C_VS + g * 64;
      auto krow3 = [&](int k) -> int { return 64 * TL[1 + k]; };
      auto ti3 = [&](int k) -> TInfo { const int n = TL[1 + k]; TInfo t; t.kbase = 64 * n; t.near = n >= cur - 2; t.win = false; t.masked = true;
          t.keep = (((n < 64 ? mylo : myhi) >> (n & 63)) & 1ull) != 0ull; return t; };
      run_pipe<1, 2>(lds, ss, qr, KS, NP0, VS, NP0, nsel, krow3, ti3, 0, cs4, tq, wsf, wid, lane);
      const float ls = halfsum(ss.l); float fr[16]; rowfac(fr, ls > 0.f ? g1 / ls : 0.f, wsf, r32, hi);
#pragma unroll
      for (int r = 0; r < 16; ++r) { otl[crow(r, hi) * 64 + r32] += ss.o[0][r] * fr[r]; otl[crow(r, hi) * 64 + 32 + r32] += ss.o[1][r] * fr[r]; } }
    ATT_TN(n4);
    { St<2> sw; st_init(sw, bfar);
      const bf16* KW = p.PROJ + rowbase * NP0 + C_KW + g * 64; const bf16* VW = p.PROJ + rowbase * NP0 + C_VW + g * 64;
      const int nlo = cur >= 8 ? cur - 8 : 0;
      auto krow4 = [&](int k) -> int { return 64 * (nlo + k); };
      auto body4 = [&](int k, int slot) { const int n = nlo + k; const int kbase = 64 * n;
          const bool near = (n >= cur - 2) || (n == cur - 8);
          f32x16 p0, p1; qk_tile(p0, p1, (lds_cptr)l3 + slot + hi * 1024 + r32 * 16, qr, sw.cval);
          if (near) fix_near4<true>(p0, p1, tq, kbase, cs4, hi);
          softmax_p<2, 0, false>(sw, p0, p1, pw, wsf, r32, hi, 0.f, true); };
      auto pv4 = [&](int k, int slot) { pv_acc<2>(sw, pw, (lds_cptr)l3 + slot + 8192 + vlane); };
      run_stream<1, 2>(lds, KW, NP0, VW, NP0, cur - nlo + 1, krow4, body4, pv4, wid, lane);
      const float lw = halfsum(sw.l); float fr[16]; rowfac(fr, lw > 0.f ? g2 / lw : 0.f, wsf, r32, hi);
#pragma unroll
      for (int r = 0; r < 16; ++r) { otl[crow(r, hi) * 64 + r32] += sw.o[0][r] * fr[r]; otl[crow(r, hi) * 64 + 32 + r32] += sw.o[1][r] * fr[r]; } }
    ATT_TN(n5);
#if ATT_PROBE && ATT_PROBE_PHASE == 3
    if (blockIdx.x == ATT_PROBE_BLOCK && wid == ATT_PROBE_WAVE && lane == 0) { g_dbg[8] += n1 - n0; g_dbg[9] += n2 - n1; g_dbg[10] += n3 - n2; g_dbg[12] += n4 - n3; g_dbg[13] += n5 - n4; g_dbg[11] += 1ull; }
#endif
    bf16* Ow = p.OC + (rowbase + t0 + wid * 8) * DM + g * 256;
#pragma unroll
    for (int i = 0; i < 4; ++i) { const int row = i * 8 + (lane >> 3), ch = lane & 7; const f32x4 a = *(const LAS3 f32x4*)(otl + row * 64 + ch * 8), c = *(const LAS3 f32x4*)(otl + row * 64 + ch * 8 + 4);
        u32x4 v; v.x = pk2(a.x, a.y); v.y = pk2(a.z, a.w); v.z = pk2(c.x, c.y); v.w = pk2(c.z, c.w); *(u32x4*)(Ow + (size_t)(row >> 2) * DM + (row & 3) * 64 + ch * 8) = v; }
}
__device__ __forceinline__ void nsa_phase(const PP& p, char* lds, int tid, int bid, int G) {
#if ATT_PROBE && ATT_PROBE_PHASE == 3
    if (bid == ATT_PROBE_BLOCK && tid == ATT_PROBE_WAVE * 64) { for (int i = 0; i < 16; ++i) g_dbg[i] = 0ull; }
#endif
    copy_bias_lds(p, lds, tid);
    const int vcu = (G % 8 == 0) ? (bid % 8) * (G / 8) + bid / 8 : bid;
    const bool bal = G == 256; const int nu = bal ? 2 : (512 - bid + G - 1) / G;
#pragma unroll 1
    for (int i = 0; i < nu; ++i) { int bg, cur;
        if (bal) { const int s_ = vcu & 63; bg = vcu >> 6; cur = i == 0 ? 127 - s_ : s_; }
        else { const int u = bid + i * G; bg = u >> 7; cur = 127 - (u & 127); }
        nsa_unit(p, lds, bg >> 1, bg & 1, cur, tid); }
    ATT_BAR();
}

typedef float f32x4v __attribute__((ext_vector_type(4)));
__device__ __forceinline__ void compress_unit(const PP& p, char* lds, int kv, int b, int g, int ct, int tid) {
    const int lane = tid & 63, fr = lane & 15, fq = lane >> 4; const int wid = __builtin_amdgcn_readfirstlane(tid >> 6);
    LAS3 bf16* hid = (LAS3 bf16*)((LAS3 char*)lds);
    LAS3 char* win = (LAS3 char*)lds + 8192;
    const unsigned lds_w = (unsigned)(uintptr_t)lds + 8192u;
    const int c0 = ct * 16; const int col = (kv ? C_VC : C_KC) + g * 64;
    const bf16* W1 = (kv ? p.CW1V : p.CW1K) + ((size_t)wid * 64 * 64 + lane) * 8;
    const bf16* W2 = (kv ? p.CW2V : p.CW2K) + (size_t)((wid & 3) * 16 + fr) * 128 + fq * 8;
    f32x4v acc = {0.f, 0.f, 0.f, 0.f};
    ATT_BAR();
    ATT_T(q0);
    { const bf16* Ab = p.PROJ + (size_t)b * SEQ * NP0 + col;
#pragma unroll 1
      for (int i = wid; i < 34; i += 8) { const int t = i * 8 + (lane >> 3), q = lane & 7; int tok = 16 * c0 + t; tok = tok < SEQ ? tok : SEQ - 1;
          glds16(Ab + (size_t)tok * NP0 + ((q ^ ((t >> 4) & 7)) * 8), lds_w + (unsigned)i * 1024u); } }
    float bias = 0.f;
#pragma unroll
    for (int j = 0; j < 8; ++j) bias += p.CMPB[(kv * 8 + j) * 128 + wid * 16 + fr];
    bf16x8 w2f[4];
#pragma unroll
    for (int ks = 0; ks < 4; ++ks) w2f[ks] = *(const bf16x8*)(W2 + ks * 32);
#pragma unroll
    for (int hb = 0; hb < 2; ++hb) {
        bf16x8 wf[32];
#pragma unroll
        for (int j = 0; j < 32; ++j) wf[j] = *(const bf16x8*)(W1 + (hb * 32 + j) * 512);
        if (hb == 0) { asm volatile("s_waitcnt vmcnt(0)" ::: "memory"); ATT_BAR(); }
        ATT_T(q1);
#pragma unroll
        for (int j = 0; j < 32; ++j) { const int ks = hb * 32 + j; const int t = 16 * fr + (ks >> 1), ch = (ks & 1) * 4 + fq;
            const bf16x8 af = *(const LAS3 bf16x8*)(win + t * 128 + ((ch ^ ((t >> 4) & 7)) * 16));
            acc = __builtin_amdgcn_mfma_f32_16x16x32_bf16(af, wf[j], acc, 0, 0, 0); }
#if ATT_PROBE && ATT_PROBE_PHASE == 1
        { asm volatile("s_nop 7\n\ts_nop 7" :: "v"(acc)); ATT_T(q2); if (blockIdx.x == ATT_PROBE_BLOCK && wid == ATT_PROBE_WAVE && lane == 0) { if (hb == 0) { g_dbg[8] += q1 - q0; g_dbg[9] += q2 - q1; g_dbg[11] += 1ull; } else { g_dbg[10] += q2 - q0; } } }
#endif
    }
#pragma unroll
    for (int r = 0; r < 4; ++r) hid[(fq * 4 + r) * 136 + wid * 16 + fr] = (bf16)f2bf(gelu_tanh(acc[r] + bias));
    ATT_BAR();
    if (wid < 4) {
        f32x4v o = {0.f, 0.f, 0.f, 0.f};
#pragma unroll
        for (int ks = 0; ks < 4; ++ks) {
            const bf16x8 af = *(const LAS3 bf16x8*)(hid + fr * 136 + ks * 32 + fq * 8);
            o = __builtin_amdgcn_mfma_f32_16x16x32_bf16(af, w2f[ks], o, 0, 0, 0);
        }
        bf16* outp = (kv ? p.VCMP : p.KCMP) + (size_t)((b * 2 + g) * 512 + c0) * 64 + wid * 16 + fr;
#pragma unroll
        for (int r = 0; r < 4; ++r) { const int c = c0 + fq * 4 + r; outp[(size_t)(fq * 4 + r) * 64] = c < NCMP ? (bf16)f2bf(o[r]) : (bf16)0; }
    }
}
__device__ __forceinline__ void compress_phase(const PP& p, char* lds, int tid, int bid, int G) {
#if ATT_PROBE && ATT_PROBE_PHASE == 1
    if (bid == ATT_PROBE_BLOCK && tid == ATT_PROBE_WAVE * 64) { for (int i = 0; i < 16; ++i) g_dbg[i] = 0ull; }
    __syncthreads();
#endif
    for (int u = bid; u < 256; u += G) { const int ct = u & 31, bg = (u >> 5) & 3, kv = u >> 7; compress_unit(p, lds, kv, bg >> 1, bg & 1, ct, tid); }
    ATT_BAR();
}

constexpr size_t WS_MLCNT = WS_CTL + 32768;
constexpr size_t WS_MLIST = WS_W2_0;
constexpr int ML_FAR_PER_BH = 256 * 465;
__device__ __forceinline__ int ml_far_off(int n) { return 256 * (30 * n - n * (n - 1) / 2); }
constexpr size_t WS_PO0 = WS_XB, WS_PO1 = WS_XB + 16 * MiB, WS_PO2 = 218 * MiB, WS_PO3 = WS_WIN0, WS_PM = 234 * MiB;
__device__ __forceinline__ unsigned short* ml_list(unsigned char* ws, bool near, int bh, int n) {
    unsigned short* base = (unsigned short*)(ws + WS_MLIST);
    return near ? base + ((size_t)bh * 32 + n) * 256 : base + (size_t)32 * 32 * 256 + (size_t)bh * ML_FAR_PER_BH + ml_far_off(n); }

__device__ __forceinline__ unsigned moba_gate_mask(const PP& p, int b, int h, int c, int tid) {
    const int lane = tid & 63, r32 = lane & 31, hi = lane >> 5; const int wid = __builtin_amdgcn_readfirstlane(tid >> 6);
    if (c == 0) return 0u;
    const size_t rowbase = (size_t)b * SEQ; const int tq = c * 256 + wid * 32 + r32; const int bh = b * 16 + h;
    const bf16* Qg = p.PROJ + rowbase * NP1 + h * 64;
    bf16x8 qr[4];
#pragma unroll
    for (int d0 = 0; d0 < 4; ++d0) qr[d0] = *(const bf16x8*)(Qg + (size_t)tq * NP1 + d0 * 16 + hi * 8);
    unsigned mymask;
    f32x16 g = f32x16{};
    const float* km0 = p.KMP + ((size_t)bh * 32 + r32) * 64 + hi * 8; const float* km1 = km0 + (size_t)2 * 16 * 32 * 64;
#pragma unroll
    for (int d0 = 0; d0 < 4; ++d0) {
        const f32x4 a0 = *(const f32x4*)(km0 + d0 * 16), a1 = *(const f32x4*)(km0 + d0 * 16 + 4), c0 = *(const f32x4*)(km1 + d0 * 16), c1 = *(const f32x4*)(km1 + d0 * 16 + 4);
        float v[8] = {a0.x + c0.x, a0.y + c0.y, a0.z + c0.z, a0.w + c0.w, a1.x + c1.x, a1.y + c1.y, a1.z + c1.z, a1.w + c1.w};
        bf16x8 fh, fl;
#pragma unroll
        for (int j = 0; j < 8; ++j) { const float x = v[j] * (1.0f / 256.f); const unsigned hb = f2bf(x); fh[j] = (short)hb; fl[j] = (short)f2bf(x - bf2f(hb)); }
        g = __builtin_amdgcn_mfma_f32_32x32x16_bf16(fh, qr[d0], g, 0, 0, 0);
        g = __builtin_amdgcn_mfma_f32_32x32x16_bf16(fl, qr[d0], g, 0, 0, 0);
    }
    if (c <= 3) mymask = (1u << c) - 1u;
    else {
        float xo[16], xt[16]; float t1 = -INFINITY, t2 = -INFINITY, t3 = -INFINITY;
#pragma unroll
        for (int r = 0; r < 16; ++r) { const float own = g[r];
            auto rr = __builtin_amdgcn_permlane32_swap(__float_as_uint(own), __float_as_uint(own), false, false);
            const float oth = hi ? __uint_as_float(rr[0]) : __uint_as_float(rr[1]);
            xo[r] = crow(r, hi) < c ? own : -INFINITY; xt[r] = crow(r, hi ^ 1) < c ? oth : -INFINITY;
            { const float x = xo[r]; const float n2 = __builtin_amdgcn_fmed3f(t1, x, t2), n3 = __builtin_amdgcn_fmed3f(t2, x, t3); t1 = __builtin_fmaxf(t1, x); t2 = n2; t3 = n3; }
            { const float x = xt[r]; const float n2 = __builtin_amdgcn_fmed3f(t1, x, t2), n3 = __builtin_amdgcn_fmed3f(t2, x, t3); t1 = __builtin_fmaxf(t1, x); t2 = n2; t3 = n3; } }
        unsigned gt = 0u, ge = 0u; const int sh = 4 * hi, sht = 4 * (hi ^ 1);
#pragma unroll
        for (int r = 0; r < 16; ++r) { const unsigned bo = (1u << ((r & 3) + 8 * (r >> 2))) << sh, bt = (1u << ((r & 3) + 8 * (r >> 2))) << sht;
            gt |= xo[r] > t3 ? bo : 0u; ge |= xo[r] >= t3 ? bo : 0u; gt |= xt[r] > t3 ? bt : 0u; ge |= xt[r] >= t3 ? bt : 0u; }
        unsigned eq = ge & ~gt, sel = gt; int need = 3 - __builtin_popcount(gt);
#pragma unroll
        for (int i = 0; i < 3; ++i) { const bool take = need > 0 && eq != 0u; const unsigned low = eq & (0u - eq); sel |= take ? low : 0u; eq = take ? (eq & (eq - 1u)) : eq; need -= take ? 1 : 0; }
        mymask = sel;
    }
    return mymask;
}
__device__ __forceinline__ void moba_route_item(const PP& p, unsigned char* ws, char* lds, int b, int h, int n, int part, int nparts, int tid) {
    const int lane = tid & 63, r32 = lane & 31, hi = lane >> 5; const int wid = __builtin_amdgcn_readfirstlane(tid >> 6);
    LAS3 char* l3 = (LAS3 char*)lds; const int bh = b * 16 + h;
    LAS3 float* wsf = (LAS3 float*)(l3 + L_WSF) + wid * 64; const LAS3 float* bl = (const LAS3 float*)(l3 + L_BIAS) + h * 128;
    const float bfar = ((const LAS3 float*)(l3 + L_MISC + 64))[h];
    const unsigned* cnts = (const unsigned*)(ws + WS_MLCNT);
    const int cntN = (int)cnts[bh * 32 + n], cntF = (int)cnts[1024 + bh * 32 + n];
    const int gN = (cntN + 31) >> 5, gF = (cntF + 31) >> 5, gT = gN + gF + 8;
    const int g_lo = 32 * part, g_hi = (part + 1 == nparts || 32 * (part + 1) > gT) ? gT : 32 * (part + 1);
    if (g_lo >= g_hi) return;
    const size_t rowbase = (size_t)b * SEQ;
    const bf16* Qg = p.PROJ + rowbase * NP1 + h * 64; const bf16* Kg = p.PROJ + rowbase * NP1 + 1024 + h * 64; const bf16* Vg = p.PROJ + rowbase * NP1 + 2048 + h * 64;
    const unsigned lds0 = (unsigned)(uintptr_t)lds;
    ATT_T(r0);
    ATT_BAR();
    __builtin_amdgcn_s_waitcnt(0x0F70);
#pragma unroll
    for (int tt = 0; tt < 4; ++tt) issue_tile<1, 2>(Kg, NP1, Vg, NP1, n * 256 + tt * 64, lds0 + tt * 16384, wid, lane);
    LAS3 float* cs4 = (LAS3 float*)(l3 + 69632);
    for (int i = tid; i < 4 * 136; i += NTHR) { const int sft = i / 136, kk = i - sft * 136; const int bi = kk + sft - 3; cs4[i] = bl[bi < 0 ? 0 : (bi > 127 ? 127 : bi)]; }
    ATT_WAIT_BAR(0);
    ATT_T(r1);
#if ATT_PROBE && ATT_PROBE_PHASE == 82
    if (b == 0 && blockIdx.x == ATT_PROBE_BLOCK && wid == ATT_PROBE_WAVE && lane == 0) { g_dbg[9] += r1 - r0; g_dbg[10] -= r1; }
#endif
    const unsigned short* listN = ml_list(ws, true, bh, n); const unsigned short* listF = ml_list(ws, false, bh, n);
    LAS3 unsigned* ent = (LAS3 unsigned*)(l3 + 65536) + wid * 32;
    LAS3 bf16* stg = (LAS3 bf16*)(l3 + L_OST) + wid * 2048;
    bf16* PO[4] = {(bf16*)p.out, (bf16*)p.out + (size_t)16 * 1024 * 1024, (bf16*)(ws + WS_PO2), p.OC}; float* PM = (float*)(ws + WS_WIN0);
    const int vlane = ((lane >> 4) & 1) * 32 + (lane & 3) * 8 + (4 * hi + ((lane & 15) >> 2)) * 64;
    auto fetch = [&](int g, unsigned& e, bool& valid, bool& own, bool& near, bf16x8 (&qr)[4]) __attribute__((always_inline)) {
        own = g >= gN + gF; near = g < gN; const int gi = near ? g : (own ? g - gN - gF : g - gN); const int cnt = near ? cntN : cntF; const unsigned short* list = near ? listN : listF;
        const int idx = gi * 32 + r32; valid = own || idx < cnt;
        e = own ? (unsigned)(n * 256 + idx) | (3u << 13) : (valid ? (unsigned)list[idx] : (unsigned)(n * 256));
        const int t = (int)(e & 8191u);
#pragma unroll
        for (int d0 = 0; d0 < 4; ++d0) qr[d0] = *(const bf16x8*)(Qg + (size_t)t * NP1 + d0 * 16 + hi * 8);
    };
    unsigned e = 0u, en = 0u; bool valid = false, own = false, near = false, validn = false, ownn = false, nearn = false; bf16x8 qr[4], qrn[4];
    if (g_lo + wid < g_hi) fetch(g_lo + wid, e, valid, own, near, qr);
#pragma unroll 1
    for (int g = g_lo + wid; g < g_hi; g += 8) {
        if (g + 8 < g_hi) fetch(g + 8, en, validn, ownn, nearn, qrn);
        const int t = (int)(e & 8191u); const unsigned slot = e >> 13;
        if (hi == 0) ent[r32] = e | (valid ? 0x10000u : 0u);
        St<2> st; st_init(st, bfar);
        u32x4 pw[4];
        const int ntl = own ? ((32 * (g - gN - gF) + 31) >> 6) + 1 : 4;
#pragma unroll 1
        for (int tt = 0; tt < ntl; ++tt) {
            f32x16 p0, p1;
            qk_tile(p0, p1, (lds_cptr)l3 + tt * 16384 + hi * 1024 + r32 * 16, qr, valid ? st.cval : -INFINITY);
            if (own ? (32 * (g - gN - gF) - (64 * tt + 63) < 128) : (near && tt >= 2)) fix_near4<false>(p0, p1, t, n * 256 + tt * 64, cs4, hi);
            softmax_p<2, 0, false>(st, p0, p1, pw, wsf, r32, hi, 0.f, true);
            pv_acc<2>(st, pw, (lds_cptr)l3 + tt * 16384 + 8192 + vlane);
        }
        const float lt = halfsum(st.l); float fr[16]; rowfac(fr, lt > 0.f ? 1.0f / lt : 0.f, wsf, r32, hi);
#pragma unroll
        for (int r = 0; r < 16; ++r) { st.o[0][r] *= fr[r]; st.o[1][r] *= fr[r]; }
        stage_o<2>(st.o, stg, r32, hi);
        if (hi == 0 && valid) PM[((rowbase + t) * 16 + h) * 4 + slot] = st.mhat + __log2f(lt);
#pragma unroll
        for (int i = 0; i < 4; ++i) { const int row = i * 8 + (lane >> 3), ch = lane & 7; const unsigned ee = ent[row];
            const u32x4 v = *(const LAS3 u32x4*)(stg + row * 64 + ch * 8);
            if (ee & 0x10000u) { const unsigned sl = (ee >> 13) & 3u; bf16* dst = (sl == 0 ? PO[0] : (sl == 1 ? PO[1] : (sl == 2 ? PO[2] : PO[3]))) + ((rowbase + (ee & 8191u)) * 16 + h) * 64 + ch * 8; *(u32x4*)dst = v; } }
        e = en; valid = validn; own = ownn; near = nearn;
#pragma unroll
        for (int d0 = 0; d0 < 4; ++d0) qr[d0] = qrn[d0];
    }
#if ATT_PROBE && ATT_PROBE_PHASE == 82
    { ATT_T(r2); if (b == 0 && blockIdx.x == ATT_PROBE_BLOCK && wid == ATT_PROBE_WAVE && lane == 0) { g_dbg[10] += r2; g_dbg[12] += (unsigned long long)((g_hi - g_lo - wid + 7) / 8); } }
#endif
}
__device__ __forceinline__ void moba_merge_phase(const PP& p, unsigned char* ws, int tid, int bid, int G) {
#if ATT_PROBE && ATT_PROBE_PHASE == 83
    if (bid == ATT_PROBE_BLOCK && tid == ATT_PROBE_WAVE * 64) { for (int i = 0; i < 16; ++i) g_dbg[i] = 0ull; }
    __syncthreads();
#endif
    ATT_T(mg0);
    const float* PMb = (const float*)(ws + WS_WIN0);
    const bf16* PO[4] = {(const bf16*)p.out, (const bf16*)p.out + (size_t)16 * 1024 * 1024, (const bf16*)(ws + WS_PO2), p.OC};
#pragma unroll 1
    for (int i = bid * NTHR + tid; i < M * 16 * 2; i += G * NTHR) {
        const int half = i & 1, h = (i >> 1) & 15, row = i >> 5; const int c = (row & (SEQ - 1)) >> 8; const int nsl = c < 3 ? c : 3;
        const f32x4 m4 = *(const f32x4*)(PMb + ((size_t)row * 16 + h) * 4);
        const float ms[4] = {nsl > 0 ? m4.x : -INFINITY, nsl > 1 ? m4.y : -INFINITY, nsl > 2 ? m4.z : -INFINITY, m4.w};
        const float mx = fmaxf(fmaxf(ms[0], ms[1]), fmaxf(ms[2], ms[3]));
        float w[4], wsum = 0.f;
#pragma unroll
        for (int s_ = 0; s_ < 4; ++s_) { w[s_] = exp2f(ms[s_] - mx); wsum += w[s_]; }
        const float inv = 1.0f / wsum;
        float acc[32];
#pragma unroll
        for (int j = 0; j < 32; ++j) acc[j] = 0.f;
#pragma unroll
        for (int s_ = 0; s_ < 4; ++s_) { if (s_ == 3 || s_ < nsl) { const bf16* src = PO[s_] + ((size_t)row * 16 + h) * 64 + half * 32; const float ww = w[s_] * inv;
#pragma unroll
            for (int j = 0; j < 32; j += 8) { const v4u u = *(const v4u*)(src + j);
                acc[j] += ww * bf2f(u.x & 0xffff); acc[j + 1] += ww * bf2f(u.x >> 16); acc[j + 2] += ww * bf2f(u.y & 0xffff); acc[j + 3] += ww * bf2f(u.y >> 16);
                acc[j + 4] += ww * bf2f(u.z & 0xffff); acc[j + 5] += ww * bf2f(u.z >> 16); acc[j + 6] += ww * bf2f(u.w & 0xffff); acc[j + 7] += ww * bf2f(u.w >> 16); } } }
        bf16* dst = p.OC + (size_t)row * DM + h * 64 + half * 32;
#pragma unroll
        for (int j = 0; j < 32; j += 8) { u32x4 o; o.x = pk2(acc[j], acc[j + 1]); o.y = pk2(acc[j + 2], acc[j + 3]); o.z = pk2(acc[j + 4], acc[j + 5]); o.w = pk2(acc[j + 6], acc[j + 7]); *(u32x4*)(dst + j) = o; }
    }
#if ATT_PROBE && ATT_PROBE_PHASE == 83
    { asm volatile("s_waitcnt vmcnt(0)" ::: "memory"); __syncthreads(); ATT_T(mg1); if (bid == ATT_PROBE_BLOCK && tid == ATT_PROBE_WAVE * 64) { g_dbg[8] += mg1 - mg0; g_dbg[11] += 1ull; } }
#endif
}
__device__ __forceinline__ void moba_r1_phase(const PP& p, unsigned char* ws, char* lds, int tid, int bid, int G) {
#if ATT_PROBE && ATT_PROBE_PHASE == 81
    if (bid == ATT_PROBE_BLOCK && tid == ATT_PROBE_WAVE * 64) { for (int i = 0; i < 16; ++i) g_dbg[i] = 0ull; }
    __syncthreads();
#endif
    ATT_T(g0);
    const int lane = tid & 63, r32 = lane & 31, hi = lane >> 5; const int wid = __builtin_amdgcn_readfirstlane(tid >> 6);
    LAS3 unsigned* lc = (LAS3 unsigned*)((LAS3 char*)lds + 65536);
#pragma unroll 1
    for (int u0 = bid; u0 < 1024; u0 += 4 * G) {
        unsigned mk[4];
#pragma unroll
        for (int j = 0; j < 4; ++j) { const int u = u0 + j * G; mk[j] = 0u;
            if (u < 1024) mk[j] = moba_gate_mask(p, (u >> 5) >> 4, (u >> 5) & 15, u & 31, tid); }
        ATT_T(gm1);
        ATT_BAR();
        if (tid < 256) lc[tid] = 0u;
        ATT_BAR();
        unsigned lp[4][3];
#pragma unroll
        for (int j = 0; j < 4; ++j) { const int c = (u0 + j * G) & 31; unsigned m = hi == 0 ? mk[j] : 0u;
#pragma unroll
            for (int s_ = 0; s_ < 3; ++s_) { lp[j][s_] = 0u; if (m) { const int n = __builtin_ctz(m); m &= m - 1u; const bool near = n == c - 1;
                lp[j][s_] = __hip_atomic_fetch_add(lc + j * 64 + (near ? 0 : 32) + n, 1u, __ATOMIC_RELAXED, __HIP_MEMORY_SCOPE_WORKGROUP); } } }
        ATT_BAR();
        if (tid < 256) { const int j = tid >> 6, sl = tid & 63; const int u = u0 + j * G; const int bh = u >> 5; const unsigned cn = lc[tid]; unsigned base = 0u;
            if (cn) base = __hip_atomic_fetch_add((unsigned*)(ws + WS_MLCNT) + (sl < 32 ? 0 : 1024) + bh * 32 + (sl & 31), cn, __ATOMIC_RELAXED, __HIP_MEMORY_SCOPE_AGENT);
            lc[tid] = base; }
        ATT_BAR();
#if ATT_PROBE && ATT_PROBE_PHASE == 81
        { ATT_T(gm2); if (bid == ATT_PROBE_BLOCK && tid == ATT_PROBE_WAVE * 64) { g_dbg[9] += gm1 - g0; g_dbg[10] += gm2 - gm1; } }
#endif
#pragma unroll
        for (int j = 0; j < 4; ++j) { const int u = u0 + j * G; const int c = u & 31, bh = u >> 5; const int tq = c * 256 + wid * 32 + r32; unsigned m = hi == 0 ? mk[j] : 0u;
#pragma unroll
            for (int s_ = 0; s_ < 3; ++s_) { if (m) { const int n = __builtin_ctz(m); m &= m - 1u; const bool near = n == c - 1;
                ml_list(ws, near, bh, n)[lc[j * 64 + (near ? 0 : 32) + n] + lp[j][s_]] = (unsigned short)((unsigned)tq | ((unsigned)s_ << 13)); } } }
    }
    ATT_BAR();
#if ATT_PROBE && ATT_PROBE_PHASE == 81
    { ATT_T(g1); if (bid == ATT_PROBE_BLOCK && tid == ATT_PROBE_WAVE * 64) { g_dbg[8] += g1 - g0; g_dbg[11] += 1ull; } }
#endif
}
__device__ __forceinline__ int moba_nparts(int n) { return n < 3 ? 3 : (n < 12 ? 2 : 1); }
__device__ __forceinline__ void moba_r2_phase(const PP& p, unsigned char* ws, char* lds, int tid, int bid, int G) {
#if ATT_PROBE && ATT_PROBE_PHASE == 82
    if (bid == ATT_PROBE_BLOCK && tid == ATT_PROBE_WAVE * 64) { for (int i = 0; i < 16; ++i) g_dbg[i] = 0ull; }
#endif
    copy_bias_lds(p, lds, tid);
    unsigned* qhead = (unsigned*)(ws + WS_MLCNT) + 2048;
    LAS3 int* itl = (LAS3 int*)((LAS3 char*)lds + L_MISC + 128);
#pragma unroll 1
    for (;;) {
        ATT_T(q0);
        ATT_BAR();
        if (tid == 0) itl[0] = (int)__hip_atomic_fetch_add(qhead, 1u, __ATOMIC_RELAXED, __HIP_MEMORY_SCOPE_AGENT);
        ATT_BAR();
        int it = itl[0]; const int b = it & 1; it >>= 1;
        ATT_T(q1);
#if ATT_PROBE && ATT_PROBE_PHASE == 82
        if (b == 0 && blockIdx.x == ATT_PROBE_BLOCK && tid == ATT_PROBE_WAVE * 64) { g_dbg[8] += q1 - q0; g_dbg[11] += 1ull; }
#endif
        if (it >= 16 * 47) break;
        int n = 0;
        for (;; ++n) { const int sz = 16 * moba_nparts(n); if (it < sz) break; it -= sz; }
        const int np = moba_nparts(n); const int h = it / np, part = it % np;
        moba_route_item(p, ws, lds, b, h, n, part, np, tid);
    }
    ATT_BAR();
}
}

#define LAS __attribute__((address_space(3)))
#define XB_TMO      128
#define XB_XCNT(j)  (256  + 64 * (j))
#define XB_XSUB(j)  (1280 + 64 * (j))
#define XB_XGEN(j)  (2304 + 64 * (j))
#define XB_TOP      3328
#define XB_TOPGEN   3392
#define XCD_BAR_WORDS 3456
#define XB_SPIN_CAP (1u << 18)

__device__ __forceinline__ unsigned xb_ld(unsigned* p)              { return __hip_atomic_load(p, __ATOMIC_RELAXED, __HIP_MEMORY_SCOPE_AGENT); }
__device__ __forceinline__ unsigned xb_add(unsigned* p, unsigned v) { return __hip_atomic_fetch_add(p, v, __ATOMIC_RELAXED, __HIP_MEMORY_SCOPE_AGENT); }
__device__ __forceinline__ unsigned xb_xcc_id() { return (unsigned)__builtin_amdgcn_s_getreg((3 << 11) | 20) & 0xFu; }
#define XB_SPIN(cond, bar) do { unsigned _sp = 0; while (cond) { __builtin_amdgcn_s_sleep(1); \
    if ((++_sp & 255u) == 0u) { if (xb_ld(&(bar)[XB_TMO])) break; if (_sp > XB_SPIN_CAP) { atomicAdd(&(bar)[XB_TMO], 1u); break; } } } } while (0)

struct XcdBarrier {
    unsigned* bar; unsigned x;
    volatile LAS unsigned* st;
};

__device__ __forceinline__ XcdBarrier xcd_barrier_post(unsigned* bar, volatile LAS unsigned* st) {
    XcdBarrier b; b.bar = bar; b.x = xb_xcc_id(); b.st = st;
    if (threadIdx.x == 0) (void)xb_add(&bar[XB_XCNT(b.x)], 1u);
    return b;
}
__device__ __forceinline__ void xcd_barrier_complete(unsigned* bar, unsigned x, unsigned& nloc, unsigned& nx) {
    const unsigned G = gridDim.x * gridDim.y * gridDim.z;
    unsigned sum, cnt, mine, sp = 0u;
    for (;;) {
        sum = 0u; cnt = 0u; mine = 0u;
#pragma unroll
        for (unsigned j = 0; j < 16; ++j) { const unsigned c = xb_ld(&bar[XB_XCNT(j)]); sum += c; cnt += (c > 0u) ? 1u : 0u; mine = (j == x) ? c : mine; }
        if (sum == G) break;
        __builtin_amdgcn_s_sleep(1);
        if ((++sp & 255u) == 0u) { if (xb_ld(&bar[XB_TMO])) break; if (sp > XB_SPIN_CAP) { atomicAdd(&bar[XB_TMO], 1u); break; } }
    }
    nloc = mine > 0u ? mine : 1u; nx = cnt > 0u ? cnt : 1u;
}

__device__ __forceinline__ void xcd_barrier(const XcdBarrier& b) {
    asm volatile("s_waitcnt vmcnt(0)" ::: "memory");
    __syncthreads();
    if (threadIdx.x == 0) {
        unsigned* bar = b.bar;
        __builtin_amdgcn_s_waitcnt(0);
        unsigned nloc = b.st[0], nx = b.st[1];
        if (nloc == 0u) { xcd_barrier_complete(bar, b.x, nloc, nx); b.st[0] = nloc; b.st[1] = nx; }
        const unsigned old = xb_add(&bar[XB_XSUB(b.x)], 1u);
        const unsigned gen = old / nloc;
        if (old + 1u == (gen + 1u) * nloc) {
            __builtin_amdgcn_fence(__ATOMIC_RELEASE, "agent");
            asm volatile("s_waitcnt vmcnt(0)" ::: "memory");
            const unsigned og = xb_add(&bar[XB_TOP], 1u);
            const unsigned tg = og / nx;
            if (og + 1u == (tg + 1u) * nx) xb_add(&bar[XB_TOPGEN], 1u);
            else XB_SPIN(xb_ld(&bar[XB_TOPGEN]) == tg, bar);
            __builtin_amdgcn_fence(__ATOMIC_ACQUIRE, "agent");
            xb_add(&bar[XB_XGEN(b.x)], 1u);
            asm volatile("s_waitcnt vmcnt(0)" ::: "memory");
        } else {
            XB_SPIN(xb_ld(&bar[XB_XGEN(b.x)]) == gen, bar);
            __builtin_amdgcn_fence(__ATOMIC_ACQUIRE, "agent");
            asm volatile("s_waitcnt vmcnt(0)" ::: "memory");
        }
    }
    __syncthreads();
}
namespace pg8 {
struct EpiFinalNorm {
    static constexpr bool PERM = true, AFTER_DRAIN = false, HAS_PRE = false;
    const bf16_t* xb; float* SS; const float* gain; float* out; unsigned* flags; unsigned* bar;
    __device__ __forceinline__ void operator()(const f32x4 (&acc)[2][2][4][2], const Unit& u, int wr, int wc, int fr, int fq) const {
        const int col0 = u.pn * BM + wc * 32 + 8 * fq;
        f32x4 o[2][4][2][2];
#pragma unroll
        for (int ai = 0; ai < 2; ++ai) {
#pragma unroll
            for (int m = 0; m < 4; ++m) { const size_t off = (size_t)(u.pm * BM + ai * HALF + wr * 64 + m * 16 + fr) * DM + col0;
#pragma unroll
                for (int bj = 0; bj < 2; ++bj) { const u32x4 w = *(const u32x4*)(xb + off + bj * HALF);
                    o[ai][m][bj][0] = (f32x4){__builtin_bit_cast(float, w.x << 16), __builtin_bit_cast(float, w.x & 0xffff0000u), __builtin_bit_cast(float, w.y << 16), __builtin_bit_cast(float, w.y & 0xffff0000u)};
                    o[ai][m][bj][1] = (f32x4){__builtin_bit_cast(float, w.z << 16), __builtin_bit_cast(float, w.z & 0xffff0000u), __builtin_bit_cast(float, w.w << 16), __builtin_bit_cast(float, w.w & 0xffff0000u)}; } }
#pragma unroll
            for (int m = 0; m < 4; ++m) { const int row = u.pm * BM + ai * HALF + wr * 64 + m * 16 + fr; float sq = 0.f;
#pragma unroll
                for (int bj = 0; bj < 2; ++bj)
#pragma unroll
                    for (int n = 0; n < 2; ++n) { const f32x4 v = o[ai][m][bj][n] + acc[ai][bj][m][n]; o[ai][m][bj][n] = v;
                        sq += (v[0] * v[0] + v[1] * v[1]) + (v[2] * v[2] + v[3] * v[3]); }
                sq = pg8_sum_fq(sq);
                if (fq == 0) SS[(size_t)row * 16 + u.pn * 4 + wc] = sq; }
        }
        asm volatile("s_waitcnt vmcnt(0)" ::: "memory");
        __syncthreads();
        if (threadIdx.x == 0) {
            unsigned* f = flags + u.pm * 16;
            __builtin_amdgcn_fence(__ATOMIC_RELEASE, "agent");
            asm volatile("s_waitcnt vmcnt(0)" ::: "memory");
            (void)xb_add(f, 1u);
            XB_SPIN(xb_ld(f) < 4u, bar);
            __builtin_amdgcn_fence(__ATOMIC_ACQUIRE, "agent");
            asm volatile("s_waitcnt vmcnt(0)" ::: "memory");
        }
        __syncthreads();
        f32x4 gg[2][2];
#pragma unroll
        for (int bj = 0; bj < 2; ++bj)
#pragma unroll
            for (int n = 0; n < 2; ++n) gg[bj][n] = *(const f32x4*)(gain + col0 + bj * HALF + n * 4);
#pragma unroll
        for (int ai = 0; ai < 2; ++ai)
#pragma unroll
            for (int m = 0; m < 4; ++m) { const int row = u.pm * BM + ai * HALF + wr * 64 + m * 16 + fr; const float rs = rstd_of(SS, row);
#pragma unroll
                for (int bj = 0; bj < 2; ++bj)
#pragma unroll
                    for (int n = 0; n < 2; ++n) *(f32x4*)(out + (size_t)row * DM + col0 + bj * HALF + n * 4) = o[ai][m][bj][n] * rs * gg[bj][n]; }
    }
};
}
constexpr size_t WS_RBFLAG = WS_CTL + 49152;
__device__ __forceinline__ void gemm_final(char* lds, const bf16* A, const bf16* Bt, int K, const bf16* xb, float* SS, const float* gain, float* out, unsigned* flags, unsigned* bar, int bid, int G) {
    pg8::Gemm g{A, Bt, M, DM, K}; pg8::StaticOrder S; S.init(M, DM, G, bid);
    pg8::EpiFinalNorm E{xb, SS, gain, out, flags, bar};
    pg8::gemm_phase<pg8::EpiFinalNorm, pg8::StaticOrder, GEMM_ALIGN, GEMM_SP2>((PG8_LAS unsigned char*)lds, g, S, E);
}
template <int MODE> __device__ __forceinline__ void gemm_rowscale(char* lds, const bf16* A, const bf16* Bt, int N, int ldc, int K, bf16* O, const float* SS, float* KMP, float* GATES, int kt_lo, int kt_hi, int gate_tile, int tid, int bid, int G) {
#if USE_PG8
    pg8::Gemm g{A, Bt, M, N, K}; pg8::StaticOrder S; S.init(M, N, G, bid);
    PG8_LAS float* rsl = nullptr; int rs_pm = -1;
    if (G == 256) { rsl = (PG8_LAS float*)((PG8_LAS unsigned char*)lds + 131072); rs_pm = 8 * (bid & 7) + ((bid >> 3) & 7); }
    pg8::EpiRowScaleBf16<MODE> E{O, SS, KMP, GATES, ldc, kt_lo, kt_hi, gate_tile, rsl, rs_pm};
    pg8::gemm_phase<pg8::EpiRowScaleBf16<MODE>, pg8::StaticOrder, GEMM_ALIGN, GEMM_SP2>((PG8_LAS unsigned char*)lds, g, S, E);
#else
    if (MODE == 0) ngemm_phase(lds, A, Bt, N, K, NEpiProj{O, SS, N}, tid, bid, G); else ngemm_phase(lds, A, Bt, N, K, NEpiMlp1{O, SS}, tid, bid, G);
#endif
}
template <bool INBF> __device__ __forceinline__ void gemm_residual(char* lds, const bf16* A, const bf16* Bt, int K, const float* xin32, bf16* xb, float* SS, int tid, int bid, int G) {
    pg8::Gemm g{A, Bt, M, DM, K}; pg8::StaticOrder S; S.init(M, DM, G, bid);
    pg8::EpiResidual<INBF> E{xin32, xb, SS};
    pg8::gemm_phase<pg8::EpiResidual<INBF>, pg8::StaticOrder, GEMM_ALIGN, GEMM_SP2>((PG8_LAS unsigned char*)lds, g, S, E);
}

constexpr int NPHASE = 13;
__global__ void __launch_bounds__(NTHR, 2) mk_fwd(Args args) {
    extern __shared__ __attribute__((aligned(16))) char lds[];
    cg::grid_group grid = cg::this_grid();
    const int tid = threadIdx.x, bid = blockIdx.x, G = gridDim.x;
    unsigned char* ws = args.ws;
    PP p;
    p.x = args.in[0]; p.bias_table = args.in[1]; p.norm_mix = args.in[2]; p.norm_mlp = args.in[3]; p.norm_final = args.in[4]; p.mlp_w1 = args.in[5]; p.mlp_w2 = args.in[6];
    p.ev_w_in = args.in[7]; p.ev_w_out = args.in[8]; p.pos_k = args.in[9]; p.w1_k = args.in[10]; p.w2_k = args.in[11]; p.pos_v = args.in[12]; p.w1_v = args.in[13]; p.w2_v = args.in[14];
    p.lq1 = args.in[15]; p.lk1 = args.in[16]; p.lq2 = args.in[17]; p.lk2 = args.in[18]; p.subln = args.in[19]; p.od_w_in = args.in[20]; p.od_w_out = args.in[21];
    p.out = args.out;
    p.SSA = (float*)(ws + WS_SSA); p.SSB = (float*)(ws + WS_SSB); p.GATES = (float*)(ws + WS_GATES); p.CMPB = (float*)(ws + WS_CMPB); p.BIASL = (float*)(ws + WS_BIASL);
    p.KMEAN = (float*)(ws + WS_KMEAN); p.KMP = (float*)(ws + WS_KMP);
    p.KCMP = (bf16*)(ws + WS_KCMP); p.VCMP = (bf16*)(ws + WS_VCMP);
    p.WIN0 = (bf16*)(ws + WS_WIN0); p.WOUT0 = (bf16*)(ws + WS_WOUT0); p.W1_0 = (bf16*)(ws + WS_W1_0); p.W2_0 = (bf16*)(ws + WS_W2_0);
    p.WIN1 = (bf16*)(ws + WS_WIN1); p.WOUT1 = (bf16*)(ws + WS_WOUT1); p.W1_1 = (bf16*)(ws + WS_W1_1); p.W2_1 = (bf16*)(ws + WS_W2_1);
    p.CW1K = (bf16*)(ws + WS_CW1K); p.CW1V = (bf16*)(ws + WS_CW1V); p.CW2K = (bf16*)(ws + WS_CW2K); p.CW2V = (bf16*)(ws + WS_CW2V);
    p.XB = (bf16*)(ws + WS_XB); p.OC = (bf16*)(ws + WS_OC); p.H = (bf16*)(ws + WS_H); p.PROJ = (bf16*)(ws + WS_PROJ);
    volatile LAS unsigned* xst = (volatile LAS unsigned*)((LAS char*)lds + att::L_MISC);
    if (tid == 0) { xst[0] = 0u; xst[1] = 0u; }
    __syncthreads();
    const bool self_zero = args.ph_lo == 0 && args.ph_hi > 1;
    XcdBarrier xbar; xbar.bar = (unsigned*)(ws + WS_CTL); xbar.x = 0u; xbar.st = xst;
    if (!self_zero) xbar = xcd_barrier_post((unsigned*)(ws + WS_CTL), xst);
    else if (bid == 0) { for (int i = tid; i < 16384; i += NTHR) ((unsigned*)(ws + WS_CTL))[i] = 0u; }
    const int lo = args.ph_lo, hi = args.ph_hi;
#define IN(k) (lo <= (k) && (k) < hi)
#define SEAM(k) do { if (IN(k) && IN((k) + 1)) { if ((k) == 0) grid.sync(); else xcd_barrier(xbar); } } while (0)

    if (IN(0)) { p0_prologue(p, lds, tid, bid, G);
#if PROBE_DOUBLE == 100
        __syncthreads(); p0_prologue(p, lds, tid, bid, G);
#endif
    }
    SEAM(0);
    if (self_zero) xbar = xcd_barrier_post((unsigned*)(ws + WS_CTL), xst);
    if (IN(1)) { gemm_rowscale<0>(lds, p.XB, p.WIN0, NP0G, NP0, DM, p.PROJ, p.SSA, nullptr, p.GATES, 0, 0, NP0 / 256, tid, bid, G);
#if PROBE_DOUBLE == 101
        xcd_barrier(xbar); gemm_rowscale<0>(lds, p.XB, p.WIN0, NP0G, NP0, DM, p.PROJ, p.SSA, nullptr, p.GATES, 0, 0, NP0 / 256, tid, bid, G);
#endif
    }
    SEAM(1);
    if (IN(2)) {
#if USE_MFMA_CMP
        att::compress_phase(p, lds, tid, bid, G);
#if PROBE_DOUBLE == 1
        __syncthreads(); att::compress_phase(p, lds, tid, bid, G);
#endif
#else
        ncompress_phase(p, lds, tid, bid, G);
#endif
#if USE_MFMA_DIFF
        att::diff_phase(p, lds, tid, bid, G);
#if PROBE_DOUBLE == 2
        xcd_barrier(xbar); att::diff_phase(p, lds, tid, bid, G);
#endif
#else
        ndiff_phase(p, lds, tid, bid, G);
#endif
    }
    SEAM(2);
    if (IN(3)) {
#if USE_MFMA_NSA
        att::nsa_phase(p, lds, tid, bid, G);
#if PROBE_DOUBLE == 3
        xcd_barrier(xbar); att::nsa_phase(p, lds, tid, bid, G);
#endif
#else
        nnsa_phase(p, lds, tid, bid, G);
#endif
    }
    SEAM(3);
    if (IN(4)) { gemm_residual<true>(lds, p.OC, p.WOUT0, DM, nullptr, p.XB, p.SSB, tid, bid, G);
#if PROBE_DOUBLE == 4
        xcd_barrier(xbar); gemm_residual<true>(lds, p.OC, p.WOUT0, DM, nullptr, p.XB, p.SSB, tid, bid, G);
#endif
    }
    SEAM(4);
#if PROBE_DOUBLE == 900
    xcd_barrier(xbar); xcd_barrier(xbar); xcd_barrier(xbar); xcd_barrier(xbar); xcd_barrier(xbar); xcd_barrier(xbar); xcd_barrier(xbar); xcd_barrier(xbar);
#endif
    if (IN(5)) { gemm_rowscale<1>(lds, p.XB, p.W1_0, FF, FF, DM, p.H, p.SSB, nullptr, nullptr, 0, 0, -1, tid, bid, G);
#if PROBE_DOUBLE == 5
        xcd_barrier(xbar); gemm_rowscale<1>(lds, p.XB, p.W1_0, FF, FF, DM, p.H, p.SSB, nullptr, nullptr, 0, 0, -1, tid, bid, G);
#endif
    }
    SEAM(5);
    if (IN(6)) { gemm_residual<true>(lds, p.H, p.W2_0, FF, nullptr, p.XB, p.SSA, tid, bid, G); }
    SEAM(6);
    if (IN(7)) {
#if USE_PG8
        gemm_rowscale<0>(lds, p.XB, p.WIN1, NP1, NP1, DM, p.PROJ, p.SSA, p.KMP, nullptr, 4, 8, -1, tid, bid, G);
#else
        gemm_rowscale<0>(lds, p.XB, p.WIN1, NP1, NP1, DM, p.PROJ, p.SSA, nullptr, nullptr, 0, 0, -1, tid, bid, G);
        grid.sync();
        nkmean_phase(p, tid, bid, G);
#endif
    }
    SEAM(7);
    if (IN(8)) {
#if USE_PG8
#endif
#if USE_MFMA_MOBA && USE_MOBA_ROUTED
        att::moba_r1_phase(p, ws, lds, tid, bid, G); xcd_barrier(xbar);
        att::moba_r2_phase(p, ws, lds, tid, bid, G); xcd_barrier(xbar);
        att::moba_merge_phase(p, ws, tid, bid, G);
#elif USE_MFMA_MOBA
        att::moba_phase(p, lds, tid, bid, G);
#if PROBE_DOUBLE == 8
        xcd_barrier(xbar); att::moba_phase(p, lds, tid, bid, G);
#endif
#else
        nmoba_phase(p, tid, bid, G);
#endif
    }
    SEAM(8);
    if (IN(9)) { gemm_residual<true>(lds, p.OC, p.WOUT1, DM, nullptr, p.XB, p.SSB, tid, bid, G); }
    SEAM(9);
    if (IN(10)) { gemm_rowscale<1>(lds, p.XB, p.W1_1, FF, FF, DM, p.H, p.SSB, nullptr, nullptr, 0, 0, -1, tid, bid, G); }
    SEAM(10);
    const bool fuse_fn = !ATT_PROBE && G == 256 && IN(11) && IN(12);
    if (IN(11)) { if (fuse_fn) gemm_final(lds, p.H, p.W2_1, FF, p.XB, p.SSA, p.norm_final, p.out, (unsigned*)(ws + WS_RBFLAG), (unsigned*)(ws + WS_CTL), bid, G);
        else gemm_residual<true>(lds, p.H, p.W2_1, FF, nullptr, p.XB, p.SSA, tid, bid, G); }
    if (!fuse_fn) SEAM(11);
    if (IN(12) && !fuse_fn) { final_norm_phase(p, tid, bid, G);
#if ATT_PROBE
        __syncthreads();
        if (bid == 0 && tid == 0) { const unsigned long long den = ATT_PROBE_SEL >= 8 ? att::g_dbg[11] * 100ull : att::g_dbg[4]; const float v = (float)((double)att::g_dbg[ATT_PROBE_SEL] / (double)(den ? den : 1ull)) * 0.01f; p.out[0] += v; }
#endif
    }
#undef IN
#undef SEAM
}

extern "C" void kernel_launch(void* const* d_in, const int* in_sizes, int n_in, void* d_out, int out_size, void* d_ws, size_t ws_size, hipStream_t stream) {
    static int grid = 0;
    if (grid == 0) {
        if (n_in != 22 || out_size != M * DM || ws_size < WS_END) { fprintf(stderr, "kernel_launch: unexpected shapes (n_in %d out %d ws %zu)\n", n_in, out_size, ws_size); grid = -1; return; }
        int dev = 0, cus = 0, per_cu = 0;
        if (hipGetDevice(&dev) != hipSuccess || hipDeviceGetAttribute(&cus, hipDeviceAttributeMultiprocessorCount, dev) != hipSuccess) { grid = -1; return; }
        if (hipFuncSetAttribute((const void*)mk_fwd, hipFuncAttributeMaxDynamicSharedMemorySize, LDS_BYTES) != hipSuccess) { fprintf(stderr, "kernel_launch: hipFuncSetAttribute failed\n"); grid = -1; return; }
        if (hipOccupancyMaxActiveBlocksPerMultiprocessor(&per_cu, (const void*)mk_fwd, NTHR, LDS_BYTES) != hipSuccess || per_cu < 1) { fprintf(stderr, "kernel_launch: occupancy query says %d blocks per CU\n", per_cu); (void)hipGetLastError(); grid = -1; return; }
        grid = cus * 1;
    }
    if (grid < 0) return;
    Args a{};
    for (int i = 0; i < 22; ++i) a.in[i] = (const float*)d_in[i];
    a.out = (float*)d_out; a.ws = (unsigned char*)d_ws; a.ph_lo = 0; a.ph_hi = NPHASE;
    void* kargs[] = {&a};
    hipError_t e = hipLaunchCooperativeKernel((const void*)mk_fwd, dim3(grid), dim3(NTHR), kargs, LDS_BYTES, stream);
    if (e != hipSuccess) fprintf(stderr, "kernel_launch: cooperative launch failed: %s (grid %d)\n", hipGetErrorString(e), grid);
}
```

```cpp
#include <hip/hip_runtime.h>
#include <hip/hip_cooperative_groups.h>
#include <cstdint>
#include <cstdio>

typedef unsigned short bf16;
typedef unsigned v4u __attribute__((ext_vector_type(4)));
typedef float f32x4 __attribute__((ext_vector_type(4)));

constexpr int BATCH = 2, SEQ = 8192, DM = 1024, M = BATCH * SEQ, FF = 4096;
constexpr int NP0 = 2816, NP1 = 3072, EVEN_PROJ = 2840;
constexpr float EPS = 1e-6f;
constexpr float LOG2E = 1.4426950408889634f, C2 = 0.125f * LOG2E;
constexpr int C_Q = 0, C_KC = 512, C_VC = 640, C_KS = 768, C_VS = 896, C_KW = 1024, C_VW = 1152, C_DQ = 1280, C_DK = 1792, C_DV = 2304;
constexpr int NCMP = 511;

constexpr size_t MiB = 1u << 20;
constexpr size_t WS_CTL = 0;
constexpr size_t WS_SSA = 1 * MiB, WS_SSB = 2 * MiB;
constexpr size_t WS_GATES = 3 * MiB;
constexpr size_t WS_KCMP = 4 * MiB + 512 * 1024, WS_VCMP = WS_KCMP + 256 * 1024;
constexpr size_t WS_CMPB = 5 * MiB;
constexpr size_t WS_BIASL = 5 * MiB + 16384;
constexpr size_t WS_KMEAN = 5 * MiB + 256 * 1024;
constexpr size_t WS_WIN0 = 8 * MiB, WS_WOUT0 = 14 * MiB, WS_W1_0 = 16 * MiB, WS_W2_0 = 24 * MiB;
constexpr size_t WS_WIN1 = 32 * MiB, WS_WOUT1 = 38 * MiB, WS_W1_1 = 40 * MiB, WS_W2_1 = 48 * MiB;
constexpr size_t WS_CW1K = 56 * MiB, WS_CW1V = 56 * MiB + 512 * 1024, WS_CW2K = 57 * MiB, WS_CW2V = 57 * MiB + 64 * 1024;
constexpr size_t WS_XB = 58 * MiB, WS_OC = 90 * MiB, WS_H = 122 * MiB, WS_PROJ = 122 * MiB, WS_END = 250 * MiB;

__device__ __forceinline__ unsigned f2bf(float f) { unsigned u = __builtin_bit_cast(unsigned, f); return (u + 0x7fffu + ((u >> 16) & 1u)) >> 16; }
__device__ __forceinline__ float bf2f(unsigned h) { return __builtin_bit_cast(float, h << 16); }
__device__ __forceinline__ unsigned pk2(float lo, float hi) { return f2bf(lo) | (f2bf(hi) << 16); }
__device__ __forceinline__ float wave_sum(float v) {
#pragma unroll
    for (int o = 1; o < 64; o <<= 1) v += __shfl_xor(v, o);
    return v;
}
__device__ __forceinline__ float wave_max(float v) {
#pragma unroll
    for (int o = 1; o < 64; o <<= 1) v = fmaxf(v, __shfl_xor(v, o));
    return v;
}
__device__ __forceinline__ float rstd_of(const float* SS, int row) {
    const f32x4* p = (const f32x4*)(SS + (size_t)row * 16);
    f32x4 a = p[0], b = p[1], c = p[2], d = p[3];
    float s = ((a.x + a.y) + (a.z + a.w)) + ((b.x + b.y) + (b.z + b.w)) + ((c.x + c.y) + (c.z + c.w)) + ((d.x + d.y) + (d.z + d.w));
    return 1.0f / sqrtf(s * (1.0f / DM) + EPS);
}
__device__ __forceinline__ int t5_bucket(int rel) {
    int n = rel < 0 ? 0 : rel;
    if (n < 16) return n;
    int large = 16 + (int)(logf((float)n / 16.0f) / logf(8.0f) * 16.0f);
    return large < 31 ? large : 31;
}

namespace pg8 {
#define PG8_LAS __attribute__((address_space(3)))
typedef unsigned short bf16_t;
typedef short bf16x8 __attribute__((ext_vector_type(8)));
typedef float f32x4 __attribute__((ext_vector_type(4)));
typedef unsigned u32x4 __attribute__((ext_vector_type(4)));
constexpr int BM = 256, BK = 64, HALF = 128, HTB = HALF * BK * 2  , STAGE_BYTES = 8 * HTB, NXCD = 8, WGM = 8;

__host__ __device__ __forceinline__ int lds_byte(int r, int c) { const int st = (r >> 4) * 2 + (c >> 5), rr = r & 15, cc = c & 31, ob = rr * 64 + cc * 2; return st * 1024 + (ob ^ (((ob >> 9) & 1) << 5)); }
__host__ __device__ __forceinline__ void stage_rc(int b, int& R, int& C) { const int st = b / 1024, sb = b % 1024, swz = sb ^ (((sb >> 9) & 1) << 5); R = (st >> 1) * 16 + swz / 64; C = (st & 1) * 32 + (swz % 64) / 2; }
__host__ __device__ __forceinline__ int perm32(int rho) { const int n = rho >> 4, i = rho & 15; return 8 * (i >> 2) + 4 * n + (i & 3); }

struct Unit { int pm, pn; };
struct Gemm { const bf16_t* A; const bf16_t* Bt; int M, N, K; };

struct StaticOrder {
    int nM, nN, nwg, G, c;
    __host__ __device__ void init(int M, int N, int G_, int c_) { nM = M / BM; nN = N / BM; nwg = nM * nN; G = G_; c = c_; }
    __host__ __device__ bool next(int i, Unit& u) const {
        const long L = (long)i * G + c; if (L >= nwg) return false;
        int wgid = (int)L; { const int q = nwg / NXCD, r = nwg % NXCD, xcd = wgid % NXCD, off = wgid / NXCD; wgid = (xcd < r ? xcd * (q + 1) : r * (q + 1) + (xcd - r) * q) + off; }
        const int nig = WGM * nN, gid = wgid / nig, fm = gid * WGM, gsz = (nM - fm) < WGM ? (nM - fm) : WGM;
        u.pm = fm + ((wgid % nig) % gsz); u.pn = (wgid % nig) / gsz; return true;
    }
    __device__ __forceinline__ void a_ready(const Unit&) const {}
    __device__ __forceinline__ void done(const Unit&) const {}
};
__device__ __forceinline__ unsigned cvt_pk_bf16(float lo, float hi) { unsigned r; asm volatile("v_cvt_pk_bf16_f32 %0, %1, %2" : "=v"(r) : "v"(lo), "v"(hi)); return r; }
typedef float f32x2 __attribute__((ext_vector_type(2)));
template <class Epi, class Sched, bool ALIGN_EPI = false, bool SP2 = false>
__device__ __forceinline__ void gemm_phase(PG8_LAS unsigned char* lds, const Gemm g, const Sched& S, const Epi& E) {
    const int tid = threadIdx.x, wid = __builtin_amdgcn_readfirstlane(tid >> 6), lane = tid & 63, wr = wid >> 2, wc = wid & 3, fr = lane & 15, fq = lane >> 4;
    const int K = g.K, nt = K / BK;
    unsigned voffA[2], voffB[2];
#pragma unroll
    for (int i = 0; i < 2; ++i) { int R, C; stage_rc(tid * 16 + i * 8192, R, C); const int Rb = Epi::PERM ? ((R & ~31) + perm32(R & 31)) : R;
        voffA[i] = (unsigned)(R * K + C) * 2u; voffB[i] = (unsigned)(Rb * K + C) * 2u; }
    const size_t kstep = (size_t)(BK * 2);
    const size_t hstep = (size_t)HALF * K * 2;
    const size_t tstep = 2 * hstep;
    const unsigned ldsw = (unsigned)wid * 1024u;
    const int aoff = lds_byte(wr * 64 + fr, fq * 8), boff = lds_byte(wc * 32 + fr, fq * 8);
#define PG8_SA(b, h) (((b) * 2 + (h)) * HTB)
#define PG8_SB(b, h) ((4 + (b) * 2 + (h)) * HTB)
#define PG8_STAGE(bufoff, gbase, voff) do { _Pragma("unroll") for (int _i = 0; _i < 2; ++_i) \
        __builtin_amdgcn_global_load_lds((const unsigned*)((const char*)(gbase) + (voff)[_i]), (PG8_LAS unsigned*)(lds + (bufoff) + ldsw + _i * 8192), 16, 0, 0); } while (0)
#define PG8_LDA(dst, b, h) do { _Pragma("unroll") for (int m = 0; m < 4; ++m) _Pragma("unroll") for (int k = 0; k < 2; ++k) dst[m][k] = *(const PG8_LAS bf16x8*)(lds + PG8_SA(b, h) + aoff + m * 2048 + k * 1024); } while (0)
#define PG8_LDB(dst, b, h) do { _Pragma("unroll") for (int n = 0; n < 2; ++n) _Pragma("unroll") for (int k = 0; k < 2; ++k) dst[n][k] = *(const PG8_LAS bf16x8*)(lds + PG8_SB(b, h) + boff + n * 2048 + k * 1024); } while (0)
#define PG8_MMA(ai, bj, At, Bt) do { __builtin_amdgcn_s_setprio(1); _Pragma("unroll") for (int m = 0; m < 4; ++m) _Pragma("unroll") for (int n = 0; n < 2; ++n) _Pragma("unroll") for (int k = 0; k < 2; ++k) \
        acc[ai][bj][m][n] = __builtin_amdgcn_mfma_f32_16x16x32_bf16(Bt[n][k], At[m][k], acc[ai][bj][m][n], 0, 0, 0); __builtin_amdgcn_s_setprio(0); } while (0)
#define PG8_WAIT_V(n) asm volatile("s_waitcnt vmcnt(" #n ")" ::: "memory")
#define PG8_WAIT_L(n) asm volatile("s_waitcnt lgkmcnt(" #n ")" ::: "memory")
#define PG8_BAR __builtin_amdgcn_s_barrier()
#define PG8_SCHED __builtin_amdgcn_sched_barrier(0)
    Unit cur, nxt; int ui = 0;
    if (!S.next(0, cur)) return;
    f32x4 acc[2][2][4][2];
#pragma unroll
    for (int a = 0; a < 2; ++a)
#pragma unroll
        for (int b = 0; b < 2; ++b)
#pragma unroll
            for (int m = 0; m < 4; ++m)
#pragma unroll
                for (int n = 0; n < 2; ++n) acc[a][b][m][n] = (f32x4){0.f, 0.f, 0.f, 0.f};
    bf16x8 At[4][2], B0[2][2], B1[2][2];
    const char* cA = (const char*)g.A + (size_t)cur.pm * tstep; const char* cB = (const char*)g.Bt + (size_t)cur.pn * tstep;
    S.a_ready(cur);
    if constexpr (SP2) {
        PG8_STAGE(PG8_SB(0, 0), cB, voffB); PG8_STAGE(PG8_SB(0, 1), cB + hstep, voffB); PG8_STAGE(PG8_SA(0, 0), cA, voffA); PG8_STAGE(PG8_SA(0, 1), cA + hstep, voffA);
        if (wr == 1) PG8_BAR;
        PG8_WAIT_V(2); PG8_BAR;
        PG8_STAGE(PG8_SB(1, 0), cB + kstep, voffB); PG8_STAGE(PG8_SA(1, 0), cA + kstep, voffA); PG8_STAGE(PG8_SB(1, 1), cB + hstep + kstep, voffB);
        PG8_WAIT_V(6); PG8_BAR;
    } else {
        PG8_STAGE(PG8_SB(0, 0), cB, voffB); PG8_STAGE(PG8_SA(0, 0), cA, voffA); PG8_STAGE(PG8_SB(0, 1), cB + hstep, voffB); PG8_STAGE(PG8_SA(0, 1), cA + hstep, voffA);
        if (wr == 1) PG8_BAR;
        PG8_WAIT_V(4); PG8_BAR;
        PG8_STAGE(PG8_SB(1, 0), cB + kstep, voffB); PG8_STAGE(PG8_SA(1, 0), cA + kstep, voffA); PG8_STAGE(PG8_SB(1, 1), cB + hstep + kstep, voffB);
        PG8_WAIT_V(6); PG8_BAR;
    }
    for (;;) {
        const bool has_next = S.next(ui + 1, nxt);
        const char* nA = has_next ? (const char*)g.A + (size_t)nxt.pm * tstep : cA; const char* nB = has_next ? (const char*)g.Bt + (size_t)nxt.pn * tstep : cB;
        for (int t = 0; t < nt; t += 2) {
            const bool last = (t == nt - 2);
            const char* a1 = cA + (size_t)(t + 1) * kstep;
            const char* a2 = last ? nA : cA + (size_t)(t + 2) * kstep; const char* b2 = last ? nB : cB + (size_t)(t + 2) * kstep;
            const char* a3 = a2 + kstep; const char* b3 = b2 + kstep;
            if (last && has_next) S.a_ready(nxt);
            if constexpr (SP2) {
            PG8_LDB(B0, 0, 0); PG8_LDB(B1, 0, 1); PG8_SCHED; PG8_LDA(At, 0, 0); PG8_STAGE(PG8_SA(1, 1), a1 + hstep, voffA);
            PG8_WAIT_V(8); PG8_WAIT_L(0); PG8_BAR; PG8_MMA(0, 0, At, B0); PG8_MMA(0, 1, At, B1); PG8_BAR; PG8_SCHED;
            PG8_LDA(At, 0, 1); PG8_STAGE(PG8_SB(0, 0), b2, voffB); PG8_STAGE(PG8_SB(0, 1), b2 + hstep, voffB); PG8_STAGE(PG8_SA(0, 0), a2, voffA);
            PG8_WAIT_V(8); PG8_WAIT_L(0); PG8_BAR; PG8_MMA(1, 0, At, B0); PG8_MMA(1, 1, At, B1); PG8_BAR; PG8_SCHED;
            PG8_LDB(B0, 1, 0); PG8_LDB(B1, 1, 1); PG8_SCHED; PG8_LDA(At, 1, 0); PG8_STAGE(PG8_SA(0, 1), a2 + hstep, voffA);
            PG8_WAIT_V(8); PG8_WAIT_L(0); PG8_BAR; PG8_MMA(0, 0, At, B0); PG8_MMA(0, 1, At, B1); PG8_BAR; PG8_SCHED;
            PG8_LDA(At, 1, 1); PG8_STAGE(PG8_SB(1, 0), b3, voffB); PG8_STAGE(PG8_SB(1, 1), b3 + hstep, voffB); PG8_STAGE(PG8_SA(1, 0), a3, voffA);
            PG8_WAIT_V(8); PG8_WAIT_L(0); PG8_BAR; PG8_MMA(1, 0, At, B0); PG8_MMA(1, 1, At, B1); PG8_BAR; PG8_SCHED;
            } else {
            PG8_LDB(B0, 0, 0); PG8_SCHED; PG8_LDA(At, 0, 0); PG8_STAGE(PG8_SA(1, 1), a1 + hstep, voffA);
            PG8_WAIT_L(8); PG8_BAR; PG8_WAIT_L(0); PG8_MMA(0, 0, At, B0); PG8_BAR; PG8_SCHED;
            PG8_LDB(B1, 0, 1); PG8_STAGE(PG8_SB(0, 0), b2, voffB);
            PG8_BAR; PG8_WAIT_L(0); PG8_MMA(0, 1, At, B1); PG8_BAR;
            PG8_LDA(At, 0, 1); PG8_STAGE(PG8_SA(0, 0), a2, voffA);
            PG8_BAR; PG8_WAIT_L(0); PG8_MMA(1, 0, At, B0); PG8_BAR; PG8_SCHED;
            PG8_STAGE(PG8_SB(0, 1), b2 + hstep, voffB);
            PG8_WAIT_V(6); PG8_BAR; PG8_MMA(1, 1, At, B1); PG8_BAR;
            PG8_LDB(B0, 1, 0); PG8_SCHED; PG8_LDA(At, 1, 0); PG8_STAGE(PG8_SA(0, 1), a2 + hstep, voffA);
            PG8_WAIT_L(8); PG8_BAR; PG8_WAIT_L(0); PG8_MMA(0, 0, At, B0); PG8_BAR; PG8_SCHED;
            PG8_LDB(B1, 1, 1); PG8_STAGE(PG8_SB(1, 0), b3, voffB);
            PG8_BAR; PG8_WAIT_L(0); PG8_MMA(0, 1, At, B1); PG8_BAR;
            PG8_LDA(At, 1, 1); PG8_STAGE(PG8_SA(1, 0), a3, voffA);
            PG8_BAR; PG8_WAIT_L(0); PG8_MMA(1, 0, At, B0); PG8_BAR; PG8_SCHED;
            PG8_STAGE(PG8_SB(1, 1), b3 + hstep, voffB);
            PG8_WAIT_V(6); PG8_BAR; PG8_MMA(1, 1, At, B1); PG8_BAR;
            }
        }
        if constexpr (ALIGN_EPI) { if (wr == 0) PG8_BAR; }
        if constexpr (!Epi::AFTER_DRAIN) { E(acc, cur, wr, wc, fr, fq); S.done(cur); }
        if (!has_next) break;
#pragma unroll
        for (int a = 0; a < 2; ++a)
#pragma unroll
            for (int b = 0; b < 2; ++b)
#pragma unroll
                for (int m = 0; m < 4; ++m)
#pragma unroll
                    for (int n = 0; n < 2; ++n) acc[a][b][m][n] = (f32x4){0.f, 0.f, 0.f, 0.f};
        cur = nxt; cA = nA; cB = nB; ++ui;
        if constexpr (ALIGN_EPI) { if (wr == 1) PG8_BAR; }
    }
    PG8_WAIT_V(0);
    if constexpr (!ALIGN_EPI) { if (wr == 0) PG8_BAR; }
    PG8_BAR;
    if constexpr (Epi::AFTER_DRAIN) { E.fused(acc, cur, wr, wc, fr, fq, lds, wid, lane); S.done(cur); }
#undef PG8_SA
#undef PG8_SB
#undef PG8_STAGE
#undef PG8_LDA
#undef PG8_LDB
#undef PG8_MMA
#undef PG8_WAIT_V
#undef PG8_WAIT_L
#undef PG8_BAR
#undef PG8_SCHED
}
}

namespace pg8 {
template <int MODE> struct EpiRowScaleBf16 {
    static constexpr bool PERM = true, AFTER_DRAIN = false;
    bf16_t* O; const float* SS; float* KMP; float* GATES; int ldc, kt_lo, kt_hi, gate_tile; const PG8_LAS float* rsl; int rs_pm;
    __device__ __forceinline__ void operator()(const f32x4 (&acc)[2][2][4][2], const Unit& u, int wr, int wc, int fr, int fq) const {
        const int row0 = u.pm * BM + wr * 64 + fr, col0 = u.pn * BM + wc * 32 + 8 * fq;
        if (MODE == 0 && u.pn == gate_tile) {
            if (wc == 0 && fq < 3) {
#pragma unroll
                for (int ai = 0; ai < 2; ++ai)
#pragma unroll
                    for (int m = 0; m < 4; ++m) { const int row = row0 + ai * HALF + m * 16; const float rs = (rsl && u.pm == rs_pm) ? rsl[wr * 64 + fr + ai * HALF + m * 16] : rstd_of(SS, row); float* gp = GATES + (size_t)row * 24 + 8 * fq;
                        f32x4 g0 = acc[ai][0][m][0] * rs, g1 = acc[ai][0][m][1] * rs;
#pragma unroll
                        for (int e = 0; e < 4; ++e) { g0[e] = 1.0f / (1.0f + __expf(-g0[e])); g1[e] = 1.0f / (1.0f + __expf(-g1[e])); }
                        *(f32x4*)gp = g0; *(f32x4*)(gp + 4) = g1; }
            }
            return;
        }
        const bool do_km = (u.pn >= kt_lo && u.pn < kt_hi);
        float cs[2][8];
#pragma unroll
        for (int bj = 0; bj < 2; ++bj)
#pragma unroll
            for (int e = 0; e < 8; ++e) cs[bj][e] = 0.f;
#pragma unroll
        for (int ai = 0; ai < 2; ++ai) {
            float rsv[4];
#pragma unroll
            for (int m = 0; m < 4; ++m) rsv[m] = (rsl && u.pm == rs_pm) ? rsl[wr * 64 + fr + ai * HALF + m * 16] : rstd_of(SS, row0 + ai * HALF + m * 16);
#pragma unroll
            for (int m = 0; m < 4; ++m) { const int row = row0 + ai * HALF + m * 16; const float rs = rsv[m]; bf16_t* rowp = O + (size_t)row * ldc + col0;
#pragma unroll
                for (int bj = 0; bj < 2; ++bj) { f32x4 v0 = acc[ai][bj][m][0] * rs, v1 = acc[ai][bj][m][1] * rs;
                    if (MODE == 1) {
#pragma unroll
                        for (int e = 0; e < 4; ++e) { float a = v0[e] > 0.f ? v0[e] : 0.f; v0[e] = a * a; float b = v1[e] > 0.f ? v1[e] : 0.f; v1[e] = b * b; } }
                    if (MODE == 0 && do_km) {
#pragma unroll
                        for (int e = 0; e < 4; ++e) { cs[bj][e] += v0[e]; cs[bj][4 + e] += v1[e]; } }
                    u32x4 w; w.x = cvt_pk_bf16(v0[0], v0[1]); w.y = cvt_pk_bf16(v0[2], v0[3]); w.z = cvt_pk_bf16(v1[0], v1[1]); w.w = cvt_pk_bf16(v1[2], v1[3]);
                    *(u32x4*)(rowp + bj * HALF) = w; } }
        }
        if (MODE == 0 && do_km) {
            const int b = u.pm >> 5, blk = u.pm & 31;
#pragma unroll
            for (int bj = 0; bj < 2; ++bj)
#pragma unroll
                for (int e = 0; e < 8; ++e) { float s = cs[bj][e]; s += __shfl_xor(s, 1); s += __shfl_xor(s, 2); s += __shfl_xor(s, 4); s += __shfl_xor(s, 8);
                    if (fr == 0) { const int kc = (u.pn - kt_lo) * BM + bj * HALF + wc * 32 + 8 * fq + e;
                        KMP[(((size_t)wr * 2 + b) * 16 + (kc >> 6)) * 32 * 64 + (size_t)blk * 64 + (kc & 63)] = s; } }
        }
    }
};
__device__ __forceinline__ float pg8_sum_fq(float v) {
    auto a = __builtin_amdgcn_permlane16_swap(__float_as_uint(v), __float_as_uint(v), false, false); const float s = __uint_as_float(a[0]) + __uint_as_float(a[1]);
    auto b = __builtin_amdgcn_permlane32_swap(__float_as_uint(s), __float_as_uint(s), false, false); return __uint_as_float(b[0]) + __uint_as_float(b[1]);
}
template <bool INBF> struct EpiResidual {
    static constexpr bool PERM = true, AFTER_DRAIN = false;
    const float* xin32; bf16_t* xb; float* SS;
    __device__ __forceinline__ void operator()(const f32x4 (&acc)[2][2][4][2], const Unit& u, int wr, int wc, int fr, int fq) const {
        const int col0 = u.pn * BM + wc * 32 + 8 * fq;
#pragma unroll
        for (int ai = 0; ai < 2; ++ai) {
            f32x4 bs[4][2][2];
#pragma unroll
            for (int m = 0; m < 4; ++m) { const size_t off = (size_t)(u.pm * BM + ai * HALF + wr * 64 + m * 16 + fr) * DM + col0;
#pragma unroll
                for (int bj = 0; bj < 2; ++bj) {
                    if (INBF) { const u32x4 w = *(const u32x4*)(xb + off + bj * HALF);
                        bs[m][bj][0] = (f32x4){__builtin_bit_cast(float, w.x << 16), __builtin_bit_cast(float, w.x & 0xffff0000u), __builtin_bit_cast(float, w.y << 16), __builtin_bit_cast(float, w.y & 0xffff0000u)};
                        bs[m][bj][1] = (f32x4){__builtin_bit_cast(float, w.z << 16), __builtin_bit_cast(float, w.z & 0xffff0000u), __builtin_bit_cast(float, w.w << 16), __builtin_bit_cast(float, w.w & 0xffff0000u)}; }
                    else { bs[m][bj][0] = *(const f32x4*)(xin32 + off + bj * HALF); bs[m][bj][1] = *(const f32x4*)(xin32 + off + bj * HALF + 4); } } }
#pragma unroll
            for (int m = 0; m < 4; ++m) { const int row = u.pm * BM + ai * HALF + wr * 64 + m * 16 + fr; const size_t off = (size_t)row * DM + col0; float sq = 0.f;
#pragma unroll
                for (int bj = 0; bj < 2; ++bj) { const f32x4 o0 = bs[m][bj][0] + acc[ai][bj][m][0], o1 = bs[m][bj][1] + acc[ai][bj][m][1];
                    sq += ((o0[0] * o0[0] + o0[1] * o0[1]) + (o0[2] * o0[2] + o0[3] * o0[3])) + ((o1[0] * o1[0] + o1[1] * o1[1]) + (o1[2] * o1[2] + o1[3] * o1[3]));
                    u32x4 w; w.x = cvt_pk_bf16(o0[0], o0[1]); w.y = cvt_pk_bf16(o0[2], o0[3]); w.z = cvt_pk_bf16(o1[0], o1[1]); w.w = cvt_pk_bf16(o1[2], o1[3]);
                    *(u32x4*)(xb + off + bj * HALF) = w; }
                sq = pg8_sum_fq(sq);
                if (fq == 0) SS[(size_t)row * 16 + u.pn * 4 + wc] = sq; }
        }
    }
};
}

namespace cg = cooperative_groups;
constexpr int NTHR = 512;
constexpr int NP0G = 3072;
constexpr int LDS_BYTES = 147456 + 8704;
constexpr size_t WS_KMP = 6 * MiB;
#ifndef USE_MFMA_MOBA
#define USE_MFMA_MOBA 1
#endif
#ifndef USE_MOBA_ROUTED
#define USE_MOBA_ROUTED 1
#endif
#ifndef USE_MFMA_DIFF
#define USE_MFMA_DIFF 1
#endif
#ifndef USE_MFMA_NSA
#define USE_MFMA_NSA 1
#endif
#ifndef PROBE_DOUBLE
#define PROBE_DOUBLE 0
#endif
#ifndef USE_MFMA_CMP
#define USE_MFMA_CMP 1
#endif
#ifndef GEMM_ALIGN
#define GEMM_ALIGN true
#endif
#ifndef GEMM_SP2
#define GEMM_SP2 true
#endif
#ifndef USE_PG8
#define USE_PG8 1
#endif

struct Args { const float* in[22]; float* out; unsigned char* ws; int ph_lo, ph_hi; };

struct PP {
    const float *x, *bias_table, *norm_mix, *norm_mlp, *norm_final, *mlp_w1, *mlp_w2, *ev_w_in, *ev_w_out, *pos_k, *w1_k, *w2_k, *pos_v, *w1_v, *w2_v, *lq1, *lk1, *lq2, *lk2, *subln, *od_w_in, *od_w_out;
    float* out; float *SSA, *SSB, *GATES, *CMPB, *BIASL, *KMEAN, *KMP;
    bf16 *KCMP, *VCMP, *WIN0, *WOUT0, *W1_0, *W2_0, *WIN1, *WOUT1, *W1_1, *W2_1, *CW1K, *CW1V, *CW2K, *CW2V, *XB, *OC, *H, *PROJ;
};

struct WJob { const float* W; bf16* WT; const float* kscale; int K, Nsrc, Ndst, kind; };
__device__ __forceinline__ void transpose_item(const WJob& J, int item, float* scr, int lane) {
    const int nblk = J.Ndst / 32, kb = item / nblk, nb = item % nblk, k0 = 64 * kb, n0 = 32 * nb;
    int s0 = n0; float cs = 1.0f; int nvalid = 32;
    if (J.kind == 1) { s0 = n0 < 1280 ? n0 : n0 + 24; if (n0 < 512 || (n0 >= C_DQ && n0 < C_DK)) cs = C2;
        if (n0 >= NP0) { s0 = 1280 + (n0 - NP0); nvalid = n0 == NP0 ? 24 : 0; if (nvalid == 0) s0 = 0; } }
    if (J.kind == 2) { if (n0 < 1024) cs = C2; }
#pragma unroll
    for (int i = 0; i < 32; ++i) { const int kk = 2 * i + (lane >> 5); scr[kk * 33 + (lane & 31)] = (lane & 31) < nvalid ? J.W[(size_t)(k0 + kk) * J.Nsrc + s0 + (lane & 31)] : 0.f; }
    __builtin_amdgcn_s_waitcnt(0xC07F); asm volatile("" ::: "memory");
    const int c = lane & 7;
    float ks[8];
#pragma unroll
    for (int i = 0; i < 8; ++i) ks[i] = (J.kscale ? J.kscale[k0 + 8 * c + i] : 1.0f) * cs;
#pragma unroll
    for (int j = 0; j < 4; ++j) { const int n = (lane >> 3) + 8 * j; const float* s = scr + (8 * c) * 33 + n;
        v4u o; o.x = pk2(s[0 * 33] * ks[0], s[1 * 33] * ks[1]); o.y = pk2(s[2 * 33] * ks[2], s[3 * 33] * ks[3]); o.z = pk2(s[4 * 33] * ks[4], s[5 * 33] * ks[5]); o.w = pk2(s[6 * 33] * ks[6], s[7 * 33] * ks[7]);
        if (J.kind == 3) { const int nn = n0 + n, kc = (k0 >> 3) + c;
            *(v4u*)(J.WT + ((((size_t)(nn >> 4) * (J.K >> 5) + (kc >> 2)) * 4 + (kc & 3)) * 16 + (nn & 15)) * 8) = o; }
        else *(v4u*)(J.WT + (size_t)(n0 + n) * J.K + k0 + 8 * c) = o; }
    __builtin_amdgcn_s_waitcnt(0xC07F); asm volatile("" ::: "memory");
}
__device__ __forceinline__ void job_items(const WJob& J, int& base, int gw, int NGW, float* scr, int lane) {
    const int nit = (J.K / 64) * (J.Ndst / 32);
    const int first = ((gw - base) % NGW + NGW) % NGW;
    for (int it = first; it < nit; it += NGW) transpose_item(J, it, scr, lane);
    base += nit;
}
constexpr int WG_PITCH = 1028;
__device__ __forceinline__ void p0_prologue(const PP& p, char* lds, int tid, int bid, int G) {
    const int lane = tid & 63, wave = tid >> 6;
    {
        float* scr = (float*)lds + wave * 64 * 33;
        const int gw = bid * 8 + wave, NGW = G * 8; int base = 0;
        job_items(WJob{p.ev_w_in, p.WIN0, p.norm_mix, DM, EVEN_PROJ, NP0G, 1}, base, gw, NGW, scr, lane);
        job_items(WJob{p.ev_w_out, p.WOUT0, nullptr, DM, DM, DM, 0}, base, gw, NGW, scr, lane);
        job_items(WJob{p.mlp_w1, p.W1_0, p.norm_mlp, DM, FF, FF, 0}, base, gw, NGW, scr, lane);
        job_items(WJob{p.mlp_w2, p.W2_0, nullptr, FF, DM, DM, 0}, base, gw, NGW, scr, lane);
        job_items(WJob{p.od_w_in, p.WIN1, p.norm_mix + DM, DM, NP1, NP1, 2}, base, gw, NGW, scr, lane);
        job_items(WJob{p.od_w_out, p.WOUT1, nullptr, DM, DM, DM, 0}, base, gw, NGW, scr, lane);
        job_items(WJob{p.mlp_w1 + (size_t)DM * FF, p.W1_1, p.norm_mlp + DM, DM, FF, FF, 0}, base, gw, NGW, scr, lane);
        job_items(WJob{p.mlp_w2 + (size_t)DM * FF, p.W2_1, nullptr, FF, DM, DM, 0}, base, gw, NGW, scr, lane);
        job_items(WJob{p.w1_k, p.CW1K, nullptr, 2048, 128, 128, 3}, base, gw, NGW, scr, lane);
        job_items(WJob{p.w1_v, p.CW1V, nullptr, 2048, 128, 128, 3}, base, gw, NGW, scr, lane);
        job_items(WJob{p.w2_k, p.CW2K, nullptr, 128, 64, 64, 0}, base, gw, NGW, scr, lane);
        job_items(WJob{p.w2_v, p.CW2V, nullptr, 128, 64, 64, 0}, base, gw, NGW, scr, lane);
    }
    __syncthreads();
    if (bid == 0) { for (int i = tid; i < 16 * 128; i += NTHR) { const int h = i >> 7, rel = i & 127; p.BIASL[i] = p.bias_table[t5_bucket(rel) * 16 + h] * LOG2E; } }
#pragma unroll 1
    for (int job = 0; job < 16; ++job) { if (bid != (1 + job) % G) continue;
        const int which = job >> 3, prt = job & 7;
        const float* pos = which == 0 ? p.pos_k : p.pos_v; const float* w1 = which == 0 ? p.w1_k : p.w1_v;
        float* part = (float*)lds; const int n = tid & 127, pr = tid >> 7; const int k0 = prt * 256 + pr * 64; float s = 0.f;
#pragma unroll
        for (int j = 0; j < 64; ++j) s += pos[k0 + j] * w1[(size_t)(k0 + j) * 128 + n];
        part[pr * 128 + n] = s; __syncthreads();
        if (tid < 128) p.CMPB[(which * 8 + prt) * 128 + tid] = (part[tid] + part[128 + tid]) + (part[256 + tid] + part[384 + tid]);
        __syncthreads(); }
    __syncthreads();
#pragma unroll 4
    for (int row = bid * 8 + wave; row < M; row += G * 8) {
        const f32x4* xr = (const f32x4*)(p.x + (size_t)row * DM) + lane;
        f32x4 v[4]; float s = 0.f;
#pragma unroll
        for (int j = 0; j < 4; ++j) { v[j] = xr[64 * j]; s += (v[j].x * v[j].x + v[j].y * v[j].y) + (v[j].z * v[j].z + v[j].w * v[j].w); }
        s = wave_sum(s);
        unsigned long long* o8 = (unsigned long long*)(p.XB + (size_t)row * DM) + lane;
#pragma unroll
        for (int j = 0; j < 4; ++j) o8[64 * j] = (unsigned long long)pk2(v[j].x, v[j].y) | ((unsigned long long)pk2(v[j].z, v[j].w) << 32);
        if (lane < 16) p.SSA[(size_t)row * 16 + lane] = lane == 0 ? s : 0.f;
    }
    __syncthreads();
}

struct NEpiProj { bf16* out; const float* SS; int ldc;
    __device__ __forceinline__ float rowscale(int row) const { return rstd_of(SS, row); }
    __device__ __forceinline__ float tile4(int row, int col, const float (&a)[4], float rs) const {
#pragma unroll
        for (int j = 0; j < 4; ++j) out[(size_t)row * ldc + col + j] = (bf16)f2bf(a[j] * rs);
        return 0.f; }
    __device__ __forceinline__ void rowstat(int, int, float) const {} };
struct NEpiRes { const float* xin; float* xout; bf16* xb; float* SS;
    __device__ __forceinline__ float rowscale(int) const { return 1.f; }
    __device__ __forceinline__ float tile4(int row, int col, const float (&a)[4], float) const { float sq = 0.f;
#pragma unroll
        for (int j = 0; j < 4; ++j) { const float v = xin[(size_t)row * DM + col + j] + a[j]; xout[(size_t)row * DM + col + j] = v; xb[(size_t)row * DM + col + j] = (bf16)f2bf(v); sq += v * v; }
        return sq; }
    __device__ __forceinline__ void rowstat(int row, int slot, float s) const { SS[(size_t)row * 16 + slot] = s; } };
struct NEpiMlp1 { bf16* H; const float* SS;
    __device__ __forceinline__ float rowscale(int row) const { return rstd_of(SS, row); }
    __device__ __forceinline__ float tile4(int row, int col, const float (&a)[4], float rs) const {
#pragma unroll
        for (int j = 0; j < 4; ++j) { float v = a[j] * rs; v = v > 0.f ? v : 0.f; H[(size_t)row * FF + col + j] = (bf16)f2bf(v * v); }
        return 0.f; }
    __device__ __forceinline__ void rowstat(int, int, float) const {} };

template <class Epi>
__device__ __forceinline__ void ngemm_phase(char* lds, const bf16* A, const bf16* Bt, int N, int K, const Epi& E, int tid, int bid, int G) {
    const int sub = tid >> 8, t = tid & 255, tx = t & 15, ty = t >> 4;
    float* As = (float*)lds + sub * (2 * 32 * 65); float* Bs = As + 32 * 65;
    const int nbx = N / 64, npairs = nbx * (M / 64) / 2;
    const int lr = t >> 2, lk = (t & 3) * 8;
    for (int it = bid; it < npairs; it += G) {
        const int tile = it * 2 + sub; const int m0 = (tile / nbx) * 64, n0 = (tile % nbx) * 64;
        float acc[4][4] = {};
        for (int k0 = 0; k0 < K; k0 += 32) {
            const v4u a = *(const v4u*)(A + (size_t)(m0 + lr) * K + k0 + lk);
            const v4u b = *(const v4u*)(Bt + (size_t)(n0 + lr) * K + k0 + lk);
            __syncthreads();
            const unsigned au[4] = {a.x, a.y, a.z, a.w}, bu[4] = {b.x, b.y, b.z, b.w};
#pragma unroll
            for (int i = 0; i < 4; ++i) { As[(lk + 2 * i) * 65 + lr] = bf2f(au[i] & 0xffff); As[(lk + 2 * i + 1) * 65 + lr] = bf2f(au[i] >> 16); Bs[(lk + 2 * i) * 65 + lr] = bf2f(bu[i] & 0xffff); Bs[(lk + 2 * i + 1) * 65 + lr] = bf2f(bu[i] >> 16); }
            __syncthreads();
#pragma unroll 8
            for (int k = 0; k < 32; ++k) {
                float av[4], bv[4];
#pragma unroll
                for (int i = 0; i < 4; ++i) { av[i] = As[k * 65 + ty * 4 + i]; bv[i] = Bs[k * 65 + tx * 4 + i]; }
#pragma unroll
                for (int i = 0; i < 4; ++i)
#pragma unroll
                    for (int j = 0; j < 4; ++j) acc[i][j] += av[i] * bv[j];
            }
        }
#pragma unroll
        for (int i = 0; i < 4; ++i) { const int row = m0 + ty * 4 + i; const float rs = E.rowscale(row);
            float sq = E.tile4(row, n0 + tx * 4, acc[i], rs);
            sq += __shfl_xor(sq, 1); sq += __shfl_xor(sq, 2); sq += __shfl_xor(sq, 4); sq += __shfl_xor(sq, 8);
            if (tx == 0) E.rowstat(row, n0 / 64, sq); }
    }
    __syncthreads();
}

__device__ __forceinline__ float gelu_tanh(float x) { const float u = 0.7978845608028654f * (x + 0.044715f * x * x * x); return 0.5f * x * (1.0f + tanhf(u)); }
__device__ __forceinline__ void ncompress_phase(const PP& p, char* lds, int tid, int bid, int G) {
    const int sub = tid >> 7, t = tid & 127;
    float* a = (float*)lds + sub * (2048 + 128); float* hid = a + 2048;
    for (int it = bid; it < 1024; it += G) {
        int id = it * 4 + sub; const int c = id % 512; id /= 512; const int g = id % 2; id /= 2; const int b = id % 2; const int kv = id / 2;
        bf16* outp = (kv ? p.VCMP : p.KCMP) + ((size_t)((b * 2 + g) * 512 + c)) * 64;
        const bool live = c < NCMP; const int cc = live ? c : 0;
        const int col = (kv ? C_VC : C_KC) + g * 64;
        __syncthreads();
        for (int i = t; i < 2048; i += 128) { const int j = i >> 6, d = i & 63; a[i] = bf2f(p.PROJ[(size_t)(b * SEQ + 16 * cc + j) * NP0 + col + d]); }
        __syncthreads();
        const bf16* w1 = (kv ? p.CW1V : p.CW1K) + (size_t)t * 2048; float s = 0.f; for (int j = 0; j < 8; ++j) s += p.CMPB[(kv * 8 + j) * 128 + t];
        for (int k = 0; k < 2048; k += 8) { const v4u u = *(const v4u*)(w1 + k);
            s += a[k] * bf2f(u.x & 0xffff) + a[k + 1] * bf2f(u.x >> 16) + a[k + 2] * bf2f(u.y & 0xffff) + a[k + 3] * bf2f(u.y >> 16) + a[k + 4] * bf2f(u.z & 0xffff) + a[k + 5] * bf2f(u.z >> 16) + a[k + 6] * bf2f(u.w & 0xffff) + a[k + 7] * bf2f(u.w >> 16); }
        hid[t] = bf2f(f2bf(gelu_tanh(s)));
        __syncthreads();
        if (t < 64) { const bf16* w2 = (kv ? p.CW2V : p.CW2K) + (size_t)t * 128; float o = 0.f; for (int n = 0; n < 128; ++n) o += hid[n] * bf2f(w2[n]); outp[t] = live ? (bf16)f2bf(o) : (bf16)0; }
    }
    __syncthreads();
}

template <int NV> struct NAcc { float m, l, o[NV]; };
template <int NV> __device__ __forceinline__ void nacc_init(NAcc<NV>& a) { a.m = -1e30f; a.l = 0.f;
#pragma unroll
    for (int j = 0; j < NV; ++j) a.o[j] = 0.f; }
__device__ __forceinline__ void load_q64(float (&q)[64], const bf16* qp) {
#pragma unroll
    for (int i = 0; i < 8; ++i) { const v4u u = ((const v4u*)qp)[i];
        q[8 * i + 0] = bf2f(u.x & 0xffff); q[8 * i + 1] = bf2f(u.x >> 16); q[8 * i + 2] = bf2f(u.y & 0xffff); q[8 * i + 3] = bf2f(u.y >> 16);
        q[8 * i + 4] = bf2f(u.z & 0xffff); q[8 * i + 5] = bf2f(u.z >> 16); q[8 * i + 6] = bf2f(u.w & 0xffff); q[8 * i + 7] = bf2f(u.w >> 16); }
}
__device__ __forceinline__ float dot64(const float (&q)[64], const bf16* kp) {
    float s = 0.f;
#pragma unroll
    for (int i = 0; i < 8; ++i) { const v4u u = ((const v4u*)kp)[i];
        s += q[8 * i + 0] * bf2f(u.x & 0xffff) + q[8 * i + 1] * bf2f(u.x >> 16) + q[8 * i + 2] * bf2f(u.y & 0xffff) + q[8 * i + 3] * bf2f(u.y >> 16)
           + q[8 * i + 4] * bf2f(u.z & 0xffff) + q[8 * i + 5] * bf2f(u.z >> 16) + q[8 * i + 6] * bf2f(u.w & 0xffff) + q[8 * i + 7] * bf2f(u.w >> 16); }
    return s;
}
template <int NV> __device__ __forceinline__ void ntile(NAcc<NV>& a, const float (&q)[64], const bf16* kp, const bf16* vp, bool valid, float bias, int lane) {
    const float s = valid ? dot64(q, kp) + bias : -INFINITY;
    const float tm = wave_max(s);
    const float mn = fmaxf(a.m, tm), f = exp2f(a.m - mn), pr = exp2f(s - mn);
    a.l = a.l * f + wave_sum(pr); a.m = mn;
#pragma unroll
    for (int j = 0; j < NV; ++j) a.o[j] *= f;
    const unsigned long long vpi = (unsigned long long)(uintptr_t)vp;
    const unsigned vlo = (unsigned)vpi, vhi = (unsigned)(vpi >> 32);
    for (int k = 0; k < 64; ++k) {
        const float pk = __shfl(pr, k);
        const unsigned lo = __shfl(vlo, k), hi = __shfl(vhi, k);
        if (pk != 0.f) { const bf16* vr = (const bf16*)(uintptr_t)(((unsigned long long)hi << 32) | lo);
#pragma unroll
            for (int j = 0; j < NV; ++j) a.o[j] += pk * bf2f(vr[lane + 64 * j]); }
    }
}

__device__ __forceinline__ void nnsa_phase(const PP& p, char* lds, int tid, int bid, int G) {
    const int sub = tid >> 8, t256 = tid & 255, lane = tid & 63, r = t256 >> 6;
    float* base = (float*)lds + sub * (4 * 512 + 4 * 128 + 128 + 16);
    float* sc = base + r * 512; float* imph = base + 4 * 512; float* score = imph + 4 * 128; int* sel = (int*)(score + 128);
    for (int it = bid; it < M * 2 / 2; it += G) {
        int id = it * 2 + sub; const int t = id % SEQ; id /= SEQ; const int g = id % 2; const int b = id / 2;
        const int hh = g * 4 + r; const size_t row = (size_t)b * SEQ + t;
        const float* bl = p.BIASL + hh * 128;
        float q[64]; load_q64(q, p.PROJ + row * NP0 + C_Q + hh * 64);
        const int nvis = t >= 31 ? ((t - 31) / 16 + 1 < NCMP ? (t - 31) / 16 + 1 : NCMP) : 0;
        const bf16* kc = p.KCMP + (size_t)((b * 2 + g) * 512) * 64; const bf16* vc = p.VCMP + (size_t)((b * 2 + g) * 512) * 64;
        __syncthreads();
        float mx = -INFINITY;
        for (int c0 = 0; c0 < nvis; c0 += 64) { const int c = c0 + lane; float s = -INFINITY;
            if (c < nvis) { int rel = t - (16 * c + 31); rel = rel > 127 ? 127 : rel; s = dot64(q, kc + (size_t)c * 64) + bl[rel]; }
            sc[c] = s; mx = fmaxf(mx, s); }
        mx = wave_max(mx);
        float ls = 0.f;
        for (int c0 = 0; c0 < nvis; c0 += 64) { const int c = c0 + lane; const float e = exp2f(sc[c] - mx); sc[c] = e; ls += e; }
        ls = wave_sum(ls);
        const float rl = ls > 0.f ? 1.0f / ls : 0.f;
        for (int c = lane; c < 512; c += 64) sc[c] = c < nvis ? sc[c] * rl : 0.f;
        float oc = 0.f;
        for (int c = 0; c < nvis; ++c) oc += sc[c] * bf2f(vc[(size_t)c * 64 + lane]);
        for (int n = lane; n < 128; n += 64) { float a = ((sc[4 * n] + sc[4 * n + 1]) + sc[4 * n + 2]) + 0.5f * sc[4 * n + 3]; if (n > 0) a += 0.5f * sc[4 * n - 1]; imph[r * 128 + n] = a; }
        __syncthreads();
        const int cur = t >> 6;
        if (t256 < 128) { const int n = t256; const float imp = (imph[n] + imph[128 + n]) + (imph[256 + n] + imph[384 + n]);
            const bool elig = n <= cur, forced = (n == 0) || (n == cur) || (n == cur - 1);
            score[n] = elig ? imp + (forced ? 1000.f : 0.f) : -1.0f; }
        __syncthreads();
        if (t256 < 128) { const int n = t256; const float v = score[n]; int rank = 0;
            for (int j = 0; j < 128; ++j) { const float u = score[j]; rank += (u > v || (u == v && j < n)) ? 1 : 0; }
            if (rank < 16) sel[rank] = n; }
        __syncthreads();
        NAcc<1> as; nacc_init(as);
        for (int i = 0; i < 16; ++i) { const int n = sel[i]; const int pos = 64 * n + lane; const int rel = t - pos; const size_t kr = (size_t)b * SEQ + pos;
            if (64 * n > t) continue;
            ntile<1>(as, q, p.PROJ + kr * NP0 + C_KS + g * 64, p.PROJ + kr * NP0 + C_VS + g * 64, rel >= 0, bl[rel < 0 ? 0 : (rel > 127 ? 127 : rel)], lane); }
        NAcc<1> aw; nacc_init(aw);
        for (int n = cur - 8; n <= cur; ++n) { if (n < 0) continue; const int pos = 64 * n + lane; const int rel = t - pos; const size_t kr = (size_t)b * SEQ + pos;
            ntile<1>(aw, q, p.PROJ + kr * NP0 + C_KW + g * 64, p.PROJ + kr * NP0 + C_VW + g * 64, rel >= 0 && rel < 512, bl[rel < 0 ? 0 : (rel > 127 ? 127 : rel)], lane); }
        const float g0 = p.GATES[row * 24 + hh], g1 = p.GATES[row * 24 + 8 + hh], g2 = p.GATES[row * 24 + 16 + hh];
        const float os = as.l > 0.f ? as.o[0] / as.l : 0.f, ow = aw.l > 0.f ? aw.o[0] / aw.l : 0.f;
        p.OC[row * DM + hh * 64 + lane] = (bf16)f2bf(g0 * oc + g1 * os + g2 * ow);
    }
    __syncthreads();
}

__device__ __forceinline__ void ndiff_phase(const PP& p, char* lds, int tid, int bid, int G) {
    const int sub = tid >> 7, lane = tid & 63, mp = (tid >> 6) & 1;
    float* o2 = (float*)lds + sub * 128;
    for (int it = bid; it < M * 4 / 4; it += G) {
        int id = it * 4 + sub; const int h = id % 4; id /= 4; const int t = id % SEQ; const int b = id / SEQ;
        const size_t row = (size_t)b * SEQ + t; const float* bl = p.BIASL + (8 + h) * 128;
        float q[64]; load_q64(q, p.PROJ + row * NP0 + C_DQ + h * 128 + mp * 64);
        NAcc<2> a; nacc_init(a);
        for (int p0 = 0; p0 <= t; p0 += 64) { const int pos = p0 + lane; const int rel = t - pos; const size_t kr = (size_t)b * SEQ + pos;
            ntile<2>(a, q, p.PROJ + kr * NP0 + C_DK + h * 128 + mp * 64, p.PROJ + kr * NP0 + C_DV + h * 128, rel >= 0, bl[rel < 0 ? 0 : (rel > 127 ? 127 : rel)], lane); }
        const float il = 1.0f / a.l; float v0 = a.o[0] * il, v1 = a.o[1] * il;
        __syncthreads();
        if (mp == 1) { o2[lane] = v0; o2[lane + 64] = v1; }
        __syncthreads();
        if (mp == 0) {
            const float lam = expf(wave_sum(p.lq1[lane] * p.lk1[lane])) - expf(wave_sum(p.lq2[lane] * p.lk2[lane])) + 0.2f;
            v0 -= lam * o2[lane]; v1 -= lam * o2[lane + 64];
            const float ss = wave_sum(v0 * v0 + v1 * v1); const float rs = 1.0f / sqrtf(ss * (1.0f / 128.f) + EPS);
            p.OC[row * DM + 512 + h * 128 + lane] = (bf16)f2bf(v0 * rs * p.subln[lane] * 0.8f);
            p.OC[row * DM + 512 + h * 128 + 64 + lane] = (bf16)f2bf(v1 * rs * p.subln[64 + lane] * 0.8f);
        }
    }
    __syncthreads();
}

__device__ __forceinline__ void nkmean_phase(const PP& p, int tid, int bid, int G) {
    for (int it = bid; it < 64 * 2; it += G) { const int bb = it >> 1, half = it & 1; const int b = bb / 32, n = bb % 32; const int col = half * 512 + tid; float s = 0.f;
        for (int r = 0; r < 256; ++r) s += bf2f(p.PROJ[(size_t)(b * SEQ + n * 256 + r) * NP1 + 1024 + col]);
        p.KMEAN[((size_t)(b * 16 + (col >> 6)) * 32 + n) * 64 + (col & 63)] = s * (1.0f / 256.f); }
}
__device__ __forceinline__ void kmean_from_partials(const PP& p, int tid, int bid, int G) {
    for (int i = bid * NTHR + tid; i < 2 * 16 * 32 * 64; i += G * NTHR) p.KMEAN[i] = (p.KMP[i] + p.KMP[2 * 16 * 32 * 64 + i]) * (1.0f / 256.f);
}
__device__ __forceinline__ void nmoba_phase(const PP& p, int tid, int bid, int G) {
    const int lane = tid & 63, w = tid >> 6;
    for (int it = bid; it < M * 16 / 8; it += G) {
        int id = it * 8 + w; const int h = id % 16; id /= 16; const int t = id % SEQ; const int b = id / SEQ;
        const size_t row = (size_t)b * SEQ + t; const float* bl = p.BIASL + h * 128; const int c = t >> 8;
        float q[64]; load_q64(q, p.PROJ + row * NP1 + h * 64);
        float gate = -1e30f;
        if (lane < 32 && lane < c) { const float* km = p.KMEAN + ((size_t)(b * 16 + h) * 32 + lane) * 64; float s = 0.f;
#pragma unroll
            for (int d = 0; d < 64; ++d) s += q[d] * km[d];
            gate = s; }
        if (lane >= 32) gate = -INFINITY;
        int rank = 0;
        for (int j = 0; j < 32; ++j) { const float u = __shfl(gate, j); rank += (u > gate || (u == gate && j < lane)) ? 1 : 0; }
        const bool chosen = lane < 32 && rank < 3 && lane < c;
        const unsigned long long cm = __ballot(chosen);
        NAcc<1> a; nacc_init(a);
        for (int n = 0; n < c; ++n) { if (!((cm >> n) & 1ull)) continue;
            for (int j = 0; j < 4; ++j) { const int pos = n * 256 + j * 64 + lane; const int rel = t - pos; const size_t kr = (size_t)b * SEQ + pos;
                ntile<1>(a, q, p.PROJ + kr * NP1 + 1024 + h * 64, p.PROJ + kr * NP1 + 2048 + h * 64, true, bl[rel > 127 ? 127 : rel], lane); } }
        for (int j = 0; j < 4; ++j) { const int pos = c * 256 + j * 64 + lane; const int rel = t - pos; const size_t kr = (size_t)b * SEQ + pos;
            if (c * 256 + j * 64 > t) break;
            ntile<1>(a, q, p.PROJ + kr * NP1 + 1024 + h * 64, p.PROJ + kr * NP1 + 2048 + h * 64, rel >= 0, bl[rel < 0 ? 0 : (rel > 127 ? 127 : rel)], lane); }
        p.OC[row * DM + h * 64 + lane] = (bf16)f2bf(a.o[0] / a.l);
    }
}
__device__ __forceinline__ void final_norm_phase(const PP& p, int tid, int bid, int G) {
    const int lane = tid & 63, wave = tid >> 6;
#pragma unroll 4
    for (int row = bid * 8 + wave; row < M; row += G * 8) {
        const unsigned long long* xr = (const unsigned long long*)(p.XB + (size_t)row * DM) + lane; f32x4* orow = (f32x4*)(p.out + (size_t)row * DM) + lane; const f32x4* gr = (const f32x4*)p.norm_final + lane; f32x4 v[4]; float s = 0.f;
#pragma unroll
        for (int j = 0; j < 4; ++j) { const unsigned long long w = xr[64 * j]; const unsigned lo = (unsigned)w, hi = (unsigned)(w >> 32);
            v[j] = (f32x4){bf2f(lo & 0xffff), bf2f(lo >> 16), bf2f(hi & 0xffff), bf2f(hi >> 16)}; s += (v[j].x * v[j].x + v[j].y * v[j].y) + (v[j].z * v[j].z + v[j].w * v[j].w); }
        s = wave_sum(s); const float rstd = 1.0f / sqrtf(s * (1.0f / DM) + EPS);
#pragma unroll
        for (int j = 0; j < 4; ++j) { const f32x4 gg = gr[64 * j]; orow[64 * j] = v[j] * rstd * gg; }
    }
}


namespace att {
#ifndef ATT_PROBE
#define ATT_PROBE 0
#endif
#ifndef ATT_PROBE_PHASE
#define ATT_PROBE_PHASE 8
#endif
#ifndef ATT_PROBE_SEL
#define ATT_PROBE_SEL 0
#endif
#ifndef ATT_PROBE_BLOCK
#define ATT_PROBE_BLOCK 0
#endif
#ifndef ATT_PROBE_WAVE
#define ATT_PROBE_WAVE 0
#endif
#if ATT_PROBE
__device__ unsigned long long g_dbg[16];
#define ATT_T(x) const unsigned long long x = __builtin_amdgcn_s_memtime()
#else
#define ATT_T(x)
#endif
#if ATT_PROBE && (ATT_PROBE_PHASE == 2 || ATT_PROBE_PHASE == 3)
#define ATT_TP(x) ATT_T(x)
#else
#define ATT_TP(x) const unsigned long long x = 0ull
#endif
#if ATT_PROBE && ATT_PROBE_PHASE == 8
#define ATT_TS(x) ATT_T(x)
#else
#define ATT_TS(x) const unsigned long long x = 0ull
#endif
#if ATT_PROBE && ATT_PROBE_PHASE == 3
#define ATT_TN(x) ATT_T(x)
#else
#define ATT_TN(x)
#endif
#define LAS3 __attribute__((address_space(3)))
typedef short bf16x8 __attribute__((ext_vector_type(8)));
typedef short s16x4 __attribute__((ext_vector_type(4)));
typedef short v4i16_t __attribute__((ext_vector_type(4)));
typedef float f32x16 __attribute__((ext_vector_type(16)));
typedef unsigned u32x4 __attribute__((ext_vector_type(4)));
typedef LAS3 const char* lds_cptr;
constexpr float THR = 8.f, NEGBIG = -1e30f;
constexpr int L_RING = 0, L_OST = 98304, L_WSF = 131072, L_BIAS = 133120, L_MISC = 141312;

__device__ __forceinline__ int crow(int r, int hi) { return (r & 3) + 8 * (r >> 2) + 4 * hi; }
__device__ __forceinline__ void glds16(const void* gsrc, unsigned lds_dst) { unsigned keep;
    asm volatile("s_mov_b32 %0, m0\n\ts_mov_b32 m0, %2\n\ts_nop 0\n\tglobal_load_lds_dwordx4 %1, off\n\ts_mov_b32 m0, %0" : "=&s"(keep) : "v"(gsrc), "s"(lds_dst) : "memory"); }
__device__ __forceinline__ void glds16s(const void* sbase, unsigned voff, unsigned lds_dst) { unsigned keep;
    asm volatile("s_nop 4\n\ts_mov_b32 %0, m0\n\ts_mov_b32 m0, %3\n\ts_nop 0\n\tglobal_load_lds_dwordx4 %1, %2\n\ts_mov_b32 m0, %0" : "=&s"(keep) : "v"(voff), "s"(sbase), "s"(lds_dst) : "memory"); }
#define ATT_WAIT_BAR(N) asm volatile("s_waitcnt vmcnt(" #N ") lgkmcnt(0)\n\ts_barrier" ::: "memory")
#define ATT_BAR() asm volatile("s_waitcnt lgkmcnt(0)\n\ts_barrier" ::: "memory")
typedef float f32x2_t __attribute__((ext_vector_type(2))); typedef __bf16 bf16x2_t __attribute__((ext_vector_type(2)));
__device__ __forceinline__ unsigned cvtpk(float lo, float hi) { f32x2_t v = {lo, hi}; bf16x2_t b = __builtin_convertvector(v, bf16x2_t); return __builtin_bit_cast(unsigned, b); }
__device__ __forceinline__ s16x4 vtr(lds_cptr p) { return __builtin_bit_cast(s16x4, __builtin_amdgcn_ds_read_tr16_b64_v4i16((LAS3 v4i16_t*)p)); }
#define ATT_MX3(a, b, c) __builtin_fmaxf(__builtin_fmaxf((a), (b)), (c))
__device__ __forceinline__ float rowmax(const f32x16& p0, const f32x16& p1) {
    float a = ATT_MX3(p0[0], p0[1], p1[0]), b = ATT_MX3(p0[2], p0[3], p1[1]); a = ATT_MX3(a, p1[2], p1[3]);
#pragma unroll
    for (int r = 4; r < 16; r += 4) { a = ATT_MX3(a, p0[r], p0[r + 1]); b = ATT_MX3(b, p0[r + 2], p0[r + 3]); a = ATT_MX3(a, p1[r], p1[r + 1]); b = ATT_MX3(b, p1[r + 2], p1[r + 3]); }
    float m = __builtin_fmaxf(a, b); auto rr = __builtin_amdgcn_permlane32_swap(__float_as_uint(m), __float_as_uint(m), false, false);
    return __builtin_fmaxf(__uint_as_float(rr[0]), __uint_as_float(rr[1]));
}
__device__ __forceinline__ float fadd_s(float a, float b) { float r; asm("v_add_f32_e32 %0, %1, %2" : "=v"(r) : "v"(a), "v"(b)); return r; }
__device__ __forceinline__ float dpp_x1(float v) { return __int_as_float(__builtin_amdgcn_update_dpp(0, __float_as_int(v), 0xB1, 0xF, 0xF, true)); }
__device__ __forceinline__ float dpp_x2(float v) { return __int_as_float(__builtin_amdgcn_update_dpp(0, __float_as_int(v), 0x4E, 0xF, 0xF, true)); }
__device__ __forceinline__ float halfsum(float v) { auto rr = __builtin_amdgcn_permlane32_swap(__float_as_uint(v), __float_as_uint(v), false, false); return __uint_as_float(rr[0]) + __uint_as_float(rr[1]); }

template <int ND> struct St { float mhat, l, cval; f32x16 o[ND]; };
template <int ND> __device__ __forceinline__ void st_init(St<ND>& s, float bfar) { s.mhat = 0.f; s.l = 0.f; s.cval = bfar;
#pragma unroll
    for (int d = 0; d < ND; ++d) s.o[d] = f32x16{}; }
template <int ND> __device__ __forceinline__ void st_setref(St<ND>& s, float bfar, float mhat) { s.mhat = mhat; s.cval = bfar - mhat; }
__device__ __forceinline__ f32x16 splat16(float v) { f32x16 c;
#pragma unroll
    for (int r = 0; r < 16; ++r) c[r] = v;
    return c; }

__device__ __forceinline__ void qk_tile(f32x16& p0, f32x16& p1, lds_cptr kp, const bf16x8 (&qr)[4], float cv) {
    const f32x16 c = splat16(cv);
    bf16x8 kf[8];
#pragma unroll
    for (int d0 = 0; d0 < 4; ++d0) { kf[2 * d0] = *(const LAS3 bf16x8*)(kp + d0 * 2048); kf[2 * d0 + 1] = *(const LAS3 bf16x8*)(kp + d0 * 2048 + 512); }
    __builtin_amdgcn_sched_barrier(0);
    p0 = __builtin_amdgcn_mfma_f32_32x32x16_bf16(kf[0], qr[0], c, 0, 0, 0); p1 = __builtin_amdgcn_mfma_f32_32x32x16_bf16(kf[1], qr[0], c, 0, 0, 0);
#pragma unroll
    for (int d0 = 1; d0 < 4; ++d0) { p0 = __builtin_amdgcn_mfma_f32_32x32x16_bf16(kf[2 * d0], qr[d0], p0, 0, 0, 0); p1 = __builtin_amdgcn_mfma_f32_32x32x16_bf16(kf[2 * d0 + 1], qr[d0], p1, 0, 0, 0); }
}
template <int ND, int MODE, bool MASKED>
__device__ __forceinline__ void softmax_p(St<ND>& st, f32x16& p0, f32x16& p1, u32x4 (&pw)[4], LAS3 float* wsf, int r32, int hi, float rl, bool keep) {
    if (MODE != 2) {
        float rm = rowmax(p0, p1);
        if (MASKED) rm = keep ? rm : -INFINITY;
        const bool fresh = st.l == 0.f;
        const bool mv = rm > THR || (fresh && rm < -20.f && rm > -INFINITY);
        if (__any(mv)) {
            const float dl = mv ? (fresh ? rm : __builtin_fmaxf(rm, 0.f)) : 0.f;
            const float f = fresh ? 1.f : __builtin_amdgcn_exp2f(-dl);
            st.l *= f; st.mhat += dl;
#pragma unroll
            for (int r = 0; r < 16; ++r) { p0[r] -= dl; p1[r] -= dl; }
            st.cval -= dl;
            if (MODE == 0) {
                if (hi == 0) wsf[r32] = f;
#pragma unroll
                for (int r = 0; r < 16; ++r) { const float fr = wsf[crow(r, hi)];
#pragma unroll
                    for (int d = 0; d < ND; ++d) st.o[d][r] *= fr; }
            }
        }
    }
    float s0 = 0.f, s1 = 0.f;
#pragma unroll
    for (int r = 0; r < 16; ++r) { p0[r] = __builtin_amdgcn_exp2f(p0[r]); p1[r] = __builtin_amdgcn_exp2f(p1[r]); s0 += p0[r]; s1 += p1[r]; }
    if (MODE != 2) { const float sm = s0 + s1; st.l += MASKED ? (keep ? sm : 0.f) : sm; }
    if (MODE == 2) {
#pragma unroll
        for (int r = 0; r < 16; ++r) { p0[r] *= rl; p1[r] *= rl; }
    }
    if (MODE == 1) return;
#pragma unroll
    for (int k = 0; k < 2; ++k)
#pragma unroll
        for (int j = 0; j < 4; ++j) { pw[k][j] = cvtpk(p0[8 * k + 2 * j], p0[8 * k + 2 * j + 1]); pw[2 + k][j] = cvtpk(p1[8 * k + 2 * j], p1[8 * k + 2 * j + 1]); }
    if (MASKED) { const unsigned km = keep ? 0xffffffffu : 0u;
#pragma unroll
        for (int k = 0; k < 4; ++k)
#pragma unroll
            for (int j = 0; j < 4; ++j) pw[k][j] &= km; }
}
template <int ND>
__device__ __forceinline__ void pv_acc(St<ND>& st, const u32x4 (&pw)[4], lds_cptr vp) {
    if constexpr (ND == 2) {
        s16x4 lo[2][4], hh[2][4];
#pragma unroll
        for (int d0 = 0; d0 < 2; ++d0)
#pragma unroll
            for (int ks = 0; ks < 4; ++ks) { lo[d0][ks] = vtr(vp + d0 * 4096 + ks * 1024); hh[d0][ks] = vtr(vp + d0 * 4096 + ks * 1024 + 512); }
        __builtin_amdgcn_sched_barrier(0);
#pragma unroll
        for (int ks = 0; ks < 4; ++ks)
#pragma unroll
            for (int d0 = 0; d0 < 2; ++d0) {
                const bf16x8 vf = (bf16x8){lo[d0][ks][0], lo[d0][ks][1], lo[d0][ks][2], lo[d0][ks][3], hh[d0][ks][0], hh[d0][ks][1], hh[d0][ks][2], hh[d0][ks][3]};
                st.o[d0] = __builtin_amdgcn_mfma_f32_32x32x16_bf16(__builtin_bit_cast(bf16x8, pw[ks]), vf, st.o[d0], 0, 0, 0);
            }
        return;
    }
#pragma unroll
    for (int d0 = 0; d0 < ND; ++d0) {
        s16x4 lo[4], hh[4];
#pragma unroll
        for (int ks = 0; ks < 4; ++ks) { lo[ks] = vtr(vp + d0 * 4096 + ks * 1024); hh[ks] = vtr(vp + d0 * 4096 + ks * 1024 + 512); }
        __builtin_amdgcn_sched_barrier(0);
#pragma unroll
        for (int ks = 0; ks < 4; ++ks) {
            const bf16x8 vf = (bf16x8){lo[ks][0], lo[ks][1], lo[ks][2], lo[ks][3], hh[ks][0], hh[ks][1], hh[ks][2], hh[ks][3]};
            st.o[d0] = __builtin_amdgcn_mfma_f32_32x32x16_bf16(__builtin_bit_cast(bf16x8, pw[ks]), vf, st.o[d0], 0, 0, 0);
        }
    }
}
template <bool WIN>
__device__ __forceinline__ void fix_near(f32x16& p0, f32x16& p1, int tq, int kbase, int kstep, const LAS3 float* bl, int hi) {
    const int relb = tq - kbase - kstep * 4 * hi;
    float b0[16], b1[16];
#pragma unroll
    for (int r = 0; r < 16; ++r) { const int rel0 = relb - kstep * ((r & 3) + 8 * (r >> 2)), rel1 = rel0 - 32 * kstep;
        b0[r] = bl[rel0 < 0 ? 0 : (rel0 > 127 ? 127 : rel0)]; b1[r] = bl[rel1 < 0 ? 0 : (rel1 > 127 ? 127 : rel1)]; }
#pragma unroll
    for (int r = 0; r < 16; ++r) { asm volatile("" : "+v"(b0[r]), "+v"(b1[r])); }
#pragma unroll
    for (int r = 0; r < 16; ++r) { const int rel0 = relb - kstep * ((r & 3) + 8 * (r >> 2)), rel1 = rel0 - 32 * kstep;
        const bool k0 = rel0 >= 0 && (!WIN || rel0 < 512), k1 = rel1 >= 0 && (!WIN || rel1 < 512);
        p0[r] = k0 ? p0[r] + b0[r] : -INFINITY; p1[r] = k1 ? p1[r] + b1[r] : -INFINITY; }
}
template <bool WIN>
__device__ __forceinline__ void fix_near4(f32x16& p0, f32x16& p1, int tq, int kbase, const LAS3 float* cs, int hi) {
    const int relb = tq - kbase - 4 * hi;
    f32x4 v0[4], v1[4];
#pragma unroll
    for (int q = 0; q < 4; ++q) { const int ua = relb - 8 * q - 3, ub = ua - 32;
        const int a = ua < -3 ? 0 : (ua > 128 ? 131 : ua + 3), b = ub < -3 ? 0 : (ub > 128 ? 131 : ub + 3);
        v0[q] = *(const LAS3 f32x4*)(cs + (a & 3) * 136 + (a & ~3)); v1[q] = *(const LAS3 f32x4*)(cs + (b & 3) * 136 + (b & ~3)); }
#pragma unroll
    for (int q = 0; q < 4; ++q) { asm volatile("" : "+v"(v0[q]), "+v"(v1[q])); }
#pragma unroll
    for (int q = 0; q < 4; ++q)
#pragma unroll
        for (int e2 = 0; e2 < 4; ++e2) { const int rel0 = relb - 8 * q - e2, rel1 = rel0 - 32;
            const bool k0 = rel0 >= 0 && (!WIN || rel0 < 512), k1 = rel1 >= 0 && (!WIN || rel1 < 512);
            p0[4 * q + e2] = k0 ? p0[4 * q + e2] + v0[q][3 - e2] : -INFINITY; p1[4 * q + e2] = k1 ? p1[4 * q + e2] + v1[q][3 - e2] : -INFINITY; }
}
constexpr int L_FIX4 = 147456;
__device__ __forceinline__ void build_fix4(LAS3 float* dst, const LAS3 float* bd, int nheads, int tid) {
    for (int i = tid; i < nheads * 544; i += 512) { const int hd = i / 544, r = i - hd * 544, sft = r / 136, kk = r - sft * 136; const int bi = kk + sft - 3;
        dst[i] = bd[hd * 128 + (bi < 0 ? 0 : (bi > 127 ? 127 : bi))]; }
}
__device__ __forceinline__ void kill_tile(f32x16& p0, f32x16& p1, bool keep) {
#pragma unroll
    for (int r = 0; r < 16; ++r) { p0[r] = keep ? p0[r] : -INFINITY; p1[r] = keep ? p1[r] : -INFINITY; }
}
template <int NKM, int ND>
__device__ __forceinline__ void issue_tile(const bf16* kg, int kpitch, const bf16* vg, int vpitch, int krow0, unsigned slot, int wid, int lane) {
#pragma unroll
    for (int m = 0; m < NKM; ++m) glds16(kg + (size_t)(krow0 + lane) * kpitch + m * 64 + wid * 8, (unsigned)__builtin_amdgcn_readfirstlane(slot + m * 8192 + wid * 1024));
#pragma unroll
    for (int j = 0; j < ND / 2; ++j) { const int pi = wid + 8 * j;
        glds16(vg + (size_t)(krow0 + 16 * (pi & 3) + (lane >> 2)) * vpitch + (pi >> 2) * 32 + (lane & 3) * 8, (unsigned)__builtin_amdgcn_readfirstlane(slot + NKM * 8192 + pi * 1024)); }
}
#ifndef ATT_STAGGER
#define ATT_STAGGER 0
#endif
#if ATT_STAGGER
template <int NKM, int ND, class KRow, class H1, class H2>
__device__ __forceinline__ void run_stream(char* lds, const bf16* kg, int kpitch, const bf16* vg, int vpitch, int n, KRow krow, H1 h1, H2 h2, int wid, int lane) {
    constexpr int SLOTB = NKM * 8192 + ND * 4096;
    const unsigned lds0 = (unsigned)(uintptr_t)lds + L_RING;
    const bool late = wid >= 4;
    ATT_BAR();
    __builtin_amdgcn_s_waitcnt(0x0F70);
    if (n <= 0) return;
    issue_tile<NKM, ND>(kg, kpitch, vg, vpitch, krow(0), lds0, wid, lane);
    if (n > 1) issue_tile<NKM, ND>(kg, kpitch, vg, vpitch, krow(1), lds0 + SLOTB, wid, lane);
#define ATT_WB(more) do { if (more) { if (NKM + ND / 2 == 2) ATT_WAIT_BAR(2); else if (NKM + ND / 2 == 3) ATT_WAIT_BAR(3); else ATT_WAIT_BAR(4); } else ATT_WAIT_BAR(0); } while (0)
    if (late) ATT_WB(n > 1);
    int s_prev = 2 * SLOTB, s_cur = 0, s_nxt = SLOTB;
    for (int k = 0; k < n; ++k) {
        if (late) { ATT_BAR(); if (k + 2 < n) issue_tile<NKM, ND>(kg, kpitch, vg, vpitch, krow(k + 2), lds0 + s_prev, wid, lane); }
        else ATT_WB(k + 1 < n);
        h1(k, L_RING + s_cur);
        if (late) ATT_WB(k + 2 < n);
        else { ATT_BAR(); if (k + 2 < n) issue_tile<NKM, ND>(kg, kpitch, vg, vpitch, krow(k + 2), lds0 + s_prev, wid, lane); }
        h2(k, L_RING + s_cur);
        const int t = s_prev; s_prev = s_cur; s_cur = s_nxt; s_nxt = t;
    }
    if (!late) ATT_BAR();
#undef ATT_WB
}
#else
template <int NKM, int ND, class KRow, class H1, class H2>
__device__ __forceinline__ void run_stream(char* lds, const bf16* kg, int kpitch, const bf16* vg, int vpitch, int n, KRow krow, H1 h1, H2 h2, int wid, int lane) {
    constexpr int SLOTB = NKM * 8192 + ND * 4096;
    const unsigned lds0 = (unsigned)(uintptr_t)lds + L_RING;
    ATT_BAR();
    __builtin_amdgcn_s_waitcnt(0x0F70);
    if (n <= 0) return;
    issue_tile<NKM, ND>(kg, kpitch, vg, vpitch, krow(0), lds0, wid, lane);
    if (n > 1) issue_tile<NKM, ND>(kg, kpitch, vg, vpitch, krow(1), lds0 + SLOTB, wid, lane);
    int s_cur = 0, s_nxt = SLOTB, s_nn = 2 * SLOTB;
#if ATT_PROBE
    unsigned long long tw = 0, t1 = 0, t2 = 0, ti = 0;
#endif
    for (int k = 0; k < n; ++k) {
        ATT_TS(a0);
        if (k + 1 < n) { if (NKM + ND / 2 == 2) ATT_WAIT_BAR(2); else if (NKM + ND / 2 == 3) ATT_WAIT_BAR(3); else ATT_WAIT_BAR(4); }
        else ATT_WAIT_BAR(0);
        ATT_TS(a1);
        if (k + 2 < n) issue_tile<NKM, ND>(kg, kpitch, vg, vpitch, krow(k + 2), lds0 + s_nn, wid, lane);
        ATT_TS(a2);
        h1(k, L_RING + s_cur);
        ATT_TS(a3);
        h2(k, L_RING + s_cur);
#if ATT_PROBE
        asm volatile("s_waitcnt lgkmcnt(0)" ::: "memory");
        ATT_TS(a4);
        tw += a1 - a0; ti += a2 - a1; t1 += a3 - a2; t2 += a4 - a3;
#endif
        const int t = s_cur; s_cur = s_nxt; s_nxt = s_nn; s_nn = t;
    }
#if ATT_PROBE
    if (blockIdx.x == ATT_PROBE_BLOCK && wid == ATT_PROBE_WAVE && lane == 0) { g_dbg[0] += tw; g_dbg[1] += ti; g_dbg[2] += t1; g_dbg[3] += t2; g_dbg[4] += (unsigned long long)n; }
#endif
}
#endif
struct TInfo { int kbase; bool near, win, masked, keep; };
#define ATT_PIN(x) asm volatile("" : "+v"(x))
#define ATT_SB() __builtin_amdgcn_sched_barrier(0)
template <int NKM, int ND, class KRow, class TI>
__device__ __forceinline__ void run_pipe(char* lds, St<ND>& st, const bf16x8 (&qr)[4], const bf16* kg, int kpitch, const bf16* vg, int vpitch, int n, KRow krow, TI tinfo,
                                         int koff, const LAS3 float* bl, int tq, LAS3 float* wsf, int wid, int lane) {
    constexpr int SLOTB = NKM * 8192 + ND * 4096, CNT = NKM + ND / 2;
    static_assert(CNT == 2 || CNT == 4, "wait literals");
    const int r32 = lane & 31, hi = lane >> 5;
    LAS3 char* l3 = (LAS3 char*)lds;
    const unsigned lds0 = (unsigned)(uintptr_t)lds + L_RING;
    const int vlane = NKM * 8192 + ((lane >> 4) & 1) * 32 + (lane & 3) * 8 + (4 * hi + ((lane & 15) >> 2)) * 64;
    const int klane = koff + hi * 1024 + r32 * 16;
    const unsigned kvoff = (unsigned)(lane * kpitch + wid * 8) * 2u;
    const unsigned vvoff = (unsigned)((16 * (wid & 3) + (lane >> 2)) * vpitch + (wid >> 2) * 32 + (lane & 3) * 8) * 2u;
    auto issue = [&](int t, unsigned slot) __attribute__((always_inline)) {
        const int kr = __builtin_amdgcn_readfirstlane(krow(t));
        const bf16* kb = kg + (size_t)kr * kpitch; const bf16* vb = vg + (size_t)kr * vpitch;
#pragma unroll
        for (int m = 0; m < NKM; ++m) glds16s(kb + m * 64, kvoff, (unsigned)__builtin_amdgcn_readfirstlane(slot + m * 8192 + wid * 1024));
#pragma unroll
        for (int j = 0; j < ND / 2; ++j) glds16s(vb + j * 64, vvoff, (unsigned)__builtin_amdgcn_readfirstlane(slot + NKM * 8192 + (wid + 8 * j) * 1024));
    };
    ATT_BAR();
    __builtin_amdgcn_s_waitcnt(0x0F70);
    if (n <= 0) return;
#pragma unroll
    for (int t = 0; t < 3; ++t) if (t < n) issue(t, lds0 + t * SLOTB);
    if (n >= 3) { if (CNT == 2) ATT_WAIT_BAR(4); else ATT_WAIT_BAR(8); } else if (n == 2) { if (CNT == 2) ATT_WAIT_BAR(2); else ATT_WAIT_BAR(4); } else ATT_WAIT_BAR(0);
    f32x16 pA0, pA1, pB0, pB1; TInfo iS = tinfo(0);
    qk_tile(pA0, pA1, (lds_cptr)l3 + L_RING + klane, qr, (iS.masked && !iS.keep) ? -INFINITY : st.cval);
    if (iS.near) { if (iS.win) fix_near4<true>(pA0, pA1, tq, iS.kbase, bl, hi); else fix_near4<false>(pA0, pA1, tq, iS.kbase, bl, hi); }
    float rmS = rowmax(pA0, pA1);
    int s0 = 0, s1 = SLOTB, s2 = 2 * SLOTB, s3 = 3 * SLOTB;
    auto step = [&](int k, f32x16& pS0, f32x16& pS1, f32x16& pN0, f32x16& pN1) __attribute__((always_inline)) {
        const bool hasN = k + 1 < n;
        ATT_TP(a0);
        if (k + 2 < n) { if (CNT == 2) ATT_WAIT_BAR(2); else ATT_WAIT_BAR(4); } else ATT_WAIT_BAR(0);
        ATT_TP(a1);
        ATT_TP(a2);
        bf16x8 kfa[4];
        const lds_cptr kpn = (lds_cptr)l3 + L_RING + s1 + klane;
        TInfo iN = iS;
#pragma unroll
        for (int d0 = 0; d0 < 2; ++d0) { kfa[2 * d0] = *(const LAS3 bf16x8*)(kpn + d0 * 2048); kfa[2 * d0 + 1] = *(const LAS3 bf16x8*)(kpn + d0 * 2048 + 512); }
        if (hasN) iN = tinfo(k + 1);
        {   const float rm = rmS;
            const bool fresh = st.l == 0.f;
            const bool mv = rm > THR || (fresh && rm < -20.f && rm > -INFINITY);
            if (__any(mv)) {
                const float dl = mv ? (fresh ? rm : __builtin_fmaxf(rm, 0.f)) : 0.f;
                const float f = fresh ? 1.f : __builtin_amdgcn_exp2f(-dl);
                st.l *= f; st.mhat += dl;
#pragma unroll
                for (int r = 0; r < 16; ++r) { pS0[r] -= dl; pS1[r] -= dl; }
                st.cval -= dl;
                if (hi == 0) wsf[r32] = f;
#pragma unroll
                for (int r = 0; r < 16; ++r) { const float fr = wsf[crow(r, hi)];
#pragma unroll
                    for (int d = 0; d < ND; ++d) st.o[d][r] *= fr; }
            }
        }
        ATT_SB();
        ATT_TP(a2b);
        {
            const f32x16 c16 = splat16((iN.masked && !iN.keep) ? -INFINITY : st.cval);
#pragma unroll
            for (int i = 0; i < 8; ++i) { const int d0 = i >> 1;
                const bf16x8 kfr = kfa[i & 3];
                if ((i & 1) == 0) pN0 = __builtin_amdgcn_mfma_f32_32x32x16_bf16(kfr, qr[d0], d0 == 0 ? c16 : pN0, 0, 0, 0);
                else pN1 = __builtin_amdgcn_mfma_f32_32x32x16_bf16(kfr, qr[d0], d0 == 0 ? c16 : pN1, 0, 0, 0);
                if (i < 4) kfa[i] = *(const LAS3 bf16x8*)(kpn + ((4 + i) >> 1) * 2048 + ((4 + i) & 1) * 512);
                if (i < 4) {
#pragma unroll
                    for (int e = 0; e < 4; ++e) { float t = __builtin_amdgcn_exp2f(pS0[4 * i + e]); ATT_PIN(t); pS0[4 * i + e] = t; }
                } else {
#pragma unroll
                    for (int e = 0; e < 4; ++e) { float t = __builtin_amdgcn_exp2f(pS1[4 * (i - 4) + e]); ATT_PIN(t); pS1[4 * (i - 4) + e] = t; }
                }
                ATT_SB(); }
        }
        ATT_TP(a2c);
        if (hasN && iN.near) { if (iN.win) fix_near4<true>(pN0, pN1, tq, iN.kbase, bl, hi); else fix_near4<false>(pN0, pN1, tq, iN.kbase, bl, hi); }
        ATT_SB();
        ATT_TP(a3);
        {   const lds_cptr vp = (lds_cptr)l3 + L_RING + s0 + vlane;
            u32x4 pw[4]; s16x4 lo[4], hh[4];
#pragma unroll
            for (int ks = 0; ks < 4; ++ks) { lo[ks] = vtr(vp + ks * 1024); hh[ks] = vtr(vp + ks * 1024 + 512); }
#pragma unroll
            for (int j = 0; j < 4; ++j) pw[0][j] = cvtpk(pS0[2 * j], pS0[2 * j + 1]);
            f32x2_t sa = {0.f, 0.f}, sb = {0.f, 0.f}; float ma = -INFINITY, mb = -INFINITY;
            ATT_SB();
#pragma unroll
            for (int d0 = 0; d0 < ND; ++d0) {
#pragma unroll
                for (int ks = 0; ks < 4; ++ks) {
                    const bf16x8 vf = (bf16x8){lo[ks][0], lo[ks][1], lo[ks][2], lo[ks][3], hh[ks][0], hh[ks][1], hh[ks][2], hh[ks][3]};
                    st.o[d0] = __builtin_amdgcn_mfma_f32_32x32x16_bf16(__builtin_bit_cast(bf16x8, pw[ks]), vf, st.o[d0], 0, 0, 0);
                    if (d0 == 0 && ks < 3) {
                        const int q = ks + 1;
#pragma unroll
                        for (int j = 0; j < 4; ++j) pw[q][j] = (q < 2 ? cvtpk(pS0[8 * q + 2 * j], pS0[8 * q + 2 * j + 1]) : cvtpk(pS1[8 * (q - 2) + 2 * j], pS1[8 * (q - 2) + 2 * j + 1]));
                    }
                    const int g = d0 * 4 + ks;
                    if (g < 4) { sa += (f32x2_t){pS0[4 * g], pS0[4 * g + 1]}; sa += (f32x2_t){pS0[4 * g + 2], pS0[4 * g + 3]}; ATT_PIN(sa);
                        ma = ATT_MX3(ma, pN0[4 * g], pN0[4 * g + 1]); ma = ATT_MX3(ma, pN0[4 * g + 2], pN0[4 * g + 3]); ATT_PIN(ma); }
                    else if (g < 8) { sb += (f32x2_t){pS1[4 * (g - 4)], pS1[4 * (g - 4) + 1]}; sb += (f32x2_t){pS1[4 * (g - 4) + 2], pS1[4 * (g - 4) + 3]}; ATT_PIN(sb);
                        mb = ATT_MX3(mb, pN1[4 * (g - 4)], pN1[4 * (g - 4) + 1]); mb = ATT_MX3(mb, pN1[4 * (g - 4) + 2], pN1[4 * (g - 4) + 3]); ATT_PIN(mb); }
                    if (g == 1 && k + 3 < n) issue(k + 3, lds0 + s3);
                    if (ks == 3 && d0 + 1 < ND) {
#pragma unroll
                        for (int k2 = 0; k2 < 4; ++k2) { lo[k2] = vtr(vp + (d0 + 1) * 4096 + k2 * 1024); hh[k2] = vtr(vp + (d0 + 1) * 4096 + k2 * 1024 + 512); }
                    }
                    ATT_SB();
                }
            }
            const f32x2_t s2 = sa + sb; st.l += s2.x + s2.y;
            { const float m = __builtin_fmaxf(ma, mb); auto rr = __builtin_amdgcn_permlane32_swap(__float_as_uint(m), __float_as_uint(m), false, false);
                rmS = __builtin_fmaxf(__uint_as_float(rr[0]), __uint_as_float(rr[1])); }
        }
#if ATT_PROBE
        asm volatile("s_waitcnt lgkmcnt(0)" ::: "memory");
        ATT_TP(a4);
        if ((ATT_PROBE_PHASE == 2) == (NKM == 2) && blockIdx.x == ATT_PROBE_BLOCK && wid == ATT_PROBE_WAVE && lane == 0) { g_dbg[0] += a1 - a0; g_dbg[1] += a2 - a1; g_dbg[2] += a3 - a2; g_dbg[3] += a4 - a3; g_dbg[4] += 1ull; g_dbg[5] += a2b - a2; g_dbg[6] += a2c - a2b; g_dbg[7] += a3 - a2c; }
#endif
        iS = iN;
        const int t = s0; s0 = s1; s1 = s2; s2 = s3; s3 = t;
    };
    int k = 0;
    for (; k + 2 <= n; k += 2) { step(k, pA0, pA1, pB0, pB1); step(k + 1, pB0, pB1, pA0, pA1); }
    if (k < n) step(k, pA0, pA1, pB0, pB1);
}

__device__ __forceinline__ void rowfac(float (&fr)[16], float f, LAS3 float* wsf, int r32, int hi) {
    if (hi == 0) wsf[r32] = f;
#pragma unroll
    for (int r = 0; r < 16; ++r) fr[r] = wsf[crow(r, hi)];
}
template <int ND>
__device__ __forceinline__ void stage_o(const f32x16 (&o)[ND], LAS3 bf16* stg, int r32, int hi) {
#pragma unroll
    for (int r = 0; r < 16; ++r) { const int orow = crow(r, hi);
#pragma unroll
        for (int d0 = 0; d0 < ND; ++d0) stg[orow * (32 * ND) + d0 * 32 + r32] = (bf16)f2bf(o[d0][r]); }
}

constexpr int MB_KM = 65536, MB_RM = 73728, MB_UNI = 74752, MB_PB = 74756, MB_G = 74944;
__device__ __forceinline__ void moba_unit(const PP& p, char* lds, int b, int h, int c, int tid) {
    const int lane = tid & 63, r32 = lane & 31, hi = lane >> 5; const int wid = __builtin_amdgcn_readfirstlane(tid >> 6);
    LAS3 char* l3 = (LAS3 char*)lds;
    LAS3 float* KM = (LAS3 float*)(l3 + MB_KM); LAS3 unsigned* RM = (LAS3 unsigned*)(l3 + MB_RM); LAS3 unsigned* UNI = (LAS3 unsigned*)(l3 + MB_UNI); LAS3 int* PB = (LAS3 int*)(l3 + MB_PB); LAS3 float* Gs = (LAS3 float*)(l3 + MB_G);
    LAS3 float* wsf = (LAS3 float*)(l3 + L_WSF) + wid * 64; const LAS3 float* bl = (const LAS3 float*)(l3 + L_BIAS) + h * 128;
    ATT_T(u0);
    const size_t rowbase = (size_t)b * SEQ; const int q0 = c * 256;
    const bf16* Qg = p.PROJ + rowbase * NP1 + h * 64; const bf16* Kg = p.PROJ + rowbase * NP1 + 1024 + h * 64; const bf16* Vg = p.PROJ + rowbase * NP1 + 2048 + h * 64;
    ATT_BAR();
    if (tid == 0) UNI[0] = 0u;
    const int tq = q0 + wid * 32 + r32;
    bf16x8 qr[4];
#pragma unroll
    for (int d0 = 0; d0 < 4; ++d0) qr[d0] = *(const bf16x8*)(Qg + (size_t)tq * NP1 + d0 * 16 + hi * 8);
    unsigned mymask;
    {   f32x16 g = f32x16{};
        const float* km0 = p.KMP + ((size_t)(b * 16 + h) * 32 + r32) * 64 + hi * 8; const float* km1 = km0 + (size_t)2 * 16 * 32 * 64;
#pragma unroll
        for (int d0 = 0; d0 < 4; ++d0) {
            const f32x4 a0 = *(const f32x4*)(km0 + d0 * 16), a1 = *(const f32x4*)(km0 + d0 * 16 + 4), c0 = *(const f32x4*)(km1 + d0 * 16), c1 = *(const f32x4*)(km1 + d0 * 16 + 4);
            float v[8] = {a0.x + c0.x, a0.y + c0.y, a0.z + c0.z, a0.w + c0.w, a1.x + c1.x, a1.y + c1.y, a1.z + c1.z, a1.w + c1.w};
            bf16x8 fh, fl;
#pragma unroll
            for (int j = 0; j < 8; ++j) { const float x = v[j] * (1.0f / 256.f); const unsigned hb = f2bf(x); fh[j] = (short)hb; fl[j] = (short)f2bf(x - bf2f(hb)); }
            g = __builtin_amdgcn_mfma_f32_32x32x16_bf16(fh, qr[d0], g, 0, 0, 0);
            g = __builtin_amdgcn_mfma_f32_32x32x16_bf16(fl, qr[d0], g, 0, 0, 0);
        }
        if (c <= 3) mymask = (1u << c) - 1u;
        else {
        float xo[16], xt[16]; float t1 = -INFINITY, t2 = -INFINITY, t3 = -INFINITY;
#pragma unroll
        for (int r = 0; r < 16; ++r) { const float own = g[r];
            auto rr = __builtin_amdgcn_permlane32_swap(__float_as_uint(own), __float_as_uint(own), false, false);
            const float oth = hi ? __uint_as_float(rr[0]) : __uint_as_float(rr[1]);
            xo[r] = crow(r, hi) < c ? own : -INFINITY; xt[r] = crow(r, hi ^ 1) < c ? oth : -INFINITY;
            { const float x = xo[r]; const float n2 = __builtin_amdgcn_fmed3f(t1, x, t2), n3 = __builtin_amdgcn_fmed3f(t2, x, t3); t1 = __builtin_fmaxf(t1, x); t2 = n2; t3 = n3; }
            { const float x = xt[r]; const float n2 = __builtin_amdgcn_fmed3f(t1, x, t2), n3 = __builtin_amdgcn_fmed3f(t2, x, t3); t1 = __builtin_fmaxf(t1, x); t2 = n2; t3 = n3; } }
        unsigned gt = 0u, ge = 0u; const int sh = 4 * hi, sht = 4 * (hi ^ 1);
#pragma unroll
        for (int r = 0; r < 16; ++r) { const unsigned bo = (1u << ((r & 3) + 8 * (r >> 2))) << sh, bt = (1u << ((r & 3) + 8 * (r >> 2))) << sht;
            gt |= xo[r] > t3 ? bo : 0u; ge |= xo[r] >= t3 ? bo : 0u; gt |= xt[r] > t3 ? bt : 0u; ge |= xt[r] >= t3 ? bt : 0u; }
        unsigned eq = ge & ~gt, sel = gt; int need = 3 - __builtin_popcount(gt);
#pragma unroll
        for (int i = 0; i < 3; ++i) { const bool take = need > 0 && eq != 0u; const unsigned low = eq & (0u - eq); sel |= take ? low : 0u; eq = take ? (eq & (eq - 1u)) : eq; need -= take ? 1 : 0; }
        mymask = sel;
        }
        unsigned m = mymask;
#pragma unroll
        for (int o = 1; o < 32; o <<= 1) m |= __shfl_xor(m, o);
        ATT_BAR();
        if (lane == 0) __hip_atomic_fetch_or(UNI, m, __ATOMIC_RELAXED, __HIP_MEMORY_SCOPE_WORKGROUP);
    }
    ATT_BAR();
    if (tid == 0) { unsigned u = UNI[0]; int i = 0; while (u) { PB[i++] = __builtin_ctz(u); u &= u - 1u; } }
    ATT_BAR();
    const unsigned uni = UNI[0];
    const int npast = __builtin_popcount(uni), ntile = 4 * npast + 4;
    const float bfar = ((const LAS3 float*)(l3 + L_MISC + 64))[h];
    St<2> st; st_init(st, bfar);
    auto blk_of = [&](int k) -> int { const int i = k >> 2; return i < npast ? PB[i] : c; };
    auto krow = [&](int k) -> int { return blk_of(k) * 256 + (k & 3) * 64; };
    ATT_T(u1);
    auto tinfo = [&](int k) -> TInfo { const int n = blk_of(k), j = k & 3; TInfo t; t.kbase = n * 256 + j * 64; const bool own = n == c;
        t.near = own || (n == c - 1 && j >= 2); t.win = false; t.masked = !own; t.keep = own ? true : ((mymask >> n) & 1u) != 0u; return t; };
    run_pipe<1, 2>(lds, st, qr, Kg, NP1, Vg, NP1, ntile, krow, tinfo, 0, bl, tq, wsf, wid, lane);
    ATT_T(u2);
    const float lt = halfsum(st.l); float fr[16]; rowfac(fr, lt > 0.f ? 1.0f / lt : 0.f, wsf, r32, hi);
#pragma unroll
    for (int r = 0; r < 16; ++r) { st.o[0][r] *= fr[r]; st.o[1][r] *= fr[r]; }
    LAS3 bf16* stg = (LAS3 bf16*)(l3 + L_OST) + wid * 2048;
    stage_o<2>(st.o, stg, r32, hi);
    bf16* Ow = p.OC + (rowbase + q0 + wid * 32) * DM + h * 64;
#pragma unroll
    for (int i = 0; i < 4; ++i) { const int row = i * 8 + (lane >> 3), ch = lane & 7; const u32x4 v = *(const LAS3 u32x4*)(stg + row * 64 + ch * 8); *(u32x4*)(Ow + (size_t)row * DM + ch * 8) = v; }
#if ATT_PROBE && ATT_PROBE_PHASE == 8
    { ATT_T(u3); if (blockIdx.x == ATT_PROBE_BLOCK && wid == ATT_PROBE_WAVE && lane == 0) { g_dbg[8] += u1 - u0; g_dbg[9] += u2 - u1; g_dbg[10] += u3 - u2; g_dbg[11] += 1ull; } }
#endif
}
__device__ __forceinline__ void copy_bias_lds(const PP& p, char* lds, int tid) {
    LAS3 float* B = (LAS3 float*)((LAS3 char*)lds + L_BIAS); LAS3 float* BF = (LAS3 float*)((LAS3 char*)lds + L_MISC + 64);
    for (int i = tid; i < 16 * 128; i += NTHR) B[i] = p.BIASL[i] - p.BIASL[(i & ~127) + 127];
    if (tid < 16) BF[tid] = p.BIASL[tid * 128 + 127];
}
__device__ __forceinline__ void moba_phase(const PP& p, char* lds, int tid, int bid, int G) {
#if ATT_PROBE && ATT_PROBE_PHASE == 8
    if (bid == ATT_PROBE_BLOCK && tid == ATT_PROBE_WAVE * 64) { for (int i = 0; i < 16; ++i) g_dbg[i] = 0ull; }
#endif
    copy_bias_lds(p, lds, tid);
    const int vcu = (G % 8 == 0) ? (bid % 8) * (G / 8) + bid / 8 : bid;
    const bool bal = G == 256; const int nu = bal ? 4 : (1024 - bid + G - 1) / G;
#pragma unroll 1
    for (int i = 0; i < nu; ++i) { int bh, c;
        if (bal) { const int s_ = vcu & 7; bh = vcu >> 3; c = i == 0 ? 31 - s_ : (i == 1 ? 16 + s_ : (i == 2 ? 15 - s_ : s_)); }
        else { const int u = bid + i * G; bh = u >> 5; c = 31 - (u & 31); }
        moba_unit(p, lds, bh >> 4, bh & 15, c, tid); }
    ATT_BAR();
}

__device__ __forceinline__ void diff_unit(const PP& p, char* lds, int b, int h, int qt, int tid, float lam) {
    const int lane = tid & 63, r32 = lane & 31, hi = lane >> 5; const int wid = __builtin_amdgcn_readfirstlane(tid >> 6); const int mp = wid >> 2, wq = wid & 3;
    LAS3 char* l3 = (LAS3 char*)lds;
    LAS3 float* wsf = (LAS3 float*)(l3 + L_WSF) + wid * 64; const LAS3 float* bl = (const LAS3 float*)(l3 + L_BIAS) + (8 + h) * 128;
    const size_t rowbase = (size_t)b * SEQ; const int q0 = qt * 128; const int tq = q0 + wq * 32 + r32;
    const bf16* Qg = p.PROJ + rowbase * NP0 + C_DQ + h * 128 + mp * 64; const bf16* Kg = p.PROJ + rowbase * NP0 + C_DK + h * 128; const bf16* Vg = p.PROJ + rowbase * NP0 + C_DV + h * 128;
    bf16x8 qr[4];
#pragma unroll
    for (int d0 = 0; d0 < 4; ++d0) qr[d0] = *(const bf16x8*)(Qg + (size_t)tq * NP0 + d0 * 16 + hi * 8);
    const float bfar = ((const LAS3 float*)(l3 + L_MISC + 64))[8 + h];
    St<4> st; st_init(st, bfar);
    const int NT = 2 * (qt + 1);
    auto krow = [&](int k) -> int { return 64 * k; };
    auto tinfo = [&](int k) -> TInfo { TInfo t; t.kbase = 64 * k; t.near = k >= NT - 4; t.win = false; t.masked = false; t.keep = true; return t; };
    LAS3 float* cs4 = (LAS3 float*)(l3 + L_FIX4);
    build_fix4(cs4, (const LAS3 float*)(l3 + L_BIAS) + (8 + h) * 128, 1, tid);
    run_pipe<2, 4>(lds, st, qr, Kg, NP0, Vg, NP0, NT, krow, tinfo, mp * 8192, cs4, tq, wsf, wid, lane);
    const float lt = halfsum(st.l); float fr[16]; rowfac(fr, lt > 0.f ? 1.0f / lt : 0.f, wsf, r32, hi);
    ATT_BAR();
    LAS3 float* OL = (LAS3 float*)l3 + (size_t)mp * 128 * 128;
#pragma unroll
    for (int r = 0; r < 16; ++r) { const int row = wq * 32 + crow(r, hi);
#pragma unroll
        for (int d0 = 0; d0 < 4; ++d0) OL[row * 128 + d0 * 32 + r32] = st.o[d0][r] * fr[r]; }
    ATT_BAR();
    {   const int row = tid >> 2, part = tid & 3; const LAS3 float* o1 = (const LAS3 float*)l3 + row * 128 + part * 32; const LAS3 float* o2 = o1 + 128 * 128;
        float v[32]; float ss = 0.f;
#pragma unroll
        for (int j = 0; j < 32; j += 4) { const f32x4 a = *(const LAS3 f32x4*)(o1 + j), c = *(const LAS3 f32x4*)(o2 + j);
            v[j] = a.x - lam * c.x; v[j + 1] = a.y - lam * c.y; v[j + 2] = a.z - lam * c.z; v[j + 3] = a.w - lam * c.w;
            ss += (v[j] * v[j] + v[j + 1] * v[j + 1]) + (v[j + 2] * v[j + 2] + v[j + 3] * v[j + 3]); }
        ss += dpp_x1(ss); ss += dpp_x2(ss);
        const float rs = 0.8f / sqrtf(ss * (1.0f / 128.f) + EPS);
        bf16* dst = p.OC + (rowbase + q0 + row) * DM + 512 + h * 128 + part * 32; const float* sg = p.subln + part * 32;
#pragma unroll
        for (int j = 0; j < 32; j += 8) { u32x4 w;
            w.x = pk2(v[j] * rs * sg[j], v[j + 1] * rs * sg[j + 1]); w.y = pk2(v[j + 2] * rs * sg[j + 2], v[j + 3] * rs * sg[j + 3]);
            w.z = pk2(v[j + 4] * rs * sg[j + 4], v[j + 5] * rs * sg[j + 5]); w.w = pk2(v[j + 6] * rs * sg[j + 6], v[j + 7] * rs * sg[j + 7]);
            *(u32x4*)(dst + j) = w; }
    }
}
__device__ __forceinline__ void diff_phase(const PP& p, char* lds, int tid, int bid, int G) {
#if ATT_PROBE && ATT_PROBE_PHASE == 2
    if (bid == ATT_PROBE_BLOCK && tid == ATT_PROBE_WAVE * 64) { for (int i = 0; i < 16; ++i) g_dbg[i] = 0ull; }
#endif
    copy_bias_lds(p, lds, tid);
    const int vcu = (G % 8 == 0) ? (bid % 8) * (G / 8) + bid / 8 : bid;
    const bool bal = G == 256; const int nu = bal ? 2 : (512 - bid + G - 1) / G;
    const int lane_ = tid & 63;
    const float lam = __builtin_bit_cast(float, __builtin_amdgcn_readfirstlane(__builtin_bit_cast(int, expf(wave_sum(p.lq1[lane_] * p.lk1[lane_])) - expf(wave_sum(p.lq2[lane_] * p.lk2[lane_])) + 0.2f)));
#pragma unroll 1
    for (int i = 0; i < nu; ++i) { int bh, qt;
        if (bal) { const int s_ = vcu & 31; bh = vcu >> 5; qt = i == 0 ? 63 - s_ : s_; }
        else { const int u = bid + i * G; bh = u >> 6; qt = 63 - (u & 63); }
        diff_unit(p, lds, bh >> 2, bh & 3, qt, tid, lam); }
    ATT_BAR();
}

constexpr int NS_IMP = 65536, NS_SELM = L_MISC + 256, NS_UNI = L_MISC + 1280, NS_TL = L_MISC + 1296;
__device__ __forceinline__ void nsa_unit(const PP& p, char* lds, int b, int g, int cur, int tid) {
    const int lane = tid & 63, r32 = lane & 31, hi = lane >> 5; const int wid = __builtin_amdgcn_readfirstlane(tid >> 6);
    LAS3 char* l3 = (LAS3 char*)lds;
    LAS3 float* IMP = (LAS3 float*)(l3 + NS_IMP); LAS3 unsigned* SELM = (LAS3 unsigned*)(l3 + NS_SELM); LAS3 unsigned* UNI = (LAS3 unsigned*)(l3 + NS_UNI); LAS3 int* TL = (LAS3 int*)(l3 + NS_TL);
    const int tokl = wid * 8 + (r32 >> 2), head = r32 & 3, hh = g * 4 + head;
    LAS3 float* wsf = (LAS3 float*)(l3 + L_WSF) + wid * 64; const LAS3 float* bl = (const LAS3 float*)(l3 + L_BIAS) + hh * 128;
    const size_t rowbase = (size_t)b * SEQ; const int t0 = cur * 64; const int tq = t0 + tokl; const int twmin = t0 + wid * 8, twmax = twmin + 7;
    const bf16* Qg = p.PROJ + (rowbase + tq) * NP0 + C_Q + hh * 64;
    bf16x8 qr[4];
#pragma unroll
    for (int d0 = 0; d0 < 4; ++d0) qr[d0] = *(const bf16x8*)(Qg + d0 * 16 + hi * 8);
    const float* gp = p.GATES + (rowbase + tq) * 24 + hh; const float g0 = gp[0], g1 = gp[8], g2 = gp[16];
    const float bfar = ((const LAS3 float*)(l3 + L_MISC + 64))[hh];
    const int vlane = ((lane >> 4) & 1) * 32 + (lane & 3) * 8 + (4 * hi + ((lane & 15) >> 2)) * 64;
    ATT_TN(n0);
    ATT_BAR();
    for (int i = tid; i < 64 * 128; i += NTHR) IMP[i] = 0.f;
    build_fix4((LAS3 float*)(l3 + L_FIX4), (const LAS3 float*)(l3 + L_BIAS) + g * 4 * 128, 4, tid);
    const LAS3 float* cs4 = (const LAS3 float*)(l3 + L_FIX4) + head * 544;
    if (tid < 4) UNI[tid] = 0u;
    const int nvis = (4 * cur + 3) < NCMP ? (4 * cur + 3) : NCMP; const int ntc = (nvis + 63) >> 6;
    const bf16* KC = p.KCMP + (size_t)((b * 2 + g) * 512) * 64; const bf16* VC = p.VCMP + (size_t)((b * 2 + g) * 512) * 64;
    auto krow64 = [&](int k) -> int { return 64 * k; };
    St<2> sc; st_init(sc, bfar); const float* ccur = &sc.cval;
    auto cmp_scores = [&](f32x16& p0, f32x16& p1, int k, int slot) -> bool {
        const int c0 = 64 * k;
        if (16 * c0 + 31 > twmax) return false;
        const bool near = (twmin - (16 * (c0 + 63) + 31)) < 128;
        qk_tile(p0, p1, (lds_cptr)l3 + slot + hi * 1024 + r32 * 16, qr, *ccur);
        if (near) fix_near<false>(p0, p1, tq, 16 * c0 + 31, 16, bl, hi);
        return true;
    };
    u32x4 pw[4]; bool pend = false;
    auto nop2 = [&](int, int) {};
    auto body1 = [&](int k, int slot) { f32x16 p0, p1; if (!cmp_scores(p0, p1, k, slot)) return; softmax_p<2, 1, false>(sc, p0, p1, pw, wsf, r32, hi, 0.f, true); };
    run_stream<1, 2>(lds, KC, 64, VC, 64, ntc, krow64, body1, nop2, wid, lane);
    ATT_TN(n1);
    const float lc = halfsum(sc.l); const float rlc = lc > 0.f ? 1.0f / lc : 0.f;
    St<2> so; st_init(so, bfar); st_setref(so, bfar, sc.mhat); ccur = &so.cval;
    auto body2 = [&](int k, int slot) { f32x16 p0, p1; pend = false; if (!cmp_scores(p0, p1, k, slot)) return;
        softmax_p<2, 2, false>(so, p0, p1, pw, wsf, r32, hi, rlc, true); pend = true;
#pragma unroll
        for (int R = 0; R < 4; ++R) {
            float a0 = ((p0[4 * R] + p0[4 * R + 1]) + p0[4 * R + 2]) + 0.5f * p0[4 * R + 3], s0 = 0.5f * p0[4 * R + 3];
            float a1 = ((p1[4 * R] + p1[4 * R + 1]) + p1[4 * R + 2]) + 0.5f * p1[4 * R + 3], s1 = 0.5f * p1[4 * R + 3];
            a0 += dpp_x1(a0); a0 += dpp_x2(a0); s0 += dpp_x1(s0); s0 += dpp_x2(s0);
            a1 += dpp_x1(a1); a1 += dpp_x2(a1); s1 += dpp_x1(s1); s1 += dpp_x2(s1);
            const int n0 = 16 * k + 2 * R + hi, n1 = n0 + 8;
            if (head == 0) { LAS3 float* ip = IMP + tokl * 128;
                __hip_atomic_fetch_add(ip + n0, a0, __ATOMIC_RELAXED, __HIP_MEMORY_SCOPE_WORKGROUP); __hip_atomic_fetch_add(ip + n0 + 1, s0, __ATOMIC_RELAXED, __HIP_MEMORY_SCOPE_WORKGROUP);
                __hip_atomic_fetch_add(ip + n1, a1, __ATOMIC_RELAXED, __HIP_MEMORY_SCOPE_WORKGROUP); if (n1 + 1 < 128) __hip_atomic_fetch_add(ip + n1 + 1, s1, __ATOMIC_RELAXED, __HIP_MEMORY_SCOPE_WORKGROUP); }
        }
    };
    auto pv2 = [&](int k, int slot) { if (pend) pv_acc<2>(so, pw, (lds_cptr)l3 + slot + 8192 + vlane); };
    run_stream<1, 2>(lds, KC, 64, VC, 64, ntc, krow64, body2, pv2, wid, lane);
    ATT_TN(n2);
    __builtin_amdgcn_s_waitcnt(0xC07F); asm volatile("" ::: "memory");
#define NSA_TI 4
#pragma unroll 1
    for (int tk4 = 0; tk4 < 8; tk4 += NSA_TI) {
        const bool c0 = lane >= 1 && lane <= cur - 2, c1 = lane + 64 <= cur - 2;
        unsigned u0[NSA_TI], u1[NSA_TI], T[NSA_TI];
#pragma unroll
        for (int j = 0; j < NSA_TI; ++j) { const int tl = wid * 8 + tk4 + j; T[j] = 0u;
            u0[j] = c0 ? __float_as_uint(IMP[tl * 128 + lane]) : 0u; u1[j] = c1 ? __float_as_uint(IMP[tl * 128 + 64 + lane]) : 0u; }
        if (cur >= 16) {
#pragma unroll 1
            for (int bit = 30; bit >= 0; --bit) {
#pragma unroll
                for (int j = 0; j < NSA_TI; ++j) { const unsigned trial = T[j] | (1u << bit);
                    const int cnt = __builtin_popcountll(__ballot(u0[j] >= trial)) + __builtin_popcountll(__ballot(u1[j] >= trial));
                    if (cnt >= 13) T[j] = trial; }
            }
        }
#pragma unroll
        for (int j = 0; j < NSA_TI; ++j) { const int tl = wid * 8 + tk4 + j; unsigned long long mlo = 0ull, mhi = 0ull;
            if (cur < 16) { mlo = (2ull << cur) - 1ull; }
            else { mlo = 1ull; if (cur - 1 < 64) mlo |= 1ull << (cur - 1); else mhi |= 1ull << (cur - 1 - 64); if (cur < 64) mlo |= 1ull << cur; else mhi |= 1ull << (cur - 64);
                const unsigned long long g0 = __ballot(c0 && u0[j] > T[j]), g1 = __ballot(c1 && u1[j] > T[j]);
                unsigned long long e0 = __ballot(c0 && u0[j] == T[j]), e1 = __ballot(c1 && u1[j] == T[j]);
                int need = 13 - (__builtin_popcountll(g0) + __builtin_popcountll(g1));
                unsigned long long t0 = 0ull, t1 = 0ull;
                while (need > 0 && e0) { t0 |= e0 & (0ull - e0); e0 &= e0 - 1ull; --need; }
                while (need > 0 && e1) { t1 |= e1 & (0ull - e1); e1 &= e1 - 1ull; --need; }
                mlo |= g0 | t0; mhi |= g1 | t1; }
            if (lane == 0) { const unsigned m0 = (unsigned)mlo, m1 = (unsigned)(mlo >> 32), m2 = (unsigned)mhi, m3 = (unsigned)(mhi >> 32);
                SELM[tl * 4 + 0] = m0; SELM[tl * 4 + 1] = m1; SELM[tl * 4 + 2] = m2; SELM[tl * 4 + 3] = m3;
                __hip_atomic_fetch_or(UNI + 0, m0, __ATOMIC_RELAXED, __HIP_MEMORY_SCOPE_WORKGROUP); __hip_atomic_fetch_or(UNI + 1, m1, __ATOMIC_RELAXED, __HIP_MEMORY_SCOPE_WORKGROUP);
                __hip_atomic_fetch_or(UNI + 2, m2, __ATOMIC_RELAXED, __HIP_MEMORY_SCOPE_WORKGROUP); __hip_atomic_fetch_or(UNI + 3, m3, __ATOMIC_RELAXED, __HIP_MEMORY_SCOPE_WORKGROUP); }
        }
    }
    ATT_BAR();
    if (wid == 0) {
        const unsigned s0 = (unsigned)__builtin_amdgcn_readfirstlane((int)UNI[0]), s1 = (unsigned)__builtin_amdgcn_readfirstlane((int)UNI[1]);
        const unsigned s2 = (unsigned)__builtin_amdgcn_readfirstlane((int)UNI[2]), s3 = (unsigned)__builtin_amdgcn_readfirstlane((int)UNI[3]);
        const int nlo = __builtin_popcount(s0) + __builtin_popcount(s1);
        const unsigned blo = __builtin_amdgcn_mbcnt_hi(s1, __builtin_amdgcn_mbcnt_lo(s0, 0u)), bhi = __builtin_amdgcn_mbcnt_hi(s3, __builtin_amdgcn_mbcnt_lo(s2, 0u));
        const unsigned mylo = lane < 32 ? s0 >> lane : s1 >> (lane - 32), myhi2 = lane < 32 ? s2 >> lane : s3 >> (lane - 32);
        if (mylo & 1u) TL[1 + blo] = lane;
        if (myhi2 & 1u) TL[1 + nlo + bhi] = 64 + lane;
        if (lane == 0) TL[0] = nlo + __builtin_popcount(s2) + __builtin_popcount(s3); }
    ATT_BAR();
    const int nsel = TL[0];
    LAS3 float* otl = (LAS3 float*)(l3 + (wid < 4 ? NS_IMP + wid * 8192 : L_OST + (wid - 4) * 8192));
    { float fr[16]; rowfac(fr, g0, wsf, r32, hi);
#pragma unroll
      for (int r = 0; r < 16; ++r) { otl[crow(r, hi) * 64 + r32] = so.o[0][r] * fr[r]; otl[crow(r, hi) * 64 + 32 + r32] = so.o[1][r] * fr[r]; } }
    const unsigned long long mylo = (unsigned long long)SELM[tokl * 4 + 0] | ((unsigned long long)SELM[tokl * 4 + 1] << 32), myhi = (unsigned long long)SELM[tokl * 4 + 2] | ((unsigned long long)SELM[tokl * 4 + 3] << 32);
    ATT_TN(n3);
    { St<2> ss; st_init(ss, bfar);
      const bf16* KS = p.PROJ + rowbase * NP0 + C_KS + g * 64; const bf16* VS = p.PROJ + rowbase * NP0 + C_VS + g * 64;
      auto krow3 = [&](int k) -> int { return 64 * TL[1 + k]; };
      auto ti3 = [&](int k) -> TInfo { const int n = TL[1 + k]; TInfo t; t.kbase = 64 * n; t.near = n >= cur - 2; t.win = false; t.masked = true;
          t.keep = (((n < 64 ? mylo : myhi) >> (n & 63)) & 1ull) != 0ull; return t; };
      run_pipe<1, 2>(lds, ss, qr, KS, NP0, VS, NP0, nsel, krow3, ti3, 0, cs4, tq, wsf, wid, lane);
      const float ls = halfsum(ss.l); float fr[16]; rowfac(fr, ls > 0.f ? g1 / ls : 0.f, wsf, r32, hi);
#pragma unroll
      for (int r = 0; r < 16; ++r) { otl[crow(r, hi) * 64 + r32] += ss.o[0][r] * fr[r]; otl[crow(r, hi) * 64 + 32 + r32] += ss.o[1][r] * fr[r]; } }
    ATT_TN(n4);
    { St<2> sw; st_init(sw, bfar);
      const bf16* KW = p.PROJ + rowbase * NP0 + C_KW + g * 64; const bf16* VW = p.PROJ + rowbase * NP0 + C_VW + g * 64;
      const int nlo = cur >= 8 ? cur - 8 : 0;
      auto krow4 = [&](int k) -> int { return 64 * (nlo + k); };
      auto body4 = [&](int k, int slot) { const int n = nlo + k; const int kbase = 64 * n;
          const bool near = (n >= cur - 2) || (n == cur - 8);
          f32x16 p0, p1; qk_tile(p0, p1, (lds_cptr)l3 + slot + hi * 1024 + r32 * 16, qr, sw.cval);
          if (near) fix_near4<true>(p0, p1, tq, kbase, cs4, hi);
          softmax_p<2, 0, false>(sw, p0, p1, pw, wsf, r32, hi, 0.f, true); };
      auto pv4 = [&](int k, int slot) { pv_acc<2>(sw, pw, (lds_cptr)l3 + slot + 8192 + vlane); };
      run_stream<1, 2>(lds, KW, NP0, VW, NP0, cur - nlo + 1, krow4, body4, pv4, wid, lane);
      const float lw = halfsum(sw.l); float fr[16]; rowfac(fr, lw > 0.f ? g2 / lw : 0.f, wsf, r32, hi);
#pragma unroll
      for (int r = 0; r < 16; ++r) { otl[crow(r, hi) * 64 + r32] += sw.o[0][r] * fr[r]; otl[crow(r, hi) * 64 + 32 + r32] += sw.o[1][r] * fr[r]; } }
    ATT_TN(n5);
#if ATT_PROBE && ATT_PROBE_PHASE == 3
    if (blockIdx.x == ATT_PROBE_BLOCK && wid == ATT_PROBE_WAVE && lane == 0) { g_dbg[8] += n1 - n0; g_dbg[9] += n2 - n1; g_dbg[10] += n3 - n2; g_dbg[12] += n4 - n3; g_dbg[13] += n5 - n4; g_dbg[11] += 1ull; }
#endif
    bf16* Ow = p.OC + (rowbase + t0 + wid * 8) * DM + g * 256;
#pragma unroll
    for (int i = 0; i < 4; ++i) { const int row = i * 8 + (lane >> 3), ch = lane & 7; const f32x4 a = *(const LAS3 f32x4*)(otl + row * 64 + ch * 8), c = *(const LAS3 f32x4*)(otl + row * 64 + ch * 8 + 4);
        u32x4 v; v.x = pk2(a.x, a.y); v.y = pk2(a.z, a.w); v.z = pk2(c.x, c.y); v.w = pk2(c.z, c.w); *(u32x4*)(Ow + (size_t)(row >> 2) * DM + (row & 3) * 64 + ch * 8) = v; }
}
__device__ __forceinline__ void nsa_phase(const PP& p, char* lds, int tid, int bid, int G) {
#if ATT_PROBE && ATT_PROBE_PHASE == 3
    if (bid == ATT_PROBE_BLOCK && tid == ATT_PROBE_WAVE * 64) { for (int i = 0; i < 16; ++i) g_dbg[i] = 0ull; }
#endif
    copy_bias_lds(p, lds, tid);
    const int vcu = (G % 8 == 0) ? (bid % 8) * (G / 8) + bid / 8 : bid;
    const bool bal = G == 256; const int nu = bal ? 2 : (512 - bid + G - 1) / G;
#pragma unroll 1
    for (int i = 0; i < nu; ++i) { int bg, cur;
        if (bal) { const int s_ = vcu & 63; bg = vcu >> 6; cur = i == 0 ? 127 - s_ : s_; }
        else { const int u = bid + i * G; bg = u >> 7; cur = 127 - (u & 127); }
        nsa_unit(p, lds, bg >> 1, bg & 1, cur, tid); }
    ATT_BAR();
}

typedef float f32x4v __attribute__((ext_vector_type(4)));
__device__ __forceinline__ void compress_unit(const PP& p, char* lds, int kv, int b, int g, int ct, int tid) {
    const int lane = tid & 63, fr = lane & 15, fq = lane >> 4; const int wid = __builtin_amdgcn_readfirstlane(tid >> 6);
    LAS3 bf16* hid = (LAS3 bf16*)((LAS3 char*)lds);
    LAS3 char* win = (LAS3 char*)lds + 8192;
    const unsigned lds_w = (unsigned)(uintptr_t)lds + 8192u;
    const int c0 = ct * 16; const int col = (kv ? C_VC : C_KC) + g * 64;
    const bf16* W1 = (kv ? p.CW1V : p.CW1K) + ((size_t)wid * 64 * 64 + lane) * 8;
    const bf16* W2 = (kv ? p.CW2V : p.CW2K) + (size_t)((wid & 3) * 16 + fr) * 128 + fq * 8;
    f32x4v acc = {0.f, 0.f, 0.f, 0.f};
    ATT_BAR();
    ATT_T(q0);
    { const bf16* Ab = p.PROJ + (size_t)b * SEQ * NP0 + col;
#pragma unroll 1
      for (int i = wid; i < 34; i += 8) { const int t = i * 8 + (lane >> 3), q = lane & 7; int tok = 16 * c0 + t; tok = tok < SEQ ? tok : SEQ - 1;
          glds16(Ab + (size_t)tok * NP0 + ((q ^ ((t >> 4) & 7)) * 8), lds_w + (unsigned)i * 1024u); } }
    float bias = 0.f;
#pragma unroll
    for (int j = 0; j < 8; ++j) bias += p.CMPB[(kv * 8 + j) * 128 + wid * 16 + fr];
    bf16x8 w2f[4];
#pragma unroll
    for (int ks = 0; ks < 4; ++ks) w2f[ks] = *(const bf16x8*)(W2 + ks * 32);
#pragma unroll
    for (int hb = 0; hb < 2; ++hb) {
        bf16x8 wf[32];
#pragma unroll
        for (int j = 0; j < 32; ++j) wf[j] = *(const bf16x8*)(W1 + (hb * 32 + j) * 512);
        if (hb == 0) { asm volatile("s_waitcnt vmcnt(0)" ::: "memory"); ATT_BAR(); }
        ATT_T(q1);
#pragma unroll
        for (int j = 0; j < 32; ++j) { const int ks = hb * 32 + j; const int t = 16 * fr + (ks >> 1), ch = (ks & 1) * 4 + fq;
            const bf16x8 af = *(const LAS3 bf16x8*)(win + t * 128 + ((ch ^ ((t >> 4) & 7)) * 16));
            acc = __builtin_amdgcn_mfma_f32_16x16x32_bf16(af, wf[j], acc, 0, 0, 0); }
#if ATT_PROBE && ATT_PROBE_PHASE == 1
        { asm volatile("s_nop 7\n\ts_nop 7" :: "v"(acc)); ATT_T(q2); if (blockIdx.x == ATT_PROBE_BLOCK && wid == ATT_PROBE_WAVE && lane == 0) { if (hb == 0) { g_dbg[8] += q1 - q0; g_dbg[9] += q2 - q1; g_dbg[11] += 1ull; } else { g_dbg[10] += q2 - q0; } } }
#endif
    }
#pragma unroll
    for (int r = 0; r < 4; ++r) hid[(fq * 4 + r) * 136 + wid * 16 + fr] = (bf16)f2bf(gelu_tanh(acc[r] + bias));
    ATT_BAR();
    if (wid < 4) {
        f32x4v o = {0.f, 0.f, 0.f, 0.f};
#pragma unroll
        for (int ks = 0; ks < 4; ++ks) {
            const bf16x8 af = *(const LAS3 bf16x8*)(hid + fr * 136 + ks * 32 + fq * 8);
            o = __builtin_amdgcn_mfma_f32_16x16x32_bf16(af, w2f[ks], o, 0, 0, 0);
        }
        bf16* outp = (kv ? p.VCMP : p.KCMP) + (size_t)((b * 2 + g) * 512 + c0) * 64 + wid * 16 + fr;
#pragma unroll
        for (int r = 0; r < 4; ++r) { const int c = c0 + fq * 4 + r; outp[(size_t)(fq * 4 + r) * 64] = c < NCMP ? (bf16)f2bf(o[r]) : (bf16)0; }
    }
}
__device__ __forceinline__ void compress_phase(const PP& p, char* lds, int tid, int bid, int G) {
#if ATT_PROBE && ATT_PROBE_PHASE == 1
    if (bid == ATT_PROBE_BLOCK && tid == ATT_PROBE_WAVE * 64) { for (int i = 0; i < 16; ++i) g_dbg[i] = 0ull; }
    __syncthreads();
#endif
    for (int u = bid; u < 256; u += G) { const int ct = u & 31, bg = (u >> 5) & 3, kv = u >> 7; compress_unit(p, lds, kv, bg >> 1, bg & 1, ct, tid); }
    ATT_BAR();
}

constexpr size_t WS_MLCNT = WS_CTL + 32768;
constexpr size_t WS_MLIST = WS_W2_0;
constexpr int ML_FAR_PER_BH = 256 * 465;
__device__ __forceinline__ int ml_far_off(int n) { return 256 * (30 * n - n * (n - 1) / 2); }
constexpr size_t WS_PO0 = WS_XB, WS_PO1 = WS_XB + 16 * MiB, WS_PO2 = 218 * MiB, WS_PO3 = WS_WIN0, WS_PM = 234 * MiB;
__device__ __forceinline__ unsigned short* ml_list(unsigned char* ws, bool near, int bh, int n) {
    unsigned short* base = (unsigned short*)(ws + WS_MLIST);
    return near ? base + ((size_t)bh * 32 + n) * 256 : base + (size_t)32 * 32 * 256 + (size_t)bh * ML_FAR_PER_BH + ml_far_off(n); }

__device__ __forceinline__ unsigned moba_gate_mask(const PP& p, int b, int h, int c, int tid) {
    const int lane = tid & 63, r32 = lane & 31, hi = lane >> 5; const int wid = __builtin_amdgcn_readfirstlane(tid >> 6);
    if (c == 0) return 0u;
    const size_t rowbase = (size_t)b * SEQ; const int tq = c * 256 + wid * 32 + r32; const int bh = b * 16 + h;
    const bf16* Qg = p.PROJ + rowbase * NP1 + h * 64;
    bf16x8 qr[4];
#pragma unroll
    for (int d0 = 0; d0 < 4; ++d0) qr[d0] = *(const bf16x8*)(Qg + (size_t)tq * NP1 + d0 * 16 + hi * 8);
    unsigned mymask;
    f32x16 g = f32x16{};
    const float* km0 = p.KMP + ((size_t)bh * 32 + r32) * 64 + hi * 8; const float* km1 = km0 + (size_t)2 * 16 * 32 * 64;
#pragma unroll
    for (int d0 = 0; d0 < 4; ++d0) {
        const f32x4 a0 = *(const f32x4*)(km0 + d0 * 16), a1 = *(const f32x4*)(km0 + d0 * 16 + 4), c0 = *(const f32x4*)(km1 + d0 * 16), c1 = *(const f32x4*)(km1 + d0 * 16 + 4);
        float v[8] = {a0.x + c0.x, a0.y + c0.y, a0.z + c0.z, a0.w + c0.w, a1.x + c1.x, a1.y + c1.y, a1.z + c1.z, a1.w + c1.w};
        bf16x8 fh, fl;
#pragma unroll
        for (int j = 0; j < 8; ++j) { const float x = v[j] * (1.0f / 256.f); const unsigned hb = f2bf(x); fh[j] = (short)hb; fl[j] = (short)f2bf(x - bf2f(hb)); }
        g = __builtin_amdgcn_mfma_f32_32x32x16_bf16(fh, qr[d0], g, 0, 0, 0);
        g = __builtin_amdgcn_mfma_f32_32x32x16_bf16(fl, qr[d0], g, 0, 0, 0);
    }
    if (c <= 3) mymask = (1u << c) - 1u;
    else {
        float xo[16], xt[16]; float t1 = -INFINITY, t2 = -INFINITY, t3 = -INFINITY;
#pragma unroll
        for (int r = 0; r < 16; ++r) { const float own = g[r];
            auto rr = __builtin_amdgcn_permlane32_swap(__float_as_uint(own), __float_as_uint(own), false, false);
            const float oth = hi ? __uint_as_float(rr[0]) : __uint_as_float(rr[1]);
            xo[r] = crow(r, hi) < c ? own : -INFINITY; xt[r] = crow(r, hi ^ 1) < c ? oth : -INFINITY;
            { const float x = xo[r]; const float n2 = __builtin_amdgcn_fmed3f(t1, x, t2), n3 = __builtin_amdgcn_fmed3f(t2, x, t3); t1 = __builtin_fmaxf(t1, x); t2 = n2; t3 = n3; }
            { const float x = xt[r]; const float n2 = __builtin_amdgcn_fmed3f(t1, x, t2), n3 = __builtin_amdgcn_fmed3f(t2, x, t3); t1 = __builtin_fmaxf(t1, x); t2 = n2; t3 = n3; } }
        unsigned gt = 0u, ge = 0u; const int sh = 4 * hi, sht = 4 * (hi ^ 1);
#pragma unroll
        for (int r = 0; r < 16; ++r) { const unsigned bo = (1u << ((r & 3) + 8 * (r >> 2))) << sh, bt = (1u << ((r & 3) + 8 * (r >> 2))) << sht;
            gt |= xo[r] > t3 ? bo : 0u; ge |= xo[r] >= t3 ? bo : 0u; gt |= xt[r] > t3 ? bt : 0u; ge |= xt[r] >= t3 ? bt : 0u; }
        unsigned eq = ge & ~gt, sel = gt; int need = 3 - __builtin_popcount(gt);
#pragma unroll
        for (int i = 0; i < 3; ++i) { const bool take = need > 0 && eq != 0u; const unsigned low = eq & (0u - eq); sel |= take ? low : 0u; eq = take ? (eq & (eq - 1u)) : eq; need -= take ? 1 : 0; }
        mymask = sel;
    }
    return mymask;
}
__device__ __forceinline__ void moba_route_item(const PP& p, unsigned char* ws, char* lds, int b, int h, int n, int part, int nparts, int tid) {
    const int lane = tid & 63, r32 = lane & 31, hi = lane >> 5; const int wid = __builtin_amdgcn_readfirstlane(tid >> 6);
    LAS3 char* l3 = (LAS3 char*)lds; const int bh = b * 16 + h;
    LAS3 float* wsf = (LAS3 float*)(l3 + L_WSF) + wid * 64; const LAS3 float* bl = (const LAS3 float*)(l3 + L_BIAS) + h * 128;
    const float bfar = ((const LAS3 float*)(l3 + L_MISC + 64))[h];
    const unsigned* cnts = (const unsigned*)(ws + WS_MLCNT);
    const int cntN = (int)cnts[bh * 32 + n], cntF = (int)cnts[1024 + bh * 32 + n];
    const int gN = (cntN + 31) >> 5, gF = (cntF + 31) >> 5, gT = gN + gF + 8;
    const int g_lo = 32 * part, g_hi = (part + 1 == nparts || 32 * (part + 1) > gT) ? gT : 32 * (part + 1);
    if (g_lo >= g_hi) return;
    const size_t rowbase = (size_t)b * SEQ;
    const bf16* Qg = p.PROJ + rowbase * NP1 + h * 64; const bf16* Kg = p.PROJ + rowbase * NP1 + 1024 + h * 64; const bf16* Vg = p.PROJ + rowbase * NP1 + 2048 + h * 64;
    const unsigned lds0 = (unsigned)(uintptr_t)lds;
    ATT_T(r0);
    ATT_BAR();
    __builtin_amdgcn_s_waitcnt(0x0F70);
#pragma unroll
    for (int tt = 0; tt < 4; ++tt) issue_tile<1, 2>(Kg, NP1, Vg, NP1, n * 256 + tt * 64, lds0 + tt * 16384, wid, lane);
    LAS3 float* cs4 = (LAS3 float*)(l3 + 69632);
    for (int i = tid; i < 4 * 136; i += NTHR) { const int sft = i / 136, kk = i - sft * 136; const int bi = kk + sft - 3; cs4[i] = bl[bi < 0 ? 0 : (bi > 127 ? 127 : bi)]; }
    ATT_WAIT_BAR(0);
    ATT_T(r1);
#if ATT_PROBE && ATT_PROBE_PHASE == 82
    if (b == 0 && blockIdx.x == ATT_PROBE_BLOCK && wid == ATT_PROBE_WAVE && lane == 0) { g_dbg[9] += r1 - r0; g_dbg[10] -= r1; }
#endif
    const unsigned short* listN = ml_list(ws, true, bh, n); const unsigned short* listF = ml_list(ws, false, bh, n);
    LAS3 unsigned* ent = (LAS3 unsigned*)(l3 + 65536) + wid * 32;
    LAS3 bf16* stg = (LAS3 bf16*)(l3 + L_OST) + wid * 2048;
    bf16* PO[4] = {(bf16*)p.out, (bf16*)p.out + (size_t)16 * 1024 * 1024, (bf16*)(ws + WS_PO2), p.OC}; float* PM = (float*)(ws + WS_WIN0);
    const int vlane = ((lane >> 4) & 1) * 32 + (lane & 3) * 8 + (4 * hi + ((lane & 15) >> 2)) * 64;
    auto fetch = [&](int g, unsigned& e, bool& valid, bool& own, bool& near, bf16x8 (&qr)[4]) __attribute__((always_inline)) {
        own = g >= gN + gF; near = g < gN; const int gi = near ? g : (own ? g - gN - gF : g - gN); const int cnt = near ? cntN : cntF; const unsigned short* list = near ? listN : listF;
        const int idx = gi * 32 + r32; valid = own || idx < cnt;
        e = own ? (unsigned)(n * 256 + idx) | (3u << 13) : (valid ? (unsigned)list[idx] : (unsigned)(n * 256));
        const int t = (int)(e & 8191u);
#pragma unroll
        for (int d0 = 0; d0 < 4; ++d0) qr[d0] = *(const bf16x8*)(Qg + (size_t)t * NP1 + d0 * 16 + hi * 8);
    };
    unsigned e = 0u, en = 0u; bool valid = false, own = false, near = false, validn = false, ownn = false, nearn = false; bf16x8 qr[4], qrn[4];
    if (g_lo + wid < g_hi) fetch(g_lo + wid, e, valid, own, near, qr);
#pragma unroll 1
    for (int g = g_lo + wid; g < g_hi; g += 8) {
        if (g + 8 < g_hi) fetch(g + 8, en, validn, ownn, nearn, qrn);
        const int t = (int)(e & 8191u); const unsigned slot = e >> 13;
        if (hi == 0) ent[r32] = e | (valid ? 0x10000u : 0u);
        St<2> st; st_init(st, bfar);
        u32x4 pw[4];
        const int ntl = own ? ((32 * (g - gN - gF) + 31) >> 6) + 1 : 4;
#pragma unroll 1
        for (int tt = 0; tt < ntl; ++tt) {
            f32x16 p0, p1;
            qk_tile(p0, p1, (lds_cptr)l3 + tt * 16384 + hi * 1024 + r32 * 16, qr, valid ? st.cval : -INFINITY);
            if (own ? (32 * (g - gN - gF) - (64 * tt + 63) < 128) : (near && tt >= 2)) fix_near4<false>(p0, p1, t, n * 256 + tt * 64, cs4, hi);
            softmax_p<2, 0, false>(st, p0, p1, pw, wsf, r32, hi, 0.f, true);
            pv_acc<2>(st, pw, (lds_cptr)l3 + tt * 16384 + 8192 + vlane);
        }
        const float lt = halfsum(st.l); float fr[16]; rowfac(fr, lt > 0.f ? 1.0f / lt : 0.f, wsf, r32, hi);
#pragma unroll
        for (int r = 0; r < 16; ++r) { st.o[0][r] *= fr[r]; st.o[1][r] *= fr[r]; }
        stage_o<2>(st.o, stg, r32, hi);
        if (hi == 0 && valid) PM[((rowbase + t) * 16 + h) * 4 + slot] = st.mhat + __log2f(lt);
#pragma unroll
        for (int i = 0; i < 4; ++i) { const int row = i * 8 + (lane >> 3), ch = lane & 7; const unsigned ee = ent[row];
            const u32x4 v = *(const LAS3 u32x4*)(stg + row * 64 + ch * 8);
            if (ee & 0x10000u) { const unsigned sl = (ee >> 13) & 3u; bf16* dst = (sl == 0 ? PO[0] : (sl == 1 ? PO[1] : (sl == 2 ? PO[2] : PO[3]))) + ((rowbase + (ee & 8191u)) * 16 + h) * 64 + ch * 8; *(u32x4*)dst = v; } }
        e = en; valid = validn; own = ownn; near = nearn;
#pragma unroll
        for (int d0 = 0; d0 < 4; ++d0) qr[d0] = qrn[d0];
    }
#if ATT_PROBE && ATT_PROBE_PHASE == 82
    { ATT_T(r2); if (b == 0 && blockIdx.x == ATT_PROBE_BLOCK && wid == ATT_PROBE_WAVE && lane == 0) { g_dbg[10] += r2; g_dbg[12] += (unsigned long long)((g_hi - g_lo - wid + 7) / 8); } }
#endif
}
__device__ __forceinline__ void moba_merge_phase(const PP& p, unsigned char* ws, int tid, int bid, int G) {
#if ATT_PROBE && ATT_PROBE_PHASE == 83
    if (bid == ATT_PROBE_BLOCK && tid == ATT_PROBE_WAVE * 64) { for (int i = 0; i < 16; ++i) g_dbg[i] = 0ull; }
    __syncthreads();
#endif
    ATT_T(mg0);
    const float* PMb = (const float*)(ws + WS_WIN0);
    const bf16* PO[4] = {(const bf16*)p.out, (const bf16*)p.out + (size_t)16 * 1024 * 1024, (const bf16*)(ws + WS_PO2), p.OC};
#pragma unroll 1
    for (int i = bid * NTHR + tid; i < M * 16 * 2; i += G * NTHR) {
        const int half = i & 1, h = (i >> 1) & 15, row = i >> 5; const int c = (row & (SEQ - 1)) >> 8; const int nsl = c < 3 ? c : 3;
        const f32x4 m4 = *(const f32x4*)(PMb + ((size_t)row * 16 + h) * 4);
        const float ms[4] = {nsl > 0 ? m4.x : -INFINITY, nsl > 1 ? m4.y : -INFINITY, nsl > 2 ? m4.z : -INFINITY, m4.w};
        const float mx = fmaxf(fmaxf(ms[0], ms[1]), fmaxf(ms[2], ms[3]));
        float w[4], wsum = 0.f;
#pragma unroll
        for (int s_ = 0; s_ < 4; ++s_) { w[s_] = exp2f(ms[s_] - mx); wsum += w[s_]; }
        const float inv = 1.0f / wsum;
        float acc[32];
#pragma unroll
        for (int j = 0; j < 32; ++j) acc[j] = 0.f;
#pragma unroll
        for (int s_ = 0; s_ < 4; ++s_) { if (s_ == 3 || s_ < nsl) { const bf16* src = PO[s_] + ((size_t)row * 16 + h) * 64 + half * 32; const float ww = w[s_] * inv;
#pragma unroll
            for (int j = 0; j < 32; j += 8) { const v4u u = *(const v4u*)(src + j);
                acc[j] += ww * bf2f(u.x & 0xffff); acc[j + 1] += ww * bf2f(u.x >> 16); acc[j + 2] += ww * bf2f(u.y & 0xffff); acc[j + 3] += ww * bf2f(u.y >> 16);
                acc[j + 4] += ww * bf2f(u.z & 0xffff); acc[j + 5] += ww * bf2f(u.z >> 16); acc[j + 6] += ww * bf2f(u.w & 0xffff); acc[j + 7] += ww * bf2f(u.w >> 16); } } }
        bf16* dst = p.OC + (size_t)row * DM + h * 64 + half * 32;
#pragma unroll
        for (int j = 0; j < 32; j += 8) { u32x4 o; o.x = pk2(acc[j], acc[j + 1]); o.y = pk2(acc[j + 2], acc[j + 3]); o.z = pk2(acc[j + 4], acc[j + 5]); o.w = pk2(acc[j + 6], acc[j + 7]); *(u32x4*)(dst + j) = o; }
    }
#if ATT_PROBE && ATT_PROBE_PHASE == 83
    { asm volatile("s_waitcnt vmcnt(0)" ::: "memory"); __syncthreads(); ATT_T(mg1); if (bid == ATT_PROBE_BLOCK && tid == ATT_PROBE_WAVE * 64) { g_dbg[8] += mg1 - mg0; g_dbg[11] += 1ull; } }
#endif
}
__device__ __forceinline__ void moba_r1_phase(const PP& p, unsigned char* ws, char* lds, int tid, int bid, int G) {
#if ATT_PROBE && ATT_PROBE_PHASE == 81
    if (bid == ATT_PROBE_BLOCK && tid == ATT_PROBE_WAVE * 64) { for (int i = 0; i < 16; ++i) g_dbg[i] = 0ull; }
    __syncthreads();
#endif
    ATT_T(g0);
    const int lane = tid & 63, r32 = lane & 31, hi = lane >> 5; const int wid = __builtin_amdgcn_readfirstlane(tid >> 6);
    LAS3 unsigned* lc = (LAS3 unsigned*)((LAS3 char*)lds + 65536);
#pragma unroll 1
    for (int u0 = bid; u0 < 1024; u0 += 4 * G) {
        unsigned mk[4];
#pragma unroll
        for (int j = 0; j < 4; ++j) { const int u = u0 + j * G; mk[j] = 0u;
            if (u < 1024) mk[j] = moba_gate_mask(p, (u >> 5) >> 4, (u >> 5) & 15, u & 31, tid); }
        ATT_T(gm1);
        ATT_BAR();
        if (tid < 256) lc[tid] = 0u;
        ATT_BAR();
        unsigned lp[4][3];
#pragma unroll
        for (int j = 0; j < 4; ++j) { const int c = (u0 + j * G) & 31; unsigned m = hi == 0 ? mk[j] : 0u;
#pragma unroll
            for (int s_ = 0; s_ < 3; ++s_) { lp[j][s_] = 0u; if (m) { const int n = __builtin_ctz(m); m &= m - 1u; const bool near = n == c - 1;
                lp[j][s_] = __hip_atomic_fetch_add(lc + j * 64 + (near ? 0 : 32) + n, 1u, __ATOMIC_RELAXED, __HIP_MEMORY_SCOPE_WORKGROUP); } } }
        ATT_BAR();
        if (tid < 256) { const int j = tid >> 6, sl = tid & 63; const int u = u0 + j * G; const int bh = u >> 5; const unsigned cn = lc[tid]; unsigned base = 0u;
            if (cn) base = __hip_atomic_fetch_add((unsigned*)(ws + WS_MLCNT) + (sl < 32 ? 0 : 1024) + bh * 32 + (sl & 31), cn, __ATOMIC_RELAXED, __HIP_MEMORY_SCOPE_AGENT);
            lc[tid] = base; }
        ATT_BAR();
#if ATT_PROBE && ATT_PROBE_PHASE == 81
        { ATT_T(gm2); if (bid == ATT_PROBE_BLOCK && tid == ATT_PROBE_WAVE * 64) { g_dbg[9] += gm1 - g0; g_dbg[10] += gm2 - gm1; } }
#endif
#pragma unroll
        for (int j = 0; j < 4; ++j) { const int u = u0 + j * G; const int c = u & 31, bh = u >> 5; const int tq = c * 256 + wid * 32 + r32; unsigned m = hi == 0 ? mk[j] : 0u;
#pragma unroll
            for (int s_ = 0; s_ < 3; ++s_) { if (m) { const int n = __builtin_ctz(m); m &= m - 1u; const bool near = n == c - 1;
                ml_list(ws, near, bh, n)[lc[j * 64 + (near ? 0 : 32) + n] + lp[j][s_]] = (unsigned short)((unsigned)tq | ((unsigned)s_ << 13)); } } }
    }
    ATT_BAR();
#if ATT_PROBE && ATT_PROBE_PHASE == 81
    { ATT_T(g1); if (bid == ATT_PROBE_BLOCK && tid == ATT_PROBE_WAVE * 64) { g_dbg[8] += g1 - g0; g_dbg[11] += 1ull; } }
#endif
}
__device__ __forceinline__ int moba_nparts(int n) { return n < 3 ? 3 : (n < 12 ? 2 : 1); }
__device__ __forceinline__ void moba_r2_phase(const PP& p, unsigned char* ws, char* lds, int tid, int bid, int G) {
#if ATT_PROBE && ATT_PROBE_PHASE == 82
    if (bid == ATT_PROBE_BLOCK && tid == ATT_PROBE_WAVE * 64) { for (int i = 0; i < 16; ++i) g_dbg[i] = 0ull; }
#endif
    copy_bias_lds(p, lds, tid);
    unsigned* qhead = (unsigned*)(ws + WS_MLCNT) + 2048;
    LAS3 int* itl = (LAS3 int*)((LAS3 char*)lds + L_MISC + 128);
#pragma unroll 1
    for (;;) {
        ATT_T(q0);
        ATT_BAR();
        if (tid == 0) itl[0] = (int)__hip_atomic_fetch_add(qhead, 1u, __ATOMIC_RELAXED, __HIP_MEMORY_SCOPE_AGENT);
        ATT_BAR();
        int it = itl[0]; const int b = it & 1; it >>= 1;
        ATT_T(q1);
#if ATT_PROBE && ATT_PROBE_PHASE == 82
        if (b == 0 && blockIdx.x == ATT_PROBE_BLOCK && tid == ATT_PROBE_WAVE * 64) { g_dbg[8] += q1 - q0; g_dbg[11] += 1ull; }
#endif
        if (it >= 16 * 47) break;
        int n = 0;
        for (;; ++n) { const int sz = 16 * moba_nparts(n); if (it < sz) break; it -= sz; }
        const int np = moba_nparts(n); const int h = it / np, part = it % np;
        moba_route_item(p, ws, lds, b, h, n, part, np, tid);
    }
    ATT_BAR();
}
}

#define LAS __attribute__((address_space(3)))
#define XB_TMO      128
#define XB_XCNT(j)  (256  + 64 * (j))
#define XB_XSUB(j)  (1280 + 64 * (j))
#define XB_XGEN(j)  (2304 + 64 * (j))
#define XB_TOP      3328
#define XB_TOPGEN   3392
#define XCD_BAR_WORDS 3456
#define XB_SPIN_CAP (1u << 18)

__device__ __forceinline__ unsigned xb_ld(unsigned* p)              { return __hip_atomic_load(p, __ATOMIC_RELAXED, __HIP_MEMORY_SCOPE_AGENT); }
__device__ __forceinline__ unsigned xb_add(unsigned* p, unsigned v) { return __hip_atomic_fetch_add(p, v, __ATOMIC_RELAXED, __HIP_MEMORY_SCOPE_AGENT); }
__device__ __forceinline__ unsigned xb_xcc_id() { return (unsigned)__builtin_amdgcn_s_getreg((3 << 11) | 20) & 0xFu; }
#define XB_SPIN(cond, bar) do { unsigned _sp = 0; while (cond) { __builtin_amdgcn_s_sleep(1); \
    if ((++_sp & 255u) == 0u) { if (xb_ld(&(bar)[XB_TMO])) break; if (_sp > XB_SPIN_CAP) { atomicAdd(&(bar)[XB_TMO], 1u); break; } } } } while (0)

struct XcdBarrier {
    unsigned* bar; unsigned x;
    volatile LAS unsigned* st;
};

__device__ __forceinline__ XcdBarrier xcd_barrier_post(unsigned* bar, volatile LAS unsigned* st) {
    XcdBarrier b; b.bar = bar; b.x = xb_xcc_id(); b.st = st;
    if (threadIdx.x == 0) (void)xb_add(&bar[XB_XCNT(b.x)], 1u);
    return b;
}
__device__ __forceinline__ void xcd_barrier_complete(unsigned* bar, unsigned x, unsigned& nloc, unsigned& nx) {
    const unsigned G = gridDim.x * gridDim.y * gridDim.z;
    unsigned sum, cnt, mine, sp = 0u;
    for (;;) {
        sum = 0u; cnt = 0u; mine = 0u;
#pragma unroll
        for (unsigned j = 0; j < 16; ++j) { const unsigned c = xb_ld(&bar[XB_XCNT(j)]); sum += c; cnt += (c > 0u) ? 1u : 0u; mine = (j == x) ? c : mine; }
        if (sum == G) break;
        __builtin_amdgcn_s_sleep(1);
        if ((++sp & 255u) == 0u) { if (xb_ld(&bar[XB_TMO])) break; if (sp > XB_SPIN_CAP) { atomicAdd(&bar[XB_TMO], 1u); break; } }
    }
    nloc = mine > 0u ? mine : 1u; nx = cnt > 0u ? cnt : 1u;
}

__device__ __forceinline__ void xcd_barrier(const XcdBarrier& b) {
    asm volatile("s_waitcnt vmcnt(0)" ::: "memory");
    __syncthreads();
    if (threadIdx.x == 0) {
        unsigned* bar = b.bar;
        __builtin_amdgcn_s_waitcnt(0);
        unsigned nloc = b.st[0], nx = b.st[1];
        if (nloc == 0u) { xcd_barrier_complete(bar, b.x, nloc, nx); b.st[0] = nloc; b.st[1] = nx; }
        const unsigned old = xb_add(&bar[XB_XSUB(b.x)], 1u);
        const unsigned gen = old / nloc;
        if (old + 1u == (gen + 1u) * nloc) {
            __builtin_amdgcn_fence(__ATOMIC_RELEASE, "agent");
            asm volatile("s_waitcnt vmcnt(0)" ::: "memory");
            const unsigned og = xb_add(&bar[XB_TOP], 1u);
            const unsigned tg = og / nx;
            if (og + 1u == (tg + 1u) * nx) xb_add(&bar[XB_TOPGEN], 1u);
            else XB_SPIN(xb_ld(&bar[XB_TOPGEN]) == tg, bar);
            __builtin_amdgcn_fence(__ATOMIC_ACQUIRE, "agent");
            xb_add(&bar[XB_XGEN(b.x)], 1u);
            asm volatile("s_waitcnt vmcnt(0)" ::: "memory");
        } else {
            XB_SPIN(xb_ld(&bar[XB_XGEN(b.x)]) == gen, bar);
            __builtin_amdgcn_fence(__ATOMIC_ACQUIRE, "agent");
            asm volatile("s_waitcnt vmcnt(0)" ::: "memory");
        }
    }
    __syncthreads();
}
namespace pg8 {
struct EpiFinalNorm {
    static constexpr bool PERM = true, AFTER_DRAIN = false;
    const bf16_t* xb; float* SS; const float* gain; float* out; unsigned* flags; unsigned* bar;
    __device__ __forceinline__ void operator()(const f32x4 (&acc)[2][2][4][2], const Unit& u, int wr, int wc, int fr, int fq) const {
        const int col0 = u.pn * BM + wc * 32 + 8 * fq;
        f32x4 o[2][4][2][2];
#pragma unroll
        for (int ai = 0; ai < 2; ++ai) {
#pragma unroll
            for (int m = 0; m < 4; ++m) { const size_t off = (size_t)(u.pm * BM + ai * HALF + wr * 64 + m * 16 + fr) * DM + col0;
#pragma unroll
                for (int bj = 0; bj < 2; ++bj) { const u32x4 w = *(const u32x4*)(xb + off + bj * HALF);
                    o[ai][m][bj][0] = (f32x4){__builtin_bit_cast(float, w.x << 16), __builtin_bit_cast(float, w.x & 0xffff0000u), __builtin_bit_cast(float, w.y << 16), __builtin_bit_cast(float, w.y & 0xffff0000u)};
                    o[ai][m][bj][1] = (f32x4){__builtin_bit_cast(float, w.z << 16), __builtin_bit_cast(float, w.z & 0xffff0000u), __builtin_bit_cast(float, w.w << 16), __builtin_bit_cast(float, w.w & 0xffff0000u)}; } }
#pragma unroll
            for (int m = 0; m < 4; ++m) { const int row = u.pm * BM + ai * HALF + wr * 64 + m * 16 + fr; float sq = 0.f;
#pragma unroll
                for (int bj = 0; bj < 2; ++bj)
#pragma unroll
                    for (int n = 0; n < 2; ++n) { const f32x4 v = o[ai][m][bj][n] + acc[ai][bj][m][n]; o[ai][m][bj][n] = v;
                        sq += (v[0] * v[0] + v[1] * v[1]) + (v[2] * v[2] + v[3] * v[3]); }
                sq = pg8_sum_fq(sq);
                if (fq == 0) SS[(size_t)row * 16 + u.pn * 4 + wc] = sq; }
        }
        asm volatile("s_waitcnt vmcnt(0)" ::: "memory");
        __syncthreads();
        if (threadIdx.x == 0) {
            unsigned* f = flags + u.pm * 16;
            __builtin_amdgcn_fence(__ATOMIC_RELEASE, "agent");
            asm volatile("s_waitcnt vmcnt(0)" ::: "memory");
            (void)xb_add(f, 1u);
            XB_SPIN(xb_ld(f) < 4u, bar);
            __builtin_amdgcn_fence(__ATOMIC_ACQUIRE, "agent");
            asm volatile("s_waitcnt vmcnt(0)" ::: "memory");
        }
        __syncthreads();
        f32x4 gg[2][2];
#pragma unroll
        for (int bj = 0; bj < 2; ++bj)
#pragma unroll
            for (int n = 0; n < 2; ++n) gg[bj][n] = *(const f32x4*)(gain + col0 + bj * HALF + n * 4);
#pragma unroll
        for (int ai = 0; ai < 2; ++ai)
#pragma unroll
            for (int m = 0; m < 4; ++m) { const int row = u.pm * BM + ai * HALF + wr * 64 + m * 16 + fr; const float rs = rstd_of(SS, row);
#pragma unroll
                for (int bj = 0; bj < 2; ++bj)
#pragma unroll
                    for (int n = 0; n < 2; ++n) *(f32x4*)(out + (size_t)row * DM + col0 + bj * HALF + n * 4) = o[ai][m][bj][n] * rs * gg[bj][n]; }
    }
};
}
constexpr size_t WS_RBFLAG = WS_CTL + 49152;
__device__ __forceinline__ void gemm_final(char* lds, const bf16* A, const bf16* Bt, int K, const bf16* xb, float* SS, const float* gain, float* out, unsigned* flags, unsigned* bar, int bid, int G) {
    pg8::Gemm g{A, Bt, M, DM, K}; pg8::StaticOrder S; S.init(M, DM, G, bid);
    pg8::EpiFinalNorm E{xb, SS, gain, out, flags, bar};
    pg8::gemm_phase<pg8::EpiFinalNorm, pg8::StaticOrder, GEMM_ALIGN, GEMM_SP2>((PG8_LAS unsigned char*)lds, g, S, E);
}
template <int MODE> __device__ __forceinline__ void gemm_rowscale(char* lds, const bf16* A, const bf16* Bt, int N, int ldc, int K, bf16* O, const float* SS, float* KMP, float* GATES, int kt_lo, int kt_hi, int gate_tile, int tid, int bid, int G) {
#if USE_PG8
    pg8::Gemm g{A, Bt, M, N, K}; pg8::StaticOrder S; S.init(M, N, G, bid);
    const PG8_LAS float* rsl = nullptr; int rs_pm = -1;
    if (G == 256) { PG8_LAS float* w = (PG8_LAS float*)((PG8_LAS unsigned char*)lds + 131072); rs_pm = 8 * (bid & 7) + ((bid >> 3) & 7);
        if (tid < 256) w[tid] = rstd_of(SS, rs_pm * 256 + tid);
        __syncthreads(); rsl = w; }
    pg8::EpiRowScaleBf16<MODE> E{O, SS, KMP, GATES, ldc, kt_lo, kt_hi, gate_tile, rsl, rs_pm};
    pg8::gemm_phase<pg8::EpiRowScaleBf16<MODE>, pg8::StaticOrder, GEMM_ALIGN, GEMM_SP2>((PG8_LAS unsigned char*)lds, g, S, E);
#else
    if (MODE == 0) ngemm_phase(lds, A, Bt, N, K, NEpiProj{O, SS, N}, tid, bid, G); else ngemm_phase(lds, A, Bt, N, K, NEpiMlp1{O, SS}, tid, bid, G);
#endif
}
template <bool INBF> __device__ __forceinline__ void gemm_residual(char* lds, const bf16* A, const bf16* Bt, int K, const float* xin32, bf16* xb, float* SS, int tid, int bid, int G) {
    pg8::Gemm g{A, Bt, M, DM, K}; pg8::StaticOrder S; S.init(M, DM, G, bid);
    pg8::EpiResidual<INBF> E{xin32, xb, SS};
    pg8::gemm_phase<pg8::EpiResidual<INBF>, pg8::StaticOrder, GEMM_ALIGN, GEMM_SP2>((PG8_LAS unsigned char*)lds, g, S, E);
}

constexpr int NPHASE = 13;
__global__ void __launch_bounds__(NTHR, 2) mk_fwd(Args args) {
    extern __shared__ __attribute__((aligned(16))) char lds[];
    cg::grid_group grid = cg::this_grid();
    const int tid = threadIdx.x, bid = blockIdx.x, G = gridDim.x;
    unsigned char* ws = args.ws;
    PP p;
    p.x = args.in[0]; p.bias_table = args.in[1]; p.norm_mix = args.in[2]; p.norm_mlp = args.in[3]; p.norm_final = args.in[4]; p.mlp_w1 = args.in[5]; p.mlp_w2 = args.in[6];
    p.ev_w_in = args.in[7]; p.ev_w_out = args.in[8]; p.pos_k = args.in[9]; p.w1_k = args.in[10]; p.w2_k = args.in[11]; p.pos_v = args.in[12]; p.w1_v = args.in[13]; p.w2_v = args.in[14];
    p.lq1 = args.in[15]; p.lk1 = args.in[16]; p.lq2 = args.in[17]; p.lk2 = args.in[18]; p.subln = args.in[19]; p.od_w_in = args.in[20]; p.od_w_out = args.in[21];
    p.out = args.out;
    p.SSA = (float*)(ws + WS_SSA); p.SSB = (float*)(ws + WS_SSB); p.GATES = (float*)(ws + WS_GATES); p.CMPB = (float*)(ws + WS_CMPB); p.BIASL = (float*)(ws + WS_BIASL);
    p.KMEAN = (float*)(ws + WS_KMEAN); p.KMP = (float*)(ws + WS_KMP);
    p.KCMP = (bf16*)(ws + WS_KCMP); p.VCMP = (bf16*)(ws + WS_VCMP);
    p.WIN0 = (bf16*)(ws + WS_WIN0); p.WOUT0 = (bf16*)(ws + WS_WOUT0); p.W1_0 = (bf16*)(ws + WS_W1_0); p.W2_0 = (bf16*)(ws + WS_W2_0);
    p.WIN1 = (bf16*)(ws + WS_WIN1); p.WOUT1 = (bf16*)(ws + WS_WOUT1); p.W1_1 = (bf16*)(ws + WS_W1_1); p.W2_1 = (bf16*)(ws + WS_W2_1);
    p.CW1K = (bf16*)(ws + WS_CW1K); p.CW1V = (bf16*)(ws + WS_CW1V); p.CW2K = (bf16*)(ws + WS_CW2K); p.CW2V = (bf16*)(ws + WS_CW2V);
    p.XB = (bf16*)(ws + WS_XB); p.OC = (bf16*)(ws + WS_OC); p.H = (bf16*)(ws + WS_H); p.PROJ = (bf16*)(ws + WS_PROJ);
    volatile LAS unsigned* xst = (volatile LAS unsigned*)((LAS char*)lds + att::L_MISC);
    if (tid == 0) { xst[0] = 0u; xst[1] = 0u; }
    __syncthreads();
    const bool self_zero = args.ph_lo == 0 && args.ph_hi > 1;
    XcdBarrier xbar; xbar.bar = (unsigned*)(ws + WS_CTL); xbar.x = 0u; xbar.st = xst;
    if (!self_zero) xbar = xcd_barrier_post((unsigned*)(ws + WS_CTL), xst);
    else if (bid == 0) { for (int i = tid; i < 16384; i += NTHR) ((unsigned*)(ws + WS_CTL))[i] = 0u; }
    const int lo = args.ph_lo, hi = args.ph_hi;
#define IN(k) (lo <= (k) && (k) < hi)
#define SEAM(k) do { if (IN(k) && IN((k) + 1)) { if ((k) == 0) grid.sync(); else xcd_barrier(xbar); } } while (0)

    if (IN(0)) { p0_prologue(p, lds, tid, bid, G);
#if PROBE_DOUBLE == 100
        __syncthreads(); p0_prologue(p, lds, tid, bid, G);
#endif
    }
    SEAM(0);
    if (self_zero) xbar = xcd_barrier_post((unsigned*)(ws + WS_CTL), xst);
    if (IN(1)) { gemm_rowscale<0>(lds, p.XB, p.WIN0, NP0G, NP0, DM, p.PROJ, p.SSA, nullptr, p.GATES, 0, 0, NP0 / 256, tid, bid, G);
#if PROBE_DOUBLE == 101
        xcd_barrier(xbar); gemm_rowscale<0>(lds, p.XB, p.WIN0, NP0G, NP0, DM, p.PROJ, p.SSA, nullptr, p.GATES, 0, 0, NP0 / 256, tid, bid, G);
#endif
    }
    SEAM(1);
    if (IN(2)) {
#if USE_MFMA_CMP
        att::compress_phase(p, lds, tid, bid, G);
#if PROBE_DOUBLE == 1
        __syncthreads(); att::compress_phase(p, lds, tid, bid, G);
#endif
#else
        ncompress_phase(p, lds, tid, bid, G);
#endif
#if USE_MFMA_DIFF
        att::diff_phase(p, lds, tid, bid, G);
#if PROBE_DOUBLE == 2
        xcd_barrier(xbar); att::diff_phase(p, lds, tid, bid, G);
#endif
#else
        ndiff_phase(p, lds, tid, bid, G);
#endif
    }
    SEAM(2);
    if (IN(3)) {
#if USE_MFMA_NSA
        att::nsa_phase(p, lds, tid, bid, G);
#if PROBE_DOUBLE == 3
        xcd_barrier(xbar); att::nsa_phase(p, lds, tid, bid, G);
#endif
#else
        nnsa_phase(p, lds, tid, bid, G);
#endif
    }
    SEAM(3);
    if (IN(4)) { gemm_residual<true>(lds, p.OC, p.WOUT0, DM, nullptr, p.XB, p.SSB, tid, bid, G);
#if PROBE_DOUBLE == 4
        xcd_barrier(xbar); gemm_residual<true>(lds, p.OC, p.WOUT0, DM, nullptr, p.XB, p.SSB, tid, bid, G);
#endif
    }
    SEAM(4);
#if PROBE_DOUBLE == 900
    xcd_barrier(xbar); xcd_barrier(xbar); xcd_barrier(xbar); xcd_barrier(xbar); xcd_barrier(xbar); xcd_barrier(xbar); xcd_barrier(xbar); xcd_barrier(xbar);
#endif
    if (IN(5)) { gemm_rowscale<1>(lds, p.XB, p.W1_0, FF, FF, DM, p.H, p.SSB, nullptr, nullptr, 0, 0, -1, tid, bid, G);
#if PROBE_DOUBLE == 5
        xcd_barrier(xbar); gemm_rowscale<1>(lds, p.XB, p.W1_0, FF, FF, DM, p.H, p.SSB, nullptr, nullptr, 0, 0, -1, tid, bid, G);
#endif
    }
    SEAM(5);
    if (IN(6)) { gemm_residual<true>(lds, p.H, p.W2_0, FF, nullptr, p.XB, p.SSA, tid, bid, G); }
    SEAM(6);
    if (IN(7)) {
#if USE_PG8
        gemm_rowscale<0>(lds, p.XB, p.WIN1, NP1, NP1, DM, p.PROJ, p.SSA, p.KMP, nullptr, 4, 8, -1, tid, bid, G);
#else
        gemm_rowscale<0>(lds, p.XB, p.WIN1, NP1, NP1, DM, p.PROJ, p.SSA, nullptr, nullptr, 0, 0, -1, tid, bid, G);
        grid.sync();
        nkmean_phase(p, tid, bid, G);
#endif
    }
    SEAM(7);
    if (IN(8)) {
#if USE_PG8
#endif
#if USE_MFMA_MOBA && USE_MOBA_ROUTED
        att::moba_r1_phase(p, ws, lds, tid, bid, G); xcd_barrier(xbar);
        att::moba_r2_phase(p, ws, lds, tid, bid, G); xcd_barrier(xbar);
        att::moba_merge_phase(p, ws, tid, bid, G);
#elif USE_MFMA_MOBA
        att::moba_phase(p, lds, tid, bid, G);
#if PROBE_DOUBLE == 8
        xcd_barrier(xbar); att::moba_phase(p, lds, tid, bid, G);
#endif
#else
        nmoba_phase(p, tid, bid, G);
#endif
    }
    SEAM(8);
    if (IN(9)) { gemm_residual<true>(lds, p.OC, p.WOUT1, DM, nullptr, p.XB, p.SSB, tid, bid, G); }
    SEAM(9);
    if (IN(10)) { gemm_rowscale<1>(lds, p.XB, p.W1_1, FF, FF, DM, p.H, p.SSB, nullptr, nullptr, 0, 0, -1, tid, bid, G); }
    SEAM(10);
    const bool fuse_fn = !ATT_PROBE && G == 256 && IN(11) && IN(12);
    if (IN(11)) { if (fuse_fn) gemm_final(lds, p.H, p.W2_1, FF, p.XB, p.SSA, p.norm_final, p.out, (unsigned*)(ws + WS_RBFLAG), (unsigned*)(ws + WS_CTL), bid, G);
        else gemm_residual<true>(lds, p.H, p.W2_1, FF, nullptr, p.XB, p.SSA, tid, bid, G); }
    if (!fuse_fn) SEAM(11);
    if (IN(12) && !fuse_fn) { final_norm_phase(p, tid, bid, G);
#if ATT_PROBE
        __syncthreads();
        if (bid == 0 && tid == 0) { const unsigned long long den = ATT_PROBE_SEL >= 8 ? att::g_dbg[11] * 100ull : att::g_dbg[4]; const float v = (float)((double)att::g_dbg[ATT_PROBE_SEL] / (double)(den ? den : 1ull)) * 0.01f; p.out[0] += v; }
#endif
    }
#undef IN
#undef SEAM
}

extern "C" void kernel_launch(void* const* d_in, const int* in_sizes, int n_in, void* d_out, int out_size, void* d_ws, size_t ws_size, hipStream_t stream) {
    static int grid = 0;
    if (grid == 0) {
        if (n_in != 22 || out_size != M * DM || ws_size < WS_END) { fprintf(stderr, "kernel_launch: unexpected shapes (n_in %d out %d ws %zu)\n", n_in, out_size, ws_size); grid = -1; return; }
        int dev = 0, cus = 0, per_cu = 0;
        if (hipGetDevice(&dev) != hipSuccess || hipDeviceGetAttribute(&cus, hipDeviceAttributeMultiprocessorCount, dev) != hipSuccess) { grid = -1; return; }
        if (hipFuncSetAttribute((const void*)mk_fwd, hipFuncAttributeMaxDynamicSharedMemorySize, LDS_BYTES) != hipSuccess) { fprintf(stderr, "kernel_launch: hipFuncSetAttribute failed\n"); grid = -1; return; }
        if (hipOccupancyMaxActiveBlocksPerMultiprocessor(&per_cu, (const void*)mk_fwd, NTHR, LDS_BYTES) != hipSuccess || per_cu < 1) { fprintf(stderr, "kernel_launch: occupancy query says %d blocks per CU\n", per_cu); (void)hipGetLastError(); grid = -1; return; }
        grid = cus * 1;
    }
    if (grid < 0) return;
    Args a{};
    for (int i = 0; i < 22; ++i) a.in[i] = (const float*)d_in[i];
    a.out = (float*)d_out; a.ws = (unsigned char*)d_ws; a.ph_lo = 0; a.ph_hi = NPHASE;
    void* kargs[] = {&a};
    hipError_t e = hipLaunchCooperativeKernel((const void*)mk_fwd, dim3(grid), dim3(NTHR), kargs, LDS_BYTES, stream);
    if (e != hipSuccess) fprintf(stderr, "kernel_launch: cooperative launch failed: %s (grid %d)\n", hipGetErrorString(e), grid);
}
```

```cpp
#include <hip/hip_runtime.h>
#include <hip/hip_cooperative_groups.h>
#include <cstdint>
#include <cstdio>

typedef unsigned short bf16;
typedef unsigned v4u __attribute__((ext_vector_type(4)));
typedef float f32x4 __attribute__((ext_vector_type(4)));

constexpr int BATCH = 2, SEQ = 8192, DM = 1024, M = BATCH * SEQ, FF = 4096;
constexpr int NP0 = 2816, NP1 = 3072, EVEN_PROJ = 2840;
constexpr float EPS = 1e-6f;
constexpr float LOG2E = 1.4426950408889634f, C2 = 0.125f * LOG2E;
constexpr int C_Q = 0, C_KC = 512, C_VC = 640, C_KS = 768, C_VS = 896, C_KW = 1024, C_VW = 1152, C_DQ = 1280, C_DK = 1792, C_DV = 2304;
constexpr int NCMP = 511;

constexpr size_t MiB = 1u << 20;
constexpr size_t WS_CTL = 0;
constexpr size_t WS_SSA = 1 * MiB, WS_SSB = 2 * MiB;
constexpr size_t WS_GATES = 3 * MiB;
constexpr size_t WS_KCMP = 4 * MiB + 512 * 1024, WS_VCMP = WS_KCMP + 256 * 1024;
constexpr size_t WS_CMPB = 5 * MiB;
constexpr size_t WS_BIASL = 5 * MiB + 16384;
constexpr size_t WS_KMEAN = 5 * MiB + 256 * 1024;
constexpr size_t WS_WIN0 = 8 * MiB, WS_WOUT0 = 14 * MiB, WS_W1_0 = 16 * MiB, WS_W2_0 = 24 * MiB;
constexpr size_t WS_WIN1 = 32 * MiB, WS_WOUT1 = 38 * MiB, WS_W1_1 = 40 * MiB, WS_W2_1 = 48 * MiB;
constexpr size_t WS_CW1K = 56 * MiB, WS_CW1V = 56 * MiB + 512 * 1024, WS_CW2K = 57 * MiB, WS_CW2V = 57 * MiB + 64 * 1024;
constexpr size_t WS_XB = 58 * MiB, WS_OC = 90 * MiB, WS_H = 122 * MiB, WS_PROJ = 122 * MiB, WS_END = 250 * MiB;

__device__ __forceinline__ unsigned f2bf(float f) { unsigned u = __builtin_bit_cast(unsigned, f); return (u + 0x7fffu + ((u >> 16) & 1u)) >> 16; }
__device__ __forceinline__ float bf2f(unsigned h) { return __builtin_bit_cast(float, h << 16); }
__device__ __forceinline__ unsigned pk2(float lo, float hi) { return f2bf(lo) | (f2bf(hi) << 16); }
__device__ __forceinline__ float wave_sum(float v) {
#pragma unroll
    for (int o = 1; o < 64; o <<= 1) v += __shfl_xor(v, o);
    return v;
}
__device__ __forceinline__ float wave_max(float v) {
#pragma unroll
    for (int o = 1; o < 64; o <<= 1) v = fmaxf(v, __shfl_xor(v, o));
    return v;
}
__device__ __forceinline__ float rstd_of(const float* SS, int row) {
    const f32x4* p = (const f32x4*)(SS + (size_t)row * 16);
    f32x4 a = p[0], b = p[1], c = p[2], d = p[3];
    float s = ((a.x + a.y) + (a.z + a.w)) + ((b.x + b.y) + (b.z + b.w)) + ((c.x + c.y) + (c.z + c.w)) + ((d.x + d.y) + (d.z + d.w));
    return 1.0f / sqrtf(s * (1.0f / DM) + EPS);
}
__device__ __forceinline__ int t5_bucket(int rel) {
    int n = rel < 0 ? 0 : rel;
    if (n < 16) return n;
    int large = 16 + (int)(logf((float)n / 16.0f) / logf(8.0f) * 16.0f);
    return large < 31 ? large : 31;
}

namespace pg8 {
#define PG8_LAS __attribute__((address_space(3)))
typedef unsigned short bf16_t;
typedef short bf16x8 __attribute__((ext_vector_type(8)));
typedef float f32x4 __attribute__((ext_vector_type(4)));
typedef unsigned u32x4 __attribute__((ext_vector_type(4)));
constexpr int BM = 256, BK = 64, HALF = 128, HTB = HALF * BK * 2  , STAGE_BYTES = 8 * HTB, NXCD = 8, WGM = 8;

__host__ __device__ __forceinline__ int lds_byte(int r, int c) { const int st = (r >> 4) * 2 + (c >> 5), rr = r & 15, cc = c & 31, ob = rr * 64 + cc * 2; return st * 1024 + (ob ^ (((ob >> 9) & 1) << 5)); }
__host__ __device__ __forceinline__ void stage_rc(int b, int& R, int& C) { const int st = b / 1024, sb = b % 1024, swz = sb ^ (((sb >> 9) & 1) << 5); R = (st >> 1) * 16 + swz / 64; C = (st & 1) * 32 + (swz % 64) / 2; }
__host__ __device__ __forceinline__ int perm32(int rho) { const int n = rho >> 4, i = rho & 15; return 8 * (i >> 2) + 4 * n + (i & 3); }

struct Unit { int pm, pn; };
struct Gemm { const bf16_t* A; const bf16_t* Bt; int M, N, K; };

struct StaticOrder {
    int nM, nN, nwg, G, c;
    __host__ __device__ void init(int M, int N, int G_, int c_) { nM = M / BM; nN = N / BM; nwg = nM * nN; G = G_; c = c_; }
    __host__ __device__ bool next(int i, Unit& u) const {
        const long L = (long)i * G + c; if (L >= nwg) return false;
        int wgid = (int)L; { const int q = nwg / NXCD, r = nwg % NXCD, xcd = wgid % NXCD, off = wgid / NXCD; wgid = (xcd < r ? xcd * (q + 1) : r * (q + 1) + (xcd - r) * q) + off; }
        const int nig = WGM * nN, gid = wgid / nig, fm = gid * WGM, gsz = (nM - fm) < WGM ? (nM - fm) : WGM;
        u.pm = fm + ((wgid % nig) % gsz); u.pn = (wgid % nig) / gsz; return true;
    }
    __device__ __forceinline__ void a_ready(const Unit&) const {}
    __device__ __forceinline__ void done(const Unit&) const {}
};
__device__ __forceinline__ unsigned cvt_pk_bf16(float lo, float hi) { unsigned r; asm volatile("v_cvt_pk_bf16_f32 %0, %1, %2" : "=v"(r) : "v"(lo), "v"(hi)); return r; }
typedef float f32x2 __attribute__((ext_vector_type(2)));
template <class Epi, class Sched, bool ALIGN_EPI = false, bool SP2 = false>
__device__ __forceinline__ void gemm_phase(PG8_LAS unsigned char* lds, const Gemm g, const Sched& S, const Epi& E) {
    const int tid = threadIdx.x, wid = __builtin_amdgcn_readfirstlane(tid >> 6), lane = tid & 63, wr = wid >> 2, wc = wid & 3, fr = lane & 15, fq = lane >> 4;
    const int K = g.K, nt = K / BK;
    unsigned voffA[2], voffB[2];
#pragma unroll
    for (int i = 0; i < 2; ++i) { int R, C; stage_rc(tid * 16 + i * 8192, R, C); const int Rb = Epi::PERM ? ((R & ~31) + perm32(R & 31)) : R;
        voffA[i] = (unsigned)(R * K + C) * 2u; voffB[i] = (unsigned)(Rb * K + C) * 2u; }
    const size_t kstep = (size_t)(BK * 2);
    const size_t hstep = (size_t)HALF * K * 2;
    const size_t tstep = 2 * hstep;
    const unsigned ldsw = (unsigned)wid * 1024u;
    const int aoff = lds_byte(wr * 64 + fr, fq * 8), boff = lds_byte(wc * 32 + fr, fq * 8);
#define PG8_SA(b, h) (((b) * 2 + (h)) * HTB)
#define PG8_SB(b, h) ((4 + (b) * 2 + (h)) * HTB)
#define PG8_STAGE(bufoff, gbase, voff) do { _Pragma("unroll") for (int _i = 0; _i < 2; ++_i) \
        __builtin_amdgcn_global_load_lds((const unsigned*)((const char*)(gbase) + (voff)[_i]), (PG8_LAS unsigned*)(lds + (bufoff) + ldsw + _i * 8192), 16, 0, 0); } while (0)
#define PG8_LDA(dst, b, h) do { _Pragma("unroll") for (int m = 0; m < 4; ++m) _Pragma("unroll") for (int k = 0; k < 2; ++k) dst[m][k] = *(const PG8_LAS bf16x8*)(lds + PG8_SA(b, h) + aoff + m * 2048 + k * 1024); } while (0)
#define PG8_LDB(dst, b, h) do { _Pragma("unroll") for (int n = 0; n < 2; ++n) _Pragma("unroll") for (int k = 0; k < 2; ++k) dst[n][k] = *(const PG8_LAS bf16x8*)(lds + PG8_SB(b, h) + boff + n * 2048 + k * 1024); } while (0)
#define PG8_MMA(ai, bj, At, Bt) do { __builtin_amdgcn_s_setprio(1); _Pragma("unroll") for (int m = 0; m < 4; ++m) _Pragma("unroll") for (int n = 0; n < 2; ++n) _Pragma("unroll") for (int k = 0; k < 2; ++k) \
        acc[ai][bj][m][n] = __builtin_amdgcn_mfma_f32_16x16x32_bf16(Bt[n][k], At[m][k], acc[ai][bj][m][n], 0, 0, 0); __builtin_amdgcn_s_setprio(0); } while (0)
#define PG8_WAIT_V(n) asm volatile("s_waitcnt vmcnt(" #n ")" ::: "memory")
#define PG8_WAIT_L(n) asm volatile("s_waitcnt lgkmcnt(" #n ")" ::: "memory")
#define PG8_BAR __builtin_amdgcn_s_barrier()
#define PG8_SCHED __builtin_amdgcn_sched_barrier(0)
    Unit cur, nxt; int ui = 0;
    if (!S.next(0, cur)) return;
    f32x4 acc[2][2][4][2];
#pragma unroll
    for (int a = 0; a < 2; ++a)
#pragma unroll
        for (int b = 0; b < 2; ++b)
#pragma unroll
            for (int m = 0; m < 4; ++m)
#pragma unroll
                for (int n = 0; n < 2; ++n) acc[a][b][m][n] = (f32x4){0.f, 0.f, 0.f, 0.f};
    bf16x8 At[4][2], B0[2][2], B1[2][2];
    const char* cA = (const char*)g.A + (size_t)cur.pm * tstep; const char* cB = (const char*)g.Bt + (size_t)cur.pn * tstep;
    S.a_ready(cur);
    if constexpr (SP2) {
        PG8_STAGE(PG8_SB(0, 0), cB, voffB); PG8_STAGE(PG8_SB(0, 1), cB + hstep, voffB); PG8_STAGE(PG8_SA(0, 0), cA, voffA); PG8_STAGE(PG8_SA(0, 1), cA + hstep, voffA);
        if (wr == 1) PG8_BAR;
        PG8_WAIT_V(2); PG8_BAR;
        PG8_STAGE(PG8_SB(1, 0), cB + kstep, voffB); PG8_STAGE(PG8_SA(1, 0), cA + kstep, voffA); PG8_STAGE(PG8_SB(1, 1), cB + hstep + kstep, voffB);
        PG8_WAIT_V(6); PG8_BAR;
    } else {
        PG8_STAGE(PG8_SB(0, 0), cB, voffB); PG8_STAGE(PG8_SA(0, 0), cA, voffA); PG8_STAGE(PG8_SB(0, 1), cB + hstep, voffB); PG8_STAGE(PG8_SA(0, 1), cA + hstep, voffA);
        if (wr == 1) PG8_BAR;
        PG8_WAIT_V(4); PG8_BAR;
        PG8_STAGE(PG8_SB(1, 0), cB + kstep, voffB); PG8_STAGE(PG8_SA(1, 0), cA + kstep, voffA); PG8_STAGE(PG8_SB(1, 1), cB + hstep + kstep, voffB);
        PG8_WAIT_V(6); PG8_BAR;
    }
    for (;;) {
        const bool has_next = S.next(ui + 1, nxt);
        const char* nA = has_next ? (const char*)g.A + (size_t)nxt.pm * tstep : cA; const char* nB = has_next ? (const char*)g.Bt + (size_t)nxt.pn * tstep : cB;
        for (int t = 0; t < nt; t += 2) {
            const bool last = (t == nt - 2);
            const char* a1 = cA + (size_t)(t + 1) * kstep;
            const char* a2 = last ? nA : cA + (size_t)(t + 2) * kstep; const char* b2 = last ? nB : cB + (size_t)(t + 2) * kstep;
            const char* a3 = a2 + kstep; const char* b3 = b2 + kstep;
            if (last && has_next) S.a_ready(nxt);
            if constexpr (SP2) {
            PG8_LDB(B0, 0, 0); PG8_LDB(B1, 0, 1); PG8_SCHED; PG8_LDA(At, 0, 0); PG8_STAGE(PG8_SA(1, 1), a1 + hstep, voffA);
            PG8_WAIT_V(8); PG8_WAIT_L(0); PG8_BAR; PG8_MMA(0, 0, At, B0); PG8_MMA(0, 1, At, B1); PG8_BAR; PG8_SCHED;
            PG8_LDA(At, 0, 1); PG8_STAGE(PG8_SB(0, 0), b2, voffB); PG8_STAGE(PG8_SB(0, 1), b2 + hstep, voffB); PG8_STAGE(PG8_SA(0, 0), a2, voffA);
            PG8_WAIT_V(8); PG8_WAIT_L(0); PG8_BAR; PG8_MMA(1, 0, At, B0); PG8_MMA(1, 1, At, B1); PG8_BAR; PG8_SCHED;
            PG8_LDB(B0, 1, 0); PG8_LDB(B1, 1, 1); PG8_SCHED; PG8_LDA(At, 1, 0); PG8_STAGE(PG8_SA(0, 1), a2 + hstep, voffA);
            PG8_WAIT_V(8); PG8_WAIT_L(0); PG8_BAR; PG8_MMA(0, 0, At, B0); PG8_MMA(0, 1, At, B1); PG8_BAR; PG8_SCHED;
            PG8_LDA(At, 1, 1); PG8_STAGE(PG8_SB(1, 0), b3, voffB); PG8_STAGE(PG8_SB(1, 1), b3 + hstep, voffB); PG8_STAGE(PG8_SA(1, 0), a3, voffA);
            PG8_WAIT_V(8); PG8_WAIT_L(0); PG8_BAR; PG8_MMA(1, 0, At, B0); PG8_MMA(1, 1, At, B1); PG8_BAR; PG8_SCHED;
            } else {
            PG8_LDB(B0, 0, 0); PG8_SCHED; PG8_LDA(At, 0, 0); PG8_STAGE(PG8_SA(1, 1), a1 + hstep, voffA);
            PG8_WAIT_L(8); PG8_BAR; PG8_WAIT_L(0); PG8_MMA(0, 0, At, B0); PG8_BAR; PG8_SCHED;
            PG8_LDB(B1, 0, 1); PG8_STAGE(PG8_SB(0, 0), b2, voffB);
            PG8_BAR; PG8_WAIT_L(0); PG8_MMA(0, 1, At, B1); PG8_BAR;
            PG8_LDA(At, 0, 1); PG8_STAGE(PG8_SA(0, 0), a2, voffA);
            PG8_BAR; PG8_WAIT_L(0); PG8_MMA(1, 0, At, B0); PG8_BAR; PG8_SCHED;
            PG8_STAGE(PG8_SB(0, 1), b2 + hstep, voffB);
            PG8_WAIT_V(6); PG8_BAR; PG8_MMA(1, 1, At, B1); PG8_BAR;
            PG8_LDB(B0, 1, 0); PG8_SCHED; PG8_LDA(At, 1, 0); PG8_STAGE(PG8_SA(0, 1), a2 + hstep, voffA);
            PG8_WAIT_L(8); PG8_BAR; PG8_WAIT_L(0); PG8_MMA(0, 0, At, B0); PG8_BAR; PG8_SCHED;
            PG8_LDB(B1, 1, 1); PG8_STAGE(PG8_SB(1, 0), b3, voffB);
            PG8_BAR; PG8_WAIT_L(0); PG8_MMA(0, 1, At, B1); PG8_BAR;
            PG8_LDA(At, 1, 1); PG8_STAGE(PG8_SA(1, 0), a3, voffA);
            PG8_BAR; PG8_WAIT_L(0); PG8_MMA(1, 0, At, B0); PG8_BAR; PG8_SCHED;
            PG8_STAGE(PG8_SB(1, 1), b3 + hstep, voffB);
            PG8_WAIT_V(6); PG8_BAR; PG8_MMA(1, 1, At, B1); PG8_BAR;
            }
        }
        if constexpr (ALIGN_EPI) { if (wr == 0) PG8_BAR; }
        if constexpr (!Epi::AFTER_DRAIN) { E(acc, cur, wr, wc, fr, fq); S.done(cur); }
        if (!has_next) break;
#pragma unroll
        for (int a = 0; a < 2; ++a)
#pragma unroll
            for (int b = 0; b < 2; ++b)
#pragma unroll
                for (int m = 0; m < 4; ++m)
#pragma unroll
                    for (int n = 0; n < 2; ++n) acc[a][b][m][n] = (f32x4){0.f, 0.f, 0.f, 0.f};
        cur = nxt; cA = nA; cB = nB; ++ui;
        if constexpr (ALIGN_EPI) { if (wr == 1) PG8_BAR; }
    }
    PG8_WAIT_V(0);
    if constexpr (!ALIGN_EPI) { if (wr == 0) PG8_BAR; }
    PG8_BAR;
    if constexpr (Epi::AFTER_DRAIN) { E.fused(acc, cur, wr, wc, fr, fq, lds, wid, lane); S.done(cur); }
#undef PG8_SA
#undef PG8_SB
#undef PG8_STAGE
#undef PG8_LDA
#undef PG8_LDB
#undef PG8_MMA
#undef PG8_WAIT_V
#undef PG8_WAIT_L
#undef PG8_BAR
#undef PG8_SCHED
}
}

namespace pg8 {
template <int MODE> struct EpiRowScaleBf16 {
    static constexpr bool PERM = true, AFTER_DRAIN = false;
    bf16_t* O; const float* SS; float* KMP; float* GATES; int ldc, kt_lo, kt_hi, gate_tile; const PG8_LAS float* rsl; int rs_pm;
    __device__ __forceinline__ void operator()(const f32x4 (&acc)[2][2][4][2], const Unit& u, int wr, int wc, int fr, int fq) const {
        const int row0 = u.pm * BM + wr * 64 + fr, col0 = u.pn * BM + wc * 32 + 8 * fq;
        if (MODE == 0 && u.pn == gate_tile) {
            if (wc == 0 && fq < 3) {
#pragma unroll
                for (int ai = 0; ai < 2; ++ai)
#pragma unroll
                    for (int m = 0; m < 4; ++m) { const int row = row0 + ai * HALF + m * 16; const float rs = (rsl && u.pm == rs_pm) ? rsl[wr * 64 + fr + ai * HALF + m * 16] : rstd_of(SS, row); float* gp = GATES + (size_t)row * 24 + 8 * fq;
                        f32x4 g0 = acc[ai][0][m][0] * rs, g1 = acc[ai][0][m][1] * rs;
#pragma unroll
                        for (int e = 0; e < 4; ++e) { g0[e] = 1.0f / (1.0f + __expf(-g0[e])); g1[e] = 1.0f / (1.0f + __expf(-g1[e])); }
                        *(f32x4*)gp = g0; *(f32x4*)(gp + 4) = g1; }
            }
            return;
        }
        const bool do_km = (u.pn >= kt_lo && u.pn < kt_hi);
        float cs[2][8];
#pragma unroll
        for (int bj = 0; bj < 2; ++bj)
#pragma unroll
            for (int e = 0; e < 8; ++e) cs[bj][e] = 0.f;
#pragma unroll
        for (int ai = 0; ai < 2; ++ai) {
            float rsv[4];
#pragma unroll
            for (int m = 0; m < 4; ++m) rsv[m] = (rsl && u.pm == rs_pm) ? rsl[wr * 64 + fr + ai * HALF + m * 16] : rstd_of(SS, row0 + ai * HALF + m * 16);
#pragma unroll
            for (int m = 0; m < 4; ++m) { const int row = row0 + ai * HALF + m * 16; const float rs = rsv[m]; bf16_t* rowp = O + (size_t)row * ldc + col0;
#pragma unroll
                for (int bj = 0; bj < 2; ++bj) { f32x4 v0 = acc[ai][bj][m][0] * rs, v1 = acc[ai][bj][m][1] * rs;
                    if (MODE == 1) {
#pragma unroll
                        for (int e = 0; e < 4; ++e) { float a = v0[e] > 0.f ? v0[e] : 0.f; v0[e] = a * a; float b = v1[e] > 0.f ? v1[e] : 0.f; v1[e] = b * b; } }
                    if (MODE == 0 && do_km) {
#pragma unroll
                        for (int e = 0; e < 4; ++e) { cs[bj][e] += v0[e]; cs[bj][4 + e] += v1[e]; } }
                    u32x4 w; w.x = cvt_pk_bf16(v0[0], v0[1]); w.y = cvt_pk_bf16(v0[2], v0[3]); w.z = cvt_pk_bf16(v1[0], v1[1]); w.w = cvt_pk_bf16(v1[2], v1[3]);
                    *(u32x4*)(rowp + bj * HALF) = w; } }
        }
        if (MODE == 0 && do_km) {
            const int b = u.pm >> 5, blk = u.pm & 31;
#pragma unroll
            for (int bj = 0; bj < 2; ++bj)
#pragma unroll
                for (int e = 0; e < 8; ++e) { float s = cs[bj][e]; s += __shfl_xor(s, 1); s += __shfl_xor(s, 2); s += __shfl_xor(s, 4); s += __shfl_xor(s, 8);
                    if (fr == 0) { const int kc = (u.pn - kt_lo) * BM + bj * HALF + wc * 32 + 8 * fq + e;
                        KMP[(((size_t)wr * 2 + b) * 16 + (kc >> 6)) * 32 * 64 + (size_t)blk * 64 + (kc & 63)] = s; } }
        }
    }
};
__device__ __forceinline__ float pg8_sum_fq(float v) {
    auto a = __builtin_amdgcn_permlane16_swap(__float_as_uint(v), __float_as_uint(v), false, false); const float s = __uint_as_float(a[0]) + __uint_as_float(a[1]);
    auto b = __builtin_amdgcn_permlane32_swap(__float_as_uint(s), __float_as_uint(s), false, false); return __uint_as_float(b[0]) + __uint_as_float(b[1]);
}
template <bool INBF> struct EpiResidual {
    static constexpr bool PERM = true, AFTER_DRAIN = false;
    const float* xin32; bf16_t* xb; float* SS;
    __device__ __forceinline__ void operator()(const f32x4 (&acc)[2][2][4][2], const Unit& u, int wr, int wc, int fr, int fq) const {
        const int col0 = u.pn * BM + wc * 32 + 8 * fq;
#pragma unroll
        for (int ai = 0; ai < 2; ++ai) {
            f32x4 bs[4][2][2];
#pragma unroll
            for (int m = 0; m < 4; ++m) { const size_t off = (size_t)(u.pm * BM + ai * HALF + wr * 64 + m * 16 + fr) * DM + col0;
#pragma unroll
                for (int bj = 0; bj < 2; ++bj) {
                    if (INBF) { const u32x4 w = *(const u32x4*)(xb + off + bj * HALF);
                        bs[m][bj][0] = (f32x4){__builtin_bit_cast(float, w.x << 16), __builtin_bit_cast(float, w.x & 0xffff0000u), __builtin_bit_cast(float, w.y << 16), __builtin_bit_cast(float, w.y & 0xffff0000u)};
                        bs[m][bj][1] = (f32x4){__builtin_bit_cast(float, w.z << 16), __builtin_bit_cast(float, w.z & 0xffff0000u), __builtin_bit_cast(float, w.w << 16), __builtin_bit_cast(float, w.w & 0xffff0000u)}; }
                    else { bs[m][bj][0] = *(const f32x4*)(xin32 + off + bj * HALF); bs[m][bj][1] = *(const f32x4*)(xin32 + off + bj * HALF + 4); } } }
#pragma unroll
            for (int m = 0; m < 4; ++m) { const int row = u.pm * BM + ai * HALF + wr * 64 + m * 16 + fr; const size_t off = (size_t)row * DM + col0; float sq = 0.f;
#pragma unroll
                for (int bj = 0; bj < 2; ++bj) { const f32x4 o0 = bs[m][bj][0] + acc[ai][bj][m][0], o1 = bs[m][bj][1] + acc[ai][bj][m][1];
                    sq += ((o0[0] * o0[0] + o0[1] * o0[1]) + (o0[2] * o0[2] + o0[3] * o0[3])) + ((o1[0] * o1[0] + o1[1] * o1[1]) + (o1[2] * o1[2] + o1[3] * o1[3]));
                    u32x4 w; w.x = cvt_pk_bf16(o0[0], o0[1]); w.y = cvt_pk_bf16(o0[2], o0[3]); w.z = cvt_pk_bf16(o1[0], o1[1]); w.w = cvt_pk_bf16(o1[2], o1[3]);
                    *(u32x4*)(xb + off + bj * HALF) = w; }
                sq = pg8_sum_fq(sq);
                if (fq == 0) SS[(size_t)row * 16 + u.pn * 4 + wc] = sq; }
        }
    }
};
}

namespace cg = cooperative_groups;
constexpr int NTHR = 512;
constexpr int NP0G = 3072;
constexpr int LDS_BYTES = 147456 + 8704;
constexpr size_t WS_KMP = 6 * MiB;
#ifndef USE_MFMA_MOBA
#define USE_MFMA_MOBA 1
#endif
#ifndef USE_MOBA_ROUTED
#define USE_MOBA_ROUTED 1
#endif
#ifndef USE_MFMA_DIFF
#define USE_MFMA_DIFF 1
#endif
#ifndef USE_MFMA_NSA
#define USE_MFMA_NSA 1
#endif
#ifndef PROBE_DOUBLE
#define PROBE_DOUBLE 0
#endif
#ifndef USE_MFMA_CMP
#define USE_MFMA_CMP 1
#endif
#ifndef GEMM_ALIGN
#define GEMM_ALIGN true
#endif
#ifndef GEMM_SP2
#define GEMM_SP2 true
#endif
#ifndef USE_PG8
#define USE_PG8 1
#endif

struct Args { const float* in[22]; float* out; unsigned char* ws; int ph_lo, ph_hi; };

struct PP {
    const float *x, *bias_table, *norm_mix, *norm_mlp, *norm_final, *mlp_w1, *mlp_w2, *ev_w_in, *ev_w_out, *pos_k, *w1_k, *w2_k, *pos_v, *w1_v, *w2_v, *lq1, *lk1, *lq2, *lk2, *subln, *od_w_in, *od_w_out;
    float* out; float *SSA, *SSB, *GATES, *CMPB, *BIASL, *KMEAN, *KMP;
    bf16 *KCMP, *VCMP, *WIN0, *WOUT0, *W1_0, *W2_0, *WIN1, *WOUT1, *W1_1, *W2_1, *CW1K, *CW1V, *CW2K, *CW2V, *XB, *OC, *H, *PROJ;
};

struct WJob { const float* W; bf16* WT; const float* kscale; int K, Nsrc, Ndst, kind; };
__device__ __forceinline__ void transpose_item(const WJob& J, int item, float* scr, int lane) {
    const int nblk = J.Ndst / 32, kb = item / nblk, nb = item % nblk, k0 = 64 * kb, n0 = 32 * nb;
    int s0 = n0; float cs = 1.0f; int nvalid = 32;
    if (J.kind == 1) { s0 = n0 < 1280 ? n0 : n0 + 24; if (n0 < 512 || (n0 >= C_DQ && n0 < C_DK)) cs = C2;
        if (n0 >= NP0) { s0 = 1280 + (n0 - NP0); nvalid = n0 == NP0 ? 24 : 0; if (nvalid == 0) s0 = 0; } }
    if (J.kind == 2) { if (n0 < 1024) cs = C2; }
#pragma unroll
    for (int i = 0; i < 32; ++i) { const int kk = 2 * i + (lane >> 5); scr[kk * 33 + (lane & 31)] = (lane & 31) < nvalid ? __builtin_nontemporal_load(&J.W[(size_t)(k0 + kk) * J.Nsrc + s0 + (lane & 31)]) : 0.f; }
    __builtin_amdgcn_s_waitcnt(0xC07F); asm volatile("" ::: "memory");
    const int c = lane & 7;
    float ks[8];
#pragma unroll
    for (int i = 0; i < 8; ++i) ks[i] = (J.kscale ? J.kscale[k0 + 8 * c + i] : 1.0f) * cs;
#pragma unroll
    for (int j = 0; j < 4; ++j) { const int n = (lane >> 3) + 8 * j; const float* s = scr + (8 * c) * 33 + n;
        v4u o; o.x = pk2(s[0 * 33] * ks[0], s[1 * 33] * ks[1]); o.y = pk2(s[2 * 33] * ks[2], s[3 * 33] * ks[3]); o.z = pk2(s[4 * 33] * ks[4], s[5 * 33] * ks[5]); o.w = pk2(s[6 * 33] * ks[6], s[7 * 33] * ks[7]);
        if (J.kind == 3) { const int nn = n0 + n, kc = (k0 >> 3) + c;
            *(v4u*)(J.WT + ((((size_t)(nn >> 4) * (J.K >> 5) + (kc >> 2)) * 4 + (kc & 3)) * 16 + (nn & 15)) * 8) = o; }
        else *(v4u*)(J.WT + (size_t)(n0 + n) * J.K + k0 + 8 * c) = o; }
    __builtin_amdgcn_s_waitcnt(0xC07F); asm volatile("" ::: "memory");
}
__device__ __forceinline__ void job_items(const WJob& J, int& base, int gw, int NGW, float* scr, int lane) {
    const int nit = (J.K / 64) * (J.Ndst / 32);
    const int first = ((gw - base) % NGW + NGW) % NGW;
    for (int it = first; it < nit; it += NGW) transpose_item(J, it, scr, lane);
    base += nit;
}
constexpr int WG_PITCH = 1028;
__device__ __forceinline__ void p0_prologue(const PP& p, char* lds, int tid, int bid, int G) {
    const int lane = tid & 63, wave = tid >> 6;
    {
        float* scr = (float*)lds + wave * 64 * 33;
        const int gw = bid * 8 + wave, NGW = G * 8; int base = 0;
        job_items(WJob{p.ev_w_in, p.WIN0, p.norm_mix, DM, EVEN_PROJ, NP0G, 1}, base, gw, NGW, scr, lane);
        job_items(WJob{p.ev_w_out, p.WOUT0, nullptr, DM, DM, DM, 0}, base, gw, NGW, scr, lane);
        job_items(WJob{p.mlp_w1, p.W1_0, p.norm_mlp, DM, FF, FF, 0}, base, gw, NGW, scr, lane);
        job_items(WJob{p.mlp_w2, p.W2_0, nullptr, FF, DM, DM, 0}, base, gw, NGW, scr, lane);
        job_items(WJob{p.od_w_in, p.WIN1, p.norm_mix + DM, DM, NP1, NP1, 2}, base, gw, NGW, scr, lane);
        job_items(WJob{p.od_w_out, p.WOUT1, nullptr, DM, DM, DM, 0}, base, gw, NGW, scr, lane);
        job_items(WJob{p.mlp_w1 + (size_t)DM * FF, p.W1_1, p.norm_mlp + DM, DM, FF, FF, 0}, base, gw, NGW, scr, lane);
        job_items(WJob{p.mlp_w2 + (size_t)DM * FF, p.W2_1, nullptr, FF, DM, DM, 0}, base, gw, NGW, scr, lane);
        job_items(WJob{p.w1_k, p.CW1K, nullptr, 2048, 128, 128, 3}, base, gw, NGW, scr, lane);
        job_items(WJob{p.w1_v, p.CW1V, nullptr, 2048, 128, 128, 3}, base, gw, NGW, scr, lane);
        job_items(WJob{p.w2_k, p.CW2K, nullptr, 128, 64, 64, 0}, base, gw, NGW, scr, lane);
        job_items(WJob{p.w2_v, p.CW2V, nullptr, 128, 64, 64, 0}, base, gw, NGW, scr, lane);
    }
    __syncthreads();
    if (bid == 0) { for (int i = tid; i < 16 * 128; i += NTHR) { const int h = i >> 7, rel = i & 127; p.BIASL[i] = p.bias_table[t5_bucket(rel) * 16 + h] * LOG2E; } }
#pragma unroll 1
    for (int job = 0; job < 16; ++job) { if (bid != (1 + job) % G) continue;
        const int which = job >> 3, prt = job & 7;
        const float* pos = which == 0 ? p.pos_k : p.pos_v; const float* w1 = which == 0 ? p.w1_k : p.w1_v;
        float* part = (float*)lds; const int n = tid & 127, pr = tid >> 7; const int k0 = prt * 256 + pr * 64; float s = 0.f;
#pragma unroll
        for (int j = 0; j < 64; ++j) s += pos[k0 + j] * w1[(size_t)(k0 + j) * 128 + n];
        part[pr * 128 + n] = s; __syncthreads();
        if (tid < 128) p.CMPB[(which * 8 + prt) * 128 + tid] = (part[tid] + part[128 + tid]) + (part[256 + tid] + part[384 + tid]);
        __syncthreads(); }
    __syncthreads();
#pragma unroll 4
    for (int row = bid * 8 + wave; row < M; row += G * 8) {
        const f32x4* xr = (const f32x4*)(p.x + (size_t)row * DM) + lane;
        f32x4 v[4]; float s = 0.f;
#pragma unroll
        for (int j = 0; j < 4; ++j) { v[j] = __builtin_nontemporal_load(xr + 64 * j); s += (v[j].x * v[j].x + v[j].y * v[j].y) + (v[j].z * v[j].z + v[j].w * v[j].w); }
        s = wave_sum(s);
        unsigned long long* o8 = (unsigned long long*)(p.XB + (size_t)row * DM) + lane;
#pragma unroll
        for (int j = 0; j < 4; ++j) o8[64 * j] = (unsigned long long)pk2(v[j].x, v[j].y) | ((unsigned long long)pk2(v[j].z, v[j].w) << 32);
        if (lane < 16) p.SSA[(size_t)row * 16 + lane] = lane == 0 ? s : 0.f;
    }
    __syncthreads();
}

struct NEpiProj { bf16* out; const float* SS; int ldc;
    __device__ __forceinline__ float rowscale(int row) const { return rstd_of(SS, row); }
    __device__ __forceinline__ float tile4(int row, int col, const float (&a)[4], float rs) const {
#pragma unroll
        for (int j = 0; j < 4; ++j) out[(size_t)row * ldc + col + j] = (bf16)f2bf(a[j] * rs);
        return 0.f; }
    __device__ __forceinline__ void rowstat(int, int, float) const {} };
struct NEpiRes { const float* xin; float* xout; bf16* xb; float* SS;
    __device__ __forceinline__ float rowscale(int) const { return 1.f; }
    __device__ __forceinline__ float tile4(int row, int col, const float (&a)[4], float) const { float sq = 0.f;
#pragma unroll
        for (int j = 0; j < 4; ++j) { const float v = xin[(size_t)row * DM + col + j] + a[j]; xout[(size_t)row * DM + col + j] = v; xb[(size_t)row * DM + col + j] = (bf16)f2bf(v); sq += v * v; }
        return sq; }
    __device__ __forceinline__ void rowstat(int row, int slot, float s) const { SS[(size_t)row * 16 + slot] = s; } };
struct NEpiMlp1 { bf16* H; const float* SS;
    __device__ __forceinline__ float rowscale(int row) const { return rstd_of(SS, row); }
    __device__ __forceinline__ float tile4(int row, int col, const float (&a)[4], float rs) const {
#pragma unroll
        for (int j = 0; j < 4; ++j) { float v = a[j] * rs; v = v > 0.f ? v : 0.f; H[(size_t)row * FF + col + j] = (bf16)f2bf(v * v); }
        return 0.f; }
    __device__ __forceinline__ void rowstat(int, int, float) const {} };

template <class Epi>
__device__ __forceinline__ void ngemm_phase(char* lds, const bf16* A, const bf16* Bt, int N, int K, const Epi& E, int tid, int bid, int G) {
    const int sub = tid >> 8, t = tid & 255, tx = t & 15, ty = t >> 4;
    float* As = (float*)lds + sub * (2 * 32 * 65); float* Bs = As + 32 * 65;
    const int nbx = N / 64, npairs = nbx * (M / 64) / 2;
    const int lr = t >> 2, lk = (t & 3) * 8;
    for (int it = bid; it < npairs; it += G) {
        const int tile = it * 2 + sub; const int m0 = (tile / nbx) * 64, n0 = (tile % nbx) * 64;
        float acc[4][4] = {};
        for (int k0 = 0; k0 < K; k0 += 32) {
            const v4u a = *(const v4u*)(A + (size_t)(m0 + lr) * K + k0 + lk);
            const v4u b = *(const v4u*)(Bt + (size_t)(n0 + lr) * K + k0 + lk);
            __syncthreads();
            const unsigned au[4] = {a.x, a.y, a.z, a.w}, bu[4] = {b.x, b.y, b.z, b.w};
#pragma unroll
            for (int i = 0; i < 4; ++i) { As[(lk + 2 * i) * 65 + lr] = bf2f(au[i] & 0xffff); As[(lk + 2 * i + 1) * 65 + lr] = bf2f(au[i] >> 16); Bs[(lk + 2 * i) * 65 + lr] = bf2f(bu[i] & 0xffff); Bs[(lk + 2 * i + 1) * 65 + lr] = bf2f(bu[i] >> 16); }
            __syncthreads();
#pragma unroll 8
            for (int k = 0; k < 32; ++k) {
                float av[4], bv[4];
#pragma unroll
                for (int i = 0; i < 4; ++i) { av[i] = As[k * 65 + ty * 4 + i]; bv[i] = Bs[k * 65 + tx * 4 + i]; }
#pragma unroll
                for (int i = 0; i < 4; ++i)
#pragma unroll
                    for (int j = 0; j < 4; ++j) acc[i][j] += av[i] * bv[j];
            }
        }
#pragma unroll
        for (int i = 0; i < 4; ++i) { const int row = m0 + ty * 4 + i; const float rs = E.rowscale(row);
            float sq = E.tile4(row, n0 + tx * 4, acc[i], rs);
            sq += __shfl_xor(sq, 1); sq += __shfl_xor(sq, 2); sq += __shfl_xor(sq, 4); sq += __shfl_xor(sq, 8);
            if (tx == 0) E.rowstat(row, n0 / 64, sq); }
    }
    __syncthreads();
}

__device__ __forceinline__ float gelu_tanh(float x) { const float u = 0.7978845608028654f * (x + 0.044715f * x * x * x); return 0.5f * x * (1.0f + tanhf(u)); }
__device__ __forceinline__ void ncompress_phase(const PP& p, char* lds, int tid, int bid, int G) {
    const int sub = tid >> 7, t = tid & 127;
    float* a = (float*)lds + sub * (2048 + 128); float* hid = a + 2048;
    for (int it = bid; it < 1024; it += G) {
        int id = it * 4 + sub; const int c = id % 512; id /= 512; const int g = id % 2; id /= 2; const int b = id % 2; const int kv = id / 2;
        bf16* outp = (kv ? p.VCMP : p.KCMP) + ((size_t)((b * 2 + g) * 512 + c)) * 64;
        const bool live = c < NCMP; const int cc = live ? c : 0;
        const int col = (kv ? C_VC : C_KC) + g * 64;
        __syncthreads();
        for (int i = t; i < 2048; i += 128) { const int j = i >> 6, d = i & 63; a[i] = bf2f(p.PROJ[(size_t)(b * SEQ + 16 * cc + j) * NP0 + col + d]); }
        __syncthreads();
        const bf16* w1 = (kv ? p.CW1V : p.CW1K) + (size_t)t * 2048; float s = 0.f; for (int j = 0; j < 8; ++j) s += p.CMPB[(kv * 8 + j) * 128 + t];
        for (int k = 0; k < 2048; k += 8) { const v4u u = *(const v4u*)(w1 + k);
            s += a[k] * bf2f(u.x & 0xffff) + a[k + 1] * bf2f(u.x >> 16) + a[k + 2] * bf2f(u.y & 0xffff) + a[k + 3] * bf2f(u.y >> 16) + a[k + 4] * bf2f(u.z & 0xffff) + a[k + 5] * bf2f(u.z >> 16) + a[k + 6] * bf2f(u.w & 0xffff) + a[k + 7] * bf2f(u.w >> 16); }
        hid[t] = bf2f(f2bf(gelu_tanh(s)));
        __syncthreads();
        if (t < 64) { const bf16* w2 = (kv ? p.CW2V : p.CW2K) + (size_t)t * 128; float o = 0.f; for (int n = 0; n < 128; ++n) o += hid[n] * bf2f(w2[n]); outp[t] = live ? (bf16)f2bf(o) : (bf16)0; }
    }
    __syncthreads();
}

template <int NV> struct NAcc { float m, l, o[NV]; };
template <int NV> __device__ __forceinline__ void nacc_init(NAcc<NV>& a) { a.m = -1e30f; a.l = 0.f;
#pragma unroll
    for (int j = 0; j < NV; ++j) a.o[j] = 0.f; }
__device__ __forceinline__ void load_q64(float (&q)[64], const bf16* qp) {
#pragma unroll
    for (int i = 0; i < 8; ++i) { const v4u u = ((const v4u*)qp)[i];
        q[8 * i + 0] = bf2f(u.x & 0xffff); q[8 * i + 1] = bf2f(u.x >> 16); q[8 * i + 2] = bf2f(u.y & 0xffff); q[8 * i + 3] = bf2f(u.y >> 16);
        q[8 * i + 4] = bf2f(u.z & 0xffff); q[8 * i + 5] = bf2f(u.z >> 16); q[8 * i + 6] = bf2f(u.w & 0xffff); q[8 * i + 7] = bf2f(u.w >> 16); }
}
__device__ __forceinline__ float dot64(const float (&q)[64], const bf16* kp) {
    float s = 0.f;
#pragma unroll
    for (int i = 0; i < 8; ++i) { const v4u u = ((const v4u*)kp)[i];
        s += q[8 * i + 0] * bf2f(u.x & 0xffff) + q[8 * i + 1] * bf2f(u.x >> 16) + q[8 * i + 2] * bf2f(u.y & 0xffff) + q[8 * i + 3] * bf2f(u.y >> 16)
           + q[8 * i + 4] * bf2f(u.z & 0xffff) + q[8 * i + 5] * bf2f(u.z >> 16) + q[8 * i + 6] * bf2f(u.w & 0xffff) + q[8 * i + 7] * bf2f(u.w >> 16); }
    return s;
}
template <int NV> __device__ __forceinline__ void ntile(NAcc<NV>& a, const float (&q)[64], const bf16* kp, const bf16* vp, bool valid, float bias, int lane) {
    const float s = valid ? dot64(q, kp) + bias : -INFINITY;
    const float tm = wave_max(s);
    const float mn = fmaxf(a.m, tm), f = exp2f(a.m - mn), pr = exp2f(s - mn);
    a.l = a.l * f + wave_sum(pr); a.m = mn;
#pragma unroll
    for (int j = 0; j < NV; ++j) a.o[j] *= f;
    const unsigned long long vpi = (unsigned long long)(uintptr_t)vp;
    const unsigned vlo = (unsigned)vpi, vhi = (unsigned)(vpi >> 32);
    for (int k = 0; k < 64; ++k) {
        const float pk = __shfl(pr, k);
        const unsigned lo = __shfl(vlo, k), hi = __shfl(vhi, k);
        if (pk != 0.f) { const bf16* vr = (const bf16*)(uintptr_t)(((unsigned long long)hi << 32) | lo);
#pragma unroll
            for (int j = 0; j < NV; ++j) a.o[j] += pk * bf2f(vr[lane + 64 * j]); }
    }
}

__device__ __forceinline__ void nnsa_phase(const PP& p, char* lds, int tid, int bid, int G) {
    const int sub = tid >> 8, t256 = tid & 255, lane = tid & 63, r = t256 >> 6;
    float* base = (float*)lds + sub * (4 * 512 + 4 * 128 + 128 + 16);
    float* sc = base + r * 512; float* imph = base + 4 * 512; float* score = imph + 4 * 128; int* sel = (int*)(score + 128);
    for (int it = bid; it < M * 2 / 2; it += G) {
        int id = it * 2 + sub; const int t = id % SEQ; id /= SEQ; const int g = id % 2; const int b = id / 2;
        const int hh = g * 4 + r; const size_t row = (size_t)b * SEQ + t;
        const float* bl = p.BIASL + hh * 128;
        float q[64]; load_q64(q, p.PROJ + row * NP0 + C_Q + hh * 64);
        const int nvis = t >= 31 ? ((t - 31) / 16 + 1 < NCMP ? (t - 31) / 16 + 1 : NCMP) : 0;
        const bf16* kc = p.KCMP + (size_t)((b * 2 + g) * 512) * 64; const bf16* vc = p.VCMP + (size_t)((b * 2 + g) * 512) * 64;
        __syncthreads();
        float mx = -INFINITY;
        for (int c0 = 0; c0 < nvis; c0 += 64) { const int c = c0 + lane; float s = -INFINITY;
            if (c < nvis) { int rel = t - (16 * c + 31); rel = rel > 127 ? 127 : rel; s = dot64(q, kc + (size_t)c * 64) + bl[rel]; }
            sc[c] = s; mx = fmaxf(mx, s); }
        mx = wave_max(mx);
        float ls = 0.f;
        for (int c0 = 0; c0 < nvis; c0 += 64) { const int c = c0 + lane; const float e = exp2f(sc[c] - mx); sc[c] = e; ls += e; }
        ls = wave_sum(ls);
        const float rl = ls > 0.f ? 1.0f / ls : 0.f;
        for (int c = lane; c < 512; c += 64) sc[c] = c < nvis ? sc[c] * rl : 0.f;
        float oc = 0.f;
        for (int c = 0; c < nvis; ++c) oc += sc[c] * bf2f(vc[(size_t)c * 64 + lane]);
        for (int n = lane; n < 128; n += 64) { float a = ((sc[4 * n] + sc[4 * n + 1]) + sc[4 * n + 2]) + 0.5f * sc[4 * n + 3]; if (n > 0) a += 0.5f * sc[4 * n - 1]; imph[r * 128 + n] = a; }
        __syncthreads();
        const int cur = t >> 6;
        if (t256 < 128) { const int n = t256; const float imp = (imph[n] + imph[128 + n]) + (imph[256 + n] + imph[384 + n]);
            const bool elig = n <= cur, forced = (n == 0) || (n == cur) || (n == cur - 1);
            score[n] = elig ? imp + (forced ? 1000.f : 0.f) : -1.0f; }
        __syncthreads();
        if (t256 < 128) { const int n = t256; const float v = score[n]; int rank = 0;
            for (int j = 0; j < 128; ++j) { const float u = score[j]; rank += (u > v || (u == v && j < n)) ? 1 : 0; }
            if (rank < 16) sel[rank] = n; }
        __syncthreads();
        NAcc<1> as; nacc_init(as);
        for (int i = 0; i < 16; ++i) { const int n = sel[i]; const int pos = 64 * n + lane; const int rel = t - pos; const size_t kr = (size_t)b * SEQ + pos;
            if (64 * n > t) continue;
            ntile<1>(as, q, p.PROJ + kr * NP0 + C_KS + g * 64, p.PROJ + kr * NP0 + C_VS + g * 64, rel >= 0, bl[rel < 0 ? 0 : (rel > 127 ? 127 : rel)], lane); }
        NAcc<1> aw; nacc_init(aw);
        for (int n = cur - 8; n <= cur; ++n) { if (n < 0) continue; const int pos = 64 * n + lane; const int rel = t - pos; const size_t kr = (size_t)b * SEQ + pos;
            ntile<1>(aw, q, p.PROJ + kr * NP0 + C_KW + g * 64, p.PROJ + kr * NP0 + C_VW + g * 64, rel >= 0 && rel < 512, bl[rel < 0 ? 0 : (rel > 127 ? 127 : rel)], lane); }
        const float g0 = p.GATES[row * 24 + hh], g1 = p.GATES[row * 24 + 8 + hh], g2 = p.GATES[row * 24 + 16 + hh];
        const float os = as.l > 0.f ? as.o[0] / as.l : 0.f, ow = aw.l > 0.f ? aw.o[0] / aw.l : 0.f;
        p.OC[row * DM + hh * 64 + lane] = (bf16)f2bf(g0 * oc + g1 * os + g2 * ow);
    }
    __syncthreads();
}

__device__ __forceinline__ void ndiff_phase(const PP& p, char* lds, int tid, int bid, int G) {
    const int sub = tid >> 7, lane = tid & 63, mp = (tid >> 6) & 1;
    float* o2 = (float*)lds + sub * 128;
    for (int it = bid; it < M * 4 / 4; it += G) {
        int id = it * 4 + sub; const int h = id % 4; id /= 4; const int t = id % SEQ; const int b = id / SEQ;
        const size_t row = (size_t)b * SEQ + t; const float* bl = p.BIASL + (8 + h) * 128;
        float q[64]; load_q64(q, p.PROJ + row * NP0 + C_DQ + h * 128 + mp * 64);
        NAcc<2> a; nacc_init(a);
        for (int p0 = 0; p0 <= t; p0 += 64) { const int pos = p0 + lane; const int rel = t - pos; const size_t kr = (size_t)b * SEQ + pos;
            ntile<2>(a, q, p.PROJ + kr * NP0 + C_DK + h * 128 + mp * 64, p.PROJ + kr * NP0 + C_DV + h * 128, rel >= 0, bl[rel < 0 ? 0 : (rel > 127 ? 127 : rel)], lane); }
        const float il = 1.0f / a.l; float v0 = a.o[0] * il, v1 = a.o[1] * il;
        __syncthreads();
        if (mp == 1) { o2[lane] = v0; o2[lane + 64] = v1; }
        __syncthreads();
        if (mp == 0) {
            const float lam = expf(wave_sum(p.lq1[lane] * p.lk1[lane])) - expf(wave_sum(p.lq2[lane] * p.lk2[lane])) + 0.2f;
            v0 -= lam * o2[lane]; v1 -= lam * o2[lane + 64];
            const float ss = wave_sum(v0 * v0 + v1 * v1); const float rs = 1.0f / sqrtf(ss * (1.0f / 128.f) + EPS);
            p.OC[row * DM + 512 + h * 128 + lane] = (bf16)f2bf(v0 * rs * p.subln[lane] * 0.8f);
            p.OC[row * DM + 512 + h * 128 + 64 + lane] = (bf16)f2bf(v1 * rs * p.subln[64 + lane] * 0.8f);
        }
    }
    __syncthreads();
}

__device__ __forceinline__ void nkmean_phase(const PP& p, int tid, int bid, int G) {
    for (int it = bid; it < 64 * 2; it += G) { const int bb = it >> 1, half = it & 1; const int b = bb / 32, n = bb % 32; const int col = half * 512 + tid; float s = 0.f;
        for (int r = 0; r < 256; ++r) s += bf2f(p.PROJ[(size_t)(b * SEQ + n * 256 + r) * NP1 + 1024 + col]);
        p.KMEAN[((size_t)(b * 16 + (col >> 6)) * 32 + n) * 64 + (col & 63)] = s * (1.0f / 256.f); }
}
__device__ __forceinline__ void kmean_from_partials(const PP& p, int tid, int bid, int G) {
    for (int i = bid * NTHR + tid; i < 2 * 16 * 32 * 64; i += G * NTHR) p.KMEAN[i] = (p.KMP[i] + p.KMP[2 * 16 * 32 * 64 + i]) * (1.0f / 256.f);
}
__device__ __forceinline__ void nmoba_phase(const PP& p, int tid, int bid, int G) {
    const int lane = tid & 63, w = tid >> 6;
    for (int it = bid; it < M * 16 / 8; it += G) {
        int id = it * 8 + w; const int h = id % 16; id /= 16; const int t = id % SEQ; const int b = id / SEQ;
        const size_t row = (size_t)b * SEQ + t; const float* bl = p.BIASL + h * 128; const int c = t >> 8;
        float q[64]; load_q64(q, p.PROJ + row * NP1 + h * 64);
        float gate = -1e30f;
        if (lane < 32 && lane < c) { const float* km = p.KMEAN + ((size_t)(b * 16 + h) * 32 + lane) * 64; float s = 0.f;
#pragma unroll
            for (int d = 0; d < 64; ++d) s += q[d] * km[d];
            gate = s; }
        if (lane >= 32) gate = -INFINITY;
        int rank = 0;
        for (int j = 0; j < 32; ++j) { const float u = __shfl(gate, j); rank += (u > gate || (u == gate && j < lane)) ? 1 : 0; }
        const bool chosen = lane < 32 && rank < 3 && lane < c;
        const unsigned long long cm = __ballot(chosen);
        NAcc<1> a; nacc_init(a);
        for (int n = 0; n < c; ++n) { if (!((cm >> n) & 1ull)) continue;
            for (int j = 0; j < 4; ++j) { const int pos = n * 256 + j * 64 + lane; const int rel = t - pos; const size_t kr = (size_t)b * SEQ + pos;
                ntile<1>(a, q, p.PROJ + kr * NP1 + 1024 + h * 64, p.PROJ + kr * NP1 + 2048 + h * 64, true, bl[rel > 127 ? 127 : rel], lane); } }
        for (int j = 0; j < 4; ++j) { const int pos = c * 256 + j * 64 + lane; const int rel = t - pos; const size_t kr = (size_t)b * SEQ + pos;
            if (c * 256 + j * 64 > t) break;
            ntile<1>(a, q, p.PROJ + kr * NP1 + 1024 + h * 64, p.PROJ + kr * NP1 + 2048 + h * 64, rel >= 0, bl[rel < 0 ? 0 : (rel > 127 ? 127 : rel)], lane); }
        p.OC[row * DM + h * 64 + lane] = (bf16)f2bf(a.o[0] / a.l);
    }
}
__device__ __forceinline__ void final_norm_phase(const PP& p, int tid, int bid, int G) {
    const int lane = tid & 63, wave = tid >> 6;
#pragma unroll 4
    for (int row = bid * 8 + wave; row < M; row += G * 8) {
        const unsigned long long* xr = (const unsigned long long*)(p.XB + (size_t)row * DM) + lane; f32x4* orow = (f32x4*)(p.out + (size_t)row * DM) + lane; const f32x4* gr = (const f32x4*)p.norm_final + lane; f32x4 v[4]; float s = 0.f;
#pragma unroll
        for (int j = 0; j < 4; ++j) { const unsigned long long w = xr[64 * j]; const unsigned lo = (unsigned)w, hi = (unsigned)(w >> 32);
            v[j] = (f32x4){bf2f(lo & 0xffff), bf2f(lo >> 16), bf2f(hi & 0xffff), bf2f(hi >> 16)}; s += (v[j].x * v[j].x + v[j].y * v[j].y) + (v[j].z * v[j].z + v[j].w * v[j].w); }
        s = wave_sum(s); const float rstd = 1.0f / sqrtf(s * (1.0f / DM) + EPS);
#pragma unroll
        for (int j = 0; j < 4; ++j) { const f32x4 gg = gr[64 * j]; orow[64 * j] = v[j] * rstd * gg; }
    }
}


namespace att {
#ifndef ATT_PROBE
#define ATT_PROBE 0
#endif
#ifndef ATT_PROBE_PHASE
#define ATT_PROBE_PHASE 8
#endif
#ifndef ATT_PROBE_SEL
#define ATT_PROBE_SEL 0
#endif
#ifndef ATT_PROBE_BLOCK
#define ATT_PROBE_BLOCK 0
#endif
#ifndef ATT_PROBE_WAVE
#define ATT_PROBE_WAVE 0
#endif
#if ATT_PROBE
__device__ unsigned long long g_dbg[16];
#define ATT_T(x) const unsigned long long x = __builtin_amdgcn_s_memtime()
#else
#define ATT_T(x)
#endif
#if ATT_PROBE && (ATT_PROBE_PHASE == 2 || ATT_PROBE_PHASE == 3)
#define ATT_TP(x) ATT_T(x)
#else
#define ATT_TP(x) const unsigned long long x = 0ull
#endif
#if ATT_PROBE && ATT_PROBE_PHASE == 8
#define ATT_TS(x) ATT_T(x)
#else
#define ATT_TS(x) const unsigned long long x = 0ull
#endif
#if ATT_PROBE && ATT_PROBE_PHASE == 3
#define ATT_TN(x) ATT_T(x)
#else
#define ATT_TN(x)
#endif
#define LAS3 __attribute__((address_space(3)))
typedef short bf16x8 __attribute__((ext_vector_type(8)));
typedef short s16x4 __attribute__((ext_vector_type(4)));
typedef short v4i16_t __attribute__((ext_vector_type(4)));
typedef float f32x16 __attribute__((ext_vector_type(16)));
typedef unsigned u32x4 __attribute__((ext_vector_type(4)));
typedef LAS3 const char* lds_cptr;
constexpr float THR = 8.f, NEGBIG = -1e30f;
constexpr int L_RING = 0, L_OST = 98304, L_WSF = 131072, L_BIAS = 133120, L_MISC = 141312;

__device__ __forceinline__ int crow(int r, int hi) { return (r & 3) + 8 * (r >> 2) + 4 * hi; }
__device__ __forceinline__ void glds16(const void* gsrc, unsigned lds_dst) { unsigned keep;
    asm volatile("s_mov_b32 %0, m0\n\ts_mov_b32 m0, %2\n\ts_nop 0\n\tglobal_load_lds_dwordx4 %1, off\n\ts_mov_b32 m0, %0" : "=&s"(keep) : "v"(gsrc), "s"(lds_dst) : "memory"); }
__device__ __forceinline__ void glds16s(const void* sbase, unsigned voff, unsigned lds_dst) { unsigned keep;
    asm volatile("s_nop 4\n\ts_mov_b32 %0, m0\n\ts_mov_b32 m0, %3\n\ts_nop 0\n\tglobal_load_lds_dwordx4 %1, %2\n\ts_mov_b32 m0, %0" : "=&s"(keep) : "v"(voff), "s"(sbase), "s"(lds_dst) : "memory"); }
#define ATT_WAIT_BAR(N) asm volatile("s_waitcnt vmcnt(" #N ") lgkmcnt(0)\n\ts_barrier" ::: "memory")
#define ATT_BAR() asm volatile("s_waitcnt lgkmcnt(0)\n\ts_barrier" ::: "memory")
typedef float f32x2_t __attribute__((ext_vector_type(2))); typedef __bf16 bf16x2_t __attribute__((ext_vector_type(2)));
__device__ __forceinline__ unsigned cvtpk(float lo, float hi) { f32x2_t v = {lo, hi}; bf16x2_t b = __builtin_convertvector(v, bf16x2_t); return __builtin_bit_cast(unsigned, b); }
__device__ __forceinline__ s16x4 vtr(lds_cptr p) { return __builtin_bit_cast(s16x4, __builtin_amdgcn_ds_read_tr16_b64_v4i16((LAS3 v4i16_t*)p)); }
#define ATT_MX3(a, b, c) __builtin_fmaxf(__builtin_fmaxf((a), (b)), (c))
__device__ __forceinline__ float rowmax(const f32x16& p0, const f32x16& p1) {
    float a = ATT_MX3(p0[0], p0[1], p1[0]), b = ATT_MX3(p0[2], p0[3], p1[1]); a = ATT_MX3(a, p1[2], p1[3]);
#pragma unroll
    for (int r = 4; r < 16; r += 4) { a = ATT_MX3(a, p0[r], p0[r + 1]); b = ATT_MX3(b, p0[r + 2], p0[r + 3]); a = ATT_MX3(a, p1[r], p1[r + 1]); b = ATT_MX3(b, p1[r + 2], p1[r + 3]); }
    float m = __builtin_fmaxf(a, b); auto rr = __builtin_amdgcn_permlane32_swap(__float_as_uint(m), __float_as_uint(m), false, false);
    return __builtin_fmaxf(__uint_as_float(rr[0]), __uint_as_float(rr[1]));
}
__device__ __forceinline__ float fadd_s(float a, float b) { float r; asm("v_add_f32_e32 %0, %1, %2" : "=v"(r) : "v"(a), "v"(b)); return r; }
__device__ __forceinline__ float dpp_x1(float v) { return __int_as_float(__builtin_amdgcn_update_dpp(0, __float_as_int(v), 0xB1, 0xF, 0xF, true)); }
__device__ __forceinline__ float dpp_x2(float v) { return __int_as_float(__builtin_amdgcn_update_dpp(0, __float_as_int(v), 0x4E, 0xF, 0xF, true)); }
__device__ __forceinline__ float halfsum(float v) { auto rr = __builtin_amdgcn_permlane32_swap(__float_as_uint(v), __float_as_uint(v), false, false); return __uint_as_float(rr[0]) + __uint_as_float(rr[1]); }

template <int ND> struct St { float mhat, l, cval; f32x16 o[ND]; };
template <int ND> __device__ __forceinline__ void st_init(St<ND>& s, float bfar) { s.mhat = 0.f; s.l = 0.f; s.cval = bfar;
#pragma unroll
    for (int d = 0; d < ND; ++d) s.o[d] = f32x16{}; }
template <int ND> __device__ __forceinline__ void st_setref(St<ND>& s, float bfar, float mhat) { s.mhat = mhat; s.cval = bfar - mhat; }
__device__ __forceinline__ f32x16 splat16(float v) { f32x16 c;
#pragma unroll
    for (int r = 0; r < 16; ++r) c[r] = v;
    return c; }

__device__ __forceinline__ void qk_tile(f32x16& p0, f32x16& p1, lds_cptr kp, const bf16x8 (&qr)[4], float cv) {
    const f32x16 c = splat16(cv);
    bf16x8 kf[8];
#pragma unroll
    for (int d0 = 0; d0 < 4; ++d0) { kf[2 * d0] = *(const LAS3 bf16x8*)(kp + d0 * 2048); kf[2 * d0 + 1] = *(const LAS3 bf16x8*)(kp + d0 * 2048 + 512); }
    __builtin_amdgcn_sched_barrier(0);
    p0 = __builtin_amdgcn_mfma_f32_32x32x16_bf16(kf[0], qr[0], c, 0, 0, 0); p1 = __builtin_amdgcn_mfma_f32_32x32x16_bf16(kf[1], qr[0], c, 0, 0, 0);
#pragma unroll
    for (int d0 = 1; d0 < 4; ++d0) { p0 = __builtin_amdgcn_mfma_f32_32x32x16_bf16(kf[2 * d0], qr[d0], p0, 0, 0, 0); p1 = __builtin_amdgcn_mfma_f32_32x32x16_bf16(kf[2 * d0 + 1], qr[d0], p1, 0, 0, 0); }
}
template <int ND, int MODE, bool MASKED>
__device__ __forceinline__ void softmax_p(St<ND>& st, f32x16& p0, f32x16& p1, u32x4 (&pw)[4], LAS3 float* wsf, int r32, int hi, float rl, bool keep) {
    if (MODE != 2) {
        float rm = rowmax(p0, p1);
        if (MASKED) rm = keep ? rm : -INFINITY;
        const bool fresh = st.l == 0.f;
        const bool mv = rm > THR || (fresh && rm < -20.f && rm > -INFINITY);
        if (__any(mv)) {
            const float dl = mv ? (fresh ? rm : __builtin_fmaxf(rm, 0.f)) : 0.f;
            const float f = fresh ? 1.f : __builtin_amdgcn_exp2f(-dl);
            st.l *= f; st.mhat += dl;
#pragma unroll
            for (int r = 0; r < 16; ++r) { p0[r] -= dl; p1[r] -= dl; }
            st.cval -= dl;
            if (MODE == 0) {
                if (hi == 0) wsf[r32] = f;
#pragma unroll
                for (int r = 0; r < 16; ++r) { const float fr = wsf[crow(r, hi)];
#pragma unroll
                    for (int d = 0; d < ND; ++d) st.o[d][r] *= fr; }
            }
        }
    }
    float s0 = 0.f, s1 = 0.f;
#pragma unroll
    for (int r = 0; r < 16; ++r) { p0[r] = __builtin_amdgcn_exp2f(p0[r]); p1[r] = __builtin_amdgcn_exp2f(p1[r]); s0 += p0[r]; s1 += p1[r]; }
    if (MODE != 2) { const float sm = s0 + s1; st.l += MASKED ? (keep ? sm : 0.f) : sm; }
    if (MODE == 2) {
#pragma unroll
        for (int r = 0; r < 16; ++r) { p0[r] *= rl; p1[r] *= rl; }
    }
    if (MODE == 1) return;
#pragma unroll
    for (int k = 0; k < 2; ++k)
#pragma unroll
        for (int j = 0; j < 4; ++j) { pw[k][j] = cvtpk(p0[8 * k + 2 * j], p0[8 * k + 2 * j + 1]); pw[2 + k][j] = cvtpk(p1[8 * k + 2 * j], p1[8 * k + 2 * j + 1]); }
    if (MASKED) { const unsigned km = keep ? 0xffffffffu : 0u;
#pragma unroll
        for (int k = 0; k < 4; ++k)
#pragma unroll
            for (int j = 0; j < 4; ++j) pw[k][j] &= km; }
}
template <int ND>
__device__ __forceinline__ void pv_acc(St<ND>& st, const u32x4 (&pw)[4], lds_cptr vp) {
    if constexpr (ND == 2) {
        s16x4 lo[2][4], hh[2][4];
#pragma unroll
        for (int d0 = 0; d0 < 2; ++d0)
#pragma unroll
            for (int ks = 0; ks < 4; ++ks) { lo[d0][ks] = vtr(vp + d0 * 4096 + ks * 1024); hh[d0][ks] = vtr(vp + d0 * 4096 + ks * 1024 + 512); }
        __builtin_amdgcn_sched_barrier(0);
#pragma unroll
        for (int ks = 0; ks < 4; ++ks)
#pragma unroll
            for (int d0 = 0; d0 < 2; ++d0) {
                const bf16x8 vf = (bf16x8){lo[d0][ks][0], lo[d0][ks][1], lo[d0][ks][2], lo[d0][ks][3], hh[d0][ks][0], hh[d0][ks][1], hh[d0][ks][2], hh[d0][ks][3]};
                st.o[d0] = __builtin_amdgcn_mfma_f32_32x32x16_bf16(__builtin_bit_cast(bf16x8, pw[ks]), vf, st.o[d0], 0, 0, 0);
            }
        return;
    }
#pragma unroll
    for (int d0 = 0; d0 < ND; ++d0) {
        s16x4 lo[4], hh[4];
#pragma unroll
        for (int ks = 0; ks < 4; ++ks) { lo[ks] = vtr(vp + d0 * 4096 + ks * 1024); hh[ks] = vtr(vp + d0 * 4096 + ks * 1024 + 512); }
        __builtin_amdgcn_sched_barrier(0);
#pragma unroll
        for (int ks = 0; ks < 4; ++ks) {
            const bf16x8 vf = (bf16x8){lo[ks][0], lo[ks][1], lo[ks][2], lo[ks][3], hh[ks][0], hh[ks][1], hh[ks][2], hh[ks][3]};
            st.o[d0] = __builtin_amdgcn_mfma_f32_32x32x16_bf16(__builtin_bit_cast(bf16x8, pw[ks]), vf, st.o[d0], 0, 0, 0);
        }
    }
}
template <bool WIN>
__device__ __forceinline__ void fix_near(f32x16& p0, f32x16& p1, int tq, int kbase, int kstep, const LAS3 float* bl, int hi) {
    const int relb = tq - kbase - kstep * 4 * hi;
    float b0[16], b1[16];
#pragma unroll
    for (int r = 0; r < 16; ++r) { const int rel0 = relb - kstep * ((r & 3) + 8 * (r >> 2)), rel1 = rel0 - 32 * kstep;
        b0[r] = bl[rel0 < 0 ? 0 : (rel0 > 127 ? 127 : rel0)]; b1[r] = bl[rel1 < 0 ? 0 : (rel1 > 127 ? 127 : rel1)]; }
#pragma unroll
    for (int r = 0; r < 16; ++r) { asm volatile("" : "+v"(b0[r]), "+v"(b1[r])); }
#pragma unroll
    for (int r = 0; r < 16; ++r) { const int rel0 = relb - kstep * ((r & 3) + 8 * (r >> 2)), rel1 = rel0 - 32 * kstep;
        const bool k0 = rel0 >= 0 && (!WIN || rel0 < 512), k1 = rel1 >= 0 && (!WIN || rel1 < 512);
        p0[r] = k0 ? p0[r] + b0[r] : -INFINITY; p1[r] = k1 ? p1[r] + b1[r] : -INFINITY; }
}
template <bool WIN>
__device__ __forceinline__ void fix_near4(f32x16& p0, f32x16& p1, int tq, int kbase, const LAS3 float* cs, int hi) {
    const int relb = tq - kbase - 4 * hi;
    f32x4 v0[4], v1[4];
#pragma unroll
    for (int q = 0; q < 4; ++q) { const int ua = relb - 8 * q - 3, ub = ua - 32;
        const int a = ua < -3 ? 0 : (ua > 128 ? 131 : ua + 3), b = ub < -3 ? 0 : (ub > 128 ? 131 : ub + 3);
        v0[q] = *(const LAS3 f32x4*)(cs + (a & 3) * 136 + (a & ~3)); v1[q] = *(const LAS3 f32x4*)(cs + (b & 3) * 136 + (b & ~3)); }
#pragma unroll
    for (int q = 0; q < 4; ++q) { asm volatile("" : "+v"(v0[q]), "+v"(v1[q])); }
#pragma unroll
    for (int q = 0; q < 4; ++q)
#pragma unroll
        for (int e2 = 0; e2 < 4; ++e2) { const int rel0 = relb - 8 * q - e2, rel1 = rel0 - 32;
            const bool k0 = rel0 >= 0 && (!WIN || rel0 < 512), k1 = rel1 >= 0 && (!WIN || rel1 < 512);
            p0[4 * q + e2] = k0 ? p0[4 * q + e2] + v0[q][3 - e2] : -INFINITY; p1[4 * q + e2] = k1 ? p1[4 * q + e2] + v1[q][3 - e2] : -INFINITY; }
}
constexpr int L_FIX4 = 147456;
__device__ __forceinline__ void build_fix4(LAS3 float* dst, const LAS3 float* bd, int nheads, int tid) {
    for (int i = tid; i < nheads * 544; i += 512) { const int hd = i / 544, r = i - hd * 544, sft = r / 136, kk = r - sft * 136; const int bi = kk + sft - 3;
        dst[i] = bd[hd * 128 + (bi < 0 ? 0 : (bi > 127 ? 127 : bi))]; }
}
__device__ __forceinline__ void kill_tile(f32x16& p0, f32x16& p1, bool keep) {
#pragma unroll
    for (int r = 0; r < 16; ++r) { p0[r] = keep ? p0[r] : -INFINITY; p1[r] = keep ? p1[r] : -INFINITY; }
}
template <int NKM, int ND>
__device__ __forceinline__ void issue_tile(const bf16* kg, int kpitch, const bf16* vg, int vpitch, int krow0, unsigned slot, int wid, int lane) {
#pragma unroll
    for (int m = 0; m < NKM; ++m) glds16(kg + (size_t)(krow0 + lane) * kpitch + m * 64 + wid * 8, (unsigned)__builtin_amdgcn_readfirstlane(slot + m * 8192 + wid * 1024));
#pragma unroll
    for (int j = 0; j < ND / 2; ++j) { const int pi = wid + 8 * j;
        glds16(vg + (size_t)(krow0 + 16 * (pi & 3) + (lane >> 2)) * vpitch + (pi >> 2) * 32 + (lane & 3) * 8, (unsigned)__builtin_amdgcn_readfirstlane(slot + NKM * 8192 + pi * 1024)); }
}
#ifndef ATT_STAGGER
#define ATT_STAGGER 0
#endif
#if ATT_STAGGER
template <int NKM, int ND, class KRow, class H1, class H2>
__device__ __forceinline__ void run_stream(char* lds, const bf16* kg, int kpitch, const bf16* vg, int vpitch, int n, KRow krow, H1 h1, H2 h2, int wid, int lane) {
    constexpr int SLOTB = NKM * 8192 + ND * 4096;
    const unsigned lds0 = (unsigned)(uintptr_t)lds + L_RING;
    const bool late = wid >= 4;
    ATT_BAR();
    __builtin_amdgcn_s_waitcnt(0x0F70);
    if (n <= 0) return;
    issue_tile<NKM, ND>(kg, kpitch, vg, vpitch, krow(0), lds0, wid, lane);
    if (n > 1) issue_tile<NKM, ND>(kg, kpitch, vg, vpitch, krow(1), lds0 + SLOTB, wid, lane);
#define ATT_WB(more) do { if (more) { if (NKM + ND / 2 == 2) ATT_WAIT_BAR(2); else if (NKM + ND / 2 == 3) ATT_WAIT_BAR(3); else ATT_WAIT_BAR(4); } else ATT_WAIT_BAR(0); } while (0)
    if (late) ATT_WB(n > 1);
    int s_prev = 2 * SLOTB, s_cur = 0, s_nxt = SLOTB;
    for (int k = 0; k < n; ++k) {
        if (late) { ATT_BAR(); if (k + 2 < n) issue_tile<NKM, ND>(kg, kpitch, vg, vpitch, krow(k + 2), lds0 + s_prev, wid, lane); }
        else ATT_WB(k + 1 < n);
        h1(k, L_RING + s_cur);
        if (late) ATT_WB(k + 2 < n);
        else { ATT_BAR(); if (k + 2 < n) issue_tile<NKM, ND>(kg, kpitch, vg, vpitch, krow(k + 2), lds0 + s_prev, wid, lane); }
        h2(k, L_RING + s_cur);
        const int t = s_prev; s_prev = s_cur; s_cur = s_nxt; s_nxt = t;
    }
    if (!late) ATT_BAR();
#undef ATT_WB
}
#else
template <int NKM, int ND, class KRow, class H1, class H2>
__device__ __forceinline__ void run_stream(char* lds, const bf16* kg, int kpitch, const bf16* vg, int vpitch, int n, KRow krow, H1 h1, H2 h2, int wid, int lane) {
    constexpr int SLOTB = NKM * 8192 + ND * 4096;
    const unsigned lds0 = (unsigned)(uintptr_t)lds + L_RING;
    ATT_BAR();
    __builtin_amdgcn_s_waitcnt(0x0F70);
    if (n <= 0) return;
    issue_tile<NKM, ND>(kg, kpitch, vg, vpitch, krow(0), lds0, wid, lane);
    if (n > 1) issue_tile<NKM, ND>(kg, kpitch, vg, vpitch, krow(1), lds0 + SLOTB, wid, lane);
    int s_cur = 0, s_nxt = SLOTB, s_nn = 2 * SLOTB;
#if ATT_PROBE
    unsigned long long tw = 0, t1 = 0, t2 = 0, ti = 0;
#endif
    for (int k = 0; k < n; ++k) {
        ATT_TS(a0);
        if (k + 1 < n) { if (NKM + ND / 2 == 2) ATT_WAIT_BAR(2); else if (NKM + ND / 2 == 3) ATT_WAIT_BAR(3); else ATT_WAIT_BAR(4); }
        else ATT_WAIT_BAR(0);
        ATT_TS(a1);
        if (k + 2 < n) issue_tile<NKM, ND>(kg, kpitch, vg, vpitch, krow(k + 2), lds0 + s_nn, wid, lane);
        ATT_TS(a2);
        h1(k, L_RING + s_cur);
        ATT_TS(a3);
        h2(k, L_RING + s_cur);
#if ATT_PROBE
        asm volatile("s_waitcnt lgkmcnt(0)" ::: "memory");
        ATT_TS(a4);
        tw += a1 - a0; ti += a2 - a1; t1 += a3 - a2; t2 += a4 - a3;
#endif
        const int t = s_cur; s_cur = s_nxt; s_nxt = s_nn; s_nn = t;
    }
#if ATT_PROBE
    if (blockIdx.x == ATT_PROBE_BLOCK && wid == ATT_PROBE_WAVE && lane == 0) { g_dbg[0] += tw; g_dbg[1] += ti; g_dbg[2] += t1; g_dbg[3] += t2; g_dbg[4] += (unsigned long long)n; }
#endif
}
#endif
struct TInfo { int kbase; bool near, win, masked, keep; };
#define ATT_PIN(x) asm volatile("" : "+v"(x))
#define ATT_SB() __builtin_amdgcn_sched_barrier(0)
template <int NKM, int ND, class KRow, class TI>
__device__ __forceinline__ void run_pipe(char* lds, St<ND>& st, const bf16x8 (&qr)[4], const bf16* kg, int kpitch, const bf16* vg, int vpitch, int n, KRow krow, TI tinfo,
                                         int koff, const LAS3 float* bl, int tq, LAS3 float* wsf, int wid, int lane) {
    constexpr int SLOTB = NKM * 8192 + ND * 4096, CNT = NKM + ND / 2;
    static_assert(CNT == 2 || CNT == 4, "wait literals");
    const int r32 = lane & 31, hi = lane >> 5;
    LAS3 char* l3 = (LAS3 char*)lds;
    const unsigned lds0 = (unsigned)(uintptr_t)lds + L_RING;
    const int vlane = NKM * 8192 + ((lane >> 4) & 1) * 32 + (lane & 3) * 8 + (4 * hi + ((lane & 15) >> 2)) * 64;
    const int klane = koff + hi * 1024 + r32 * 16;
    const unsigned kvoff = (unsigned)(lane * kpitch + wid * 8) * 2u;
    const unsigned vvoff = (unsigned)((16 * (wid & 3) + (lane >> 2)) * vpitch + (wid >> 2) * 32 + (lane & 3) * 8) * 2u;
    auto issue = [&](int t, unsigned slot) __attribute__((always_inline)) {
        const int kr = __builtin_amdgcn_readfirstlane(krow(t));
        const bf16* kb = kg + (size_t)kr * kpitch; const bf16* vb = vg + (size_t)kr * vpitch;
#pragma unroll
        for (int m = 0; m < NKM; ++m) glds16s(kb + m * 64, kvoff, (unsigned)__builtin_amdgcn_readfirstlane(slot + m * 8192 + wid * 1024));
#pragma unroll
        for (int j = 0; j < ND / 2; ++j) glds16s(vb + j * 64, vvoff, (unsigned)__builtin_amdgcn_readfirstlane(slot + NKM * 8192 + (wid + 8 * j) * 1024));
    };
    ATT_BAR();
    __builtin_amdgcn_s_waitcnt(0x0F70);
    if (n <= 0) return;
#pragma unroll
    for (int t = 0; t < 3; ++t) if (t < n) issue(t, lds0 + t * SLOTB);
    if (n >= 3) { if (CNT == 2) ATT_WAIT_BAR(4); else ATT_WAIT_BAR(8); } else if (n == 2) { if (CNT == 2) ATT_WAIT_BAR(2); else ATT_WAIT_BAR(4); } else ATT_WAIT_BAR(0);
    f32x16 pA0, pA1, pB0, pB1; TInfo iS = tinfo(0);
    qk_tile(pA0, pA1, (lds_cptr)l3 + L_RING + klane, qr, (iS.masked && !iS.keep) ? -INFINITY : st.cval);
    if (iS.near) { if (iS.win) fix_near4<true>(pA0, pA1, tq, iS.kbase, bl, hi); else fix_near4<false>(pA0, pA1, tq, iS.kbase, bl, hi); }
    float rmS = rowmax(pA0, pA1);
    int s0 = 0, s1 = SLOTB, s2 = 2 * SLOTB, s3 = 3 * SLOTB;
    auto step = [&](int k, f32x16& pS0, f32x16& pS1, f32x16& pN0, f32x16& pN1) __attribute__((always_inline)) {
        const bool hasN = k + 1 < n;
        ATT_TP(a0);
        if (k + 2 < n) { if (CNT == 2) ATT_WAIT_BAR(2); else ATT_WAIT_BAR(4); } else ATT_WAIT_BAR(0);
        ATT_TP(a1);
        ATT_TP(a2);
        bf16x8 kfa[4];
        const lds_cptr kpn = (lds_cptr)l3 + L_RING + s1 + klane;
        TInfo iN = iS;
#pragma unroll
        for (int d0 = 0; d0 < 2; ++d0) { kfa[2 * d0] = *(const LAS3 bf16x8*)(kpn + d0 * 2048); kfa[2 * d0 + 1] = *(const LAS3 bf16x8*)(kpn + d0 * 2048 + 512); }
        if (hasN) iN = tinfo(k + 1);
        {   const float rm = rmS;
            const bool fresh = st.l == 0.f;
            const bool mv = rm > THR || (fresh && rm < -20.f && rm > -INFINITY);
            if (__any(mv)) {
                const float dl = mv ? (fresh ? rm : __builtin_fmaxf(rm, 0.f)) : 0.f;
                const float f = fresh ? 1.f : __builtin_amdgcn_exp2f(-dl);
                st.l *= f; st.mhat += dl;
#pragma unroll
                for (int r = 0; r < 16; ++r) { pS0[r] -= dl; pS1[r] -= dl; }
                st.cval -= dl;
                if (hi == 0) wsf[r32] = f;
#pragma unroll
                for (int r = 0; r < 16; ++r) { const float fr = wsf[crow(r, hi)];
#pragma unroll
                    for (int d = 0; d < ND; ++d) st.o[d][r] *= fr; }
            }
        }
        ATT_SB();
        ATT_TP(a2b);
        {
            const f32x16 c16 = splat16((iN.masked && !iN.keep) ? -INFINITY : st.cval);
#pragma unroll
            for (int i = 0; i < 8; ++i) { const int d0 = i >> 1;
                const bf16x8 kfr = kfa[i & 3];
                if ((i & 1) == 0) pN0 = __builtin_amdgcn_mfma_f32_32x32x16_bf16(kfr, qr[d0], d0 == 0 ? c16 : pN0, 0, 0, 0);
                else pN1 = __builtin_amdgcn_mfma_f32_32x32x16_bf16(kfr, qr[d0], d0 == 0 ? c16 : pN1, 0, 0, 0);
                if (i < 4) kfa[i] = *(const LAS3 bf16x8*)(kpn + ((4 + i) >> 1) * 2048 + ((4 + i) & 1) * 512);
                if (i < 4) {
#pragma unroll
                    for (int e = 0; e < 4; ++e) { float t = __builtin_amdgcn_exp2f(pS0[4 * i + e]); ATT_PIN(t); pS0[4 * i + e] = t; }
                } else {
#pragma unroll
                    for (int e = 0; e < 4; ++e) { float t = __builtin_amdgcn_exp2f(pS1[4 * (i - 4) + e]); ATT_PIN(t); pS1[4 * (i - 4) + e] = t; }
                }
                ATT_SB(); }
        }
        ATT_TP(a2c);
        if (hasN && iN.near) { if (iN.win) fix_near4<true>(pN0, pN1, tq, iN.kbase, bl, hi); else fix_near4<false>(pN0, pN1, tq, iN.kbase, bl, hi); }
        ATT_SB();
        ATT_TP(a3);
        {   const lds_cptr vp = (lds_cptr)l3 + L_RING + s0 + vlane;
            u32x4 pw[4]; s16x4 lo[4], hh[4];
#pragma unroll
            for (int ks = 0; ks < 4; ++ks) { lo[ks] = vtr(vp + ks * 1024); hh[ks] = vtr(vp + ks * 1024 + 512); }
#pragma unroll
            for (int j = 0; j < 4; ++j) pw[0][j] = cvtpk(pS0[2 * j], pS0[2 * j + 1]);
            f32x2_t sa = {0.f, 0.f}, sb = {0.f, 0.f}; float ma = -INFINITY, mb = -INFINITY;
            ATT_SB();
#pragma unroll
            for (int d0 = 0; d0 < ND; ++d0) {
#pragma unroll
                for (int ks = 0; ks < 4; ++ks) {
                    const bf16x8 vf = (bf16x8){lo[ks][0], lo[ks][1], lo[ks][2], lo[ks][3], hh[ks][0], hh[ks][1], hh[ks][2], hh[ks][3]};
                    st.o[d0] = __builtin_amdgcn_mfma_f32_32x32x16_bf16(__builtin_bit_cast(bf16x8, pw[ks]), vf, st.o[d0], 0, 0, 0);
                    if (d0 == 0 && ks < 3) {
                        const int q = ks + 1;
#pragma unroll
                        for (int j = 0; j < 4; ++j) pw[q][j] = (q < 2 ? cvtpk(pS0[8 * q + 2 * j], pS0[8 * q + 2 * j + 1]) : cvtpk(pS1[8 * (q - 2) + 2 * j], pS1[8 * (q - 2) + 2 * j + 1]));
                    }
                    const int g = d0 * 4 + ks;
                    if (g < 4) { sa += (f32x2_t){pS0[4 * g], pS0[4 * g + 1]}; sa += (f32x2_t){pS0[4 * g + 2], pS0[4 * g + 3]}; ATT_PIN(sa);
                        ma = ATT_MX3(ma, pN0[4 * g], pN0[4 * g + 1]); ma = ATT_MX3(ma, pN0[4 * g + 2], pN0[4 * g + 3]); ATT_PIN(ma); }
                    else if (g < 8) { sb += (f32x2_t){pS1[4 * (g - 4)], pS1[4 * (g - 4) + 1]}; sb += (f32x2_t){pS1[4 * (g - 4) + 2], pS1[4 * (g - 4) + 3]}; ATT_PIN(sb);
                        mb = ATT_MX3(mb, pN1[4 * (g - 4)], pN1[4 * (g - 4) + 1]); mb = ATT_MX3(mb, pN1[4 * (g - 4) + 2], pN1[4 * (g - 4) + 3]); ATT_PIN(mb); }
                    if (g == 1 && k + 3 < n) issue(k + 3, lds0 + s3);
                    if (ks == 3 && d0 + 1 < ND) {
#pragma unroll
                        for (int k2 = 0; k2 < 4; ++k2) { lo[k2] = vtr(vp + (d0 + 1) * 4096 + k2 * 1024); hh[k2] = vtr(vp + (d0 + 1) * 4096 + k2 * 1024 + 512); }
                    }
                    ATT_SB();
                }
            }
            const f32x2_t s2 = sa + sb; st.l += s2.x + s2.y;
            { const float m = __builtin_fmaxf(ma, mb); auto rr = __builtin_amdgcn_permlane32_swap(__float_as_uint(m), __float_as_uint(m), false, false);
                rmS = __builtin_fmaxf(__uint_as_float(rr[0]), __uint_as_float(rr[1])); }
        }
#if ATT_PROBE
        asm volatile("s_waitcnt lgkmcnt(0)" ::: "memory");
        ATT_TP(a4);
        if ((ATT_PROBE_PHASE == 2) == (NKM == 2) && blockIdx.x == ATT_PROBE_BLOCK && wid == ATT_PROBE_WAVE && lane == 0) { g_dbg[0] += a1 - a0; g_dbg[1] += a2 - a1; g_dbg[2] += a3 - a2; g_dbg[3] += a4 - a3; g_dbg[4] += 1ull; g_dbg[5] += a2b - a2; g_dbg[6] += a2c - a2b; g_dbg[7] += a3 - a2c; }
#endif
        iS = iN;
        const int t = s0; s0 = s1; s1 = s2; s2 = s3; s3 = t;
    };
    int k = 0;
    for (; k + 2 <= n; k += 2) { step(k, pA0, pA1, pB0, pB1); step(k + 1, pB0, pB1, pA0, pA1); }
    if (k < n) step(k, pA0, pA1, pB0, pB1);
}

__device__ __forceinline__ void rowfac(float (&fr)[16], float f, LAS3 float* wsf, int r32, int hi) {
    if (hi == 0) wsf[r32] = f;
#pragma unroll
    for (int r = 0; r < 16; ++r) fr[r] = wsf[crow(r, hi)];
}
template <int ND>
__device__ __forceinline__ void stage_o(const f32x16 (&o)[ND], LAS3 bf16* stg, int r32, int hi) {
#pragma unroll
    for (int r = 0; r < 16; ++r) { const int orow = crow(r, hi);
#pragma unroll
        for (int d0 = 0; d0 < ND; ++d0) stg[orow * (32 * ND) + d0 * 32 + r32] = (bf16)f2bf(o[d0][r]); }
}

constexpr int MB_KM = 65536, MB_RM = 73728, MB_UNI = 74752, MB_PB = 74756, MB_G = 74944;
__device__ __forceinline__ void moba_unit(const PP& p, char* lds, int b, int h, int c, int tid) {
    const int lane = tid & 63, r32 = lane & 31, hi = lane >> 5; const int wid = __builtin_amdgcn_readfirstlane(tid >> 6);
    LAS3 char* l3 = (LAS3 char*)lds;
    LAS3 float* KM = (LAS3 float*)(l3 + MB_KM); LAS3 unsigned* RM = (LAS3 unsigned*)(l3 + MB_RM); LAS3 unsigned* UNI = (LAS3 unsigned*)(l3 + MB_UNI); LAS3 int* PB = (LAS3 int*)(l3 + MB_PB); LAS3 float* Gs = (LAS3 float*)(l3 + MB_G);
    LAS3 float* wsf = (LAS3 float*)(l3 + L_WSF) + wid * 64; const LAS3 float* bl = (const LAS3 float*)(l3 + L_BIAS) + h * 128;
    ATT_T(u0);
    const size_t rowbase = (size_t)b * SEQ; const int q0 = c * 256;
    const bf16* Qg = p.PROJ + rowbase * NP1 + h * 64; const bf16* Kg = p.PROJ + rowbase * NP1 + 1024 + h * 64; const bf16* Vg = p.PROJ + rowbase * NP1 + 2048 + h * 64;
    ATT_BAR();
    if (tid == 0) UNI[0] = 0u;
    const int tq = q0 + wid * 32 + r32;
    bf16x8 qr[4];
#pragma unroll
    for (int d0 = 0; d0 < 4; ++d0) qr[d0] = *(const bf16x8*)(Qg + (size_t)tq * NP1 + d0 * 16 + hi * 8);
    unsigned mymask;
    {   f32x16 g = f32x16{};
        const float* km0 = p.KMP + ((size_t)(b * 16 + h) * 32 + r32) * 64 + hi * 8; const float* km1 = km0 + (size_t)2 * 16 * 32 * 64;
#pragma unroll
        for (int d0 = 0; d0 < 4; ++d0) {
            const f32x4 a0 = *(const f32x4*)(km0 + d0 * 16), a1 = *(const f32x4*)(km0 + d0 * 16 + 4), c0 = *(const f32x4*)(km1 + d0 * 16), c1 = *(const f32x4*)(km1 + d0 * 16 + 4);
            float v[8] = {a0.x + c0.x, a0.y + c0.y, a0.z + c0.z, a0.w + c0.w, a1.x + c1.x, a1.y + c1.y, a1.z + c1.z, a1.w + c1.w};
            bf16x8 fh, fl;
#pragma unroll
            for (int j = 0; j < 8; ++j) { const float x = v[j] * (1.0f / 256.f); const unsigned hb = f2bf(x); fh[j] = (short)hb; fl[j] = (short)f2bf(x - bf2f(hb)); }
            g = __builtin_amdgcn_mfma_f32_32x32x16_bf16(fh, qr[d0], g, 0, 0, 0);
            g = __builtin_amdgcn_mfma_f32_32x32x16_bf16(fl, qr[d0], g, 0, 0, 0);
        }
        if (c <= 3) mymask = (1u << c) - 1u;
        else {
        float xo[16], xt[16]; float t1 = -INFINITY, t2 = -INFINITY, t3 = -INFINITY;
#pragma unroll
        for (int r = 0; r < 16; ++r) { const float own = g[r];
            auto rr = __builtin_amdgcn_permlane32_swap(__float_as_uint(own), __float_as_uint(own), false, false);
            const float oth = hi ? __uint_as_float(rr[0]) : __uint_as_float(rr[1]);
            xo[r] = crow(r, hi) < c ? own : -INFINITY; xt[r] = crow(r, hi ^ 1) < c ? oth : -INFINITY;
            { const float x = xo[r]; const float n2 = __builtin_amdgcn_fmed3f(t1, x, t2), n3 = __builtin_amdgcn_fmed3f(t2, x, t3); t1 = __builtin_fmaxf(t1, x); t2 = n2; t3 = n3; }
            { const float x = xt[r]; const float n2 = __builtin_amdgcn_fmed3f(t1, x, t2), n3 = __builtin_amdgcn_fmed3f(t2, x, t3); t1 = __builtin_fmaxf(t1, x); t2 = n2; t3 = n3; } }
        unsigned gt = 0u, ge = 0u; const int sh = 4 * hi, sht = 4 * (hi ^ 1);
#pragma unroll
        for (int r = 0; r < 16; ++r) { const unsigned bo = (1u << ((r & 3) + 8 * (r >> 2))) << sh, bt = (1u << ((r & 3) + 8 * (r >> 2))) << sht;
            gt |= xo[r] > t3 ? bo : 0u; ge |= xo[r] >= t3 ? bo : 0u; gt |= xt[r] > t3 ? bt : 0u; ge |= xt[r] >= t3 ? bt : 0u; }
        unsigned eq = ge & ~gt, sel = gt; int need = 3 - __builtin_popcount(gt);
#pragma unroll
        for (int i = 0; i < 3; ++i) { const bool take = need > 0 && eq != 0u; const unsigned low = eq & (0u - eq); sel |= take ? low : 0u; eq = take ? (eq & (eq - 1u)) : eq; need -= take ? 1 : 0; }
        mymask = sel;
        }
        unsigned m = mymask;
#pragma unroll
        for (int o = 1; o < 32; o <<= 1) m |= __shfl_xor(m, o);
        ATT_BAR();
        if (lane == 0) __hip_atomic_fetch_or(UNI, m, __ATOMIC_RELAXED, __HIP_MEMORY_SCOPE_WORKGROUP);
    }
    ATT_BAR();
    if (tid == 0) { unsigned u = UNI[0]; int i = 0; while (u) { PB[i++] = __builtin_ctz(u); u &= u - 1u; } }
    ATT_BAR();
    const unsigned uni = UNI[0];
    const int npast = __builtin_popcount(uni), ntile = 4 * npast + 4;
    const float bfar = ((const LAS3 float*)(l3 + L_MISC + 64))[h];
    St<2> st; st_init(st, bfar);
    auto blk_of = [&](int k) -> int { const int i = k >> 2; return i < npast ? PB[i] : c; };
    auto krow = [&](int k) -> int { return blk_of(k) * 256 + (k & 3) * 64; };
    ATT_T(u1);
    auto tinfo = [&](int k) -> TInfo { const int n = blk_of(k), j = k & 3; TInfo t; t.kbase = n * 256 + j * 64; const bool own = n == c;
        t.near = own || (n == c - 1 && j >= 2); t.win = false; t.masked = !own; t.keep = own ? true : ((mymask >> n) & 1u) != 0u; return t; };
    run_pipe<1, 2>(lds, st, qr, Kg, NP1, Vg, NP1, ntile, krow, tinfo, 0, bl, tq, wsf, wid, lane);
    ATT_T(u2);
    const float lt = halfsum(st.l); float fr[16]; rowfac(fr, lt > 0.f ? 1.0f / lt : 0.f, wsf, r32, hi);
#pragma unroll
    for (int r = 0; r < 16; ++r) { st.o[0][r] *= fr[r]; st.o[1][r] *= fr[r]; }
    LAS3 bf16* stg = (LAS3 bf16*)(l3 + L_OST) + wid * 2048;
    stage_o<2>(st.o, stg, r32, hi);
    bf16* Ow = p.OC + (rowbase + q0 + wid * 32) * DM + h * 64;
#pragma unroll
    for (int i = 0; i < 4; ++i) { const int row = i * 8 + (lane >> 3), ch = lane & 7; const u32x4 v = *(const LAS3 u32x4*)(stg + row * 64 + ch * 8); *(u32x4*)(Ow + (size_t)row * DM + ch * 8) = v; }
#if ATT_PROBE && ATT_PROBE_PHASE == 8
    { ATT_T(u3); if (blockIdx.x == ATT_PROBE_BLOCK && wid == ATT_PROBE_WAVE && lane == 0) { g_dbg[8] += u1 - u0; g_dbg[9] += u2 - u1; g_dbg[10] += u3 - u2; g_dbg[11] += 1ull; } }
#endif
}
__device__ __forceinline__ void copy_bias_lds(const PP& p, char* lds, int tid) {
    LAS3 float* B = (LAS3 float*)((LAS3 char*)lds + L_BIAS); LAS3 float* BF = (LAS3 float*)((LAS3 char*)lds + L_MISC + 64);
    for (int i = tid; i < 16 * 128; i += NTHR) B[i] = p.BIASL[i] - p.BIASL[(i & ~127) + 127];
    if (tid < 16) BF[tid] = p.BIASL[tid * 128 + 127];
}
__device__ __forceinline__ void moba_phase(const PP& p, char* lds, int tid, int bid, int G) {
#if ATT_PROBE && ATT_PROBE_PHASE == 8
    if (bid == ATT_PROBE_BLOCK && tid == ATT_PROBE_WAVE * 64) { for (int i = 0; i < 16; ++i) g_dbg[i] = 0ull; }
#endif
    copy_bias_lds(p, lds, tid);
    const int vcu = (G % 8 == 0) ? (bid % 8) * (G / 8) + bid / 8 : bid;
    const bool bal = G == 256; const int nu = bal ? 4 : (1024 - bid + G - 1) / G;
#pragma unroll 1
    for (int i = 0; i < nu; ++i) { int bh, c;
        if (bal) { const int s_ = vcu & 7; bh = vcu >> 3; c = i == 0 ? 31 - s_ : (i == 1 ? 16 + s_ : (i == 2 ? 15 - s_ : s_)); }
        else { const int u = bid + i * G; bh = u >> 5; c = 31 - (u & 31); }
        moba_unit(p, lds, bh >> 4, bh & 15, c, tid); }
    ATT_BAR();
}

__device__ __forceinline__ void diff_unit(const PP& p, char* lds, int b, int h, int qt, int tid, float lam) {
    const int lane = tid & 63, r32 = lane & 31, hi = lane >> 5; const int wid = __builtin_amdgcn_readfirstlane(tid >> 6); const int mp = wid >> 2, wq = wid & 3;
    LAS3 char* l3 = (LAS3 char*)lds;
    LAS3 float* wsf = (LAS3 float*)(l3 + L_WSF) + wid * 64; const LAS3 float* bl = (const LAS3 float*)(l3 + L_BIAS) + (8 + h) * 128;
    const size_t rowbase = (size_t)b * SEQ; const int q0 = qt * 128; const int tq = q0 + wq * 32 + r32;
    const bf16* Qg = p.PROJ + rowbase * NP0 + C_DQ + h * 128 + mp * 64; const bf16* Kg = p.PROJ + rowbase * NP0 + C_DK + h * 128; const bf16* Vg = p.PROJ + rowbase * NP0 + C_DV + h * 128;
    bf16x8 qr[4];
#pragma unroll
    for (int d0 = 0; d0 < 4; ++d0) qr[d0] = *(const bf16x8*)(Qg + (size_t)tq * NP0 + d0 * 16 + hi * 8);
    const float bfar = ((const LAS3 float*)(l3 + L_MISC + 64))[8 + h];
    St<4> st; st_init(st, bfar);
    const int NT = 2 * (qt + 1);
    auto krow = [&](int k) -> int { return 64 * k; };
    auto tinfo = [&](int k) -> TInfo { TInfo t; t.kbase = 64 * k; t.near = k >= NT - 4; t.win = false; t.masked = false; t.keep = true; return t; };
    LAS3 float* cs4 = (LAS3 float*)(l3 + L_FIX4);
    build_fix4(cs4, (const LAS3 float*)(l3 + L_BIAS) + (8 + h) * 128, 1, tid);
    run_pipe<2, 4>(lds, st, qr, Kg, NP0, Vg, NP0, NT, krow, tinfo, mp * 8192, cs4, tq, wsf, wid, lane);
    const float lt = halfsum(st.l); float fr[16]; rowfac(fr, lt > 0.f ? 1.0f / lt : 0.f, wsf, r32, hi);
    ATT_BAR();
    LAS3 float* OL = (LAS3 float*)l3 + (size_t)mp * 128 * 128;
#pragma unroll
    for (int r = 0; r < 16; ++r) { const int row = wq * 32 + crow(r, hi);
#pragma unroll
        for (int d0 = 0; d0 < 4; ++d0) OL[row * 128 + d0 * 32 + r32] = st.o[d0][r] * fr[r]; }
    ATT_BAR();
    {   const int row = tid >> 2, part = tid & 3; const LAS3 float* o1 = (const LAS3 float*)l3 + row * 128 + part * 32; const LAS3 float* o2 = o1 + 128 * 128;
        float v[32]; float ss = 0.f;
#pragma unroll
        for (int j = 0; j < 32; j += 4) { const f32x4 a = *(const LAS3 f32x4*)(o1 + j), c = *(const LAS3 f32x4*)(o2 + j);
            v[j] = a.x - lam * c.x; v[j + 1] = a.y - lam * c.y; v[j + 2] = a.z - lam * c.z; v[j + 3] = a.w - lam * c.w;
            ss += (v[j] * v[j] + v[j + 1] * v[j + 1]) + (v[j + 2] * v[j + 2] + v[j + 3] * v[j + 3]); }
        ss += dpp_x1(ss); ss += dpp_x2(ss);
        const float rs = 0.8f / sqrtf(ss * (1.0f / 128.f) + EPS);
        bf16* dst = p.OC + (rowbase + q0 + row) * DM + 512 + h * 128 + part * 32; const float* sg = p.subln + part * 32;
#pragma unroll
        for (int j = 0; j < 32; j += 8) { u32x4 w;
            w.x = pk2(v[j] * rs * sg[j], v[j + 1] * rs * sg[j + 1]); w.y = pk2(v[j + 2] * rs * sg[j + 2], v[j + 3] * rs * sg[j + 3]);
            w.z = pk2(v[j + 4] * rs * sg[j + 4], v[j + 5] * rs * sg[j + 5]); w.w = pk2(v[j + 6] * rs * sg[j + 6], v[j + 7] * rs * sg[j + 7]);
            *(u32x4*)(dst + j) = w; }
    }
}
__device__ __forceinline__ void diff_phase(const PP& p, char* lds, int tid, int bid, int G) {
#if ATT_PROBE && ATT_PROBE_PHASE == 2
    if (bid == ATT_PROBE_BLOCK && tid == ATT_PROBE_WAVE * 64) { for (int i = 0; i < 16; ++i) g_dbg[i] = 0ull; }
#endif
    copy_bias_lds(p, lds, tid);
    const int vcu = (G % 8 == 0) ? (bid % 8) * (G / 8) + bid / 8 : bid;
    const bool bal = G == 256; const int nu = bal ? 2 : (512 - bid + G - 1) / G;
    const int lane_ = tid & 63;
    const float lam = __builtin_bit_cast(float, __builtin_amdgcn_readfirstlane(__builtin_bit_cast(int, expf(wave_sum(p.lq1[lane_] * p.lk1[lane_])) - expf(wave_sum(p.lq2[lane_] * p.lk2[lane_])) + 0.2f)));
#pragma unroll 1
    for (int i = 0; i < nu; ++i) { int bh, qt;
        if (bal) { const int s_ = vcu & 31; bh = vcu >> 5; qt = i == 0 ? 63 - s_ : s_; }
        else { const int u = bid + i * G; bh = u >> 6; qt = 63 - (u & 63); }
        diff_unit(p, lds, bh >> 2, bh & 3, qt, tid, lam); }
    ATT_BAR();
}

constexpr int NS_IMP = 65536, NS_SELM = L_MISC + 256, NS_UNI = L_MISC + 1280, NS_TL = L_MISC + 1296;
__device__ __forceinline__ void nsa_unit(const PP& p, char* lds, int b, int g, int cur, int tid) {
    const int lane = tid & 63, r32 = lane & 31, hi = lane >> 5; const int wid = __builtin_amdgcn_readfirstlane(tid >> 6);
    LAS3 char* l3 = (LAS3 char*)lds;
    LAS3 float* IMP = (LAS3 float*)(l3 + NS_IMP); LAS3 unsigned* SELM = (LAS3 unsigned*)(l3 + NS_SELM); LAS3 unsigned* UNI = (LAS3 unsigned*)(l3 + NS_UNI); LAS3 int* TL = (LAS3 int*)(l3 + NS_TL);
    const int tokl = wid * 8 + (r32 >> 2), head = r32 & 3, hh = g * 4 + head;
    LAS3 float* wsf = (LAS3 float*)(l3 + L_WSF) + wid * 64; const LAS3 float* bl = (const LAS3 float*)(l3 + L_BIAS) + hh * 128;
    const size_t rowbase = (size_t)b * SEQ; const int t0 = cur * 64; const int tq = t0 + tokl; const int twmin = t0 + wid * 8, twmax = twmin + 7;
    const bf16* Qg = p.PROJ + (rowbase + tq) * NP0 + C_Q + hh * 64;
    bf16x8 qr[4];
#pragma unroll
    for (int d0 = 0; d0 < 4; ++d0) qr[d0] = *(const bf16x8*)(Qg + d0 * 16 + hi * 8);
    const float* gp = p.GATES + (rowbase + tq) * 24 + hh; const float g0 = gp[0], g1 = gp[8], g2 = gp[16];
    const float bfar = ((const LAS3 float*)(l3 + L_MISC + 64))[hh];
    const int vlane = ((lane >> 4) & 1) * 32 + (lane & 3) * 8 + (4 * hi + ((lane & 15) >> 2)) * 64;
    ATT_TN(n0);
    ATT_BAR();
    for (int i = tid; i < 64 * 128; i += NTHR) IMP[i] = 0.f;
    build_fix4((LAS3 float*)(l3 + L_FIX4), (const LAS3 float*)(l3 + L_BIAS) + g * 4 * 128, 4, tid);
    const LAS3 float* cs4 = (const LAS3 float*)(l3 + L_FIX4) + head * 544;
    if (tid < 4) UNI[tid] = 0u;
    const int nvis = (4 * cur + 3) < NCMP ? (4 * cur + 3) : NCMP; const int ntc = (nvis + 63) >> 6;
    const bf16* KC = p.KCMP + (size_t)((b * 2 + g) * 512) * 64; const bf16* VC = p.VCMP + (size_t)((b * 2 + g) * 512) * 64;
    auto krow64 = [&](int k) -> int { return 64 * k; };
    St<2> sc; st_init(sc, bfar); const float* ccur = &sc.cval;
    auto cmp_scores = [&](f32x16& p0, f32x16& p1, int k, int slot) -> bool {
        const int c0 = 64 * k;
        if (16 * c0 + 31 > twmax) return false;
        const bool near = (twmin - (16 * (c0 + 63) + 31)) < 128;
        qk_tile(p0, p1, (lds_cptr)l3 + slot + hi * 1024 + r32 * 16, qr, *ccur);
        if (near) fix_near<false>(p0, p1, tq, 16 * c0 + 31, 16, bl, hi);
        return true;
    };
    u32x4 pw[4]; bool pend = false;
    auto nop2 = [&](int, int) {};
    auto body1 = [&](int k, int slot) { f32x16 p0, p1; if (!cmp_scores(p0, p1, k, slot)) return; softmax_p<2, 1, false>(sc, p0, p1, pw, wsf, r32, hi, 0.f, true); };
    run_stream<1, 2>(lds, KC, 64, VC, 64, ntc, krow64, body1, nop2, wid, lane);
    ATT_TN(n1);
    const float lc = halfsum(sc.l); const float rlc = lc > 0.f ? 1.0f / lc : 0.f;
    St<2> so; st_init(so, bfar); st_setref(so, bfar, sc.mhat); ccur = &so.cval;
    auto body2 = [&](int k, int slot) { f32x16 p0, p1; pend = false; if (!cmp_scores(p0, p1, k, slot)) return;
        softmax_p<2, 2, false>(so, p0, p1, pw, wsf, r32, hi, rlc, true); pend = true;
#pragma unroll
        for (int R = 0; R < 4; ++R) {
            float a0 = ((p0[4 * R] + p0[4 * R + 1]) + p0[4 * R + 2]) + 0.5f * p0[4 * R + 3], s0 = 0.5f * p0[4 * R + 3];
            float a1 = ((p1[4 * R] + p1[4 * R + 1]) + p1[4 * R + 2]) + 0.5f * p1[4 * R + 3], s1 = 0.5f * p1[4 * R + 3];
            a0 += dpp_x1(a0); a0 += dpp_x2(a0); s0 += dpp_x1(s0); s0 += dpp_x2(s0);
            a1 += dpp_x1(a1); a1 += dpp_x2(a1); s1 += dpp_x1(s1); s1 += dpp_x2(s1);
            const int n0 = 16 * k + 2 * R + hi, n1 = n0 + 8;
            if (head == 0) { LAS3 float* ip = IMP + tokl * 128;
                __hip_atomic_fetch_add(ip + n0, a0, __ATOMIC_RELAXED, __HIP_MEMORY_SCOPE_WORKGROUP); __hip_atomic_fetch_add(ip + n0 + 1, s0, __ATOMIC_RELAXED, __HIP_MEMORY_SCOPE_WORKGROUP);
                __hip_atomic_fetch_add(ip + n1, a1, __ATOMIC_RELAXED, __HIP_MEMORY_SCOPE_WORKGROUP); if (n1 + 1 < 128) __hip_atomic_fetch_add(ip + n1 + 1, s1, __ATOMIC_RELAXED, __HIP_MEMORY_SCOPE_WORKGROUP); }
        }
    };
    auto pv2 = [&](int k, int slot) { if (pend) pv_acc<2>(so, pw, (lds_cptr)l3 + slot + 8192 + vlane); };
    run_stream<1, 2>(lds, KC, 64, VC, 64, ntc, krow64, body2, pv2, wid, lane);
    ATT_TN(n2);
    __builtin_amdgcn_s_waitcnt(0xC07F); asm volatile("" ::: "memory");
#define NSA_TI 4
#pragma unroll 1
    for (int tk4 = 0; tk4 < 8; tk4 += NSA_TI) {
        const bool c0 = lane >= 1 && lane <= cur - 2, c1 = lane + 64 <= cur - 2;
        unsigned u0[NSA_TI], u1[NSA_TI], T[NSA_TI];
#pragma unroll
        for (int j = 0; j < NSA_TI; ++j) { const int tl = wid * 8 + tk4 + j; T[j] = 0u;
            u0[j] = c0 ? __float_as_uint(IMP[tl * 128 + lane]) : 0u; u1[j] = c1 ? __float_as_uint(IMP[tl * 128 + 64 + lane]) : 0u; }
        if (cur >= 16) {
#pragma unroll 1
            for (int bit = 30; bit >= 0; --bit) {
#pragma unroll
                for (int j = 0; j < NSA_TI; ++j) { const unsigned trial = T[j] | (1u << bit);
                    const int cnt = __builtin_popcountll(__ballot(u0[j] >= trial)) + __builtin_popcountll(__ballot(u1[j] >= trial));
                    if (cnt >= 13) T[j] = trial; }
            }
        }
#pragma unroll
        for (int j = 0; j < NSA_TI; ++j) { const int tl = wid * 8 + tk4 + j; unsigned long long mlo = 0ull, mhi = 0ull;
            if (cur < 16) { mlo = (2ull << cur) - 1ull; }
            else { mlo = 1ull; if (cur - 1 < 64) mlo |= 1ull << (cur - 1); else mhi |= 1ull << (cur - 1 - 64); if (cur < 64) mlo |= 1ull << cur; else mhi |= 1ull << (cur - 64);
                const unsigned long long g0 = __ballot(c0 && u0[j] > T[j]), g1 = __ballot(c1 && u1[j] > T[j]);
                unsigned long long e0 = __ballot(c0 && u0[j] == T[j]), e1 = __ballot(c1 && u1[j] == T[j]);
                int need = 13 - (__builtin_popcountll(g0) + __builtin_popcountll(g1));
                unsigned long long t0 = 0ull, t1 = 0ull;
                while (need > 0 && e0) { t0 |= e0 & (0ull - e0); e0 &= e0 - 1ull; --need; }
                while (need > 0 && e1) { t1 |= e1 & (0ull - e1); e1 &= e1 - 1ull; --need; }
                mlo |= g0 | t0; mhi |= g1 | t1; }
            if (lane == 0) { const unsigned m0 = (unsigned)mlo, m1 = (unsigned)(mlo >> 32), m2 = (unsigned)mhi, m3 = (unsigned)(mhi >> 32);
                SELM[tl * 4 + 0] = m0; SELM[tl * 4 + 1] = m1; SELM[tl * 4 + 2] = m2; SELM[tl * 4 + 3] = m3;
                __hip_atomic_fetch_or(UNI + 0, m0, __ATOMIC_RELAXED, __HIP_MEMORY_SCOPE_WORKGROUP); __hip_atomic_fetch_or(UNI + 1, m1, __ATOMIC_RELAXED, __HIP_MEMORY_SCOPE_WORKGROUP);
                __hip_atomic_fetch_or(UNI + 2, m2, __ATOMIC_RELAXED, __HIP_MEMORY_SCOPE_WORKGROUP); __hip_atomic_fetch_or(UNI + 3, m3, __ATOMIC_RELAXED, __HIP_MEMORY_SCOPE_WORKGROUP); }
        }
    }
    ATT_BAR();
    if (wid == 0) {
        const unsigned s0 = (unsigned)__builtin_amdgcn_readfirstlane((int)UNI[0]), s1 = (unsigned)__builtin_amdgcn_readfirstlane((int)UNI[1]);
        const unsigned s2 = (unsigned)__builtin_amdgcn_readfirstlane((int)UNI[2]), s3 = (unsigned)__builtin_amdgcn_readfirstlane((int)UNI[3]);
        const int nlo = __builtin_popcount(s0) + __builtin_popcount(s1);
        const unsigned blo = __builtin_amdgcn_mbcnt_hi(s1, __builtin_amdgcn_mbcnt_lo(s0, 0u)), bhi = __builtin_amdgcn_mbcnt_hi(s3, __builtin_amdgcn_mbcnt_lo(s2, 0u));
        const unsigned mylo = lane < 32 ? s0 >> lane : s1 >> (lane - 32), myhi2 = lane < 32 ? s2 >> lane : s3 >> (lane - 32);
        if (mylo & 1u) TL[1 + blo] = lane;
        if (myhi2 & 1u) TL[1 + nlo + bhi] = 64 + lane;
        if (lane == 0) TL[0] = nlo + __builtin_popcount(s2) + __builtin_popcount(s3); }
    ATT_BAR();
    const int nsel = TL[0];
    LAS3 float* otl = (LAS3 float*)(l3 + (wid < 4 ? NS_IMP + wid * 8192 : L_OST + (wid - 4) * 8192));
    { float fr[16]; rowfac(fr, g0, wsf, r32, hi);
#pragma unroll
      for (int r = 0; r < 16; ++r) { otl[crow(r, hi) * 64 + r32] = so.o[0][r] * fr[r]; otl[crow(r, hi) * 64 + 32 + r32] = so.o[1][r] * fr[r]; } }
    const unsigned long long mylo = (unsigned long long)SELM[tokl * 4 + 0] | ((unsigned long long)SELM[tokl * 4 + 1] << 32), myhi = (unsigned long long)SELM[tokl * 4 + 2] | ((unsigned long long)SELM[tokl * 4 + 3] << 32);
    ATT_TN(n3);
    { St<2> ss; st_init(ss, bfar);
      const bf16* KS = p.PROJ + rowbase * NP0 + C_KS + g * 64; const bf16* VS = p.PROJ + rowbase * NP0 + C_VS + g * 64;
      auto krow3 = [&](int k) -> int { return 64 * TL[1 + k]; };
      auto ti3 = [&](int k) -> TInfo { const int n = TL[1 + k]; TInfo t; t.kbase = 64 * n; t.near = n >= cur - 2; t.win = false; t.masked = true;
          t.keep = (((n < 64 ? mylo : myhi) >> (n & 63)) & 1ull) != 0ull; return t; };
      run_pipe<1, 2>(lds, ss, qr, KS, NP0, VS, NP0, nsel, krow3, ti3, 0, cs4, tq, wsf, wid, lane);
      const float ls = halfsum(ss.l); float fr[16]; rowfac(fr, ls > 0.f ? g1 / ls : 0.f, wsf, r32, hi);
#pragma unroll
      for (int r = 0; r < 16; ++r) { otl[crow(r, hi) * 64 + r32] += ss.o[0][r] * fr[r]; otl[crow(r, hi) * 64 + 32 + r32] += ss.o[1][r] * fr[r]; } }
    ATT_TN(n4);
    { St<2> sw; st_init(sw, bfar);
      const bf16* KW = p.PROJ + rowbase * NP0 + C_KW + g * 64; const bf16* VW = p.PROJ + rowbase * NP0 + C_VW + g * 64;
      const int nlo = cur >= 8 ? cur - 8 : 0;
      auto krow4 = [&](int k) -> int { return 64 * (nlo + k); };
      auto body4 = [&](int k, int slot) { const int n = nlo + k; const int kbase = 64 * n;
          const bool near = (n >= cur - 2) || (n == cur - 8);
          f32x16 p0, p1; qk_tile(p0, p1, (lds_cptr)l3 + slot + hi * 1024 + r32 * 16, qr, sw.cval);
          if (near) fix_near4<true>(p0, p1, tq, kbase, cs4, hi);
          softmax_p<2, 0, false>(sw, p0, p1, pw, wsf, r32, hi, 0.f, true); };
      auto pv4 = [&](int k, int slot) { pv_acc<2>(sw, pw, (lds_cptr)l3 + slot + 8192 + vlane); };
      run_stream<1, 2>(lds, KW, NP0, VW, NP0, cur - nlo + 1, krow4, body4, pv4, wid, lane);
      const float lw = halfsum(sw.l); float fr[16]; rowfac(fr, lw > 0.f ? g2 / lw : 0.f, wsf, r32, hi);
#pragma unroll
      for (int r = 0; r < 16; ++r) { otl[crow(r, hi) * 64 + r32] += sw.o[0][r] * fr[r]; otl[crow(r, hi) * 64 + 32 + r32] += sw.o[1][r] * fr[r]; } }
    ATT_TN(n5);
#if ATT_PROBE && ATT_PROBE_PHASE == 3
    if (blockIdx.x == ATT_PROBE_BLOCK && wid == ATT_PROBE_WAVE && lane == 0) { g_dbg[8] += n1 - n0; g_dbg[9] += n2 - n1; g_dbg[10] += n3 - n2; g_dbg[12] += n4 - n3; g_dbg[13] += n5 - n4; g_dbg[11] += 1ull; }
#endif
    bf16* Ow = p.OC + (rowbase + t0 + wid * 8) * DM + g * 256;
#pragma unroll
    for (int i = 0; i < 4; ++i) { const int row = i * 8 + (lane >> 3), ch = lane & 7; const f32x4 a = *(const LAS3 f32x4*)(otl + row * 64 + ch * 8), c = *(const LAS3 f32x4*)(otl + row * 64 + ch * 8 + 4);
        u32x4 v; v.x = pk2(a.x, a.y); v.y = pk2(a.z, a.w); v.z = pk2(c.x, c.y); v.w = pk2(c.z, c.w); *(u32x4*)(Ow + (size_t)(row >> 2) * DM + (row & 3) * 64 + ch * 8) = v; }
}
__device__ __forceinline__ void nsa_phase(const PP& p, char* lds, int tid, int bid, int G) {
#if ATT_PROBE && ATT_PROBE_PHASE == 3
    if (bid == ATT_PROBE_BLOCK && tid == ATT_PROBE_WAVE * 64) { for (int i = 0; i < 16; ++i) g_dbg[i] = 0ull; }
#endif
    copy_bias_lds(p, lds, tid);
    const int vcu = (G % 8 == 0) ? (bid % 8) * (G / 8) + bid / 8 : bid;
    const bool bal = G == 256; const int nu = bal ? 2 : (512 - bid + G - 1) / G;
#pragma unroll 1
    for (int i = 0; i < nu; ++i) { int bg, cur;
        if (bal) { const int s_ = vcu & 63; bg = vcu >> 6; cur = i == 0 ? 127 - s_ : s_; }
        else { const int u = bid + i * G; bg = u >> 7; cur = 127 - (u & 127); }
        nsa_unit(p, lds, bg >> 1, bg & 1, cur, tid); }
    ATT_BAR();
}

typedef float f32x4v __attribute__((ext_vector_type(4)));
__device__ __forceinline__ void compress_unit(const PP& p, char* lds, int kv, int b, int g, int ct, int tid) {
    const int lane = tid & 63, fr = lane & 15, fq = lane >> 4; const int wid = __builtin_amdgcn_readfirstlane(tid >> 6);
    LAS3 bf16* hid = (LAS3 bf16*)((LAS3 char*)lds);
    LAS3 char* win = (LAS3 char*)lds + 8192;
    const unsigned lds_w = (unsigned)(uintptr_t)lds + 8192u;
    const int c0 = ct * 16; const int col = (kv ? C_VC : C_KC) + g * 64;
    const bf16* W1 = (kv ? p.CW1V : p.CW1K) + ((size_t)wid * 64 * 64 + lane) * 8;
    const bf16* W2 = (kv ? p.CW2V : p.CW2K) + (size_t)((wid & 3) * 16 + fr) * 128 + fq * 8;
    f32x4v acc = {0.f, 0.f, 0.f, 0.f};
    ATT_BAR();
    ATT_T(q0);
    { const bf16* Ab = p.PROJ + (size_t)b * SEQ * NP0 + col;
#pragma unroll 1
      for (int i = wid; i < 34; i += 8) { const int t = i * 8 + (lane >> 3), q = lane & 7; int tok = 16 * c0 + t; tok = tok < SEQ ? tok : SEQ - 1;
          glds16(Ab + (size_t)tok * NP0 + ((q ^ ((t >> 4) & 7)) * 8), lds_w + (unsigned)i * 1024u); } }
    float bias = 0.f;
#pragma unroll
    for (int j = 0; j < 8; ++j) bias += p.CMPB[(kv * 8 + j) * 128 + wid * 16 + fr];
    bf16x8 w2f[4];
#pragma unroll
    for (int ks = 0; ks < 4; ++ks) w2f[ks] = *(const bf16x8*)(W2 + ks * 32);
#pragma unroll
    for (int hb = 0; hb < 2; ++hb) {
        bf16x8 wf[32];
#pragma unroll
        for (int j = 0; j < 32; ++j) wf[j] = *(const bf16x8*)(W1 + (hb * 32 + j) * 512);
        if (hb == 0) { asm volatile("s_waitcnt vmcnt(0)" ::: "memory"); ATT_BAR(); }
        ATT_T(q1);
#pragma unroll
        for (int j = 0; j < 32; ++j) { const int ks = hb * 32 + j; const int t = 16 * fr + (ks >> 1), ch = (ks & 1) * 4 + fq;
            const bf16x8 af = *(const LAS3 bf16x8*)(win + t * 128 + ((ch ^ ((t >> 4) & 7)) * 16));
            acc = __builtin_amdgcn_mfma_f32_16x16x32_bf16(af, wf[j], acc, 0, 0, 0); }
#if ATT_PROBE && ATT_PROBE_PHASE == 1
        { asm volatile("s_nop 7\n\ts_nop 7" :: "v"(acc)); ATT_T(q2); if (blockIdx.x == ATT_PROBE_BLOCK && wid == ATT_PROBE_WAVE && lane == 0) { if (hb == 0) { g_dbg[8] += q1 - q0; g_dbg[9] += q2 - q1; g_dbg[11] += 1ull; } else { g_dbg[10] += q2 - q0; } } }
#endif
    }
#pragma unroll
    for (int r = 0; r < 4; ++r) hid[(fq * 4 + r) * 136 + wid * 16 + fr] = (bf16)f2bf(gelu_tanh(acc[r] + bias));
    ATT_BAR();
    if (wid < 4) {
        f32x4v o = {0.f, 0.f, 0.f, 0.f};
#pragma unroll
        for (int ks = 0; ks < 4; ++ks) {
            const bf16x8 af = *(const LAS3 bf16x8*)(hid + fr * 136 + ks * 32 + fq * 8);
            o = __builtin_amdgcn_mfma_f32_16x16x32_bf16(af, w2f[ks], o, 0, 0, 0);
        }
        bf16* outp = (kv ? p.VCMP : p.KCMP) + (size_t)((b * 2 + g) * 512 + c0) * 64 + wid * 16 + fr;
#pragma unroll
        for (int r = 0; r < 4; ++r) { const int c = c0 + fq * 4 + r; outp[(size_t)(fq * 4 + r) * 64] = c < NCMP ? (bf16)f2bf(o[r]) : (bf16)0; }
    }
}
__device__ __forceinline__ void compress_phase(const PP& p, char* lds, int tid, int bid, int G) {
#if ATT_PROBE && ATT_PROBE_PHASE == 1
    if (bid == ATT_PROBE_BLOCK && tid == ATT_PROBE_WAVE * 64) { for (int i = 0; i < 16; ++i) g_dbg[i] = 0ull; }
    __syncthreads();
#endif
    for (int u = bid; u < 256; u += G) { const int ct = u & 31, bg = (u >> 5) & 3, kv = u >> 7; compress_unit(p, lds, kv, bg >> 1, bg & 1, ct, tid); }
    ATT_BAR();
}

constexpr size_t WS_MLCNT = WS_CTL + 32768;
constexpr size_t WS_MLIST = WS_W2_0;
constexpr int ML_FAR_PER_BH = 256 * 465;
__device__ __forceinline__ int ml_far_off(int n) { return 256 * (30 * n - n * (n - 1) / 2); }
constexpr size_t WS_PO0 = WS_XB, WS_PO1 = WS_XB + 16 * MiB, WS_PO2 = 218 * MiB, WS_PO3 = WS_WIN0, WS_PM = 234 * MiB;
__device__ __forceinline__ unsigned short* ml_list(unsigned char* ws, bool near, int bh, int n) {
    unsigned short* base = (unsigned short*)(ws + WS_MLIST);
    return near ? base + ((size_t)bh * 32 + n) * 256 : base + (size_t)32 * 32 * 256 + (size_t)bh * ML_FAR_PER_BH + ml_far_off(n); }

__device__ __forceinline__ unsigned moba_gate_mask(const PP& p, int b, int h, int c, int tid) {
    const int lane = tid & 63, r32 = lane & 31, hi = lane >> 5; const int wid = __builtin_amdgcn_readfirstlane(tid >> 6);
    if (c == 0) return 0u;
    const size_t rowbase = (size_t)b * SEQ; const int tq = c * 256 + wid * 32 + r32; const int bh = b * 16 + h;
    const bf16* Qg = p.PROJ + rowbase * NP1 + h * 64;
    bf16x8 qr[4];
#pragma unroll
    for (int d0 = 0; d0 < 4; ++d0) qr[d0] = *(const bf16x8*)(Qg + (size_t)tq * NP1 + d0 * 16 + hi * 8);
    unsigned mymask;
    f32x16 g = f32x16{};
    const float* km0 = p.KMP + ((size_t)bh * 32 + r32) * 64 + hi * 8; const float* km1 = km0 + (size_t)2 * 16 * 32 * 64;
#pragma unroll
    for (int d0 = 0; d0 < 4; ++d0) {
        const f32x4 a0 = *(const f32x4*)(km0 + d0 * 16), a1 = *(const f32x4*)(km0 + d0 * 16 + 4), c0 = *(const f32x4*)(km1 + d0 * 16), c1 = *(const f32x4*)(km1 + d0 * 16 + 4);
        float v[8] = {a0.x + c0.x, a0.y + c0.y, a0.z + c0.z, a0.w + c0.w, a1.x + c1.x, a1.y + c1.y, a1.z + c1.z, a1.w + c1.w};
        bf16x8 fh, fl;
#pragma unroll
        for (int j = 0; j < 8; ++j) { const float x = v[j] * (1.0f / 256.f); const unsigned hb = f2bf(x); fh[j] = (short)hb; fl[j] = (short)f2bf(x - bf2f(hb)); }
        g = __builtin_amdgcn_mfma_f32_32x32x16_bf16(fh, qr[d0], g, 0, 0, 0);
        g = __builtin_amdgcn_mfma_f32_32x32x16_bf16(fl, qr[d0], g, 0, 0, 0);
    }
    if (c <= 3) mymask = (1u << c) - 1u;
    else {
        float xo[16], xt[16]; float t1 = -INFINITY, t2 = -INFINITY, t3 = -INFINITY;
#pragma unroll
        for (int r = 0; r < 16; ++r) { const float own = g[r];
            auto rr = __builtin_amdgcn_permlane32_swap(__float_as_uint(own), __float_as_uint(own), false, false);
            const float oth = hi ? __uint_as_float(rr[0]) : __uint_as_float(rr[1]);
            xo[r] = crow(r, hi) < c ? own : -INFINITY; xt[r] = crow(r, hi ^ 1) < c ? oth : -INFINITY;
            { const float x = xo[r]; const float n2 = __builtin_amdgcn_fmed3f(t1, x, t2), n3 = __builtin_amdgcn_fmed3f(t2, x, t3); t1 = __builtin_fmaxf(t1, x); t2 = n2; t3 = n3; }
            { const float x = xt[r]; const float n2 = __builtin_amdgcn_fmed3f(t1, x, t2), n3 = __builtin_amdgcn_fmed3f(t2, x, t3); t1 = __builtin_fmaxf(t1, x); t2 = n2; t3 = n3; } }
        unsigned gt = 0u, ge = 0u; const int sh = 4 * hi, sht = 4 * (hi ^ 1);
#pragma unroll
        for (int r = 0; r < 16; ++r) { const unsigned bo = (1u << ((r & 3) + 8 * (r >> 2))) << sh, bt = (1u << ((r & 3) + 8 * (r >> 2))) << sht;
            gt |= xo[r] > t3 ? bo : 0u; ge |= xo[r] >= t3 ? bo : 0u; gt |= xt[r] > t3 ? bt : 0u; ge |= xt[r] >= t3 ? bt : 0u; }
        unsigned eq = ge & ~gt, sel = gt; int need = 3 - __builtin_popcount(gt);
#pragma unroll
        for (int i = 0; i < 3; ++i) { const bool take = need > 0 && eq != 0u; const unsigned low = eq & (0u - eq); sel |= take ? low : 0u; eq = take ? (eq & (eq - 1u)) : eq; need -= take ? 1 : 0; }
        mymask = sel;
    }
    return mymask;
}
__device__ __forceinline__ void moba_route_item(const PP& p, unsigned char* ws, char* lds, int b, int h, int n, int part, int nparts, int tid) {
    const int lane = tid & 63, r32 = lane & 31, hi = lane >> 5; const int wid = __builtin_amdgcn_readfirstlane(tid >> 6);
    LAS3 char* l3 = (LAS3 char*)lds; const int bh = b * 16 + h;
    LAS3 float* wsf = (LAS3 float*)(l3 + L_WSF) + wid * 64; const LAS3 float* bl = (const LAS3 float*)(l3 + L_BIAS) + h * 128;
    const float bfar = ((const LAS3 float*)(l3 + L_MISC + 64))[h];
    const unsigned* cnts = (const unsigned*)(ws + WS_MLCNT);
    const int cntN = (int)cnts[bh * 32 + n], cntF = (int)cnts[1024 + bh * 32 + n];
    const int gN = (cntN + 31) >> 5, gF = (cntF + 31) >> 5, gT = gN + gF + 8;
    const int g_lo = 32 * part, g_hi = (part + 1 == nparts || 32 * (part + 1) > gT) ? gT : 32 * (part + 1);
    if (g_lo >= g_hi) return;
    const size_t rowbase = (size_t)b * SEQ;
    const bf16* Qg = p.PROJ + rowbase * NP1 + h * 64; const bf16* Kg = p.PROJ + rowbase * NP1 + 1024 + h * 64; const bf16* Vg = p.PROJ + rowbase * NP1 + 2048 + h * 64;
    const unsigned lds0 = (unsigned)(uintptr_t)lds;
    ATT_T(r0);
    ATT_BAR();
    __builtin_amdgcn_s_waitcnt(0x0F70);
#pragma unroll
    for (int tt = 0; tt < 4; ++tt) issue_tile<1, 2>(Kg, NP1, Vg, NP1, n * 256 + tt * 64, lds0 + tt * 16384, wid, lane);
    LAS3 float* cs4 = (LAS3 float*)(l3 + 69632);
    for (int i = tid; i < 4 * 136; i += NTHR) { const int sft = i / 136, kk = i - sft * 136; const int bi = kk + sft - 3; cs4[i] = bl[bi < 0 ? 0 : (bi > 127 ? 127 : bi)]; }
    ATT_WAIT_BAR(0);
    ATT_T(r1);
#if ATT_PROBE && ATT_PROBE_PHASE == 82
    if (b == 0 && blockIdx.x == ATT_PROBE_BLOCK && wid == ATT_PROBE_WAVE && lane == 0) { g_dbg[9] += r1 - r0; g_dbg[10] -= r1; }
#endif
    const unsigned short* listN = ml_list(ws, true, bh, n); const unsigned short* listF = ml_list(ws, false, bh, n);
    LAS3 unsigned* ent = (LAS3 unsigned*)(l3 + 65536) + wid * 32;
    LAS3 bf16* stg = (LAS3 bf16*)(l3 + L_OST) + wid * 2048;
    bf16* PO[4] = {(bf16*)p.out, (bf16*)p.out + (size_t)16 * 1024 * 1024, (bf16*)(ws + WS_PO2), p.OC}; float* PM = (float*)(ws + WS_WIN0);
    const int vlane = ((lane >> 4) & 1) * 32 + (lane & 3) * 8 + (4 * hi + ((lane & 15) >> 2)) * 64;
    auto fetch = [&](int g, unsigned& e, bool& valid, bool& own, bool& near, bf16x8 (&qr)[4]) __attribute__((always_inline)) {
        own = g >= gN + gF; near = g < gN; const int gi = near ? g : (own ? g - gN - gF : g - gN); const int cnt = near ? cntN : cntF; const unsigned short* list = near ? listN : listF;
        const int idx = gi * 32 + r32; valid = own || idx < cnt;
        e = own ? (unsigned)(n * 256 + idx) | (3u << 13) : (valid ? (unsigned)list[idx] : (unsigned)(n * 256));
        const int t = (int)(e & 8191u);
#pragma unroll
        for (int d0 = 0; d0 < 4; ++d0) qr[d0] = *(const bf16x8*)(Qg + (size_t)t * NP1 + d0 * 16 + hi * 8);
    };
    unsigned e = 0u, en = 0u; bool valid = false, own = false, near = false, validn = false, ownn = false, nearn = false; bf16x8 qr[4], qrn[4];
    if (g_lo + wid < g_hi) fetch(g_lo + wid, e, valid, own, near, qr);
#pragma unroll 1
    for (int g = g_lo + wid; g < g_hi; g += 8) {
        if (g + 8 < g_hi) fetch(g + 8, en, validn, ownn, nearn, qrn);
        const int t = (int)(e & 8191u); const unsigned slot = e >> 13;
        if (hi == 0) ent[r32] = e | (valid ? 0x10000u : 0u);
        St<2> st; st_init(st, bfar);
        u32x4 pw[4];
        const int ntl = own ? ((32 * (g - gN - gF) + 31) >> 6) + 1 : 4;
#pragma unroll 1
        for (int tt = 0; tt < ntl; ++tt) {
            f32x16 p0, p1;
            qk_tile(p0, p1, (lds_cptr)l3 + tt * 16384 + hi * 1024 + r32 * 16, qr, valid ? st.cval : -INFINITY);
            if (own ? (32 * (g - gN - gF) - (64 * tt + 63) < 128) : (near && tt >= 2)) fix_near4<false>(p0, p1, t, n * 256 + tt * 64, cs4, hi);
            softmax_p<2, 0, false>(st, p0, p1, pw, wsf, r32, hi, 0.f, true);
            pv_acc<2>(st, pw, (lds_cptr)l3 + tt * 16384 + 8192 + vlane);
        }
        const float lt = halfsum(st.l); float fr[16]; rowfac(fr, lt > 0.f ? 1.0f / lt : 0.f, wsf, r32, hi);
#pragma unroll
        for (int r = 0; r < 16; ++r) { st.o[0][r] *= fr[r]; st.o[1][r] *= fr[r]; }
        stage_o<2>(st.o, stg, r32, hi);
        if (hi == 0 && valid) PM[((rowbase + t) * 16 + h) * 4 + slot] = st.mhat + __log2f(lt);
#pragma unroll
        for (int i = 0; i < 4; ++i) { const int row = i * 8 + (lane >> 3), ch = lane & 7; const unsigned ee = ent[row];
            const u32x4 v = *(const LAS3 u32x4*)(stg + row * 64 + ch * 8);
            if (ee & 0x10000u) { const unsigned sl = (ee >> 13) & 3u; bf16* dst = (sl == 0 ? PO[0] : (sl == 1 ? PO[1] : (sl == 2 ? PO[2] : PO[3]))) + ((rowbase + (ee & 8191u)) * 16 + h) * 64 + ch * 8; *(u32x4*)dst = v; } }
        e = en; valid = validn; own = ownn; near = nearn;
#pragma unroll
        for (int d0 = 0; d0 < 4; ++d0) qr[d0] = qrn[d0];
    }
#if ATT_PROBE && ATT_PROBE_PHASE == 82
    { ATT_T(r2); if (b == 0 && blockIdx.x == ATT_PROBE_BLOCK && wid == ATT_PROBE_WAVE && lane == 0) { g_dbg[10] += r2; g_dbg[12] += (unsigned long long)((g_hi - g_lo - wid + 7) / 8); } }
#endif
}
__device__ __forceinline__ void moba_merge_phase(const PP& p, unsigned char* ws, int tid, int bid, int G) {
#if ATT_PROBE && ATT_PROBE_PHASE == 83
    if (bid == ATT_PROBE_BLOCK && tid == ATT_PROBE_WAVE * 64) { for (int i = 0; i < 16; ++i) g_dbg[i] = 0ull; }
    __syncthreads();
#endif
    ATT_T(mg0);
    const float* PMb = (const float*)(ws + WS_WIN0);
    const bf16* PO[4] = {(const bf16*)p.out, (const bf16*)p.out + (size_t)16 * 1024 * 1024, (const bf16*)(ws + WS_PO2), p.OC};
#pragma unroll 1
    for (int i = bid * NTHR + tid; i < M * 16 * 2; i += G * NTHR) {
        const int half = i & 1, h = (i >> 1) & 15, row = i >> 5; const int c = (row & (SEQ - 1)) >> 8; const int nsl = c < 3 ? c : 3;
        const f32x4 m4 = *(const f32x4*)(PMb + ((size_t)row * 16 + h) * 4);
        const float ms[4] = {nsl > 0 ? m4.x : -INFINITY, nsl > 1 ? m4.y : -INFINITY, nsl > 2 ? m4.z : -INFINITY, m4.w};
        const float mx = fmaxf(fmaxf(ms[0], ms[1]), fmaxf(ms[2], ms[3]));
        float w[4], wsum = 0.f;
#pragma unroll
        for (int s_ = 0; s_ < 4; ++s_) { w[s_] = exp2f(ms[s_] - mx); wsum += w[s_]; }
        const float inv = 1.0f / wsum;
        float acc[32];
#pragma unroll
        for (int j = 0; j < 32; ++j) acc[j] = 0.f;
#pragma unroll
        for (int s_ = 0; s_ < 4; ++s_) { if (s_ == 3 || s_ < nsl) { const bf16* src = PO[s_] + ((size_t)row * 16 + h) * 64 + half * 32; const float ww = w[s_] * inv;
#pragma unroll
            for (int j = 0; j < 32; j += 8) { const v4u u = *(const v4u*)(src + j);
                acc[j] += ww * bf2f(u.x & 0xffff); acc[j + 1] += ww * bf2f(u.x >> 16); acc[j + 2] += ww * bf2f(u.y & 0xffff); acc[j + 3] += ww * bf2f(u.y >> 16);
                acc[j + 4] += ww * bf2f(u.z & 0xffff); acc[j + 5] += ww * bf2f(u.z >> 16); acc[j + 6] += ww * bf2f(u.w & 0xffff); acc[j + 7] += ww * bf2f(u.w >> 16); } } }
        bf16* dst = p.OC + (size_t)row * DM + h * 64 + half * 32;
#pragma unroll
        for (int j = 0; j < 32; j += 8) { u32x4 o; o.x = pk2(acc[j], acc[j + 1]); o.y = pk2(acc[j + 2], acc[j + 3]); o.z = pk2(acc[j + 4], acc[j + 5]); o.w = pk2(acc[j + 6], acc[j + 7]); *(u32x4*)(dst + j) = o; }
    }
#if ATT_PROBE && ATT_PROBE_PHASE == 83
    { asm volatile("s_waitcnt vmcnt(0)" ::: "memory"); __syncthreads(); ATT_T(mg1); if (bid == ATT_PROBE_BLOCK && tid == ATT_PROBE_WAVE * 64) { g_dbg[8] += mg1 - mg0; g_dbg[11] += 1ull; } }
#endif
}
__device__ __forceinline__ void moba_r1_phase(const PP& p, unsigned char* ws, char* lds, int tid, int bid, int G) {
#if ATT_PROBE && ATT_PROBE_PHASE == 81
    if (bid == ATT_PROBE_BLOCK && tid == ATT_PROBE_WAVE * 64) { for (int i = 0; i < 16; ++i) g_dbg[i] = 0ull; }
    __syncthreads();
#endif
    ATT_T(g0);
    const int lane = tid & 63, r32 = lane & 31, hi = lane >> 5; const int wid = __builtin_amdgcn_readfirstlane(tid >> 6);
    LAS3 unsigned* lc = (LAS3 unsigned*)((LAS3 char*)lds + 65536);
#pragma unroll 1
    for (int u0 = bid; u0 < 1024; u0 += 4 * G) {
        unsigned mk[4];
#pragma unroll
        for (int j = 0; j < 4; ++j) { const int u = u0 + j * G; mk[j] = 0u;
            if (u < 1024) mk[j] = moba_gate_mask(p, (u >> 5) >> 4, (u >> 5) & 15, u & 31, tid); }
        ATT_T(gm1);
        ATT_BAR();
        if (tid < 256) lc[tid] = 0u;
        ATT_BAR();
        unsigned lp[4][3];
#pragma unroll
        for (int j = 0; j < 4; ++j) { const int c = (u0 + j * G) & 31; unsigned m = hi == 0 ? mk[j] : 0u;
#pragma unroll
            for (int s_ = 0; s_ < 3; ++s_) { lp[j][s_] = 0u; if (m) { const int n = __builtin_ctz(m); m &= m - 1u; const bool near = n == c - 1;
                lp[j][s_] = __hip_atomic_fetch_add(lc + j * 64 + (near ? 0 : 32) + n, 1u, __ATOMIC_RELAXED, __HIP_MEMORY_SCOPE_WORKGROUP); } } }
        ATT_BAR();
        if (tid < 256) { const int j = tid >> 6, sl = tid & 63; const int u = u0 + j * G; const int bh = u >> 5; const unsigned cn = lc[tid]; unsigned base = 0u;
            if (cn) base = __hip_atomic_fetch_add((unsigned*)(ws + WS_MLCNT) + (sl < 32 ? 0 : 1024) + bh * 32 + (sl & 31), cn, __ATOMIC_RELAXED, __HIP_MEMORY_SCOPE_AGENT);
            lc[tid] = base; }
        ATT_BAR();
#if ATT_PROBE && ATT_PROBE_PHASE == 81
        { ATT_T(gm2); if (bid == ATT_PROBE_BLOCK && tid == ATT_PROBE_WAVE * 64) { g_dbg[9] += gm1 - g0; g_dbg[10] += gm2 - gm1; } }
#endif
#pragma unroll
        for (int j = 0; j < 4; ++j) { const int u = u0 + j * G; const int c = u & 31, bh = u >> 5; const int tq = c * 256 + wid * 32 + r32; unsigned m = hi == 0 ? mk[j] : 0u;
#pragma unroll
            for (int s_ = 0; s_ < 3; ++s_) { if (m) { const int n = __builtin_ctz(m); m &= m - 1u; const bool near = n == c - 1;
                ml_list(ws, near, bh, n)[lc[j * 64 + (near ? 0 : 32) + n] + lp[j][s_]] = (unsigned short)((unsigned)tq | ((unsigned)s_ << 13)); } } }
    }
    ATT_BAR();
#if ATT_PROBE && ATT_PROBE_PHASE == 81
    { ATT_T(g1); if (bid == ATT_PROBE_BLOCK && tid == ATT_PROBE_WAVE * 64) { g_dbg[8] += g1 - g0; g_dbg[11] += 1ull; } }
#endif
}
__device__ __forceinline__ int moba_nparts(int n) { return n < 3 ? 3 : (n < 12 ? 2 : 1); }
__device__ __forceinline__ void moba_r2_phase(const PP& p, unsigned char* ws, char* lds, int tid, int bid, int G) {
#if ATT_PROBE && ATT_PROBE_PHASE == 82
    if (bid == ATT_PROBE_BLOCK && tid == ATT_PROBE_WAVE * 64) { for (int i = 0; i < 16; ++i) g_dbg[i] = 0ull; }
#endif
    copy_bias_lds(p, lds, tid);
    unsigned* qhead = (unsigned*)(ws + WS_MLCNT) + 2048;
    LAS3 int* itl = (LAS3 int*)((LAS3 char*)lds + L_MISC + 128);
#pragma unroll 1
    for (;;) {
        ATT_T(q0);
        ATT_BAR();
        if (tid == 0) itl[0] = (int)__hip_atomic_fetch_add(qhead, 1u, __ATOMIC_RELAXED, __HIP_MEMORY_SCOPE_AGENT);
        ATT_BAR();
        int it = itl[0]; const int b = it & 1; it >>= 1;
        ATT_T(q1);
#if ATT_PROBE && ATT_PROBE_PHASE == 82
        if (b == 0 && blockIdx.x == ATT_PROBE_BLOCK && tid == ATT_PROBE_WAVE * 64) { g_dbg[8] += q1 - q0; g_dbg[11] += 1ull; }
#endif
        if (it >= 16 * 47) break;
        int n = 0;
        for (;; ++n) { const int sz = 16 * moba_nparts(n); if (it < sz) break; it -= sz; }
        const int np = moba_nparts(n); const int h = it / np, part = it % np;
        moba_route_item(p, ws, lds, b, h, n, part, np, tid);
    }
    ATT_BAR();
}
}

#define LAS __attribute__((address_space(3)))
#define XB_TMO      128
#define XB_XCNT(j)  (256  + 64 * (j))
#define XB_XSUB(j)  (1280 + 64 * (j))
#define XB_XGEN(j)  (2304 + 64 * (j))
#define XB_TOP      3328
#define XB_TOPGEN   3392
#define XCD_BAR_WORDS 3456
#define XB_SPIN_CAP (1u << 18)

__device__ __forceinline__ unsigned xb_ld(unsigned* p)              { return __hip_atomic_load(p, __ATOMIC_RELAXED, __HIP_MEMORY_SCOPE_AGENT); }
__device__ __forceinline__ unsigned xb_add(unsigned* p, unsigned v) { return __hip_atomic_fetch_add(p, v, __ATOMIC_RELAXED, __HIP_MEMORY_SCOPE_AGENT); }
__device__ __forceinline__ unsigned xb_xcc_id() { return (unsigned)__builtin_amdgcn_s_getreg((3 << 11) | 20) & 0xFu; }
#define XB_SPIN(cond, bar) do { unsigned _sp = 0; while (cond) { __builtin_amdgcn_s_sleep(1); \
    if ((++_sp & 255u) == 0u) { if (xb_ld(&(bar)[XB_TMO])) break; if (_sp > XB_SPIN_CAP) { atomicAdd(&(bar)[XB_TMO], 1u); break; } } } } while (0)

struct XcdBarrier {
    unsigned* bar; unsigned x;
    volatile LAS unsigned* st;
};

__device__ __forceinline__ XcdBarrier xcd_barrier_post(unsigned* bar, volatile LAS unsigned* st) {
    XcdBarrier b; b.bar = bar; b.x = xb_xcc_id(); b.st = st;
    if (threadIdx.x == 0) (void)xb_add(&bar[XB_XCNT(b.x)], 1u);
    return b;
}
__device__ __forceinline__ void xcd_barrier_complete(unsigned* bar, unsigned x, unsigned& nloc, unsigned& nx) {
    const unsigned G = gridDim.x * gridDim.y * gridDim.z;
    unsigned sum, cnt, mine, sp = 0u;
    for (;;) {
        sum = 0u; cnt = 0u; mine = 0u;
#pragma unroll
        for (unsigned j = 0; j < 16; ++j) { const unsigned c = xb_ld(&bar[XB_XCNT(j)]); sum += c; cnt += (c > 0u) ? 1u : 0u; mine = (j == x) ? c : mine; }
        if (sum == G) break;
        __builtin_amdgcn_s_sleep(1);
        if ((++sp & 255u) == 0u) { if (xb_ld(&bar[XB_TMO])) break; if (sp > XB_SPIN_CAP) { atomicAdd(&bar[XB_TMO], 1u); break; } }
    }
    nloc = mine > 0u ? mine : 1u; nx = cnt > 0u ? cnt : 1u;
}

__device__ __forceinline__ void xcd_barrier(const XcdBarrier& b) {
    asm volatile("s_waitcnt vmcnt(0)" ::: "memory");
    __syncthreads();
    if (threadIdx.x == 0) {
        unsigned* bar = b.bar;
        __builtin_amdgcn_s_waitcnt(0);
        unsigned nloc = b.st[0], nx = b.st[1];
        if (nloc == 0u) { xcd_barrier_complete(bar, b.x, nloc, nx); b.st[0] = nloc; b.st[1] = nx; }
        const unsigned old = xb_add(&bar[XB_XSUB(b.x)], 1u);
        const unsigned gen = old / nloc;
        if (old + 1u == (gen + 1u) * nloc) {
            __builtin_amdgcn_fence(__ATOMIC_RELEASE, "agent");
            asm volatile("s_waitcnt vmcnt(0)" ::: "memory");
            const unsigned og = xb_add(&bar[XB_TOP], 1u);
            const unsigned tg = og / nx;
            if (og + 1u == (tg + 1u) * nx) xb_add(&bar[XB_TOPGEN], 1u);
            else XB_SPIN(xb_ld(&bar[XB_TOPGEN]) == tg, bar);
            __builtin_amdgcn_fence(__ATOMIC_ACQUIRE, "agent");
            xb_add(&bar[XB_XGEN(b.x)], 1u);
            asm volatile("s_waitcnt vmcnt(0)" ::: "memory");
        } else {
            XB_SPIN(xb_ld(&bar[XB_XGEN(b.x)]) == gen, bar);
            __builtin_amdgcn_fence(__ATOMIC_ACQUIRE, "agent");
            asm volatile("s_waitcnt vmcnt(0)" ::: "memory");
        }
    }
    __syncthreads();
}
namespace pg8 {
struct EpiFinalNorm {
    static constexpr bool PERM = true, AFTER_DRAIN = false;
    const bf16_t* xb; float* SS; const float* gain; float* out; unsigned* flags; unsigned* bar;
    __device__ __forceinline__ void operator()(const f32x4 (&acc)[2][2][4][2], const Unit& u, int wr, int wc, int fr, int fq) const {
        const int col0 = u.pn * BM + wc * 32 + 8 * fq;
        f32x4 o[2][4][2][2];
#pragma unroll
        for (int ai = 0; ai < 2; ++ai) {
#pragma unroll
            for (int m = 0; m < 4; ++m) { const size_t off = (size_t)(u.pm * BM + ai * HALF + wr * 64 + m * 16 + fr) * DM + col0;
#pragma unroll
                for (int bj = 0; bj < 2; ++bj) { const u32x4 w = *(const u32x4*)(xb + off + bj * HALF);
                    o[ai][m][bj][0] = (f32x4){__builtin_bit_cast(float, w.x << 16), __builtin_bit_cast(float, w.x & 0xffff0000u), __builtin_bit_cast(float, w.y << 16), __builtin_bit_cast(float, w.y & 0xffff0000u)};
                    o[ai][m][bj][1] = (f32x4){__builtin_bit_cast(float, w.z << 16), __builtin_bit_cast(float, w.z & 0xffff0000u), __builtin_bit_cast(float, w.w << 16), __builtin_bit_cast(float, w.w & 0xffff0000u)}; } }
#pragma unroll
            for (int m = 0; m < 4; ++m) { const int row = u.pm * BM + ai * HALF + wr * 64 + m * 16 + fr; float sq = 0.f;
#pragma unroll
                for (int bj = 0; bj < 2; ++bj)
#pragma unroll
                    for (int n = 0; n < 2; ++n) { const f32x4 v = o[ai][m][bj][n] + acc[ai][bj][m][n]; o[ai][m][bj][n] = v;
                        sq += (v[0] * v[0] + v[1] * v[1]) + (v[2] * v[2] + v[3] * v[3]); }
                sq = pg8_sum_fq(sq);
                if (fq == 0) SS[(size_t)row * 16 + u.pn * 4 + wc] = sq; }
        }
        asm volatile("s_waitcnt vmcnt(0)" ::: "memory");
        __syncthreads();
        if (threadIdx.x == 0) {
            unsigned* f = flags + u.pm * 16;
            __builtin_amdgcn_fence(__ATOMIC_RELEASE, "agent");
            asm volatile("s_waitcnt vmcnt(0)" ::: "memory");
            (void)xb_add(f, 1u);
            XB_SPIN(xb_ld(f) < 4u, bar);
            __builtin_amdgcn_fence(__ATOMIC_ACQUIRE, "agent");
            asm volatile("s_waitcnt vmcnt(0)" ::: "memory");
        }
        __syncthreads();
        f32x4 gg[2][2];
#pragma unroll
        for (int bj = 0; bj < 2; ++bj)
#pragma unroll
            for (int n = 0; n < 2; ++n) gg[bj][n] = *(const f32x4*)(gain + col0 + bj * HALF + n * 4);
#pragma unroll
        for (int ai = 0; ai < 2; ++ai)
#pragma unroll
            for (int m = 0; m < 4; ++m) { const int row = u.pm * BM + ai * HALF + wr * 64 + m * 16 + fr; const float rs = rstd_of(SS, row);
#pragma unroll
                for (int bj = 0; bj < 2; ++bj)
#pragma unroll
                    for (int n = 0; n < 2; ++n) *(f32x4*)(out + (size_t)row * DM + col0 + bj * HALF + n * 4) = o[ai][m][bj][n] * rs * gg[bj][n]; }
    }
};
}
constexpr size_t WS_RBFLAG = WS_CTL + 49152;
__device__ __forceinline__ void gemm_final(char* lds, const bf16* A, const bf16* Bt, int K, const bf16* xb, float* SS, const float* gain, float* out, unsigned* flags, unsigned* bar, int bid, int G) {
    pg8::Gemm g{A, Bt, M, DM, K}; pg8::StaticOrder S; S.init(M, DM, G, bid);
    pg8::EpiFinalNorm E{xb, SS, gain, out, flags, bar};
    pg8::gemm_phase<pg8::EpiFinalNorm, pg8::StaticOrder, GEMM_ALIGN, GEMM_SP2>((PG8_LAS unsigned char*)lds, g, S, E);
}
template <int MODE> __device__ __forceinline__ void gemm_rowscale(char* lds, const bf16* A, const bf16* Bt, int N, int ldc, int K, bf16* O, const float* SS, float* KMP, float* GATES, int kt_lo, int kt_hi, int gate_tile, int tid, int bid, int G) {
#if USE_PG8
    pg8::Gemm g{A, Bt, M, N, K}; pg8::StaticOrder S; S.init(M, N, G, bid);
    const PG8_LAS float* rsl = nullptr; int rs_pm = -1;
    if (G == 256) { PG8_LAS float* w = (PG8_LAS float*)((PG8_LAS unsigned char*)lds + 131072); rs_pm = 8 * (bid & 7) + ((bid >> 3) & 7);
        if (tid < 256) w[tid] = rstd_of(SS, rs_pm * 256 + tid);
        __syncthreads(); rsl = w; }
    pg8::EpiRowScaleBf16<MODE> E{O, SS, KMP, GATES, ldc, kt_lo, kt_hi, gate_tile, rsl, rs_pm};
    pg8::gemm_phase<pg8::EpiRowScaleBf16<MODE>, pg8::StaticOrder, GEMM_ALIGN, GEMM_SP2>((PG8_LAS unsigned char*)lds, g, S, E);
#else
    if (MODE == 0) ngemm_phase(lds, A, Bt, N, K, NEpiProj{O, SS, N}, tid, bid, G); else ngemm_phase(lds, A, Bt, N, K, NEpiMlp1{O, SS}, tid, bid, G);
#endif
}
template <bool INBF> __device__ __forceinline__ void gemm_residual(char* lds, const bf16* A, const bf16* Bt, int K, const float* xin32, bf16* xb, float* SS, int tid, int bid, int G) {
    pg8::Gemm g{A, Bt, M, DM, K}; pg8::StaticOrder S; S.init(M, DM, G, bid);
    pg8::EpiResidual<INBF> E{xin32, xb, SS};
    pg8::gemm_phase<pg8::EpiResidual<INBF>, pg8::StaticOrder, GEMM_ALIGN, GEMM_SP2>((PG8_LAS unsigned char*)lds, g, S, E);
}

constexpr int NPHASE = 13;
__global__ void __launch_bounds__(NTHR, 2) mk_fwd(Args args) {
    extern __shared__ __attribute__((aligned(16))) char lds[];
    cg::grid_group grid = cg::this_grid();
    const int tid = threadIdx.x, bid = blockIdx.x, G = gridDim.x;
    unsigned char* ws = args.ws;
    PP p;
    p.x = args.in[0]; p.bias_table = args.in[1]; p.norm_mix = args.in[2]; p.norm_mlp = args.in[3]; p.norm_final = args.in[4]; p.mlp_w1 = args.in[5]; p.mlp_w2 = args.in[6];
    p.ev_w_in = args.in[7]; p.ev_w_out = args.in[8]; p.pos_k = args.in[9]; p.w1_k = args.in[10]; p.w2_k = args.in[11]; p.pos_v = args.in[12]; p.w1_v = args.in[13]; p.w2_v = args.in[14];
    p.lq1 = args.in[15]; p.lk1 = args.in[16]; p.lq2 = args.in[17]; p.lk2 = args.in[18]; p.subln = args.in[19]; p.od_w_in = args.in[20]; p.od_w_out = args.in[21];
    p.out = args.out;
    p.SSA = (float*)(ws + WS_SSA); p.SSB = (float*)(ws + WS_SSB); p.GATES = (float*)(ws + WS_GATES); p.CMPB = (float*)(ws + WS_CMPB); p.BIASL = (float*)(ws + WS_BIASL);
    p.KMEAN = (float*)(ws + WS_KMEAN); p.KMP = (float*)(ws + WS_KMP);
    p.KCMP = (bf16*)(ws + WS_KCMP); p.VCMP = (bf16*)(ws + WS_VCMP);
    p.WIN0 = (bf16*)(ws + WS_WIN0); p.WOUT0 = (bf16*)(ws + WS_WOUT0); p.W1_0 = (bf16*)(ws + WS_W1_0); p.W2_0 = (bf16*)(ws + WS_W2_0);
    p.WIN1 = (bf16*)(ws + WS_WIN1); p.WOUT1 = (bf16*)(ws + WS_WOUT1); p.W1_1 = (bf16*)(ws + WS_W1_1); p.W2_1 = (bf16*)(ws + WS_W2_1);
    p.CW1K = (bf16*)(ws + WS_CW1K); p.CW1V = (bf16*)(ws + WS_CW1V); p.CW2K = (bf16*)(ws + WS_CW2K); p.CW2V = (bf16*)(ws + WS_CW2V);
    p.XB = (bf16*)(ws + WS_XB); p.OC = (bf16*)(ws + WS_OC); p.H = (bf16*)(ws + WS_H); p.PROJ = (bf16*)(ws + WS_PROJ);
    volatile LAS unsigned* xst = (volatile LAS unsigned*)((LAS char*)lds + att::L_MISC);
    if (tid == 0) { xst[0] = 0u; xst[1] = 0u; }
    __syncthreads();
    const bool self_zero = args.ph_lo == 0 && args.ph_hi > 1;
    XcdBarrier xbar; xbar.bar = (unsigned*)(ws + WS_CTL); xbar.x = 0u; xbar.st = xst;
    if (!self_zero) xbar = xcd_barrier_post((unsigned*)(ws + WS_CTL), xst);
    else if (bid == 0) { for (int i = tid; i < 16384; i += NTHR) ((unsigned*)(ws + WS_CTL))[i] = 0u; }
    const int lo = args.ph_lo, hi = args.ph_hi;
#define IN(k) (lo <= (k) && (k) < hi)
#define SEAM(k) do { if (IN(k) && IN((k) + 1)) { if ((k) == 0) grid.sync(); else xcd_barrier(xbar); } } while (0)

    if (IN(0)) { p0_prologue(p, lds, tid, bid, G);
#if PROBE_DOUBLE == 100
        __syncthreads(); p0_prologue(p, lds, tid, bid, G);
#endif
    }
    SEAM(0);
    if (self_zero) xbar = xcd_barrier_post((unsigned*)(ws + WS_CTL), xst);
    if (IN(1)) { gemm_rowscale<0>(lds, p.XB, p.WIN0, NP0G, NP0, DM, p.PROJ, p.SSA, nullptr, p.GATES, 0, 0, NP0 / 256, tid, bid, G);
#if PROBE_DOUBLE == 101
        xcd_barrier(xbar); gemm_rowscale<0>(lds, p.XB, p.WIN0, NP0G, NP0, DM, p.PROJ, p.SSA, nullptr, p.GATES, 0, 0, NP0 / 256, tid, bid, G);
#endif
    }
    SEAM(1);
    if (IN(2)) {
#if USE_MFMA_CMP
        att::compress_phase(p, lds, tid, bid, G);
#if PROBE_DOUBLE == 1
        __syncthreads(); att::compress_phase(p, lds, tid, bid, G);
#endif
#else
        ncompress_phase(p, lds, tid, bid, G);
#endif
#if USE_MFMA_DIFF
        att::diff_phase(p, lds, tid, bid, G);
#if PROBE_DOUBLE == 2
        xcd_barrier(xbar); att::diff_phase(p, lds, tid, bid, G);
#endif
#else
        ndiff_phase(p, lds, tid, bid, G);
#endif
    }
    SEAM(2);
    if (IN(3)) {
#if USE_MFMA_NSA
        att::nsa_phase(p, lds, tid, bid, G);
#if PROBE_DOUBLE == 3
        xcd_barrier(xbar); att::nsa_phase(p, lds, tid, bid, G);
#endif
#else
        nnsa_phase(p, lds, tid, bid, G);
#endif
    }
    SEAM(3);
    if (IN(4)) { gemm_residual<true>(lds, p.OC, p.WOUT0, DM, nullptr, p.XB, p.SSB, tid, bid, G);
#if PROBE_DOUBLE == 4
        xcd_barrier(xbar); gemm_residual<true>(lds, p.OC, p.WOUT0, DM, nullptr, p.XB, p.SSB, tid, bid, G);
#endif
    }
    SEAM(4);
#if PROBE_DOUBLE == 900
    xcd_barrier(xbar); xcd_barrier(xbar); xcd_barrier(xbar); xcd_barrier(xbar); xcd_barrier(xbar); xcd_barrier(xbar); xcd_barrier(xbar); xcd_barrier(xbar);
#endif
    if (IN(5)) { gemm_rowscale<1>(lds, p.XB, p.W1_0, FF, FF, DM, p.H, p.SSB, nullptr, nullptr, 0, 0, -1, tid, bid, G);
#if PROBE_DOUBLE == 5
        xcd_barrier(xbar); gemm_rowscale<1>(lds, p.XB, p.W1_0, FF, FF, DM, p.H, p.SSB, nullptr, nullptr, 0, 0, -1, tid, bid, G);
#endif
    }
    SEAM(5);
    if (IN(6)) { gemm_residual<true>(lds, p.H, p.W2_0, FF, nullptr, p.XB, p.SSA, tid, bid, G); }
    SEAM(6);
    if (IN(7)) {
#if USE_PG8
        gemm_rowscale<0>(lds, p.XB, p.WIN1, NP1, NP1, DM, p.PROJ, p.SSA, p.KMP, nullptr, 4, 8, -1, tid, bid, G);
#else
        gemm_rowscale<0>(lds, p.XB, p.WIN1, NP1, NP1, DM, p.PROJ, p.SSA, nullptr, nullptr, 0, 0, -1, tid, bid, G);
        grid.sync();
        nkmean_phase(p, tid, bid, G);
#endif
    }
    SEAM(7);
    if (IN(8)) {
#if USE_PG8
#endif
#if USE_MFMA_MOBA && USE_MOBA_ROUTED
        att::moba_r1_phase(p, ws, lds, tid, bid, G); xcd_barrier(xbar);
        att::moba_r2_phase(p, ws, lds, tid, bid, G); xcd_barrier(xbar);
        att::moba_merge_phase(p, ws, tid, bid, G);
#elif USE_MFMA_MOBA
        att::moba_phase(p, lds, tid, bid, G);
#if PROBE_DOUBLE == 8
        xcd_barrier(xbar); att::moba_phase(p, lds, tid, bid, G);
#endif
#else
        nmoba_phase(p, tid, bid, G);
#endif
    }
    SEAM(8);
    if (IN(9)) { gemm_residual<true>(lds, p.OC, p.WOUT1, DM, nullptr, p.XB, p.SSB, tid, bid, G); }
    SEAM(9);
    if (IN(10)) { gemm_rowscale<1>(lds, p.XB, p.W1_1, FF, FF, DM, p.H, p.SSB, nullptr, nullptr, 0, 0, -1, tid, bid, G); }
    SEAM(10);
    const bool fuse_fn = !ATT_PROBE && G == 256 && IN(11) && IN(12);
    if (IN(11)) { if (fuse_fn) gemm_final(lds, p.H, p.W2_1, FF, p.XB, p.SSA, p.norm_final, p.out, (unsigned*)(ws + WS_RBFLAG), (unsigned*)(ws + WS_CTL), bid, G);
        else gemm_residual<true>(lds, p.H, p.W2_1, FF, nullptr, p.XB, p.SSA, tid, bid, G); }
    if (!fuse_fn) SEAM(11);
    if (IN(12) && !fuse_fn) { final_norm_phase(p, tid, bid, G);
#if ATT_PROBE
        __syncthreads();
        if (bid == 0 && tid == 0) { const unsigned long long den = ATT_PROBE_SEL >= 8 ? att::g_dbg[11] * 100ull : att::g_dbg[4]; const float v = (float)((double)att::g_dbg[ATT_PROBE_SEL] / (double)(den ? den : 1ull)) * 0.01f; p.out[0] += v; }
#endif
    }
#undef IN
#undef SEAM
}

extern "C" void kernel_launch(void* const* d_in, const int* in_sizes, int n_in, void* d_out, int out_size, void* d_ws, size_t ws_size, hipStream_t stream) {
    static int grid = 0;
    if (grid == 0) {
        if (n_in != 22 || out_size != M * DM || ws_size < WS_END) { fprintf(stderr, "kernel_launch: unexpected shapes (n_in %d out %d ws %zu)\n", n_in, out_size, ws_size); grid = -1; return; }
        int dev = 0, cus = 0, per_cu = 0;
        if (hipGetDevice(&dev) != hipSuccess || hipDeviceGetAttribute(&cus, hipDeviceAttributeMultiprocessorCount, dev) != hipSuccess) { grid = -1; return; }
        if (hipFuncSetAttribute((const void*)mk_fwd, hipFuncAttributeMaxDynamicSharedMemorySize, LDS_BYTES) != hipSuccess) { fprintf(stderr, "kernel_launch: hipFuncSetAttribute failed\n"); grid = -1; return; }
        if (hipOccupancyMaxActiveBlocksPerMultiprocessor(&per_cu, (const void*)mk_fwd, NTHR, LDS_BYTES) != hipSuccess || per_cu < 1) { fprintf(stderr, "kernel_launch: occupancy query says %d blocks per CU\n", per_cu); (void)hipGetLastError(); grid = -1; return; }
        grid = cus * 1;
    }
    if (grid < 0) return;
    Args a{};
    for (int i = 0; i < 22; ++i) a.in[i] = (const float*)d_in[i];
    a.out = (float*)d_out; a.ws = (unsigned char*)d_ws; a.ph_lo = 0; a.ph_hi = NPHASE;
    void* kargs[] = {&a};
    hipError_t e = hipLaunchCooperativeKernel((const void*)mk_fwd, dim3(grid), dim3(NTHR), kargs, LDS_BYTES, stream);
    if (e != hipSuccess) fprintf(stderr, "kernel_launch: cooperative launch failed: %s (grid %d)\n", hipGetErrorString(e), grid);
}
```
